# Optimizing an MI355X kernel written in HIP

```python
import math
import jax, jax.numpy as jnp
from jax import lax
import numpy as np

D_MODEL = 2048
BATCH = 2
SEQ = 8192
DEPTH = 2

HEAD_DIM = 128
MIX_WIDTH = D_MODEL
A_HEADS = D_MODEL // 256
A_QK_DIM = 64
A_V_DIM = 128
B_HEADS = D_MODEL // 256
MOBA_BLOCK = 256
MOBA_TOPK = 3
MOBA_Q_CHUNK = 64
C_HEADS = D_MODEL // HEAD_DIM
Q_BLOCK = 128
N_EXPERTS = 16
N_GROUPS = 4
EXPERTS_PER_GROUP = N_EXPERTS // N_GROUPS
TOP_K = 2
D_FF_EXPERT = 512

EPS = 1e-6
NEG_INF = -1e30
N_EVEN = (DEPTH + 1) // 2
N_ODD = DEPTH // 2
EVEN_SPLITS = [A_HEADS * 2 * A_QK_DIM, A_HEADS * 2 * A_QK_DIM, A_HEADS * A_V_DIM,
               B_HEADS * HEAD_DIM, B_HEADS * HEAD_DIM, B_HEADS * HEAD_DIM]
EVEN_IN = sum(EVEN_SPLITS)
ODD_SPLITS = [C_HEADS * HEAD_DIM, C_HEADS * HEAD_DIM, C_HEADS * HEAD_DIM, C_HEADS]
ODD_IN = sum(ODD_SPLITS)

kernel_name = 'hybrid_diff_moba_fox_grouped_moe_adaln'


def alibi_slopes(n):
    return jnp.asarray(2.0 ** (-8.0 * np.arange(1, n + 1) / n), dtype=jnp.float32)


def rms_norm(x, g):
    xf = x.astype(jnp.float32)
    y = xf * lax.rsqrt(jnp.mean(xf * xf, axis=-1, keepdims=True) + EPS)
    return y.astype(x.dtype) * g


def modulate(x, g, shift, scale):
    return rms_norm(x, g) * (1.0 + scale[:, None, :]) + shift[:, None, :]


def unblock(out):
    n, b, h, qb, d = out.shape
    return out.transpose(1, 0, 3, 2, 4).reshape(b, n * qb, h, d)


def split_at(t, sizes):
    return jnp.split(t, list(np.cumsum(sizes)[:-1]), axis=-1)


def diff_attention(q, k, v, lam, slopes):
    S = q.shape[2]
    scale = A_QK_DIM ** -0.5
    kpos = jnp.arange(S)

    def block(i):
        q_i = lax.dynamic_slice_in_dim(q, i * Q_BLOCK, Q_BLOCK, axis=2)
        logits = jnp.einsum('bhqmd,bhkmd->bhmqk', q_i, k).astype(jnp.float32) * scale
        dist = (i * Q_BLOCK + jnp.arange(Q_BLOCK))[:, None] - kpos[None, :]
        bias = -slopes[:, None, None] * dist.astype(jnp.float32)
        logits = jnp.where(dist >= 0, logits + bias[None, :, None], NEG_INF)
        p = jax.nn.softmax(logits, axis=-1)
        attn = p[:, :, 0] - lam * p[:, :, 1]
        return jnp.einsum('bhqk,bhkd->bhqd', attn.astype(v.dtype), v)

    return unblock(lax.map(block, jnp.arange(S // Q_BLOCK)))


def moba_attention(q, k, v, slopes):
    B, H, S, d = q.shape
    scale = d ** -0.5
    s_pad = -(-S // MOBA_BLOCK) * MOBA_BLOCK
    pad = ((0, 0), (0, 0), (0, s_pad - S), (0, 0))
    k_pad = jnp.pad(k, pad)
    v_pad = jnp.pad(v, pad)
    nb = s_pad // MOBA_BLOCK
    topk = min(MOBA_TOPK, nb)
    k_blk = k_pad.reshape(B, H, nb, MOBA_BLOCK, d)
    v_blk = v_pad.reshape(B, H, nb, MOBA_BLOCK, d)
    k_mean = k_blk.astype(jnp.float32).mean(axis=3).astype(k.dtype)
    bi = jnp.arange(B)[:, None, None, None]
    hi = jnp.arange(H)[None, :, None, None]
    blk_pos = jnp.arange(MOBA_BLOCK)

    def chunk(ci):
        start = ci * MOBA_Q_CHUNK
        own = start // MOBA_BLOCK
        qpos = start + jnp.arange(MOBA_Q_CHUNK)
        q_c = lax.dynamic_slice_in_dim(q, start, MOBA_Q_CHUNK, axis=2)
        gate = jnp.einsum('bhqd,bhnd->bhqn', q_c, k_mean).astype(jnp.float32)
        gate = jnp.where(jnp.arange(nb) < own, gate, NEG_INF)
        _, idx = lax.top_k(gate, topk)
        valid = idx < own
        k_sel = k_blk[bi, hi, idx]
        v_sel = v_blk[bi, hi, idx]
        s_sel = jnp.einsum('bhqd,bhqjpd->bhqjp', q_c, k_sel).astype(jnp.float32) * scale
        dist_sel = (qpos[None, None, :, None, None] - (idx[..., None] * MOBA_BLOCK + blk_pos)).astype(jnp.float32)
        s_sel = jnp.where(valid[..., None], s_sel - slopes[None, :, None, None, None] * dist_sel, NEG_INF)
        k_own = lax.dynamic_slice_in_dim(k_pad, own * MOBA_BLOCK, MOBA_BLOCK, axis=2)
        v_own = lax.dynamic_slice_in_dim(v_pad, own * MOBA_BLOCK, MOBA_BLOCK, axis=2)
        s_own = jnp.einsum('bhqd,bhpd->bhqp', q_c, k_own).astype(jnp.float32) * scale
        dist_own = qpos[:, None] - (own * MOBA_BLOCK + blk_pos)[None, :]
        s_own = jnp.where(dist_own >= 0, s_own - slopes[None, :, None, None] * dist_own.astype(jnp.float32), NEG_INF)
        logits = jnp.concatenate([s_sel.reshape(B, H, MOBA_Q_CHUNK, topk * MOBA_BLOCK), s_own], axis=-1)
        p = jax.nn.softmax(logits, axis=-1).astype(v.dtype)
        p_sel = p[..., :topk * MOBA_BLOCK].reshape(B, H, MOBA_Q_CHUNK, topk, MOBA_BLOCK)
        p_own = p[..., topk * MOBA_BLOCK:]
        return (jnp.einsum('bhqjp,bhqjpd->bhqd', p_sel, v_sel)
                + jnp.einsum('bhqp,bhpd->bhqd', p_own, v_own))

    return unblock(lax.map(chunk, jnp.arange(S // MOBA_Q_CHUNK)))


def forgetting_attention(q, k, v, log_f):
    S = q.shape[2]
    scale = HEAD_DIM ** -0.5
    cum = jnp.cumsum(log_f, axis=-1)
    kpos = jnp.arange(S)

    def block(i):
        q_i = lax.dynamic_slice_in_dim(q, i * Q_BLOCK, Q_BLOCK, axis=2)
        cum_i = lax.dynamic_slice_in_dim(cum, i * Q_BLOCK, Q_BLOCK, axis=2)
        logits = (jnp.einsum('bhqd,bhkd->bhqk', q_i, k).astype(jnp.float32) * scale
                  + cum_i[..., :, None] - cum[..., None, :])
        causal = (i * Q_BLOCK + jnp.arange(Q_BLOCK))[:, None] >= kpos[None, :]
        p = jax.nn.softmax(jnp.where(causal, logits, NEG_INF), axis=-1)
        return jnp.einsum('bhqk,bhkd->bhqd', p.astype(v.dtype), v)

    return unblock(lax.map(block, jnp.arange(S // Q_BLOCK)))


def even_mixer(h, w_in, w_out, lam_q1, lam_k1, lam_q2, lam_k2, subln_g, layer_idx):
    B, S, _ = h.shape
    a_q, a_k, a_v, b_q, b_k, b_v = split_at(h @ w_in, EVEN_SPLITS)
    a_q = a_q.reshape(B, S, A_HEADS, 2, A_QK_DIM).transpose(0, 2, 1, 3, 4)
    a_k = a_k.reshape(B, S, A_HEADS, 2, A_QK_DIM).transpose(0, 2, 1, 3, 4)
    a_v = a_v.reshape(B, S, A_HEADS, A_V_DIM).transpose(0, 2, 1, 3)
    heads = lambda t: t.reshape(B, S, B_HEADS, HEAD_DIM).transpose(0, 2, 1, 3)
    b_q, b_k, b_v = heads(b_q), heads(b_k), heads(b_v)
    slopes = alibi_slopes(A_HEADS + B_HEADS)
    lam_init = 0.8 - 0.6 * math.exp(-0.3 * layer_idx)
    f32 = jnp.float32
    lam = (jnp.exp(jnp.sum(lam_q1.astype(f32) * lam_k1.astype(f32)))
           - jnp.exp(jnp.sum(lam_q2.astype(f32) * lam_k2.astype(f32))) + lam_init)
    a_out = diff_attention(a_q, a_k, a_v, lam, slopes[0::2])
    a_out = rms_norm(a_out, subln_g) * (1.0 - lam_init)
    b_out = moba_attention(b_q, b_k, b_v, slopes[1::2])
    merged = jnp.concatenate([a_out.reshape(B, S, -1), b_out.reshape(B, S, -1)], axis=-1)
    return merged @ w_out


def odd_mixer(h, w_in, b_forget, w_out):
    B, S, _ = h.shape
    q, k, v, f_logit = split_at(h @ w_in, ODD_SPLITS)
    heads = lambda t: t.reshape(B, S, C_HEADS, HEAD_DIM).transpose(0, 2, 1, 3)
    log_f = jax.nn.log_sigmoid(f_logit.astype(jnp.float32) + b_forget.astype(jnp.float32)).transpose(0, 2, 1)
    out = forgetting_attention(heads(q), heads(k), heads(v), log_f)
    return out.reshape(B, S, -1) @ w_out


def moe_ffn(h, router_w, router_b, w1, w3, w2):
    B, S, D = h.shape
    t = h.reshape(-1, D)
    affinity = jax.nn.sigmoid((t @ router_w).astype(jnp.float32))
    sel = affinity + router_b.astype(jnp.float32)
    grp_score = lax.top_k(sel.reshape(-1, N_GROUPS, EXPERTS_PER_GROUP), TOP_K)[0].sum(-1)
    best = jnp.argmax(grp_score, axis=-1)
    in_grp = (jnp.arange(N_EXPERTS) // EXPERTS_PER_GROUP)[None, :] == best[:, None]
    _, idx = lax.top_k(jnp.where(in_grp, sel, NEG_INF), TOP_K)
    w = jnp.take_along_axis(affinity, idx, axis=-1)
    w = w / jnp.sum(w, axis=-1, keepdims=True)
    gates = jnp.sum(jax.nn.one_hot(idx, N_EXPERTS, dtype=jnp.float32) * w[..., None], axis=1)
    act = (jax.nn.silu(jnp.einsum('nd,edf->nef', t, w1)) * jnp.einsum('nd,edf->nef', t, w3)
           * gates[..., None].astype(t.dtype))
    return jnp.einsum('nef,efd->nd', act, w2).reshape(B, S, D)


def setup_inputs(seed: int = 0) -> dict:
    key = jax.random.key(seed)
    ks = jax.random.split(key, 24)
    D = D_MODEL

    def nrm(k, shape, scale):
        return jax.random.normal(k, shape, jnp.float32) * scale

    return {
        'x': nrm(ks[0], (BATCH, SEQ, D), 1.0),
        'c': nrm(ks[1], (BATCH, D), 1.0),
        'ada_w': nrm(ks[2], (DEPTH, D, 6 * D), 0.5 * D ** -0.5),
        'ada_b': nrm(ks[3], (DEPTH, 6 * D), 0.02),
        'attn_norm_g': 1.0 + nrm(ks[4], (DEPTH, D), 0.05),
        'ffn_norm_g': 1.0 + nrm(ks[5], (DEPTH, D), 0.05),
        'w_in_even': nrm(ks[6], (N_EVEN, D, EVEN_IN), D ** -0.5),
        'w_out_even': nrm(ks[7], (N_EVEN, MIX_WIDTH, D), MIX_WIDTH ** -0.5),
        'lam_q1': nrm(ks[8], (N_EVEN, A_QK_DIM), 0.1),
        'lam_k1': nrm(ks[9], (N_EVEN, A_QK_DIM), 0.1),
        'lam_q2': nrm(ks[10], (N_EVEN, A_QK_DIM), 0.1),
        'lam_k2': nrm(ks[11], (N_EVEN, A_QK_DIM), 0.1),
        'subln_g': 1.0 + nrm(ks[12], (N_EVEN, A_V_DIM), 0.05),
        'w_in_odd': nrm(ks[13], (N_ODD, D, ODD_IN), D ** -0.5),
        'b_forget': jax.random.uniform(ks[14], (N_ODD, C_HEADS), jnp.float32, 1.0, 4.0),
        'w_out_odd': nrm(ks[15], (N_ODD, MIX_WIDTH, D), MIX_WIDTH ** -0.5),
        'router_w': nrm(ks[16], (D, N_EXPERTS), D ** -0.5),
        'router_b': nrm(ks[17], (N_EXPERTS,), 0.01),
        'moe_w1': nrm(ks[18], (DEPTH, N_EXPERTS, D, D_FF_EXPERT), D ** -0.5),
        'moe_w3': nrm(ks[19], (DEPTH, N_EXPERTS, D, D_FF_EXPERT), D ** -0.5),
        'moe_w2': nrm(ks[20], (DEPTH, N_EXPERTS, D_FF_EXPERT, D), D_FF_EXPERT ** -0.5),
        'final_norm_g': 1.0 + nrm(ks[21], (D,), 0.05),
    }


def reference(x, c, ada_w, ada_b, attn_norm_g, ffn_norm_g, w_in_even, w_out_even,
              lam_q1, lam_k1, lam_q2, lam_k2, subln_g, w_in_odd, b_forget, w_out_odd,
              router_w, router_b, moe_w1, moe_w3, moe_w2, final_norm_g):
    cond = jax.nn.silu(c)
    for l in range(DEPTH):
        mod = cond @ ada_w[l] + ada_b[l]
        sh1, sc1, g1, sh2, sc2, g2 = jnp.split(mod, 6, axis=-1)
        h = modulate(x, attn_norm_g[l], sh1, sc1)
        j = l // 2
        if l % 2 == 0:
            y = even_mixer(h, w_in_even[j], w_out_even[j], lam_q1[j], lam_k1[j],
                           lam_q2[j], lam_k2[j], subln_g[j], l)
        else:
            y = odd_mixer(h, w_in_odd[j], b_forget[j], w_out_odd[j])
        x = x + g1[:, None, :] * y
        h = modulate(x, ffn_norm_g[l], sh2, sc2)
        x = x + g2[:, None, :] * moe_ffn(h, router_w, router_b, moe_w1[l], moe_w3[l], moe_w2[l])
    return rms_norm(x, final_norm_g)
```

```cpp
#include <hip/hip_runtime.h>
#include <cstdio>
#include <cstdint>
namespace pg8 {
#define PG8_LAS __attribute__((address_space(3)))
typedef unsigned short bf16_t;
typedef short bf16x8 __attribute__((ext_vector_type(8)));
typedef float f32x4 __attribute__((ext_vector_type(4)));
typedef unsigned u32x4 __attribute__((ext_vector_type(4)));
constexpr int BM = 256, BK = 64, HALF = 128, HTB = HALF * BK * 2  , STAGE_BYTES = 8 * HTB, NXCD = 8, WGM = 8;

__host__ __device__ __forceinline__ int lds_byte(int r, int c) { const int st = (r >> 4) * 2 + (c >> 5), rr = r & 15, cc = c & 31, ob = rr * 64 + cc * 2; return st * 1024 + (ob ^ (((ob >> 9) & 1) << 5)); }
__host__ __device__ __forceinline__ void stage_rc(int b, int& R, int& C) { const int st = b / 1024, sb = b % 1024, swz = sb ^ (((sb >> 9) & 1) << 5); R = (st >> 1) * 16 + swz / 64; C = (st & 1) * 32 + (swz % 64) / 2; }
__host__ __device__ __forceinline__ int perm32(int rho) { const int n = rho >> 4, i = rho & 15; return 8 * (i >> 2) + 4 * n + (i & 3); }

struct Unit { int pm, pn; };
struct Gemm { const bf16_t* A; const bf16_t* Bt; int M, N, K; };

struct StaticOrder {
    int nM, nN, nwg, G, c;
    __host__ __device__ void init(int M, int N, int G_, int c_) { nM = M / BM; nN = N / BM; nwg = nM * nN; G = G_; c = c_; }
    __host__ __device__ bool next(int i, Unit& u) const {
        const long L = (long)i * G + c; if (L >= nwg) return false;
        int wgid = (int)L; { const int q = nwg / NXCD, r = nwg % NXCD, xcd = wgid % NXCD, off = wgid / NXCD; wgid = (xcd < r ? xcd * (q + 1) : r * (q + 1) + (xcd - r) * q) + off; }
        const int nig = WGM * nN, gid = wgid / nig, fm = gid * WGM, gsz = (nM - fm) < WGM ? (nM - fm) : WGM;
        u.pm = fm + ((wgid % nig) % gsz); u.pn = (wgid % nig) / gsz; return true;
    }
    __device__ __forceinline__ void a_ready(const Unit&) const {}
    __device__ __forceinline__ void done(const Unit&) const {}
};

__device__ __forceinline__ unsigned cvt_pk_bf16(float lo, float hi) { unsigned r; asm volatile("v_cvt_pk_bf16_f32 %0, %1, %2" : "=v"(r) : "v"(lo), "v"(hi)); return r; }
typedef float f32x2 __attribute__((ext_vector_type(2)));
__device__ __forceinline__ f32x2 gelu_pk(f32x2 v) {
    const f32x2 av = __builtin_elementwise_abs(v), d = av * 0.2316418882f + 1.0f;
    f32x2 t; t.x = __builtin_amdgcn_rcpf(d.x); t.y = __builtin_amdgcn_rcpf(d.y);
    f32x2 q = t * 0.5307027145f + (-0.7265760135f); q = q * t + 0.7107068705f; q = q * t + (-0.142248368f); q = q * t + 0.127414796f; q = q * t;
    const f32x2 s = (v * v) * (-0.72134752044f);
    f32x2 e; e.x = __builtin_amdgcn_exp2f(s.x); e.y = __builtin_amdgcn_exp2f(s.y);
    const f32x2 m = v * (q * e), r = v - m;
    f32x2 o; o.x = v.x < 0.f ? m.x : r.x; o.y = v.y < 0.f ? m.y : r.y; return o;
}

template <int ACT  > struct EpiBf16 {
    static constexpr bool PERM = true, AFTER_DRAIN = false; static_assert(ACT == 0 || ACT == 1, "EpiBf16: ACT is 0 (none) or 1 (gelu_pk)");
    bf16_t* O; int ldc; const float* bias; int split_cols; size_t split_stride; float scale0;
    __device__ __forceinline__ void operator()(const f32x4 (&acc)[2][2][4][2], const Unit& u, int wr, int wc, int fr, int fq) const {
        const int row0 = u.pm * BM + wr * 64 + fr; int colt = u.pn * BM; bf16_t* base = O;
        float sc = 1.f; if (split_cols) { const int t = colt / split_cols; base += (size_t)t * split_stride; colt -= t * split_cols; if (t == 0) sc = scale0; }
        const int col0 = colt + wc * 32 + 8 * fq, bcol0 = u.pn * BM + wc * 32 + 8 * fq;
        f32x4 bv[2][2];
#pragma unroll
        for (int bj = 0; bj < 2; ++bj)
#pragma unroll
            for (int n = 0; n < 2; ++n) bv[bj][n] = bias ? *(const f32x4*)(bias + bcol0 + bj * HALF + 4 * n) : (f32x4){0.f, 0.f, 0.f, 0.f};
#pragma unroll
        for (int ai = 0; ai < 2; ++ai)
#pragma unroll
            for (int m = 0; m < 4; ++m) { bf16_t* rowp = base + (size_t)(row0 + ai * HALF + m * 16) * ldc + col0;
#pragma unroll
                for (int bj = 0; bj < 2; ++bj) { f32x4 v0 = acc[ai][bj][m][0] + bv[bj][0], v1 = acc[ai][bj][m][1] + bv[bj][1];
                    if (ACT == 1) { f32x2 a = gelu_pk((f32x2){v0[0], v0[1]}), b = gelu_pk((f32x2){v0[2], v0[3]}), c = gelu_pk((f32x2){v1[0], v1[1]}), d = gelu_pk((f32x2){v1[2], v1[3]});
                        v0 = (f32x4){a.x, a.y, b.x, b.y}; v1 = (f32x4){c.x, c.y, d.x, d.y}; }
                    v0 = v0 * sc; v1 = v1 * sc; u32x4 w; w.x = cvt_pk_bf16(v0[0], v0[1]); w.y = cvt_pk_bf16(v0[2], v0[3]); w.z = cvt_pk_bf16(v1[0], v1[1]); w.w = cvt_pk_bf16(v1[2], v1[3]);
                    *(u32x4*)(rowp + bj * HALF) = w; } }
    }
};

struct EpiResid {
    static constexpr bool PERM = false, AFTER_DRAIN = false;
    const float* base; float* out; const float* gate; int gate_bstride; int rows_per_batch;
    __device__ __forceinline__ void operator()(const f32x4 (&acc)[2][2][4][2], const Unit& u, int wr, int wc, int fr, int fq) const {
        const int row0 = u.pm * BM + wr * 64 + fr, col0 = u.pn * BM + wc * 32 + 4 * fq;
        const float* gp = gate + (size_t)((u.pm * BM) / rows_per_batch) * gate_bstride + col0;
        f32x4 gv[2][2];
#pragma unroll
        for (int bj = 0; bj < 2; ++bj)
#pragma unroll
            for (int n = 0; n < 2; ++n) gv[bj][n] = *(const f32x4*)(gp + bj * HALF + n * 16);
#pragma unroll
        for (int ai = 0; ai < 2; ++ai)
#pragma unroll
            for (int m = 0; m < 4; ++m) { const size_t off = (size_t)(row0 + ai * HALF + m * 16) * 2048 + col0;
#pragma unroll
                for (int bj = 0; bj < 2; ++bj)
#pragma unroll
                    for (int n = 0; n < 2; ++n) { const f32x4 bs = *(const f32x4*)(base + off + bj * HALF + n * 16);
                        *(f32x4*)(out + off + bj * HALF + n * 16) = bs + gv[bj][n] * acc[ai][bj][m][n]; }
                if (m & 1) asm volatile("" ::: "memory"); }
    }
};
struct EpiSwiGLU {
    static constexpr bool PERM = true, AFTER_DRAIN = false;
    bf16_t* O;
    __device__ __forceinline__ void operator()(const f32x4 (&acc)[2][2][4][2], const Unit& u, int wr, int wc, int fr, int fq) const {
        const int row0 = u.pm * BM + wr * 64 + fr; const int f0 = (u.pn & 3) * 128 + wc * 16 + 4 * fq;
#pragma unroll
        for (int ai = 0; ai < 2; ++ai)
#pragma unroll
            for (int m = 0; m < 4; ++m) { bf16_t* rowp = O + (size_t)(row0 + ai * HALF + m * 16) * 512 + f0;
#pragma unroll
                for (int bj = 0; bj < 2; ++bj) { const f32x4 v0 = acc[ai][bj][m][0], v1 = acc[ai][bj][m][1];
                    float r[4]; const float a[4] = {v0[0], v0[2], v1[0], v1[2]}, b[4] = {v0[1], v0[3], v1[1], v1[3]};
#pragma unroll
                    for (int q = 0; q < 4; ++q) r[q] = a[q] * b[q] * __builtin_amdgcn_rcpf(1.0f + __builtin_amdgcn_exp2f(-1.4426950408889634f * a[q]));
                    typedef unsigned u32x2 __attribute__((ext_vector_type(2)));
                    u32x2 w; w.x = cvt_pk_bf16(r[0], r[1]); w.y = cvt_pk_bf16(r[2], r[3]);
                    *(u32x2*)(rowp + bj * 64) = w; } }
    }
};
struct MoeOrder {
    unsigned pk[4]; int njs, G, c;
    __device__ __forceinline__ void init(const unsigned* cnt, int njs_, int G_, int c_) {
        njs = njs_; G = G_; c = c_; unsigned t = 0; pk[0] = pk[1] = pk[2] = pk[3] = 0u;
#pragma unroll
        for (int e = 0; e < 16; ++e) { t += (__builtin_amdgcn_readfirstlane(cnt[e]) + 255u) >> 8; pk[e >> 2] |= t << (8 * (e & 3)); }
    }
    __device__ __forceinline__ bool next(int i, Unit& u) const {
        const int L = i * G + c, rt = L >> njs, j = L & ((1 << njs) - 1);
        if (rt >= (int)(pk[3] >> 24)) return false;
        int e = 0;
#pragma unroll
        for (int q = 0; q < 16; ++q) e += ((int)((pk[q >> 2] >> (8 * (q & 3))) & 255u) <= rt) ? 1 : 0;
        u.pm = rt; u.pn = (e << njs) + j; return true;
    }
    __device__ __forceinline__ void a_ready(const Unit&) const {}
    __device__ __forceinline__ void done(const Unit&) const {}
};

template <class Epi, class Sched, bool ALIGN_EPI = false, bool SP2 = false>
__device__ __forceinline__ void gemm_phase(PG8_LAS unsigned char* lds, const Gemm g, const Sched& S, const Epi& E) {
    const int tid = threadIdx.x, wid = __builtin_amdgcn_readfirstlane(tid >> 6), lane = tid & 63, wr = wid >> 2, wc = wid & 3, fr = lane & 15, fq = lane >> 4;
    const int K = g.K, nt = K / BK;
    unsigned voffA[2], voffB[2];
#pragma unroll
    for (int i = 0; i < 2; ++i) { int R, C; stage_rc(tid * 16 + i * 8192, R, C); const int Rb = Epi::PERM ? ((R & ~31) + perm32(R & 31)) : R;
        voffA[i] = (unsigned)(R * K + C) * 2u; voffB[i] = (unsigned)(Rb * K + C) * 2u; }
    const size_t kstep = (size_t)(BK * 2);
    const size_t hstep = (size_t)HALF * K * 2;
    const size_t tstep = 2 * hstep;
    const unsigned ldsw = (unsigned)wid * 1024u;
    const int aoff = lds_byte(wr * 64 + fr, fq * 8), boff = lds_byte(wc * 32 + fr, fq * 8);
#define PG8_SA(b, h) (((b) * 2 + (h)) * HTB)
#define PG8_SB(b, h) ((4 + (b) * 2 + (h)) * HTB)
#define PG8_STAGE(bufoff, gbase, voff) do { _Pragma("unroll") for (int _i = 0; _i < 2; ++_i) \
        __builtin_amdgcn_global_load_lds((const unsigned*)((const char*)(gbase) + (voff)[_i]), (PG8_LAS unsigned*)(lds + (bufoff) + ldsw + _i * 8192), 16, 0, 0); } while (0)
#define PG8_LDA(dst, b, h) do { _Pragma("unroll") for (int m = 0; m < 4; ++m) _Pragma("unroll") for (int k = 0; k < 2; ++k) dst[m][k] = *(const PG8_LAS bf16x8*)(lds + PG8_SA(b, h) + aoff + m * 2048 + k * 1024); } while (0)
#define PG8_LDB(dst, b, h) do { _Pragma("unroll") for (int n = 0; n < 2; ++n) _Pragma("unroll") for (int k = 0; k < 2; ++k) dst[n][k] = *(const PG8_LAS bf16x8*)(lds + PG8_SB(b, h) + boff + n * 2048 + k * 1024); } while (0)
#define PG8_MMA(ai, bj, At, Bt) do { __builtin_amdgcn_s_setprio(1); _Pragma("unroll") for (int m = 0; m < 4; ++m) _Pragma("unroll") for (int n = 0; n < 2; ++n) _Pragma("unroll") for (int k = 0; k < 2; ++k) \
        acc[ai][bj][m][n] = __builtin_amdgcn_mfma_f32_16x16x32_bf16(Bt[n][k], At[m][k], acc[ai][bj][m][n], 0, 0, 0); __builtin_amdgcn_s_setprio(0); } while (0)
#define PG8_WAIT_V(n) asm volatile("s_waitcnt vmcnt(" #n ")" ::: "memory")
#define PG8_WAIT_L(n) asm volatile("s_waitcnt lgkmcnt(" #n ")" ::: "memory")
#define PG8_BAR __builtin_amdgcn_s_barrier()
#define PG8_SCHED __builtin_amdgcn_sched_barrier(0)
    Unit cur, nxt; int ui = 0;
    if (!S.next(0, cur)) return;
    f32x4 acc[2][2][4][2];
#pragma unroll
    for (int a = 0; a < 2; ++a)
#pragma unroll
        for (int b = 0; b < 2; ++b)
#pragma unroll
            for (int m = 0; m < 4; ++m)
#pragma unroll
                for (int n = 0; n < 2; ++n) acc[a][b][m][n] = (f32x4){0.f, 0.f, 0.f, 0.f};
    bf16x8 At[4][2], B0[2][2], B1[2][2];
    const char* cA = (const char*)g.A + (size_t)cur.pm * tstep; const char* cB = (const char*)g.Bt + (size_t)cur.pn * tstep;
    S.a_ready(cur);
    if constexpr (SP2) {
        PG8_STAGE(PG8_SB(0, 0), cB, voffB); PG8_STAGE(PG8_SB(0, 1), cB + hstep, voffB); PG8_STAGE(PG8_SA(0, 0), cA, voffA); PG8_STAGE(PG8_SA(0, 1), cA + hstep, voffA);
        if (wr == 1) PG8_BAR;
        PG8_WAIT_V(2); PG8_BAR;
        PG8_STAGE(PG8_SB(1, 0), cB + kstep, voffB); PG8_STAGE(PG8_SA(1, 0), cA + kstep, voffA); PG8_STAGE(PG8_SB(1, 1), cB + hstep + kstep, voffB);
        PG8_WAIT_V(6); PG8_BAR;
    } else {
        PG8_STAGE(PG8_SB(0, 0), cB, voffB); PG8_STAGE(PG8_SA(0, 0), cA, voffA); PG8_STAGE(PG8_SB(0, 1), cB + hstep, voffB); PG8_STAGE(PG8_SA(0, 1), cA + hstep, voffA);
        if (wr == 1) PG8_BAR;
        PG8_WAIT_V(4); PG8_BAR;
        PG8_STAGE(PG8_SB(1, 0), cB + kstep, voffB); PG8_STAGE(PG8_SA(1, 0), cA + kstep, voffA); PG8_STAGE(PG8_SB(1, 1), cB + hstep + kstep, voffB);
        PG8_WAIT_V(6); PG8_BAR;
    }
    for (;;) {
        const bool has_next = S.next(ui + 1, nxt);
        const char* nA = has_next ? (const char*)g.A + (size_t)nxt.pm * tstep : cA; const char* nB = has_next ? (const char*)g.Bt + (size_t)nxt.pn * tstep : cB;
        for (int t = 0; t < nt; t += 2) {
            const bool last = (t == nt - 2);
            const char* a1 = cA + (size_t)(t + 1) * kstep;
            const char* a2 = last ? nA : cA + (size_t)(t + 2) * kstep; const char* b2 = last ? nB : cB + (size_t)(t + 2) * kstep;
            const char* a3 = a2 + kstep; const char* b3 = b2 + kstep;
            if (last && has_next) S.a_ready(nxt);
            if constexpr (SP2) {
            PG8_LDB(B0, 0, 0); PG8_LDB(B1, 0, 1); PG8_SCHED; PG8_LDA(At, 0, 0); PG8_STAGE(PG8_SA(1, 1), a1 + hstep, voffA);
            PG8_WAIT_V(8); PG8_WAIT_L(0); PG8_BAR; PG8_MMA(0, 0, At, B0); PG8_MMA(0, 1, At, B1); PG8_BAR; PG8_SCHED;
            PG8_LDA(At, 0, 1); PG8_STAGE(PG8_SB(0, 0), b2, voffB); PG8_STAGE(PG8_SB(0, 1), b2 + hstep, voffB); PG8_STAGE(PG8_SA(0, 0), a2, voffA);
            PG8_WAIT_V(8); PG8_WAIT_L(0); PG8_BAR; PG8_MMA(1, 0, At, B0); PG8_MMA(1, 1, At, B1); PG8_BAR; PG8_SCHED;
            PG8_LDB(B0, 1, 0); PG8_LDB(B1, 1, 1); PG8_SCHED; PG8_LDA(At, 1, 0); PG8_STAGE(PG8_SA(0, 1), a2 + hstep, voffA);
            PG8_WAIT_V(8); PG8_WAIT_L(0); PG8_BAR; PG8_MMA(0, 0, At, B0); PG8_MMA(0, 1, At, B1); PG8_BAR; PG8_SCHED;
            PG8_LDA(At, 1, 1); PG8_STAGE(PG8_SB(1, 0), b3, voffB); PG8_STAGE(PG8_SB(1, 1), b3 + hstep, voffB); PG8_STAGE(PG8_SA(1, 0), a3, voffA);
            PG8_WAIT_V(8); PG8_WAIT_L(0); PG8_BAR; PG8_MMA(1, 0, At, B0); PG8_MMA(1, 1, At, B1); PG8_BAR; PG8_SCHED;
            } else {
            PG8_LDB(B0, 0, 0); PG8_SCHED; PG8_LDA(At, 0, 0); PG8_STAGE(PG8_SA(1, 1), a1 + hstep, voffA);
            PG8_WAIT_L(8); PG8_BAR; PG8_WAIT_L(0); PG8_MMA(0, 0, At, B0); PG8_BAR; PG8_SCHED;
            PG8_LDB(B1, 0, 1); PG8_STAGE(PG8_SB(0, 0), b2, voffB);
            PG8_BAR; PG8_WAIT_L(0); PG8_MMA(0, 1, At, B1); PG8_BAR;
            PG8_LDA(At, 0, 1); PG8_STAGE(PG8_SA(0, 0), a2, voffA);
            PG8_BAR; PG8_WAIT_L(0); PG8_MMA(1, 0, At, B0); PG8_BAR; PG8_SCHED;
            PG8_STAGE(PG8_SB(0, 1), b2 + hstep, voffB);
            PG8_WAIT_V(6); PG8_BAR; PG8_MMA(1, 1, At, B1); PG8_BAR;
            PG8_LDB(B0, 1, 0); PG8_SCHED; PG8_LDA(At, 1, 0); PG8_STAGE(PG8_SA(0, 1), a2 + hstep, voffA);
            PG8_WAIT_L(8); PG8_BAR; PG8_WAIT_L(0); PG8_MMA(0, 0, At, B0); PG8_BAR; PG8_SCHED;
            PG8_LDB(B1, 1, 1); PG8_STAGE(PG8_SB(1, 0), b3, voffB);
            PG8_BAR; PG8_WAIT_L(0); PG8_MMA(0, 1, At, B1); PG8_BAR;
            PG8_LDA(At, 1, 1); PG8_STAGE(PG8_SA(1, 0), a3, voffA);
            PG8_BAR; PG8_WAIT_L(0); PG8_MMA(1, 0, At, B0); PG8_BAR; PG8_SCHED;
            PG8_STAGE(PG8_SB(1, 1), b3 + hstep, voffB);
            PG8_WAIT_V(6); PG8_BAR; PG8_MMA(1, 1, At, B1); PG8_BAR;
            }
        }
        if constexpr (ALIGN_EPI) { if (wr == 0) PG8_BAR; }
        if constexpr (!Epi::AFTER_DRAIN) { E(acc, cur, wr, wc, fr, fq); S.done(cur); }
        if (!has_next) break;
#pragma unroll
        for (int a = 0; a < 2; ++a)
#pragma unroll
            for (int b = 0; b < 2; ++b)
#pragma unroll
                for (int m = 0; m < 4; ++m)
#pragma unroll
                    for (int n = 0; n < 2; ++n) acc[a][b][m][n] = (f32x4){0.f, 0.f, 0.f, 0.f};
        cur = nxt; cA = nA; cB = nB; ++ui;
        if constexpr (ALIGN_EPI) { if (wr == 1) PG8_BAR; }
    }
    PG8_WAIT_V(0);
    if constexpr (!ALIGN_EPI) { if (wr == 0) PG8_BAR; }
    PG8_BAR;
    if constexpr (Epi::AFTER_DRAIN) { E.fused(acc, cur, wr, wc, fr, fq, lds, wid, lane); S.done(cur); }
#undef PG8_SA
#undef PG8_SB
#undef PG8_STAGE
#undef PG8_LDA
#undef PG8_LDB
#undef PG8_MMA
#undef PG8_WAIT_V
#undef PG8_WAIT_L
#undef PG8_BAR
#undef PG8_SCHED
}
}

#ifndef PG8_SP2
#define PG8_SP2 true
#endif
#ifndef PG8_ALIGN
#define PG8_ALIGN true
#endif
constexpr int NWAVES = 8;
constexpr int BATCH = 2, SEQ = 8192, DM = 2048, M = BATCH * SEQ;
constexpr int NQKV = 6144, NQKV_ODD = 6160;
constexpr int NE = 16, FFE = 512;
constexpr int MODW = 6 * DM;
constexpr float EPS = 1e-6f;
constexpr int MAXROWS = 36864;

constexpr size_t MiB = 1u << 20;
constexpr size_t WS_CTL = 0, CTL_ZERO_BYTES = 1 * MiB;
constexpr size_t WS_MOD = 1 * MiB;
constexpr size_t WS_LAM = WS_MOD + 2 * 2 * MODW * 4;
constexpr size_t WS_KMEAN = 2 * MiB;
constexpr size_t WS_WFG = 3 * MiB;
constexpr size_t WS_WRT = 3 * MiB + 128 * 1024;
constexpr size_t WS_ROUTE = 4 * MiB;
constexpr size_t WS_LOGF = 5 * MiB;
constexpr size_t WS_CUM = 6 * MiB;
constexpr size_t WS_SCR = 8 * MiB;
constexpr size_t WS_WIN = 40 * MiB;
constexpr size_t WS_WOUT = 88 * MiB;
constexpr size_t WS_W13 = 104 * MiB;
constexpr size_t WS_W2 = 232 * MiB;
constexpr size_t WS_H = 296 * MiB;
constexpr size_t WS_QKV = 360 * MiB;
constexpr size_t WS_MRG = 552 * MiB;
constexpr size_t WS_ACT = 616 * MiB;
constexpr size_t WS_OSL = 652 * MiB;
constexpr size_t WS_END = 796 * MiB;
constexpr int CW_TMO = 0;
constexpr int CW_CNT = 1024;
constexpr int CW_BAR = 4096;

constexpr int RING_OFF = 0, RING_BYTES = 131072;
constexpr int LDSCTL_OFF = RING_BYTES, MISC_OFF = LDSCTL_OFF + 320;
constexpr int LDS_BYTES = 147456;

#define GAS __attribute__((address_space(1)))
#define LAS __attribute__((address_space(3)))
typedef unsigned short bf16;
typedef unsigned v4u __attribute__((ext_vector_type(4)));
typedef unsigned v2u __attribute__((ext_vector_type(2)));
typedef float f32x4 __attribute__((ext_vector_type(4)));
typedef float f32x16 __attribute__((ext_vector_type(16)));
typedef short bf16x8 __attribute__((ext_vector_type(8)));
typedef short s16x4 __attribute__((ext_vector_type(4)));
typedef GAS unsigned gu32;
#define RLX_AGENT __ATOMIC_RELAXED, __HIP_MEMORY_SCOPE_AGENT
#define LDS_WAIT() asm volatile("s_waitcnt lgkmcnt(0)" ::: "memory")
#define VM_WAIT() asm volatile("s_waitcnt vmcnt(0)" ::: "memory")
__device__ __forceinline__ unsigned f2bf(float f) { unsigned u = __builtin_bit_cast(unsigned, f); return (u + 0x7fffu + ((u >> 16) & 1u)) >> 16; }
__device__ __forceinline__ unsigned pk2(float lo, float hi) { return f2bf(lo) | (f2bf(hi) << 16); }
__device__ __forceinline__ float bflo(unsigned w) { return __builtin_bit_cast(float, w << 16); }
__device__ __forceinline__ float bfhi(unsigned w) { return __builtin_bit_cast(float, w & 0xffff0000u); }
__device__ __forceinline__ float wave_sum(float v) {
#pragma unroll
    for (int o = 1; o < 64; o <<= 1) v += __shfl_xor(v, o);
    return v;
}
__device__ __forceinline__ float wave_max(float v) {
#pragma unroll
    for (int o = 1; o < 64; o <<= 1) v = fmaxf(v, __shfl_xor(v, o));
    return v;
}
#define XB_TMO      128
#define XB_XCNT(j)  (256  + 64 * (j))
#define XB_XSUB(j)  (1280 + 64 * (j))
#define XB_XGEN(j)  (2304 + 64 * (j))
#define XB_TOP      3328
#define XB_TOPGEN   3392
#define XCD_BAR_WORDS 3456
#define XB_SPIN_CAP (1u << 18)

__device__ __forceinline__ unsigned xb_ld(unsigned* p)              { return __hip_atomic_load(p, __ATOMIC_RELAXED, __HIP_MEMORY_SCOPE_AGENT); }
__device__ __forceinline__ unsigned xb_add(unsigned* p, unsigned v) { return __hip_atomic_fetch_add(p, v, __ATOMIC_RELAXED, __HIP_MEMORY_SCOPE_AGENT); }
__device__ __forceinline__ unsigned xb_xcc_id() { return (unsigned)__builtin_amdgcn_s_getreg((3 << 11) | 20) & 0xFu; }
#define XB_SPIN(cond, bar) do { unsigned _sp = 0; while (cond) { __builtin_amdgcn_s_sleep(1); \
    if ((++_sp & 255u) == 0u) { if (xb_ld(&(bar)[XB_TMO])) break; if (_sp > XB_SPIN_CAP) { atomicAdd(&(bar)[XB_TMO], 1u); break; } } } } while (0)

struct XcdBarrier {
    unsigned* bar; unsigned x;
    volatile LAS unsigned* st;
};

__device__ __forceinline__ XcdBarrier xcd_barrier_post(unsigned* bar, volatile LAS unsigned* st) {
    XcdBarrier b; b.bar = bar; b.x = xb_xcc_id(); b.st = st;
    if (threadIdx.x == 0) (void)xb_add(&bar[XB_XCNT(b.x)], 1u);
    return b;
}
__device__ __forceinline__ void xcd_barrier_complete(unsigned* bar, unsigned x, unsigned& nloc, unsigned& nx) {
    const unsigned G = gridDim.x * gridDim.y * gridDim.z;
    unsigned sum, cnt, mine, sp = 0u;
    for (;;) {
        sum = 0u; cnt = 0u; mine = 0u;
#pragma unroll
        for (unsigned j = 0; j < 16; ++j) { const unsigned c = xb_ld(&bar[XB_XCNT(j)]); sum += c; cnt += (c > 0u) ? 1u : 0u; mine = (j == x) ? c : mine; }
        if (sum == G) break;
        __builtin_amdgcn_s_sleep(1);
        if ((++sp & 255u) == 0u) { if (xb_ld(&bar[XB_TMO])) break; if (sp > XB_SPIN_CAP) { atomicAdd(&bar[XB_TMO], 1u); break; } }
    }
    nloc = mine > 0u ? mine : 1u; nx = cnt > 0u ? cnt : 1u;
}

__device__ __forceinline__ void xcd_barrier(const XcdBarrier& b) {
    asm volatile("s_waitcnt vmcnt(0)" ::: "memory");
    __syncthreads();
    if (threadIdx.x == 0) {
        unsigned* bar = b.bar;
        __builtin_amdgcn_s_waitcnt(0);
        unsigned nloc = b.st[0], nx = b.st[1];
        if (nloc == 0u) { xcd_barrier_complete(bar, b.x, nloc, nx); b.st[0] = nloc; b.st[1] = nx; }
        const unsigned old = xb_add(&bar[XB_XSUB(b.x)], 1u);
        const unsigned gen = old / nloc;
        if (old + 1u == (gen + 1u) * nloc) {
            __builtin_amdgcn_fence(__ATOMIC_RELEASE, "agent");
            asm volatile("s_waitcnt vmcnt(0)" ::: "memory");
            const unsigned og = xb_add(&bar[XB_TOP], 1u);
            const unsigned tg = og / nx;
            if (og + 1u == (tg + 1u) * nx) xb_add(&bar[XB_TOPGEN], 1u);
            else XB_SPIN(xb_ld(&bar[XB_TOPGEN]) == tg, bar);
            __builtin_amdgcn_fence(__ATOMIC_ACQUIRE, "agent");
            xb_add(&bar[XB_XGEN(b.x)], 1u);
            asm volatile("s_waitcnt vmcnt(0)" ::: "memory");
        } else {
            XB_SPIN(xb_ld(&bar[XB_XGEN(b.x)]) == gen, bar);
            __builtin_amdgcn_fence(__ATOMIC_ACQUIRE, "agent");
            asm volatile("s_waitcnt vmcnt(0)" ::: "memory");
        }
    }
    __syncthreads();
}
struct Args { const float* in[22]; float* out; unsigned char* ws; int ph_lo, ph_hi; };
struct Frame { LAS unsigned char* lds; volatile LAS unsigned* MISC; gu32* ctl; int tid, lane, wave, vcu, G; };
enum { I_X = 0, I_C = 1, I_ADAW = 2, I_ADAB = 3, I_ANG = 4, I_FNG = 5, I_WINE = 6, I_WOUTE = 7, I_LQ1 = 8, I_LK1 = 9, I_LQ2 = 10, I_LK2 = 11, I_SUBLN = 12,
       I_WINO = 13, I_BF = 14, I_WOUTO = 15, I_RW = 16, I_RB = 17, I_W1 = 18, I_W3 = 19, I_W2 = 20, I_FING = 21 };

__device__ __forceinline__ void transpose_item(const float* W, int ldw, int K, int ncols, bf16* WT, int row_off, int rs, LAS float* scr, int item, int lane) {
    const int nblk = ncols / 32, kb = item / nblk, nb = item % nblk, k0 = 64 * kb, n0 = 32 * nb;
#pragma unroll 8
    for (int i = 0; i < 32; ++i) { const int kk = 2 * i + (lane >> 5); scr[kk * 33 + (lane & 31)] = W[(size_t)(k0 + kk) * ldw + n0 + (lane & 31)]; }
    LDS_WAIT(); asm volatile("" ::: "memory");
    const int c = lane & 7;
#pragma unroll
    for (int j = 0; j < 4; ++j) { const int n = (lane >> 3) + 8 * j; const LAS float* s = scr + (8 * c) * 33 + n;
        v4u o; o.x = pk2(s[0 * 33], s[1 * 33]); o.y = pk2(s[2 * 33], s[3 * 33]); o.z = pk2(s[4 * 33], s[5 * 33]); o.w = pk2(s[6 * 33], s[7 * 33]);
        *(GAS v4u*)(WT + (size_t)(row_off + (n0 + n) * rs) * K + k0 + 8 * c) = o; }
    LDS_WAIT(); asm volatile("" ::: "memory");
}
__device__ __forceinline__ void p0_prologue(const Args& A, const Frame& F) {
    unsigned char* ws = A.ws;
    for (int it = blockIdx.x; it < 96; it += F.G) {
        LAS float* cond = (LAS float*)(F.lds); LAS float* red = (LAS float*)(F.lds + 16384);
        for (int i = F.tid; i < 4096; i += 512) { const float cv = A.in[I_C][i]; cond[i] = cv / (1.0f + __expf(-cv)); }
        __syncthreads();
        const int l = it / 48, cg = it % 48;
        const float* W = A.in[I_ADAW] + (size_t)l * DM * MODW + cg * 256 + 4 * F.lane;
        f32x4 a0 = {0.f, 0.f, 0.f, 0.f}, a1 = {0.f, 0.f, 0.f, 0.f};
        const int kb = 256 * F.wave;
#pragma unroll 8
        for (int k = 0; k < 256; ++k) { const f32x4 w = *(const f32x4*)(W + (size_t)(kb + k) * MODW); a0 += cond[kb + k] * w; a1 += cond[2048 + kb + k] * w; }
        *(LAS f32x4*)(red + (F.wave * 2 + 0) * 256 + 4 * F.lane) = a0; *(LAS f32x4*)(red + (F.wave * 2 + 1) * 256 + 4 * F.lane) = a1;
        __syncthreads();
        { const int b = F.tid >> 8, n = F.tid & 255; float s = A.in[I_ADAB][l * MODW + cg * 256 + n];
#pragma unroll
          for (int w = 0; w < 8; ++w) s += red[(w * 2 + b) * 256 + n];
          ((float*)(ws + WS_MOD))[(l * 2 + b) * MODW + cg * 256 + n] = s; }
        __syncthreads();
    }
    if (blockIdx.x == 0 && F.tid == 0) { float s1 = 0.f, s2 = 0.f;
        for (int i = 0; i < 64; ++i) { s1 += A.in[I_LQ1][i] * A.in[I_LK1][i]; s2 += A.in[I_LQ2][i] * A.in[I_LK2][i]; }
        *(float*)(ws + WS_LAM) = __expf(s1) - __expf(s2) + 0.2f; }
    for (int i = blockIdx.x * 512 + F.tid; i < 16 * DM; i += F.G * 512) { const int j = i >> 11, k = i & 2047;
        ((float*)(ws + WS_WFG))[i] = A.in[I_WINO][(size_t)k * NQKV_ODD + NQKV + j]; ((float*)(ws + WS_WRT))[i] = A.in[I_RW][k * 16 + j]; }
    LAS float* scr = (LAS float*)(F.lds + F.wave * 16384);
    const int gw = F.vcu * NWAVES + F.wave, NGW = F.G * NWAVES;
    constexpr int I_IN = 32 * 192, I_OUT = 32 * 64, I_MOE = 32 * 512;
    for (int it = gw; it < 2 * I_IN + 2 * I_OUT + 3 * I_MOE; it += NGW) {
        int r = it;
        if (r < I_IN) { transpose_item(A.in[I_WINE], NQKV, DM, NQKV, (bf16*)(ws + WS_WIN), 0, 1, scr, r, F.lane); continue; } r -= I_IN;
        if (r < I_IN) { transpose_item(A.in[I_WINO], NQKV_ODD, DM, NQKV, (bf16*)(ws + WS_WIN) + (size_t)NQKV * DM, 0, 1, scr, r, F.lane); continue; } r -= I_IN;
        if (r < I_OUT) { transpose_item(A.in[I_WOUTE], DM, DM, DM, (bf16*)(ws + WS_WOUT), 0, 1, scr, r, F.lane); continue; } r -= I_OUT;
        if (r < I_OUT) { transpose_item(A.in[I_WOUTO], DM, DM, DM, (bf16*)(ws + WS_WOUT) + (size_t)DM * DM, 0, 1, scr, r, F.lane); continue; } r -= I_OUT;
        if (r < 2 * I_MOE) { const int which = r / I_MOE; r -= which * I_MOE; const int le = r >> 9, l = le >> 4, e = le & 15;
            transpose_item(A.in[which ? I_W3 : I_W1] + (size_t)le * DM * FFE, FFE, DM, FFE, (bf16*)(ws + WS_W13) + (size_t)l * 16384 * DM, e * 1024 + which, 2, scr, r & 511, F.lane); continue; }
        r -= 2 * I_MOE;
        { const int le = r >> 9, l = le >> 4, e = le & 15;
          transpose_item(A.in[I_W2] + (size_t)le * FFE * DM, DM, FFE, DM, (bf16*)(ws + WS_W2) + (size_t)l * 32768 * FFE, e * 2048, 1, scr, r & 511, F.lane); }
    }
}

template <int MODE>
__device__ __forceinline__ void norm_phase(const Args& A, const Frame& F, int l) {
    unsigned char* ws = A.ws;
    constexpr bool SIDE = (MODE == 1 || MODE == 2), COMB = (MODE == 2 || MODE == 3);
    LAS float* WT = (LAS float*)F.lds;
    if (SIDE) { const f32x4* src = (const f32x4*)(ws + (MODE == 1 ? WS_WRT : WS_WFG));
        for (int i = F.tid; i < 16 * DM / 4; i += 512) *(LAS f32x4*)(WT + 4 * i) = src[i];
        __syncthreads(); }
    const float* modl = (const float*)(ws + WS_MOD) + (size_t)l * 2 * MODW;
    const float* gain = MODE == 3 ? A.in[I_FING] : (MODE == 1 ? A.in[I_FNG] + l * DM : A.in[I_ANG] + l * DM);
    const float* xsrc = MODE == 0 ? A.in[I_X] : A.out;
    const float* modprev = (const float*)(ws + WS_MOD) + (size_t)(MODE == 3 ? 1 : 0) * 2 * MODW;
    const unsigned* route = (const unsigned*)(ws + WS_ROUTE);
    const bf16* OSL = (const bf16*)(ws + WS_OSL);
    bf16* H = (bf16*)(ws + WS_H);
    const int gw = F.vcu * NWAVES + F.wave, NGW = F.G * NWAVES, lane = F.lane;
    for (int m = gw; m < M; m += NGW) {
        const int b = m >> 13;
        f32x4 v[8];
        { const f32x4* xr = (const f32x4*)(xsrc + (size_t)m * DM) + lane;
#pragma unroll
          for (int j = 0; j < 8; ++j) v[j] = xr[64 * j]; }
        if (COMB) {
            const unsigned* rt = route + (size_t)m * 6;
            const float w0 = __builtin_bit_cast(float, rt[2]), w1 = __builtin_bit_cast(float, rt[3]);
            const v2u* o0 = (const v2u*)(OSL + (size_t)rt[4] * DM) + lane; const v2u* o1 = (const v2u*)(OSL + (size_t)rt[5] * DM) + lane;
            const f32x4* g2 = (const f32x4*)(modprev + (size_t)b * MODW + 5 * DM) + lane;
#pragma unroll
            for (int j = 0; j < 8; ++j) { const v2u a = o0[64 * j], c = o1[64 * j]; const f32x4 g = g2[64 * j];
                v[j].x += g.x * (w0 * bflo(a.x) + w1 * bflo(c.x)); v[j].y += g.y * (w0 * bfhi(a.x) + w1 * bfhi(c.x));
                v[j].z += g.z * (w0 * bflo(a.y) + w1 * bflo(c.y)); v[j].w += g.w * (w0 * bfhi(a.y) + w1 * bfhi(c.y)); }
            if (MODE == 2) { f32x4* xw = (f32x4*)(A.out + (size_t)m * DM) + lane;
#pragma unroll
                for (int j = 0; j < 8; ++j) xw[64 * j] = v[j]; }
        }
        float ss = 0.f;
#pragma unroll
        for (int j = 0; j < 8; ++j) ss += (v[j].x * v[j].x + v[j].y * v[j].y) + (v[j].z * v[j].z + v[j].w * v[j].w);
        const float rstd = 1.0f / sqrtf(wave_sum(ss) * (1.0f / DM) + EPS);
        if (MODE == 3) {
            f32x4* ow = (f32x4*)(A.out + (size_t)m * DM) + lane; const f32x4* gp = (const f32x4*)gain + lane;
#pragma unroll
            for (int j = 0; j < 8; ++j) ow[64 * j] = v[j] * rstd * gp[64 * j];
            continue;
        }
        { const f32x4* gp = (const f32x4*)gain + lane;
          const f32x4* shp = (const f32x4*)(modl + (size_t)b * MODW + (MODE == 1 ? 3 : 0) * DM) + lane;
          const f32x4* scp = (const f32x4*)(modl + (size_t)b * MODW + (MODE == 1 ? 4 : 1) * DM) + lane;
          v2u* hw = (v2u*)(H + (size_t)m * DM) + lane;
#pragma unroll
          for (int j = 0; j < 8; ++j) { v[j] = v[j] * rstd * gp[64 * j] * (1.0f + scp[64 * j]) + shp[64 * j];
              v2u o; o.x = pk2(v[j].x, v[j].y); o.y = pk2(v[j].z, v[j].w); hw[64 * j] = o; } }
        if (SIDE) {
            float z = 0.f;
#pragma unroll 1
            for (int q = 0; q < 16; ++q) { float d = 0.f;
#pragma unroll
                for (int j = 0; j < 8; ++j) { const f32x4 w = *(const LAS f32x4*)(WT + q * DM + 256 * j + 4 * lane); d += (v[j].x * w.x + v[j].y * w.y) + (v[j].z * w.z + v[j].w * w.w); }
                d = wave_sum(d); if (lane == q) z = d; }
            if (MODE == 2) {
                if (lane < 16) { z += A.in[I_BF][lane]; const float r = z >= 0.f ? -log1pf(__expf(-z)) : z - log1pf(__expf(z));
                    ((float*)(ws + WS_LOGF))[(size_t)m * 16 + lane] = r; }
            } else {
                float aff[16], sel[16];
#pragma unroll
                for (int q = 0; q < 16; ++q) { const float lgq = __shfl(z, q); aff[q] = 1.0f / (1.0f + __expf(-lgq)); sel[q] = aff[q] + A.in[I_RB][q]; }
                int best = 0; float bs = -3.0e38f;
#pragma unroll
                for (int g = 0; g < 4; ++g) { const float a = sel[4 * g], bq = sel[4 * g + 1], c = sel[4 * g + 2], d = sel[4 * g + 3];
                    const float t2 = fmaxf(fmaxf(fmaxf(a + bq, a + c), fmaxf(a + d, bq + c)), fmaxf(bq + d, c + d));
                    if (t2 > bs) { bs = t2; best = g; } }
                float cs[4], ca[4];
#pragma unroll
                for (int i = 0; i < 4; ++i) { cs[i] = sel[i]; ca[i] = aff[i]; }
#pragma unroll
                for (int g = 1; g < 4; ++g) if (best == g) {
#pragma unroll
                    for (int i = 0; i < 4; ++i) { cs[i] = sel[4 * g + i]; ca[i] = aff[4 * g + i]; } }
                int i1 = 0; float s1 = cs[0], a1 = ca[0];
#pragma unroll
                for (int i = 1; i < 4; ++i) if (cs[i] > s1) { s1 = cs[i]; a1 = ca[i]; i1 = i; }
                int i2 = -1; float s2 = -3.0e38f, a2 = 0.f;
#pragma unroll
                for (int i = 0; i < 4; ++i) if (i != i1 && cs[i] > s2) { s2 = cs[i]; a2 = ca[i]; i2 = i; }
                const int e0 = best * 4 + i1, e1 = best * 4 + i2; const float inv = 1.0f / (a1 + a2);
                if (lane == 0) { unsigned* cnt = (unsigned*)(F.ctl + CW_CNT + 64 * l);
                    const unsigned p0 = __hip_atomic_fetch_add(cnt + e0, 1u, RLX_AGENT), p1 = __hip_atomic_fetch_add(cnt + e1, 1u, RLX_AGENT);
                    unsigned* rt = (unsigned*)(ws + WS_ROUTE) + (size_t)m * 6;
                    rt[0] = (unsigned)e0; rt[1] = (unsigned)e1; rt[2] = __builtin_bit_cast(unsigned, a1 * inv); rt[3] = __builtin_bit_cast(unsigned, a2 * inv); rt[4] = p0; rt[5] = p1; }
            }
        }
    }
}
__device__ __forceinline__ void scan_phase(const Args& A, const Frame& F) {
    const float* LOGF = (const float*)(A.ws + WS_LOGF); float* CUM = (float*)(A.ws + WS_CUM);
    LAS float* wt = (LAS float*)F.lds;
    for (int u = blockIdx.x; u < BATCH * 16; u += F.G) {
        const int b = u >> 4, h = u & 15, s0 = F.tid * 16;
        float v[16]; float run = 0.f;
#pragma unroll
        for (int i = 0; i < 16; ++i) { run += LOGF[(size_t)(b * SEQ + s0 + i) * 16 + h]; v[i] = run; }
        float inc = run;
#pragma unroll
        for (int o = 1; o < 64; o <<= 1) { const float t = __shfl_up(inc, o); if (F.lane >= o) inc += t; }
        if (F.lane == 63) wt[F.wave] = inc;
        __syncthreads();
        float base = inc - run;
        for (int w = 0; w < F.wave; ++w) base += wt[w];
        float* dst = CUM + (size_t)(b * 16 + h) * SEQ + s0;
#pragma unroll
        for (int i = 0; i < 16; ++i) dst[i] = base + v[i];
        __syncthreads();
    }
}
__device__ __forceinline__ void kmean_phase(const Args& A, const Frame& F) {
    const bf16* QKV = (const bf16*)(A.ws + WS_QKV); float* KM = (float*)(A.ws + WS_KMEAN);
    LAS float* red = (LAS float*)F.lds;
    for (int u = blockIdx.x; u < BATCH * 8 * 32; u += F.G) {
        const int b = u >> 8, h = (u >> 5) & 7, blk = u & 31, c = F.tid & 15, rg = F.tid >> 4;
        float s[8] = {0.f, 0.f, 0.f, 0.f, 0.f, 0.f, 0.f, 0.f};
#pragma unroll
        for (int i = 0; i < 8; ++i) { const v4u w = *(const v4u*)(QKV + (size_t)(b * SEQ + blk * 256 + rg + 32 * i) * NQKV + 4096 + h * 128 + 8 * c);
            s[0] += bflo(w.x); s[1] += bfhi(w.x); s[2] += bflo(w.y); s[3] += bfhi(w.y); s[4] += bflo(w.z); s[5] += bfhi(w.z); s[6] += bflo(w.w); s[7] += bfhi(w.w); }
#pragma unroll
        for (int i = 0; i < 8; ++i) red[rg * 128 + 8 * c + i] = s[i];
        __syncthreads();
        if (F.tid < 128) { float t = 0.f;
#pragma unroll
            for (int r = 0; r < 32; ++r) t += red[r * 128 + F.tid];
            KM[(size_t)u * 128 + F.tid] = t * (1.0f / 256.0f); }
        __syncthreads();
    }
}
__device__ __forceinline__ void gather_phase(const Args& A, const Frame& F, int l) {
    const unsigned* cnt = (const unsigned*)(F.ctl + CW_CNT + 64 * l);
    unsigned basev = 0;
    { unsigned t = 0;
#pragma unroll
      for (int e = 0; e < 16; ++e) { if (F.lane == e) basev = t * 256u; t += (cnt[e] + 255u) >> 8; } }
    unsigned* route = (unsigned*)(A.ws + WS_ROUTE); const bf16* H = (const bf16*)(A.ws + WS_H); bf16* HS = (bf16*)(A.ws + WS_QKV);
    const int gw = F.vcu * NWAVES + F.wave, NGW = F.G * NWAVES;
    for (int m = gw; m < M; m += NGW) {
        unsigned* rt = route + (size_t)m * 6;
        const unsigned e0 = rt[0], e1 = rt[1], p0 = rt[4], p1 = rt[5];
        const unsigned s0 = __shfl(basev, (int)e0) + p0, s1 = __shfl(basev, (int)e1) + p1;
        const v4u* src = (const v4u*)(H + (size_t)m * DM) + F.lane; v4u* d0 = (v4u*)(HS + (size_t)s0 * DM) + F.lane; v4u* d1 = (v4u*)(HS + (size_t)s1 * DM) + F.lane;
        v4u x[4];
#pragma unroll
        for (int j = 0; j < 4; ++j) x[j] = src[64 * j];
#pragma unroll
        for (int j = 0; j < 4; ++j) { d0[64 * j] = x[j]; d1[64 * j] = x[j]; }
        asm volatile("" ::: "memory");
        if (F.lane == 0) { rt[4] = s0; rt[5] = s1; }
    }
}
#ifndef NAIVE_ATTN
#define NAIVE_ATTN 1
#endif
#if NAIVE_ATTN
template <int DQ>
__device__ __forceinline__ void naive_span(const bf16* Kp, const bf16* Vp, const LAS float* q, int kb, int ke, int pos, float scale, float slope, const float* CUMrow, float cq,
                                           float& mrun, float& lrun, float& o0, float& o1, int lane) {
    for (int kc = kb; kc < ke; kc += 64) {
        const int key = kc + lane;
        float s = 0.f;
        { const bf16* kr = Kp + (size_t)key * NQKV;
#pragma unroll
          for (int c = 0; c < DQ / 8; ++c) { const v4u w = *(const v4u*)(kr + 8 * c); const f32x4 qa = *(const LAS f32x4*)(q + 8 * c), qb = *(const LAS f32x4*)(q + 8 * c + 4);
              s += (qa.x * bflo(w.x) + qa.y * bfhi(w.x)) + (qa.z * bflo(w.y) + qa.w * bfhi(w.y)) + (qb.x * bflo(w.z) + qb.y * bfhi(w.z)) + (qb.z * bflo(w.w) + qb.w * bfhi(w.w)); } }
        s = s * scale + (CUMrow ? (cq - CUMrow[key]) : slope * (float)(key - pos));
        if (key > pos || key >= ke) s = -__builtin_inff();
        const float cm = wave_max(s);
        if (cm == -__builtin_inff()) continue;
        const float mn = fmaxf(mrun, cm), al = __expf(mrun - mn), p = __expf(s - mn);
        lrun = lrun * al + wave_sum(p); o0 *= al; o1 *= al; mrun = mn;
        for (int j = 0; j < 64; ++j) { const float pj = __shfl(p, j); const unsigned vv = *(const unsigned*)(Vp + (size_t)(kc + j) * NQKV + 2 * lane); o0 += pj * bflo(vv); o1 += pj * bfhi(vv); }
    }
}
template <int VAR>
__global__ void __launch_bounds__(256) naive_attn(const bf16* __restrict__ QKV, bf16* __restrict__ MRG, const float* __restrict__ CUM, const float* __restrict__ KMEAN,
                                                  const float* __restrict__ lamp, const float* __restrict__ subg) {
    __shared__ float qs[4][128];
    constexpr int NH = VAR == 2 ? 16 : 8;
    const int wave = threadIdx.x >> 6, lane = threadIdx.x & 63;
    const long id = (long)blockIdx.x * 4 + wave; const int m = (int)(id / NH), hh = (int)(id % NH), b = m >> 13, pos = m & 8191;
    const bf16* row = QKV + (size_t)m * NQKV; const bf16* base = QKV + (size_t)b * SEQ * NQKV;
    LAS float* q = (LAS float*)qs[wave];
    if (VAR == 0) {
        const float slope = exp2f(-(2.0f * hh + 1.0f) * 0.5f);
        float O0[2], O1[2];
#pragma unroll
        for (int mp = 0; mp < 2; ++mp) {
            q[lane] = bflo((unsigned)row[hh * 128 + mp * 64 + lane]); __builtin_amdgcn_wave_barrier(); LDS_WAIT();
            float mr = -1e30f, lr = 0.f, o0 = 0.f, o1 = 0.f;
            naive_span<64>(base + 1024 + hh * 128 + mp * 64, base + 2048 + hh * 128, q, 0, pos + 1, pos, 0.125f, slope, nullptr, 0.f, mr, lr, o0, o1, lane);
            O0[mp] = o0 / lr; O1[mp] = o1 / lr; __builtin_amdgcn_wave_barrier();
        }
        const float lam = *lamp; const float a0 = O0[0] - lam * O0[1], a1 = O1[0] - lam * O1[1];
        const float r = 1.0f / sqrtf(wave_sum(a0 * a0 + a1 * a1) * (1.0f / 128.0f) + EPS);
        *(unsigned*)(MRG + (size_t)m * DM + hh * 128 + 2 * lane) = pk2(a0 * r * subg[2 * lane] * 0.8f, a1 * r * subg[2 * lane + 1] * 0.8f);
    } else if (VAR == 1) {
        const float slope = exp2f(-(float)(hh + 1));
        q[lane] = bflo((unsigned)row[3072 + hh * 128 + lane]); q[64 + lane] = bflo((unsigned)row[3072 + hh * 128 + 64 + lane]); __builtin_amdgcn_wave_barrier(); LDS_WAIT();
        const int own = pos >> 8;
        float g = -3.0e38f;
        if (lane < own) { const float* km = KMEAN + ((size_t)(b * 8 + hh) * 32 + lane) * 128; float s = 0.f;
            for (int d = 0; d < 128; ++d) s += q[d] * km[d]; g = s; }
        unsigned long long selm = 0ull;
        for (int t = 0; t < 3 && t < own; ++t) { const float mx = wave_max(g); const unsigned long long bal = __ballot(g == mx); const int pick = __ffsll((long long)bal) - 1;
            selm |= 1ull << pick; if (lane == pick) g = -3.0e38f; }
        float mr = -1e30f, lr = 0.f, o0 = 0.f, o1 = 0.f;
        for (int n = 0; n < own; ++n) if ((selm >> n) & 1ull)
            naive_span<128>(base + 4096 + hh * 128, base + 5120 + hh * 128, q, n * 256, n * 256 + 256, pos, 0.08838834764831845f, slope, nullptr, 0.f, mr, lr, o0, o1, lane);
        naive_span<128>(base + 4096 + hh * 128, base + 5120 + hh * 128, q, own * 256, pos + 1, pos, 0.08838834764831845f, slope, nullptr, 0.f, mr, lr, o0, o1, lane);
        *(unsigned*)(MRG + (size_t)m * DM + 1024 + hh * 128 + 2 * lane) = pk2(o0 / lr, o1 / lr);
    } else {
        q[lane] = bflo((unsigned)row[hh * 128 + lane]); q[64 + lane] = bflo((unsigned)row[hh * 128 + 64 + lane]); __builtin_amdgcn_wave_barrier(); LDS_WAIT();
        const float* cr = CUM + (size_t)(b * 16 + hh) * SEQ;
        float mr = -1e30f, lr = 0.f, o0 = 0.f, o1 = 0.f;
        naive_span<128>(base + 2048 + hh * 128, base + 4096 + hh * 128, q, 0, pos + 1, pos, 0.08838834764831845f, 0.f, cr, cr[pos], mr, lr, o0, o1, lane);
        *(unsigned*)(MRG + (size_t)m * DM + hh * 128 + 2 * lane) = pk2(o0 / lr, o1 / lr);
    }
}
#endif
#ifndef ONE_LAUNCH
#define ONE_LAUNCH 0
#endif
constexpr int N_PHASES = 20;
#define IN(k) (lo <= (k) && (k) < hi)
#define SEAM(k) do { if (IN(k) && IN((k) + 1)) xcd_barrier(bar); } while (0)
template <int l>
__device__ __forceinline__ void layer_phases(const Args& args, const Frame& F, const XcdBarrier& bar, const int lo, const int hi) {
    unsigned char* ws = args.ws;
        const int pb = 1 + 9 * l;
        const float* modl = (const float*)(ws + WS_MOD) + (size_t)l * 2 * MODW;
        if (IN(pb + 0)) { if (l == 0) norm_phase<0>(args, F, l); else norm_phase<2>(args, F, l); SEAM(pb + 0); }
        if (IN(pb + 1)) {
            if (l == 1) { scan_phase(args, F); }
            pg8::Gemm g{(const bf16*)(ws + WS_H), (const bf16*)(ws + WS_WIN) + (size_t)l * NQKV * DM, M, NQKV, DM}; pg8::StaticOrder S; S.init(M, NQKV, F.G, (int)blockIdx.x);
            pg8::EpiBf16<0> E{(bf16*)(ws + WS_QKV), NQKV, nullptr, 0, 0, 1.f};
            pg8::gemm_phase<pg8::EpiBf16<0>, pg8::StaticOrder, PG8_ALIGN, PG8_SP2>(F.lds + RING_OFF, g, S, E);
            SEAM(pb + 1);
        }
        if (IN(pb + 2)) { if (l == 0) { kmean_phase(args, F); SEAM(pb + 2); } }
        if (IN(pb + 3)) {
            SEAM(pb + 3);
        }
        if (IN(pb + 4)) {
            pg8::Gemm g{(const bf16*)(ws + WS_MRG), (const bf16*)(ws + WS_WOUT) + (size_t)l * DM * DM, M, DM, DM}; pg8::StaticOrder S; S.init(M, DM, F.G, (int)blockIdx.x);
            pg8::EpiResid E{l == 0 ? args.in[I_X] : args.out, args.out, modl + 2 * DM, MODW, SEQ};
            pg8::gemm_phase<pg8::EpiResid, pg8::StaticOrder, PG8_ALIGN, PG8_SP2>(F.lds + RING_OFF, g, S, E);
            SEAM(pb + 4);
        }
        if (IN(pb + 5)) { norm_phase<1>(args, F, l); SEAM(pb + 5); }
        if (IN(pb + 6)) { gather_phase(args, F, l); SEAM(pb + 6); }
        if (IN(pb + 7)) {
            pg8::Gemm g{(const bf16*)(ws + WS_QKV), (const bf16*)(ws + WS_W13) + (size_t)l * 16384 * DM, MAXROWS, 16384, DM};
            pg8::MoeOrder S; S.init((const unsigned*)(F.ctl + CW_CNT + 64 * l), 2, F.G, (int)blockIdx.x);
            pg8::EpiSwiGLU E{(bf16*)(ws + WS_ACT)};
            pg8::gemm_phase<pg8::EpiSwiGLU, pg8::MoeOrder, PG8_ALIGN, PG8_SP2>(F.lds + RING_OFF, g, S, E);
            SEAM(pb + 7);
        }
        if (IN(pb + 8)) {
            pg8::Gemm g{(const bf16*)(ws + WS_ACT), (const bf16*)(ws + WS_W2) + (size_t)l * 32768 * FFE, MAXROWS, 32768, FFE};
            pg8::MoeOrder S; S.init((const unsigned*)(F.ctl + CW_CNT + 64 * l), 3, F.G, (int)blockIdx.x);
            pg8::EpiBf16<0> E{(bf16*)(ws + WS_OSL), DM, nullptr, DM, 0, 1.f};
            pg8::gemm_phase<pg8::EpiBf16<0>, pg8::MoeOrder, PG8_ALIGN, PG8_SP2>(F.lds + RING_OFF, g, S, E);
            SEAM(pb + 8);
        }
}
#undef IN
#undef SEAM
__global__ void __launch_bounds__(NWAVES * 64, 2) skel_fwd(Args args) {
    extern __shared__ __attribute__((aligned(16))) unsigned char lds[];
    Frame F;
    F.lds = (LAS unsigned char*)lds;
    F.MISC = (volatile LAS unsigned*)(F.lds + MISC_OFF);
    F.tid = threadIdx.x; F.lane = F.tid & 63; F.wave = __builtin_amdgcn_readfirstlane(F.tid >> 6);
    F.G = gridDim.x; { const int bx = blockIdx.x; F.vcu = (F.G % 8 == 0) ? (bx % 8) * (F.G / 8) + bx / 8 : bx; }
    unsigned char* ws = args.ws;
    F.ctl = (gu32*)(ws + WS_CTL);
    for (int u = F.tid; u < (LDS_BYTES - LDSCTL_OFF) / 4; u += NWAVES * 64) ((LAS unsigned*)(F.lds + LDSCTL_OFF))[u] = 0u;
    __syncthreads();
    const int lo = args.ph_lo, hi = args.ph_hi;
    XcdBarrier bar; bar.bar = (unsigned*)(F.ctl + CW_BAR); bar.x = 0; bar.st = nullptr;
    if (hi - lo > 1) bar = xcd_barrier_post((unsigned*)(F.ctl + CW_BAR), F.MISC + 8);
#define IN(k) (lo <= (k) && (k) < hi)
#define SEAM(k) do { if (IN(k) && IN((k) + 1)) xcd_barrier(bar); } while (0)

    if (IN(0)) { p0_prologue(args, F); SEAM(0); }
    layer_phases<0>(args, F, bar, lo, hi);
    layer_phases<1>(args, F, bar, lo, hi);
    if (IN(19)) norm_phase<3>(args, F, 1);
#undef IN
#undef SEAM
}

extern "C" void kernel_launch(void* const* d_in, const int* in_sizes, int n_in, void* d_out, int out_size, void* d_ws, size_t ws_size, hipStream_t stream) {
    static int grid = 0;
    if (grid == 0) {
        if (n_in != 22 || in_sizes[0] != M * DM || out_size != M * DM || ws_size < WS_END) { fprintf(stderr, "kernel_launch: unexpected shapes (n_in %d, in0 %d, out %d, ws %zu; need ws >= %zu); nothing launched\n", n_in, n_in > 0 ? in_sizes[0] : -1, out_size, ws_size, (size_t)WS_END); grid = -1; return; }
        int dev = 0, cus = 0, per_cu = 0;
        if (hipGetDevice(&dev) != hipSuccess || hipDeviceGetAttribute(&cus, hipDeviceAttributeMultiprocessorCount, dev) != hipSuccess) { grid = -1; return; }
        if (hipFuncSetAttribute((const void*)skel_fwd, hipFuncAttributeMaxDynamicSharedMemorySize, LDS_BYTES) != hipSuccess) { fprintf(stderr, "kernel_launch: hipFuncSetAttribute failed\n"); grid = -1; return; }
        if (hipOccupancyMaxActiveBlocksPerMultiprocessor(&per_cu, (const void*)skel_fwd, NWAVES * 64, LDS_BYTES) != hipSuccess || per_cu < 1) { fprintf(stderr, "kernel_launch: occupancy query says %d blocks per CU\n", per_cu); }
        (void)hipGetLastError();
        grid = cus;
    }
    if (grid < 0) return;
    if (hipMemsetAsync((char*)d_ws + WS_CTL, 0, CTL_ZERO_BYTES, stream) != hipSuccess) return;
    Args a{};
    for (int i = 0; i < 22; ++i) a.in[i] = (const float*)d_in[i];
    a.out = (float*)d_out; a.ws = (unsigned char*)d_ws;
#if ONE_LAUNCH
    a.ph_lo = 0; a.ph_hi = N_PHASES;
    hipLaunchKernelGGL(skel_fwd, dim3(grid), dim3(NWAVES * 64), LDS_BYTES, stream, a);
#else
    unsigned char* ws = (unsigned char*)d_ws;
    for (int p = 0; p < N_PHASES; ++p) {
        if (p == 12) continue;
#if NAIVE_ATTN
        if (p == 4) {
            naive_attn<0><<<M * 8 / 4, 256, 0, stream>>>((const bf16*)(ws + WS_QKV), (bf16*)(ws + WS_MRG), nullptr, nullptr, (const float*)(ws + WS_LAM), (const float*)d_in[I_SUBLN]);
            naive_attn<1><<<M * 8 / 4, 256, 0, stream>>>((const bf16*)(ws + WS_QKV), (bf16*)(ws + WS_MRG), nullptr, (const float*)(ws + WS_KMEAN), nullptr, nullptr);
            continue; }
        if (p == 13) { naive_attn<2><<<M * 16 / 4, 256, 0, stream>>>((const bf16*)(ws + WS_QKV), (bf16*)(ws + WS_MRG), (const float*)(ws + WS_CUM), nullptr, nullptr, nullptr); continue; }
#endif
        a.ph_lo = p; a.ph_hi = p + 1;
        hipLaunchKernelGGL(skel_fwd, dim3(grid), dim3(NWAVES * 64), LDS_BYTES, stream, a);
    }
#endif
}
```

```cpp
#include <hip/hip_runtime.h>
#include <cstdio>
#include <cstdint>
namespace pg8 {
#define PG8_LAS __attribute__((address_space(3)))
typedef unsigned short bf16_t;
typedef short bf16x8 __attribute__((ext_vector_type(8)));
typedef float f32x4 __attribute__((ext_vector_type(4)));
typedef unsigned u32x4 __attribute__((ext_vector_type(4)));
constexpr int BM = 256, BK = 64, HALF = 128, HTB = HALF * BK * 2  , STAGE_BYTES = 8 * HTB, NXCD = 8, WGM = 8;

__host__ __device__ __forceinline__ int lds_byte(int r, int c) { const int st = (r >> 4) * 2 + (c >> 5), rr = r & 15, cc = c & 31, ob = rr * 64 + cc * 2; return st * 1024 + (ob ^ (((ob >> 9) & 1) << 5)); }
__host__ __device__ __forceinline__ void stage_rc(int b, int& R, int& C) { const int st = b / 1024, sb = b % 1024, swz = sb ^ (((sb >> 9) & 1) << 5); R = (st >> 1) * 16 + swz / 64; C = (st & 1) * 32 + (swz % 64) / 2; }
__host__ __device__ __forceinline__ int perm32(int rho) { const int n = rho >> 4, i = rho & 15; return 8 * (i >> 2) + 4 * n + (i & 3); }

struct Unit { int pm, pn; };
struct Gemm { const bf16_t* A; const bf16_t* Bt; int M, N, K; };

struct StaticOrder {
    int nM, nN, nwg, G, c;
    __host__ __device__ void init(int M, int N, int G_, int c_) { nM = M / BM; nN = N / BM; nwg = nM * nN; G = G_; c = c_; }
    __host__ __device__ bool next(int i, Unit& u) const {
        const long L = (long)i * G + c; if (L >= nwg) return false;
        int wgid = (int)L; { const int q = nwg / NXCD, r = nwg % NXCD, xcd = wgid % NXCD, off = wgid / NXCD; wgid = (xcd < r ? xcd * (q + 1) : r * (q + 1) + (xcd - r) * q) + off; }
        const int nig = WGM * nN, gid = wgid / nig, fm = gid * WGM, gsz = (nM - fm) < WGM ? (nM - fm) : WGM;
        u.pm = fm + ((wgid % nig) % gsz); u.pn = (wgid % nig) / gsz; return true;
    }
    __device__ __forceinline__ void a_ready(const Unit&) const {}
    __device__ __forceinline__ void done(const Unit&) const {}
};

__device__ __forceinline__ unsigned cvt_pk_bf16(float lo, float hi) { unsigned r; asm volatile("v_cvt_pk_bf16_f32 %0, %1, %2" : "=v"(r) : "v"(lo), "v"(hi)); return r; }
typedef float f32x2 __attribute__((ext_vector_type(2)));
__device__ __forceinline__ f32x2 gelu_pk(f32x2 v) {
    const f32x2 av = __builtin_elementwise_abs(v), d = av * 0.2316418882f + 1.0f;
    f32x2 t; t.x = __builtin_amdgcn_rcpf(d.x); t.y = __builtin_amdgcn_rcpf(d.y);
    f32x2 q = t * 0.5307027145f + (-0.7265760135f); q = q * t + 0.7107068705f; q = q * t + (-0.142248368f); q = q * t + 0.127414796f; q = q * t;
    const f32x2 s = (v * v) * (-0.72134752044f);
    f32x2 e; e.x = __builtin_amdgcn_exp2f(s.x); e.y = __builtin_amdgcn_exp2f(s.y);
    const f32x2 m = v * (q * e), r = v - m;
    f32x2 o; o.x = v.x < 0.f ? m.x : r.x; o.y = v.y < 0.f ? m.y : r.y; return o;
}

template <int ACT  > struct EpiBf16 {
    static constexpr bool PERM = true, AFTER_DRAIN = false; static_assert(ACT == 0 || ACT == 1, "EpiBf16: ACT is 0 (none) or 1 (gelu_pk)");
    bf16_t* O; int ldc; const float* bias; int split_cols; size_t split_stride; float scale0;
    __device__ __forceinline__ void operator()(const f32x4 (&acc)[2][2][4][2], const Unit& u, int wr, int wc, int fr, int fq) const {
        const int row0 = u.pm * BM + wr * 64 + fr; int colt = u.pn * BM; bf16_t* base = O;
        float sc = 1.f; if (split_cols) { const int t = colt / split_cols; base += (size_t)t * split_stride; colt -= t * split_cols; if (t == 0) sc = scale0; }
        const int col0 = colt + wc * 32 + 8 * fq, bcol0 = u.pn * BM + wc * 32 + 8 * fq;
        f32x4 bv[2][2];
#pragma unroll
        for (int bj = 0; bj < 2; ++bj)
#pragma unroll
            for (int n = 0; n < 2; ++n) bv[bj][n] = bias ? *(const f32x4*)(bias + bcol0 + bj * HALF + 4 * n) : (f32x4){0.f, 0.f, 0.f, 0.f};
#pragma unroll
        for (int ai = 0; ai < 2; ++ai)
#pragma unroll
            for (int m = 0; m < 4; ++m) { bf16_t* rowp = base + (size_t)(row0 + ai * HALF + m * 16) * ldc + col0;
#pragma unroll
                for (int bj = 0; bj < 2; ++bj) { f32x4 v0 = acc[ai][bj][m][0] + bv[bj][0], v1 = acc[ai][bj][m][1] + bv[bj][1];
                    if (ACT == 1) { f32x2 a = gelu_pk((f32x2){v0[0], v0[1]}), b = gelu_pk((f32x2){v0[2], v0[3]}), c = gelu_pk((f32x2){v1[0], v1[1]}), d = gelu_pk((f32x2){v1[2], v1[3]});
                        v0 = (f32x4){a.x, a.y, b.x, b.y}; v1 = (f32x4){c.x, c.y, d.x, d.y}; }
                    v0 = v0 * sc; v1 = v1 * sc; u32x4 w; w.x = cvt_pk_bf16(v0[0], v0[1]); w.y = cvt_pk_bf16(v0[2], v0[3]); w.z = cvt_pk_bf16(v1[0], v1[1]); w.w = cvt_pk_bf16(v1[2], v1[3]);
                    *(u32x4*)(rowp + bj * HALF) = w; } }
    }
};

struct EpiResid {
    static constexpr bool PERM = false, AFTER_DRAIN = false;
    const float* base; float* out; const float* gate; int gate_bstride; int rows_per_batch;
    __device__ __forceinline__ void operator()(const f32x4 (&acc)[2][2][4][2], const Unit& u, int wr, int wc, int fr, int fq) const {
        const int row0 = u.pm * BM + wr * 64 + fr, col0 = u.pn * BM + wc * 32 + 4 * fq;
        const float* gp = gate + (size_t)((u.pm * BM) / rows_per_batch) * gate_bstride + col0;
        f32x4 gv[2][2];
#pragma unroll
        for (int bj = 0; bj < 2; ++bj)
#pragma unroll
            for (int n = 0; n < 2; ++n) gv[bj][n] = *(const f32x4*)(gp + bj * HALF + n * 16);
#pragma unroll
        for (int ai = 0; ai < 2; ++ai)
#pragma unroll
            for (int m = 0; m < 4; ++m) { const size_t off = (size_t)(row0 + ai * HALF + m * 16) * 2048 + col0;
#pragma unroll
                for (int bj = 0; bj < 2; ++bj)
#pragma unroll
                    for (int n = 0; n < 2; ++n) { const f32x4 bs = *(const f32x4*)(base + off + bj * HALF + n * 16);
                        *(f32x4*)(out + off + bj * HALF + n * 16) = bs + gv[bj][n] * acc[ai][bj][m][n]; }
                if (m & 1) asm volatile("" ::: "memory"); }
    }
};
struct EpiSwiGLU {
    static constexpr bool PERM = true, AFTER_DRAIN = false;
    bf16_t* O;
    __device__ __forceinline__ void operator()(const f32x4 (&acc)[2][2][4][2], const Unit& u, int wr, int wc, int fr, int fq) const {
        const int row0 = u.pm * BM + wr * 64 + fr; const int f0 = (u.pn & 3) * 128 + wc * 16 + 4 * fq;
#pragma unroll
        for (int ai = 0; ai < 2; ++ai)
#pragma unroll
            for (int m = 0; m < 4; ++m) { bf16_t* rowp = O + (size_t)(row0 + ai * HALF + m * 16) * 512 + f0;
#pragma unroll
                for (int bj = 0; bj < 2; ++bj) { const f32x4 v0 = acc[ai][bj][m][0], v1 = acc[ai][bj][m][1];
                    float r[4]; const float a[4] = {v0[0], v0[2], v1[0], v1[2]}, b[4] = {v0[1], v0[3], v1[1], v1[3]};
#pragma unroll
                    for (int q = 0; q < 4; ++q) r[q] = a[q] * b[q] * __builtin_amdgcn_rcpf(1.0f + __builtin_amdgcn_exp2f(-1.4426950408889634f * a[q]));
                    typedef unsigned u32x2 __attribute__((ext_vector_type(2)));
                    u32x2 w; w.x = cvt_pk_bf16(r[0], r[1]); w.y = cvt_pk_bf16(r[2], r[3]);
                    *(u32x2*)(rowp + bj * 64) = w; } }
    }
};
struct MoeOrder {
    unsigned pk[4]; int njs, G, c;
    __device__ __forceinline__ void init(const unsigned* cnt, int njs_, int G_, int c_) {
        njs = njs_; G = G_; c = c_; unsigned t = 0; pk[0] = pk[1] = pk[2] = pk[3] = 0u;
#pragma unroll
        for (int e = 0; e < 16; ++e) { t += (__builtin_amdgcn_readfirstlane(cnt[e]) + 255u) >> 8; pk[e >> 2] |= t << (8 * (e & 3)); }
    }
    __device__ __forceinline__ bool next(int i, Unit& u) const {
        const int L = i * G + c, rt = L >> njs, j = L & ((1 << njs) - 1);
        if (rt >= (int)(pk[3] >> 24)) return false;
        int e = 0;
#pragma unroll
        for (int q = 0; q < 16; ++q) e += ((int)((pk[q >> 2] >> (8 * (q & 3))) & 255u) <= rt) ? 1 : 0;
        u.pm = rt; u.pn = (e << njs) + j; return true;
    }
    __device__ __forceinline__ void a_ready(const Unit&) const {}
    __device__ __forceinline__ void done(const Unit&) const {}
};

template <class Epi, class Sched, bool ALIGN_EPI = false, bool SP2 = false>
__device__ __forceinline__ void gemm_phase(PG8_LAS unsigned char* lds, const Gemm g, const Sched& S, const Epi& E) {
    int tid_ = threadIdx.x; asm volatile("" : "+v"(tid_));
    const int tid = tid_, wid = __builtin_amdgcn_readfirstlane(tid >> 6), lane = tid & 63, wr = wid >> 2, wc = wid & 3, fr = lane & 15, fq = lane >> 4;
    const int K = g.K, nt = K / BK;
    unsigned voffA[2], voffB[2];
#pragma unroll
    for (int i = 0; i < 2; ++i) { int R, C; stage_rc(tid * 16 + i * 8192, R, C); const int Rb = Epi::PERM ? ((R & ~31) + perm32(R & 31)) : R;
        voffA[i] = (unsigned)(R * K + C) * 2u; voffB[i] = (unsigned)(Rb * K + C) * 2u; }
    const size_t kstep = (size_t)(BK * 2);
    const size_t hstep = (size_t)HALF * K * 2;
    const size_t tstep = 2 * hstep;
    const unsigned ldsw = (unsigned)wid * 1024u;
    const int aoff = lds_byte(wr * 64 + fr, fq * 8), boff = lds_byte(wc * 32 + fr, fq * 8);
#define PG8_SA(b, h) (((b) * 2 + (h)) * HTB)
#define PG8_SB(b, h) ((4 + (b) * 2 + (h)) * HTB)
#define PG8_STAGE(bufoff, gbase, voff) do { _Pragma("unroll") for (int _i = 0; _i < 2; ++_i) \
        __builtin_amdgcn_global_load_lds((const unsigned*)((const char*)(gbase) + (voff)[_i]), (PG8_LAS unsigned*)(lds + (bufoff) + ldsw + _i * 8192), 16, 0, 0); } while (0)
#define PG8_LDA(dst, b, h) do { _Pragma("unroll") for (int m = 0; m < 4; ++m) _Pragma("unroll") for (int k = 0; k < 2; ++k) dst[m][k] = *(const PG8_LAS bf16x8*)(lds + PG8_SA(b, h) + aoff + m * 2048 + k * 1024); } while (0)
#define PG8_LDB(dst, b, h) do { _Pragma("unroll") for (int n = 0; n < 2; ++n) _Pragma("unroll") for (int k = 0; k < 2; ++k) dst[n][k] = *(const PG8_LAS bf16x8*)(lds + PG8_SB(b, h) + boff + n * 2048 + k * 1024); } while (0)
#define PG8_MMA(ai, bj, At, Bt) do { __builtin_amdgcn_s_setprio(1); _Pragma("unroll") for (int m = 0; m < 4; ++m) _Pragma("unroll") for (int n = 0; n < 2; ++n) _Pragma("unroll") for (int k = 0; k < 2; ++k) \
        acc[ai][bj][m][n] = __builtin_amdgcn_mfma_f32_16x16x32_bf16(Bt[n][k], At[m][k], acc[ai][bj][m][n], 0, 0, 0); __builtin_amdgcn_s_setprio(0); } while (0)
#define PG8_WAIT_V(n) asm volatile("s_waitcnt vmcnt(" #n ")" ::: "memory")
#define PG8_WAIT_L(n) asm volatile("s_waitcnt lgkmcnt(" #n ")" ::: "memory")
#define PG8_BAR __builtin_amdgcn_s_barrier()
#define PG8_SCHED __builtin_amdgcn_sched_barrier(0)
    Unit cur, nxt; int ui = 0;
    if (!S.next(0, cur)) return;
    f32x4 acc[2][2][4][2];
#pragma unroll
    for (int a = 0; a < 2; ++a)
#pragma unroll
        for (int b = 0; b < 2; ++b)
#pragma unroll
            for (int m = 0; m < 4; ++m)
#pragma unroll
                for (int n = 0; n < 2; ++n) acc[a][b][m][n] = (f32x4){0.f, 0.f, 0.f, 0.f};
    bf16x8 At[4][2], B0[2][2], B1[2][2];
    const char* cA = (const char*)g.A + (size_t)cur.pm * tstep; const char* cB = (const char*)g.Bt + (size_t)cur.pn * tstep;
    S.a_ready(cur);
    if constexpr (SP2) {
        PG8_STAGE(PG8_SB(0, 0), cB, voffB); PG8_STAGE(PG8_SB(0, 1), cB + hstep, voffB); PG8_STAGE(PG8_SA(0, 0), cA, voffA); PG8_STAGE(PG8_SA(0, 1), cA + hstep, voffA);
        if (wr == 1) PG8_BAR;
        PG8_WAIT_V(2); PG8_BAR;
        PG8_STAGE(PG8_SB(1, 0), cB + kstep, voffB); PG8_STAGE(PG8_SA(1, 0), cA + kstep, voffA); PG8_STAGE(PG8_SB(1, 1), cB + hstep + kstep, voffB);
        PG8_WAIT_V(6); PG8_BAR;
    } else {
        PG8_STAGE(PG8_SB(0, 0), cB, voffB); PG8_STAGE(PG8_SA(0, 0), cA, voffA); PG8_STAGE(PG8_SB(0, 1), cB + hstep, voffB); PG8_STAGE(PG8_SA(0, 1), cA + hstep, voffA);
        if (wr == 1) PG8_BAR;
        PG8_WAIT_V(4); PG8_BAR;
        PG8_STAGE(PG8_SB(1, 0), cB + kstep, voffB); PG8_STAGE(PG8_SA(1, 0), cA + kstep, voffA); PG8_STAGE(PG8_SB(1, 1), cB + hstep + kstep, voffB);
        PG8_WAIT_V(6); PG8_BAR;
    }
    for (;;) {
        const bool has_next = S.next(ui + 1, nxt);
        const char* nA = has_next ? (const char*)g.A + (size_t)nxt.pm * tstep : cA; const char* nB = has_next ? (const char*)g.Bt + (size_t)nxt.pn * tstep : cB;
        for (int t = 0; t < nt; t += 2) {
            const bool last = (t == nt - 2);
            const char* a1 = cA + (size_t)(t + 1) * kstep;
            const char* a2 = last ? nA : cA + (size_t)(t + 2) * kstep; const char* b2 = last ? nB : cB + (size_t)(t + 2) * kstep;
            const char* a3 = a2 + kstep; const char* b3 = b2 + kstep;
            if (last && has_next) S.a_ready(nxt);
            if constexpr (SP2) {
            PG8_LDB(B0, 0, 0); PG8_LDB(B1, 0, 1); PG8_SCHED; PG8_LDA(At, 0, 0); PG8_STAGE(PG8_SA(1, 1), a1 + hstep, voffA);
            PG8_WAIT_V(8); PG8_WAIT_L(0); PG8_BAR; PG8_MMA(0, 0, At, B0); PG8_MMA(0, 1, At, B1); PG8_BAR; PG8_SCHED;
            PG8_LDA(At, 0, 1); PG8_STAGE(PG8_SB(0, 0), b2, voffB); PG8_STAGE(PG8_SB(0, 1), b2 + hstep, voffB); PG8_STAGE(PG8_SA(0, 0), a2, voffA);
            PG8_WAIT_V(8); PG8_WAIT_L(0); PG8_BAR; PG8_MMA(1, 0, At, B0); PG8_MMA(1, 1, At, B1); PG8_BAR; PG8_SCHED;
            PG8_LDB(B0, 1, 0); PG8_LDB(B1, 1, 1); PG8_SCHED; PG8_LDA(At, 1, 0); PG8_STAGE(PG8_SA(0, 1), a2 + hstep, voffA);
            PG8_WAIT_V(8); PG8_WAIT_L(0); PG8_BAR; PG8_MMA(0, 0, At, B0); PG8_MMA(0, 1, At, B1); PG8_BAR; PG8_SCHED;
            PG8_LDA(At, 1, 1); PG8_STAGE(PG8_SB(1, 0), b3, voffB); PG8_STAGE(PG8_SB(1, 1), b3 + hstep, voffB); PG8_STAGE(PG8_SA(1, 0), a3, voffA);
            PG8_WAIT_V(8); PG8_WAIT_L(0); PG8_BAR; PG8_MMA(1, 0, At, B0); PG8_MMA(1, 1, At, B1); PG8_BAR; PG8_SCHED;
            } else {
            PG8_LDB(B0, 0, 0); PG8_SCHED; PG8_LDA(At, 0, 0); PG8_STAGE(PG8_SA(1, 1), a1 + hstep, voffA);
            PG8_WAIT_L(8); PG8_BAR; PG8_WAIT_L(0); PG8_MMA(0, 0, At, B0); PG8_BAR; PG8_SCHED;
            PG8_LDB(B1, 0, 1); PG8_STAGE(PG8_SB(0, 0), b2, voffB);
            PG8_BAR; PG8_WAIT_L(0); PG8_MMA(0, 1, At, B1); PG8_BAR;
            PG8_LDA(At, 0, 1); PG8_STAGE(PG8_SA(0, 0), a2, voffA);
            PG8_BAR; PG8_WAIT_L(0); PG8_MMA(1, 0, At, B0); PG8_BAR; PG8_SCHED;
            PG8_STAGE(PG8_SB(0, 1), b2 + hstep, voffB);
            PG8_WAIT_V(6); PG8_BAR; PG8_MMA(1, 1, At, B1); PG8_BAR;
            PG8_LDB(B0, 1, 0); PG8_SCHED; PG8_LDA(At, 1, 0); PG8_STAGE(PG8_SA(0, 1), a2 + hstep, voffA);
            PG8_WAIT_L(8); PG8_BAR; PG8_WAIT_L(0); PG8_MMA(0, 0, At, B0); PG8_BAR; PG8_SCHED;
            PG8_LDB(B1, 1, 1); PG8_STAGE(PG8_SB(1, 0), b3, voffB);
            PG8_BAR; PG8_WAIT_L(0); PG8_MMA(0, 1, At, B1); PG8_BAR;
            PG8_LDA(At, 1, 1); PG8_STAGE(PG8_SA(1, 0), a3, voffA);
            PG8_BAR; PG8_WAIT_L(0); PG8_MMA(1, 0, At, B0); PG8_BAR; PG8_SCHED;
            PG8_STAGE(PG8_SB(1, 1), b3 + hstep, voffB);
            PG8_WAIT_V(6); PG8_BAR; PG8_MMA(1, 1, At, B1); PG8_BAR;
            }
        }
        if constexpr (ALIGN_EPI) { if (wr == 0) PG8_BAR; }
        if constexpr (!Epi::AFTER_DRAIN) { E(acc, cur, wr, wc, fr, fq); S.done(cur); }
        if (!has_next) break;
#pragma unroll
        for (int a = 0; a < 2; ++a)
#pragma unroll
            for (int b = 0; b < 2; ++b)
#pragma unroll
                for (int m = 0; m < 4; ++m)
#pragma unroll
                    for (int n = 0; n < 2; ++n) acc[a][b][m][n] = (f32x4){0.f, 0.f, 0.f, 0.f};
        cur = nxt; cA = nA; cB = nB; ++ui;
        if constexpr (ALIGN_EPI) { if (wr == 1) PG8_BAR; }
    }
    PG8_WAIT_V(0);
    if constexpr (!ALIGN_EPI) { if (wr == 0) PG8_BAR; }
    PG8_BAR;
    if constexpr (Epi::AFTER_DRAIN) { E.fused(acc, cur, wr, wc, fr, fq, lds, wid, lane); S.done(cur); }
#undef PG8_SA
#undef PG8_SB
#undef PG8_STAGE
#undef PG8_LDA
#undef PG8_LDB
#undef PG8_MMA
#undef PG8_WAIT_V
#undef PG8_WAIT_L
#undef PG8_BAR
#undef PG8_SCHED
}
}

#ifndef PG8_SP2
#define PG8_SP2 true
#endif
#ifndef PG8_ALIGN
#define PG8_ALIGN true
#endif
constexpr int NWAVES = 8;
constexpr int BATCH = 2, SEQ = 8192, DM = 2048, M = BATCH * SEQ;
constexpr int NQKV = 6144, NQKV_ODD = 6160;
constexpr int NE = 16, FFE = 512;
constexpr int MODW = 6 * DM;
constexpr float EPS = 1e-6f;
constexpr int MAXROWS = 36864;

constexpr size_t MiB = 1u << 20;
constexpr size_t WS_CTL = 0, CTL_ZERO_BYTES = 1 * MiB;
constexpr size_t WS_MOD = 1 * MiB;
constexpr size_t WS_LAM = WS_MOD + 2 * 2 * MODW * 4;
constexpr size_t WS_KMEAN = 2 * MiB;
constexpr size_t WS_WFG = 3 * MiB;
constexpr size_t WS_WRT = 3 * MiB + 128 * 1024;
constexpr size_t WS_ROUTE = 4 * MiB;
constexpr size_t WS_LOGF = 5 * MiB;
constexpr size_t WS_CUM = 6 * MiB;
constexpr size_t WS_SCR = 8 * MiB;
constexpr size_t WS_WIN = 40 * MiB;
constexpr size_t WS_WOUT = 88 * MiB;
constexpr size_t WS_W13 = 104 * MiB;
constexpr size_t WS_W2 = 232 * MiB;
constexpr size_t WS_H = 296 * MiB;
constexpr size_t WS_QKV = 360 * MiB;
constexpr size_t WS_MRG = 552 * MiB;
constexpr size_t WS_ACT = 616 * MiB;
constexpr size_t WS_OSL = 652 * MiB;
constexpr size_t WS_END = 796 * MiB;
constexpr int CW_TMO = 0;
constexpr int CW_CNT = 1024;
constexpr int CW_BAR = 4096;

constexpr int RING_OFF = 0, RING_BYTES = 131072;
constexpr int LDSCTL_OFF = RING_BYTES, MISC_OFF = LDSCTL_OFF + 320;
constexpr int LDS_BYTES = 147456;

#define GAS __attribute__((address_space(1)))
#define LAS __attribute__((address_space(3)))
typedef unsigned short bf16;
typedef unsigned v4u __attribute__((ext_vector_type(4)));
typedef unsigned v2u __attribute__((ext_vector_type(2)));
typedef float f32x4 __attribute__((ext_vector_type(4)));
typedef float f32x16 __attribute__((ext_vector_type(16)));
typedef short bf16x8 __attribute__((ext_vector_type(8)));
typedef short s16x4 __attribute__((ext_vector_type(4)));
typedef GAS unsigned gu32;
#define RLX_AGENT __ATOMIC_RELAXED, __HIP_MEMORY_SCOPE_AGENT
#define LDS_WAIT() asm volatile("s_waitcnt lgkmcnt(0)" ::: "memory")
#define VM_WAIT() asm volatile("s_waitcnt vmcnt(0)" ::: "memory")
__device__ __forceinline__ unsigned f2bf(float f) { unsigned u = __builtin_bit_cast(unsigned, f); return (u + 0x7fffu + ((u >> 16) & 1u)) >> 16; }
__device__ __forceinline__ unsigned pk2(float lo, float hi) { return f2bf(lo) | (f2bf(hi) << 16); }
__device__ __forceinline__ float bflo(unsigned w) { return __builtin_bit_cast(float, w << 16); }
__device__ __forceinline__ float bfhi(unsigned w) { return __builtin_bit_cast(float, w & 0xffff0000u); }
__device__ __forceinline__ int opaque_tid() { int t = threadIdx.x; asm volatile("" : "+v"(t)); return t; }
__device__ __forceinline__ float wave_sum(float v) {
#pragma unroll
    for (int o = 1; o < 64; o <<= 1) v += __shfl_xor(v, o);
    return v;
}
__device__ __forceinline__ float wave_max(float v) {
#pragma unroll
    for (int o = 1; o < 64; o <<= 1) v = fmaxf(v, __shfl_xor(v, o));
    return v;
}
#define XB_TMO      128
#define XB_XCNT(j)  (256  + 64 * (j))
#define XB_XSUB(j)  (1280 + 64 * (j))
#define XB_XGEN(j)  (2304 + 64 * (j))
#define XB_TOP      3328
#define XB_TOPGEN   3392
#define XCD_BAR_WORDS 3456
#define XB_SPIN_CAP (1u << 18)

__device__ __forceinline__ unsigned xb_ld(unsigned* p)              { return __hip_atomic_load(p, __ATOMIC_RELAXED, __HIP_MEMORY_SCOPE_AGENT); }
__device__ __forceinline__ unsigned xb_add(unsigned* p, unsigned v) { return __hip_atomic_fetch_add(p, v, __ATOMIC_RELAXED, __HIP_MEMORY_SCOPE_AGENT); }
__device__ __forceinline__ unsigned xb_xcc_id() { return (unsigned)__builtin_amdgcn_s_getreg((3 << 11) | 20) & 0xFu; }
#define XB_SPIN(cond, bar) do { unsigned _sp = 0; while (cond) { __builtin_amdgcn_s_sleep(1); \
    if ((++_sp & 255u) == 0u) { if (xb_ld(&(bar)[XB_TMO])) break; if (_sp > XB_SPIN_CAP) { atomicAdd(&(bar)[XB_TMO], 1u); break; } } } } while (0)

struct XcdBarrier {
    unsigned* bar; unsigned x;
    volatile LAS unsigned* st;
};

__device__ __forceinline__ XcdBarrier xcd_barrier_post(unsigned* bar, volatile LAS unsigned* st) {
    XcdBarrier b; b.bar = bar; b.x = xb_xcc_id(); b.st = st;
    if (threadIdx.x == 0) (void)xb_add(&bar[XB_XCNT(b.x)], 1u);
    return b;
}
__device__ __forceinline__ void xcd_barrier_complete(unsigned* bar, unsigned x, unsigned& nloc, unsigned& nx) {
    const unsigned G = gridDim.x * gridDim.y * gridDim.z;
    unsigned sum, cnt, mine, sp = 0u;
    for (;;) {
        sum = 0u; cnt = 0u; mine = 0u;
#pragma unroll
        for (unsigned j = 0; j < 16; ++j) { const unsigned c = xb_ld(&bar[XB_XCNT(j)]); sum += c; cnt += (c > 0u) ? 1u : 0u; mine = (j == x) ? c : mine; }
        if (sum == G) break;
        __builtin_amdgcn_s_sleep(1);
        if ((++sp & 255u) == 0u) { if (xb_ld(&bar[XB_TMO])) break; if (sp > XB_SPIN_CAP) { atomicAdd(&bar[XB_TMO], 1u); break; } }
    }
    nloc = mine > 0u ? mine : 1u; nx = cnt > 0u ? cnt : 1u;
}

__device__ __forceinline__ void xcd_barrier(const XcdBarrier& b) {
    asm volatile("s_waitcnt vmcnt(0)" ::: "memory");
    __syncthreads();
    if (threadIdx.x == 0) {
        unsigned* bar = b.bar;
        __builtin_amdgcn_s_waitcnt(0);
        unsigned nloc = b.st[0], nx = b.st[1];
        if (nloc == 0u) { xcd_barrier_complete(bar, b.x, nloc, nx); b.st[0] = nloc; b.st[1] = nx; }
        const unsigned old = xb_add(&bar[XB_XSUB(b.x)], 1u);
        const unsigned gen = old / nloc;
        if (old + 1u == (gen + 1u) * nloc) {
            __builtin_amdgcn_fence(__ATOMIC_RELEASE, "agent");
            asm volatile("s_waitcnt vmcnt(0)" ::: "memory");
            const unsigned og = xb_add(&bar[XB_TOP], 1u);
            const unsigned tg = og / nx;
            if (og + 1u == (tg + 1u) * nx) xb_add(&bar[XB_TOPGEN], 1u);
            else XB_SPIN(xb_ld(&bar[XB_TOPGEN]) == tg, bar);
            __builtin_amdgcn_fence(__ATOMIC_ACQUIRE, "agent");
            xb_add(&bar[XB_XGEN(b.x)], 1u);
            asm volatile("s_waitcnt vmcnt(0)" ::: "memory");
        } else {
            XB_SPIN(xb_ld(&bar[XB_XGEN(b.x)]) == gen, bar);
            __builtin_amdgcn_fence(__ATOMIC_ACQUIRE, "agent");
            asm volatile("s_waitcnt vmcnt(0)" ::: "memory");
        }
    }
    __syncthreads();
}
struct Args { const float* in[22]; float* out; unsigned char* ws; int ph_lo, ph_hi; };
struct Frame { LAS unsigned char* lds; volatile LAS unsigned* MISC; gu32* ctl; int tid, lane, wave, vcu, G; };
enum { I_X = 0, I_C = 1, I_ADAW = 2, I_ADAB = 3, I_ANG = 4, I_FNG = 5, I_WINE = 6, I_WOUTE = 7, I_LQ1 = 8, I_LK1 = 9, I_LQ2 = 10, I_LK2 = 11, I_SUBLN = 12,
       I_WINO = 13, I_BF = 14, I_WOUTO = 15, I_RW = 16, I_RB = 17, I_W1 = 18, I_W3 = 19, I_W2 = 20, I_FING = 21 };

__device__ __forceinline__ void transpose_item(const float* W, int ldw, int K, int ncols, bf16* WT, int row_off, int rs, LAS float* scr, int item, int lane) {
    const int nblk = ncols / 32, kb = item / nblk, nb = item % nblk, k0 = 64 * kb, n0 = 32 * nb;
#pragma unroll 8
    for (int i = 0; i < 32; ++i) { const int kk = 2 * i + (lane >> 5); scr[kk * 33 + (lane & 31)] = W[(size_t)(k0 + kk) * ldw + n0 + (lane & 31)]; }
    LDS_WAIT(); asm volatile("" ::: "memory");
    const int c = lane & 7;
#pragma unroll
    for (int j = 0; j < 4; ++j) { const int n = (lane >> 3) + 8 * j; const LAS float* s = scr + (8 * c) * 33 + n;
        v4u o; o.x = pk2(s[0 * 33], s[1 * 33]); o.y = pk2(s[2 * 33], s[3 * 33]); o.z = pk2(s[4 * 33], s[5 * 33]); o.w = pk2(s[6 * 33], s[7 * 33]);
        *(GAS v4u*)(WT + (size_t)(row_off + (n0 + n) * rs) * K + k0 + 8 * c) = o; }
    LDS_WAIT(); asm volatile("" ::: "memory");
}
__device__ __forceinline__ void p0_prologue(const Args& A, const Frame& F0) {
    Frame F = F0; F.tid = opaque_tid(); F.lane = F.tid & 63; F.wave = __builtin_amdgcn_readfirstlane(F.tid >> 6);
    unsigned char* ws = A.ws;
    for (int it = blockIdx.x; it < 96; it += F.G) {
        LAS float* cond = (LAS float*)(F.lds); LAS float* red = (LAS float*)(F.lds + 16384);
        for (int i = F.tid; i < 4096; i += 512) { const float cv = A.in[I_C][i]; cond[i] = cv / (1.0f + __expf(-cv)); }
        __syncthreads();
        const int l = it / 48, cg = it % 48;
        const float* W = A.in[I_ADAW] + (size_t)l * DM * MODW + cg * 256 + 4 * F.lane;
        f32x4 a0 = {0.f, 0.f, 0.f, 0.f}, a1 = {0.f, 0.f, 0.f, 0.f};
        const int kb = 256 * F.wave;
#pragma unroll 8
        for (int k = 0; k < 256; ++k) { const f32x4 w = *(const f32x4*)(W + (size_t)(kb + k) * MODW); a0 += cond[kb + k] * w; a1 += cond[2048 + kb + k] * w; }
        *(LAS f32x4*)(red + (F.wave * 2 + 0) * 256 + 4 * F.lane) = a0; *(LAS f32x4*)(red + (F.wave * 2 + 1) * 256 + 4 * F.lane) = a1;
        __syncthreads();
        { const int b = F.tid >> 8, n = F.tid & 255; float s = A.in[I_ADAB][l * MODW + cg * 256 + n];
#pragma unroll
          for (int w = 0; w < 8; ++w) s += red[(w * 2 + b) * 256 + n];
          ((float*)(ws + WS_MOD))[(l * 2 + b) * MODW + cg * 256 + n] = s; }
        __syncthreads();
    }
    if (blockIdx.x == 0 && F.tid == 0) { float s1 = 0.f, s2 = 0.f;
        for (int i = 0; i < 64; ++i) { s1 += A.in[I_LQ1][i] * A.in[I_LK1][i]; s2 += A.in[I_LQ2][i] * A.in[I_LK2][i]; }
        *(float*)(ws + WS_LAM) = __expf(s1) - __expf(s2) + 0.2f; }
    for (int i = blockIdx.x * 512 + F.tid; i < 16 * DM; i += F.G * 512) { const int j = i >> 11, k = i & 2047;
        ((float*)(ws + WS_WFG))[i] = A.in[I_WINO][(size_t)k * NQKV_ODD + NQKV + j]; ((float*)(ws + WS_WRT))[i] = A.in[I_RW][k * 16 + j]; }
    LAS float* scr = (LAS float*)(F.lds + F.wave * 16384);
    const int gw = F.vcu * NWAVES + F.wave, NGW = F.G * NWAVES;
    constexpr int I_IN = 32 * 192, I_OUT = 32 * 64, I_MOE = 32 * 512;
    for (int it = gw; it < 2 * I_IN + 2 * I_OUT + 3 * I_MOE; it += NGW) {
        int r = it;
        if (r < I_IN) { transpose_item(A.in[I_WINE], NQKV, DM, NQKV, (bf16*)(ws + WS_WIN), 0, 1, scr, r, F.lane); continue; } r -= I_IN;
        if (r < I_IN) { transpose_item(A.in[I_WINO], NQKV_ODD, DM, NQKV, (bf16*)(ws + WS_WIN) + (size_t)NQKV * DM, 0, 1, scr, r, F.lane); continue; } r -= I_IN;
        if (r < I_OUT) { transpose_item(A.in[I_WOUTE], DM, DM, DM, (bf16*)(ws + WS_WOUT), 0, 1, scr, r, F.lane); continue; } r -= I_OUT;
        if (r < I_OUT) { transpose_item(A.in[I_WOUTO], DM, DM, DM, (bf16*)(ws + WS_WOUT) + (size_t)DM * DM, 0, 1, scr, r, F.lane); continue; } r -= I_OUT;
        if (r < 2 * I_MOE) { const int which = r / I_MOE; r -= which * I_MOE; const int le = r >> 9, l = le >> 4, e = le & 15;
            transpose_item(A.in[which ? I_W3 : I_W1] + (size_t)le * DM * FFE, FFE, DM, FFE, (bf16*)(ws + WS_W13) + (size_t)l * 16384 * DM, e * 1024 + which, 2, scr, r & 511, F.lane); continue; }
        r -= 2 * I_MOE;
        { const int le = r >> 9, l = le >> 4, e = le & 15;
          transpose_item(A.in[I_W2] + (size_t)le * FFE * DM, DM, FFE, DM, (bf16*)(ws + WS_W2) + (size_t)l * 32768 * FFE, e * 2048, 1, scr, r & 511, F.lane); }
    }
}

template <int MODE>
__device__ __forceinline__ void norm_phase(const Args& A, const Frame& F0, int l) {
    Frame F = F0; F.tid = opaque_tid(); F.lane = F.tid & 63; F.wave = __builtin_amdgcn_readfirstlane(F.tid >> 6);
    unsigned char* ws = A.ws;
    constexpr bool SIDE = (MODE == 1 || MODE == 2), COMB = (MODE == 2 || MODE == 3);
    LAS float* WT = (LAS float*)F.lds;
    if (SIDE) { const f32x4* src = (const f32x4*)(ws + (MODE == 1 ? WS_WRT : WS_WFG));
        for (int i = F.tid; i < 16 * DM / 4; i += 512) *(LAS f32x4*)(WT + 4 * i) = src[i];
        __syncthreads(); }
    const float* modl = (const float*)(ws + WS_MOD) + (size_t)l * 2 * MODW;
    const float* gain = MODE == 3 ? A.in[I_FING] : (MODE == 1 ? A.in[I_FNG] + l * DM : A.in[I_ANG] + l * DM);
    const float* xsrc = MODE == 0 ? A.in[I_X] : A.out;
    const float* modprev = (const float*)(ws + WS_MOD) + (size_t)(MODE == 3 ? 1 : 0) * 2 * MODW;
    const unsigned* route = (const unsigned*)(ws + WS_ROUTE);
    const bf16* OSL = (const bf16*)(ws + WS_OSL);
    bf16* H = (bf16*)(ws + WS_H);
    const int gw = F.vcu * NWAVES + F.wave, NGW = F.G * NWAVES, lane = F.lane;
    for (int m = gw; m < M; m += NGW) {
        const int b = m >> 13;
        f32x4 v[8];
        { const f32x4* xr = (const f32x4*)(xsrc + (size_t)m * DM) + lane;
#pragma unroll
          for (int j = 0; j < 8; ++j) v[j] = xr[64 * j]; }
        if (COMB) {
            const unsigned* rt = route + (size_t)m * 6;
            const float w0 = __builtin_bit_cast(float, rt[2]), w1 = __builtin_bit_cast(float, rt[3]);
            const v2u* o0 = (const v2u*)(OSL + (size_t)rt[4] * DM) + lane; const v2u* o1 = (const v2u*)(OSL + (size_t)rt[5] * DM) + lane;
            const f32x4* g2 = (const f32x4*)(modprev + (size_t)b * MODW + 5 * DM) + lane;
#pragma unroll
            for (int j = 0; j < 8; ++j) { const v2u a = o0[64 * j], c = o1[64 * j]; const f32x4 g = g2[64 * j];
                v[j].x += g.x * (w0 * bflo(a.x) + w1 * bflo(c.x)); v[j].y += g.y * (w0 * bfhi(a.x) + w1 * bfhi(c.x));
                v[j].z += g.z * (w0 * bflo(a.y) + w1 * bflo(c.y)); v[j].w += g.w * (w0 * bfhi(a.y) + w1 * bfhi(c.y)); }
            if (MODE == 2) { f32x4* xw = (f32x4*)(A.out + (size_t)m * DM) + lane;
#pragma unroll
                for (int j = 0; j < 8; ++j) xw[64 * j] = v[j]; }
        }
        float ss = 0.f;
#pragma unroll
        for (int j = 0; j < 8; ++j) ss += (v[j].x * v[j].x + v[j].y * v[j].y) + (v[j].z * v[j].z + v[j].w * v[j].w);
        const float rstd = 1.0f / sqrtf(wave_sum(ss) * (1.0f / DM) + EPS);
        if (MODE == 3) {
            f32x4* ow = (f32x4*)(A.out + (size_t)m * DM) + lane; const f32x4* gp = (const f32x4*)gain + lane;
#pragma unroll
            for (int j = 0; j < 8; ++j) ow[64 * j] = v[j] * rstd * gp[64 * j];
            continue;
        }
        { const f32x4* gp = (const f32x4*)gain + lane;
          const f32x4* shp = (const f32x4*)(modl + (size_t)b * MODW + (MODE == 1 ? 3 : 0) * DM) + lane;
          const f32x4* scp = (const f32x4*)(modl + (size_t)b * MODW + (MODE == 1 ? 4 : 1) * DM) + lane;
          v2u* hw = (v2u*)(H + (size_t)m * DM) + lane;
#pragma unroll
          for (int j = 0; j < 8; ++j) { v[j] = v[j] * rstd * gp[64 * j] * (1.0f + scp[64 * j]) + shp[64 * j];
              v2u o; o.x = pk2(v[j].x, v[j].y); o.y = pk2(v[j].z, v[j].w); hw[64 * j] = o; } }
        if (SIDE) {
            float z = 0.f;
#pragma unroll 1
            for (int q = 0; q < 16; ++q) { float d = 0.f;
#pragma unroll
                for (int j = 0; j < 8; ++j) { const f32x4 w = *(const LAS f32x4*)(WT + q * DM + 256 * j + 4 * lane); d += (v[j].x * w.x + v[j].y * w.y) + (v[j].z * w.z + v[j].w * w.w); }
                d = wave_sum(d); if (lane == q) z = d; }
            if (MODE == 2) {
                if (lane < 16) { z += A.in[I_BF][lane]; const float r = z >= 0.f ? -log1pf(__expf(-z)) : z - log1pf(__expf(z));
                    ((float*)(ws + WS_LOGF))[(size_t)m * 16 + lane] = r; }
            } else {
                float aff[16], sel[16];
#pragma unroll
                for (int q = 0; q < 16; ++q) { const float lgq = __shfl(z, q); aff[q] = 1.0f / (1.0f + __expf(-lgq)); sel[q] = aff[q] + A.in[I_RB][q]; }
                int best = 0; float bs = -3.0e38f;
#pragma unroll
                for (int g = 0; g < 4; ++g) { const float a = sel[4 * g], bq = sel[4 * g + 1], c = sel[4 * g + 2], d = sel[4 * g + 3];
                    const float t2 = fmaxf(fmaxf(fmaxf(a + bq, a + c), fmaxf(a + d, bq + c)), fmaxf(bq + d, c + d));
                    if (t2 > bs) { bs = t2; best = g; } }
                float cs[4], ca[4];
#pragma unroll
                for (int i = 0; i < 4; ++i) { cs[i] = sel[i]; ca[i] = aff[i]; }
#pragma unroll
                for (int g = 1; g < 4; ++g) if (best == g) {
#pragma unroll
                    for (int i = 0; i < 4; ++i) { cs[i] = sel[4 * g + i]; ca[i] = aff[4 * g + i]; } }
                int i1 = 0; float s1 = cs[0], a1 = ca[0];
#pragma unroll
                for (int i = 1; i < 4; ++i) if (cs[i] > s1) { s1 = cs[i]; a1 = ca[i]; i1 = i; }
                int i2 = -1; float s2 = -3.0e38f, a2 = 0.f;
#pragma unroll
                for (int i = 0; i < 4; ++i) if (i != i1 && cs[i] > s2) { s2 = cs[i]; a2 = ca[i]; i2 = i; }
                const int e0 = best * 4 + i1, e1 = best * 4 + i2; const float inv = 1.0f / (a1 + a2);
                if (lane == 0) { unsigned* cnt = (unsigned*)(F.ctl + CW_CNT + 64 * l);
                    const unsigned p0 = __hip_atomic_fetch_add(cnt + e0, 1u, RLX_AGENT), p1 = __hip_atomic_fetch_add(cnt + e1, 1u, RLX_AGENT);
                    unsigned* rt = (unsigned*)(ws + WS_ROUTE) + (size_t)m * 6;
                    rt[0] = (unsigned)e0; rt[1] = (unsigned)e1; rt[2] = __builtin_bit_cast(unsigned, a1 * inv); rt[3] = __builtin_bit_cast(unsigned, a2 * inv); rt[4] = p0; rt[5] = p1; }
            }
        }
    }
}
__device__ __forceinline__ void scan_phase(const Args& A, const Frame& F0) {
    Frame F = F0; F.tid = opaque_tid(); F.lane = F.tid & 63; F.wave = __builtin_amdgcn_readfirstlane(F.tid >> 6);
    const float* LOGF = (const float*)(A.ws + WS_LOGF); float* CUM = (float*)(A.ws + WS_CUM);
    LAS float* wt = (LAS float*)F.lds;
    for (int u = blockIdx.x; u < BATCH * 16; u += F.G) {
        const int b = u >> 4, h = u & 15, s0 = F.tid * 16;
        float v[16]; float run = 0.f;
#pragma unroll
        for (int i = 0; i < 16; ++i) { run += LOGF[(size_t)(b * SEQ + s0 + i) * 16 + h]; v[i] = run; }
        float inc = run;
#pragma unroll
        for (int o = 1; o < 64; o <<= 1) { const float t = __shfl_up(inc, o); if (F.lane >= o) inc += t; }
        if (F.lane == 63) wt[F.wave] = inc;
        __syncthreads();
        float base = inc - run;
        for (int w = 0; w < F.wave; ++w) base += wt[w];
        float* dst = CUM + (size_t)(b * 16 + h) * SEQ + s0;
#pragma unroll
        for (int i = 0; i < 16; ++i) dst[i] = -(base + v[i]) * 11.313708498984761f;
        __syncthreads();
    }
}
__device__ __forceinline__ void kmean_phase(const Args& A, const Frame& F0) {
    Frame F = F0; F.tid = opaque_tid(); F.lane = F.tid & 63; F.wave = __builtin_amdgcn_readfirstlane(F.tid >> 6);
    const bf16* QKV = (const bf16*)(A.ws + WS_QKV); float* KM = (float*)(A.ws + WS_KMEAN);
    LAS float* red = (LAS float*)F.lds;
    for (int u = blockIdx.x; u < BATCH * 8 * 32; u += F.G) {
        const int b = u >> 8, h = (u >> 5) & 7, blk = u & 31, c = F.tid & 15, rg = F.tid >> 4;
        float s[8] = {0.f, 0.f, 0.f, 0.f, 0.f, 0.f, 0.f, 0.f};
#pragma unroll
        for (int i = 0; i < 8; ++i) { const v4u w = *(const v4u*)(QKV + (size_t)(b * SEQ + blk * 256 + rg + 32 * i) * NQKV + 4096 + h * 128 + 8 * c);
            s[0] += bflo(w.x); s[1] += bfhi(w.x); s[2] += bflo(w.y); s[3] += bfhi(w.y); s[4] += bflo(w.z); s[5] += bfhi(w.z); s[6] += bflo(w.w); s[7] += bfhi(w.w); }
#pragma unroll
        for (int i = 0; i < 8; ++i) red[rg * 128 + 8 * c + i] = s[i];
        __syncthreads();
        if (F.tid < 128) { float t = 0.f;
#pragma unroll
            for (int r = 0; r < 32; ++r) t += red[r * 128 + F.tid];
            KM[(size_t)u * 128 + F.tid] = t * (1.0f / 256.0f); }
        __syncthreads();
    }
}
__device__ __forceinline__ void gather_phase(const Args& A, const Frame& F0, int l) {
    Frame F = F0; F.tid = opaque_tid(); F.lane = F.tid & 63; F.wave = __builtin_amdgcn_readfirstlane(F.tid >> 6);
    const unsigned* cnt = (const unsigned*)(F.ctl + CW_CNT + 64 * l);
    unsigned basev = 0;
    { unsigned t = 0;
#pragma unroll
      for (int e = 0; e < 16; ++e) { if (F.lane == e) basev = t * 256u; t += (cnt[e] + 255u) >> 8; } }
    unsigned* route = (unsigned*)(A.ws + WS_ROUTE); const bf16* H = (const bf16*)(A.ws + WS_H); bf16* HS = (bf16*)(A.ws + WS_QKV);
    const int gw = F.vcu * NWAVES + F.wave, NGW = F.G * NWAVES;
    for (int m = gw; m < M; m += NGW) {
        unsigned* rt = route + (size_t)m * 6;
        const unsigned e0 = rt[0], e1 = rt[1], p0 = rt[4], p1 = rt[5];
        const unsigned s0 = __shfl(basev, (int)e0) + p0, s1 = __shfl(basev, (int)e1) + p1;
        const v4u* src = (const v4u*)(H + (size_t)m * DM) + F.lane; v4u* d0 = (v4u*)(HS + (size_t)s0 * DM) + F.lane; v4u* d1 = (v4u*)(HS + (size_t)s1 * DM) + F.lane;
        v4u x[4];
#pragma unroll
        for (int j = 0; j < 4; ++j) x[j] = src[64 * j];
#pragma unroll
        for (int j = 0; j < 4; ++j) { d0[64 * j] = x[j]; d1[64 * j] = x[j]; }
        asm volatile("" ::: "memory");
        if (F.lane == 0) { rt[4] = s0; rt[5] = s1; }
    }
}
#ifndef NAIVE_ATTN
#define NAIVE_ATTN 0
#endif
#if NAIVE_ATTN
template <int DQ>
__device__ __forceinline__ void naive_span(const bf16* Kp, const bf16* Vp, const LAS float* q, int kb, int ke, int pos, float scale, float slope, const float* CUMrow, float cq,
                                           float& mrun, float& lrun, float& o0, float& o1, int lane) {
    for (int kc = kb; kc < ke; kc += 64) {
        const int key = kc + lane;
        float s = 0.f;
        { const bf16* kr = Kp + (size_t)key * NQKV;
#pragma unroll
          for (int c = 0; c < DQ / 8; ++c) { const v4u w = *(const v4u*)(kr + 8 * c); const f32x4 qa = *(const LAS f32x4*)(q + 8 * c), qb = *(const LAS f32x4*)(q + 8 * c + 4);
              s += (qa.x * bflo(w.x) + qa.y * bfhi(w.x)) + (qa.z * bflo(w.y) + qa.w * bfhi(w.y)) + (qb.x * bflo(w.z) + qb.y * bfhi(w.z)) + (qb.z * bflo(w.w) + qb.w * bfhi(w.w)); } }
        s = s * scale + (CUMrow ? (CUMrow[key] - cq) * scale : slope * (float)(key - pos));
        if (key > pos || key >= ke) s = -__builtin_inff();
        const float cm = wave_max(s);
        if (cm == -__builtin_inff()) continue;
        const float mn = fmaxf(mrun, cm), al = __expf(mrun - mn), p = __expf(s - mn);
        lrun = lrun * al + wave_sum(p); o0 *= al; o1 *= al; mrun = mn;
        for (int j = 0; j < 64; ++j) { const float pj = __shfl(p, j); const unsigned vv = *(const unsigned*)(Vp + (size_t)(kc + j) * NQKV + 2 * lane); o0 += pj * bflo(vv); o1 += pj * bfhi(vv); }
    }
}
template <int VAR>
__global__ void __launch_bounds__(256) naive_attn(const bf16* __restrict__ QKV, bf16* __restrict__ MRG, const float* __restrict__ CUM, const float* __restrict__ KMEAN,
                                                  const float* __restrict__ lamp, const float* __restrict__ subg) {
    __shared__ float qs[4][128];
    constexpr int NH = VAR == 2 ? 16 : 8;
    const int wave = threadIdx.x >> 6, lane = threadIdx.x & 63;
    const long id = (long)blockIdx.x * 4 + wave; const int m = (int)(id / NH), hh = (int)(id % NH), b = m >> 13, pos = m & 8191;
    const bf16* row = QKV + (size_t)m * NQKV; const bf16* base = QKV + (size_t)b * SEQ * NQKV;
    LAS float* q = (LAS float*)qs[wave];
    if (VAR == 0) {
        const float slope = exp2f(-(2.0f * hh + 1.0f) * 0.5f);
        float O0[2], O1[2];
#pragma unroll
        for (int mp = 0; mp < 2; ++mp) {
            q[lane] = bflo((unsigned)row[hh * 128 + mp * 64 + lane]); __builtin_amdgcn_wave_barrier(); LDS_WAIT();
            float mr = -1e30f, lr = 0.f, o0 = 0.f, o1 = 0.f;
            naive_span<64>(base + 1024 + hh * 128 + mp * 64, base + 2048 + hh * 128, q, 0, pos + 1, pos, 0.125f, slope, nullptr, 0.f, mr, lr, o0, o1, lane);
            O0[mp] = o0 / lr; O1[mp] = o1 / lr; __builtin_amdgcn_wave_barrier();
        }
        const float lam = *lamp; const float a0 = O0[0] - lam * O0[1], a1 = O1[0] - lam * O1[1];
        const float r = 1.0f / sqrtf(wave_sum(a0 * a0 + a1 * a1) * (1.0f / 128.0f) + EPS);
        *(unsigned*)(MRG + (size_t)m * DM + hh * 128 + 2 * lane) = pk2(a0 * r * subg[2 * lane] * 0.8f, a1 * r * subg[2 * lane + 1] * 0.8f);
    } else if (VAR == 1) {
        const float slope = exp2f(-(float)(hh + 1));
        q[lane] = bflo((unsigned)row[3072 + hh * 128 + lane]); q[64 + lane] = bflo((unsigned)row[3072 + hh * 128 + 64 + lane]); __builtin_amdgcn_wave_barrier(); LDS_WAIT();
        const int own = pos >> 8;
        float g = -3.0e38f;
        if (lane < own) { const float* km = KMEAN + ((size_t)(b * 8 + hh) * 32 + lane) * 128; float s = 0.f;
            for (int d = 0; d < 128; ++d) s += q[d] * km[d]; g = s; }
        unsigned long long selm = 0ull;
        for (int t = 0; t < 3 && t < own; ++t) { const float mx = wave_max(g); const unsigned long long bal = __ballot(g == mx); const int pick = __ffsll((long long)bal) - 1;
            selm |= 1ull << pick; if (lane == pick) g = -3.0e38f; }
        float mr = -1e30f, lr = 0.f, o0 = 0.f, o1 = 0.f;
        for (int n = 0; n < own; ++n) if ((selm >> n) & 1ull)
            naive_span<128>(base + 4096 + hh * 128, base + 5120 + hh * 128, q, n * 256, n * 256 + 256, pos, 0.08838834764831845f, slope, nullptr, 0.f, mr, lr, o0, o1, lane);
        naive_span<128>(base + 4096 + hh * 128, base + 5120 + hh * 128, q, own * 256, pos + 1, pos, 0.08838834764831845f, slope, nullptr, 0.f, mr, lr, o0, o1, lane);
        *(unsigned*)(MRG + (size_t)m * DM + 1024 + hh * 128 + 2 * lane) = pk2(o0 / lr, o1 / lr);
    } else {
        q[lane] = bflo((unsigned)row[hh * 128 + lane]); q[64 + lane] = bflo((unsigned)row[hh * 128 + 64 + lane]); __builtin_amdgcn_wave_barrier(); LDS_WAIT();
        const float* cr = CUM + (size_t)(b * 16 + hh) * SEQ;
        float mr = -1e30f, lr = 0.f, o0 = 0.f, o1 = 0.f;
        naive_span<128>(base + 2048 + hh * 128, base + 4096 + hh * 128, q, 0, pos + 1, pos, 0.08838834764831845f, 0.f, cr, cr[pos], mr, lr, o0, o1, lane);
        *(unsigned*)(MRG + (size_t)m * DM + hh * 128 + 2 * lane) = pk2(o0 / lr, o1 / lr);
    }
}
#endif
namespace att {
constexpr int V_OFF = 0, K_OFF = 32768, C_OFF = 65536, G_KM = 66560, G_GT = G_KM + 16384, G_SEL = G_GT + 256 * 33 * 4, G_OR = G_SEL + 1024, ATT_LDS = G_OR + 16;
static_assert(ATT_LDS <= RING_BYTES, "attention LDS");
constexpr float THR = 8.f;
#define SBAR() __builtin_amdgcn_sched_barrier(0)
__device__ __forceinline__ int v_st(int k, int c) { const int kk = (k & ~0xC) | ((k & 4) << 1) | ((k & 8) >> 1); return ((kk >> 3) * 4 + (c >> 5)) * 512 + ((kk & 7) * 32 + (c & 31)) * 2; }
__device__ __forceinline__ int v_rd_base(int lane) { return ((lane & 3) << 3) | (((lane >> 2) & 3) << 6) | (((lane >> 4) & 1) << 5) | (((lane >> 5) & 1) << 8); }
__device__ __forceinline__ unsigned cvtpk(float lo, float hi) { unsigned r; asm volatile("v_cvt_pk_bf16_f32 %0, %1, %2" : "=v"(r) : "v"(lo), "v"(hi)); return r; }

template <int VAR>
__device__ __forceinline__ void attn_block(LAS unsigned char* lds, const bf16* __restrict__ Qp, const bf16* __restrict__ Kp, const bf16* __restrict__ Vp, const int P0,
                                           const float slope, const float* __restrict__ cumrow, const unsigned selrow, unsigned wgmask, f32x16 (&o)[4], float& l_out) {
    constexpr int DQK = VAR == 0 ? 64 : 128, NQ = DQK / 16;
    constexpr float SCALE = VAR == 0 ? 0.125f : 0.08838834764831845f, C2 = SCALE * 1.4426950408889634f, ISC = 1.0f / SCALE;
    const int tid = opaque_tid(), wid = __builtin_amdgcn_readfirstlane(tid >> 6), lane = tid & 63, r32 = lane & 31, hi = lane >> 5;
    const int qb = P0 >> 8, qlo = P0 + wid * 32, qpos = qlo + r32;
    LAS unsigned char* V_lds = lds + V_OFF; LAS unsigned char* K_lds = lds + K_OFF; LAS float* C_lds = (LAS float*)(lds + C_OFF);
    bf16x8 qr[NQ];
#pragma unroll
    for (int d0 = 0; d0 < NQ; ++d0) qr[d0] = *(const bf16x8*)(Qp + (unsigned)((wid * 32 + r32) * NQKV + hi * 8) + d0 * 16);
    unsigned offK, offV;
    if (VAR == 0) { const int row = wid * 8 + (lane >> 3), c = (lane & 7) ^ ((row >> 1) & 7); offK = (unsigned)(row * NQKV + c * 8); }
    else { const int row = wid * 4 + (lane >> 4), c = (lane & 15) ^ (row & 7); offK = (unsigned)(row * NQKV + c * 8); }
    { const int t = (lane & 31) >> 2, k = (wid >> 2) * 16 + (t >> 2) * 8 + ((wid >> 1) & 1) * 4 + (t & 3), c = ((wid & 1) * 2 + (lane >> 5)) * 32 + (lane & 3) * 8; offV = (unsigned)(k * NQKV + c); }
    const unsigned vb0 = (unsigned)(uintptr_t)(V_lds) + (unsigned)v_rd_base(lane);
    int ti_blk = 0, ti_sub = 0; unsigned rem = wgmask;
    if (VAR == 1) ti_blk = __builtin_ctz(rem);
    const int NT = VAR == 1 ? 4 * __builtin_popcount(wgmask) : 4 * (qb + 1);
#define KB_CUR() (VAR == 1 ? ti_blk * 256 + ti_sub * 64 : ti_sub * 64)
#define ADVANCE() do { if (VAR == 1) { if (++ti_sub == 4) { ti_sub = 0; rem &= rem - 1u; ti_blk = rem ? __builtin_ctz(rem) : 0; } } else ++ti_sub; } while (0)
#define GLDS(src, dstoff) __builtin_amdgcn_global_load_lds((const unsigned*)(src), (LAS unsigned*)(lds + (dstoff)), 16, 0, 0)
#define STAGE(kb, bf) do { const bf16* vb_ = Vp + (size_t)(kb) * NQKV + offV; const bf16* kb_ = Kp + (size_t)(kb) * NQKV + offK; \
        GLDS(vb_, V_OFF + (bf) * 16384 + wid * 1024); GLDS(vb_ + 32 * NQKV, V_OFF + (bf) * 16384 + 8192 + wid * 1024); \
        GLDS(kb_, K_OFF + (bf) * 16384 + wid * 1024); if (VAR != 0) GLDS(kb_ + 32 * NQKV, K_OFF + (bf) * 16384 + 8192 + wid * 1024); \
        if (VAR == 2) { if (wid == 0) __builtin_amdgcn_global_load_lds((const unsigned*)(cumrow + (kb) + lane), (LAS unsigned*)(lds + C_OFF + (bf) * 256), 4, 0, 0); } } while (0)
    float m_reg = -1e30f, l_reg = 0.f;
#pragma unroll
    for (int d0 = 0; d0 < 4; ++d0)
#pragma unroll
        for (int r = 0; r < 16; ++r) o[d0][r] = 0.f;
    const float sl = slope * ISC;
    int kb = KB_CUR();
    STAGE(kb, 0); VM_WAIT();
    __syncthreads();
    for (int i = 0; i < NT; ++i) {
        const int buf = i & 1; const int blk_cur = ti_blk;
        ADVANCE();
        const int kbn = KB_CUR(); const bool has_next = i + 1 < NT;
        if (has_next) STAGE(kbn, buf ^ 1);
        bool act = kb <= qlo + 31;
        bool selok = true;
        if (VAR == 1) { selok = (blk_cur == qb) || ((selrow >> blk_cur) & 1u); act = act && (__ballot(selok) != 0ull); }
        if (act) {
            f32x16 p0, p1;
            if (VAR == 2) {
                const LAS float* cp = C_lds + buf * 64 + 4 * hi;
                const f32x4 c0 = *(const LAS f32x4*)(cp), c1 = *(const LAS f32x4*)(cp + 8), c2 = *(const LAS f32x4*)(cp + 16), c3 = *(const LAS f32x4*)(cp + 24);
                const f32x4 e0 = *(const LAS f32x4*)(cp + 32), e1 = *(const LAS f32x4*)(cp + 40), e2 = *(const LAS f32x4*)(cp + 48), e3 = *(const LAS f32x4*)(cp + 56);
                p0 = (f32x16){c0[0], c0[1], c0[2], c0[3], c1[0], c1[1], c1[2], c1[3], c2[0], c2[1], c2[2], c2[3], c3[0], c3[1], c3[2], c3[3]};
                p1 = (f32x16){e0[0], e0[1], e0[2], e0[3], e1[0], e1[1], e1[2], e1[3], e2[0], e2[1], e2[2], e2[3], e3[0], e3[1], e3[2], e3[3]};
            } else {
                const float t0 = sl * (float)(kb - P0 + 4 * hi);
#pragma unroll
                for (int r = 0; r < 16; ++r) { p0[r] = __builtin_fmaf(sl, (float)((r & 3) + 8 * (r >> 2)), t0); p1[r] = __builtin_fmaf(sl, (float)(32 + (r & 3) + 8 * (r >> 2)), t0); }
            }
            if (VAR == 0) {
                const LAS unsigned char* ka = K_lds + buf * 16384 + r32 * 128;
                const int sw = ((r32 >> 1) & 7) << 4;
#pragma unroll
                for (int d0 = 0; d0 < 4; ++d0) { const int cb = ((2 * d0 + hi) * 16) ^ sw;
                    const bf16x8 b0 = *(const LAS bf16x8*)(ka + cb), b1 = *(const LAS bf16x8*)(ka + cb + 32 * 128);
                    p0 = __builtin_amdgcn_mfma_f32_32x32x16_bf16(b0, qr[d0], p0, 0, 0, 0); p1 = __builtin_amdgcn_mfma_f32_32x32x16_bf16(b1, qr[d0], p1, 0, 0, 0); }
            } else {
                const LAS unsigned char* kbp[4];
#pragma unroll
                for (int dd = 0; dd < 4; ++dd) kbp[dd] = K_lds + buf * 16384 + r32 * 256 + (((dd * 16 + hi * 8) * 2) ^ ((r32 & 7) << 4));
#pragma unroll
                for (int d0 = 0; d0 < NQ; ++d0) { const LAS unsigned char* a = kbp[d0 & 3] + (d0 >> 2) * 128;
                    const bf16x8 b0 = *(const LAS bf16x8*)(a), b1 = *(const LAS bf16x8*)(a + 32 * 256);
                    p0 = __builtin_amdgcn_mfma_f32_32x32x16_bf16(b0, qr[d0], p0, 0, 0, 0); p1 = __builtin_amdgcn_mfma_f32_32x32x16_bf16(b1, qr[d0], p1, 0, 0, 0); }
            }
            const float NEG = -__builtin_inff();
            if (kb + 63 > qlo) {
                const int dq = qpos - kb - 4 * hi;
#pragma unroll
                for (int r = 0; r < 16; ++r) { const int c = (r & 3) + 8 * (r >> 2); if (c > dq) p0[r] = NEG; if (c + 32 > dq) p1[r] = NEG; }
            }
            if (VAR == 1) { if (!selok) {
#pragma unroll
                for (int r = 0; r < 16; ++r) { p0[r] = NEG; p1[r] = NEG; } } }
            float pmax = p0[0];
#pragma unroll
            for (int r = 1; r < 16; ++r) pmax = fmaxf(pmax, p0[r]);
#pragma unroll
            for (int r = 0; r < 16; ++r) pmax = fmaxf(pmax, p1[r]);
            { auto rr = __builtin_amdgcn_permlane32_swap(__float_as_uint(pmax), __float_as_uint(pmax), false, false);
              pmax = fmaxf(__uint_as_float(rr[0]), __uint_as_float(rr[1])); }
            float mn, alpha;
            if (__builtin_expect(__all((pmax - m_reg) * SCALE <= THR), 1)) { mn = m_reg; alpha = 1.f; }
            else { mn = fmaxf(m_reg, pmax); alpha = __builtin_amdgcn_exp2f((m_reg - mn) * C2); m_reg = mn; }
            const float mnL = -mn * C2;
            float ps = 0.f;
#pragma unroll
            for (int r = 0; r < 16; ++r) { p0[r] = __builtin_amdgcn_exp2f(fmaf(p0[r], C2, mnL)); p1[r] = __builtin_amdgcn_exp2f(fmaf(p1[r], C2, mnL)); }
#pragma unroll
            for (int r = 0; r < 16; ++r) ps += p0[r] + p1[r];
            l_reg = l_reg * alpha + ps;
            if (__any(alpha < 1.f)) {
#pragma unroll
                for (int d0 = 0; d0 < 4; ++d0)
#pragma unroll
                    for (int r = 0; r < 16; ++r) o[d0][r] *= alpha;
            }
            bf16x8 pa0, pa1, pa2, pa3;
#define PK4(P, B_, OUT) do { unsigned a0 = cvtpk(P[B_ + 0], P[B_ + 1]), a1 = cvtpk(P[B_ + 2], P[B_ + 3]); unsigned b0 = cvtpk(P[B_ + 4], P[B_ + 5]), b1 = cvtpk(P[B_ + 6], P[B_ + 7]); \
        auto r0 = __builtin_amdgcn_permlane32_swap(a0, b0, false, false); auto r1 = __builtin_amdgcn_permlane32_swap(a1, b1, false, false); \
        v4u w = {r0[0], r1[0], r0[1], r1[1]}; OUT = __builtin_bit_cast(bf16x8, w); } while (0)
            PK4(p0, 0, pa0); PK4(p0, 8, pa1); PK4(p1, 0, pa2); PK4(p1, 8, pa3);
#undef PK4
#define TRRD(dst, off) asm volatile("ds_read_b64_tr_b16 %0, %1 offset:%2" : "=&v"(dst) : "v"(vb0), "i"(off) : "memory")
#define PV_D0(d0, VB) do { s16x4 l0, l1, l2, l3, h0, h1, h2, h3; constexpr int b_ = (VB) * 16384 + (d0) * 512; \
        TRRD(l0, b_); TRRD(h0, b_ + 2048); TRRD(l1, b_ + 4096); TRRD(h1, b_ + 6144); TRRD(l2, b_ + 8192); TRRD(h2, b_ + 10240); TRRD(l3, b_ + 12288); TRRD(h3, b_ + 14336); \
        asm volatile("s_waitcnt lgkmcnt(0)" ::: "memory"); SBAR(); \
        o[d0] = __builtin_amdgcn_mfma_f32_32x32x16_bf16((bf16x8){l0[0], l0[1], l0[2], l0[3], h0[0], h0[1], h0[2], h0[3]}, pa0, o[d0], 0, 0, 0); \
        o[d0] = __builtin_amdgcn_mfma_f32_32x32x16_bf16((bf16x8){l1[0], l1[1], l1[2], l1[3], h1[0], h1[1], h1[2], h1[3]}, pa1, o[d0], 0, 0, 0); \
        o[d0] = __builtin_amdgcn_mfma_f32_32x32x16_bf16((bf16x8){l2[0], l2[1], l2[2], l2[3], h2[0], h2[1], h2[2], h2[3]}, pa2, o[d0], 0, 0, 0); \
        o[d0] = __builtin_amdgcn_mfma_f32_32x32x16_bf16((bf16x8){l3[0], l3[1], l3[2], l3[3], h3[0], h3[1], h3[2], h3[3]}, pa3, o[d0], 0, 0, 0); } while (0)
            if (buf == 0) { PV_D0(0, 0); PV_D0(1, 0); PV_D0(2, 0); PV_D0(3, 0); } else { PV_D0(0, 1); PV_D0(1, 1); PV_D0(2, 1); PV_D0(3, 1); }
#undef PV_D0
#undef TRRD
        }
        VM_WAIT();
        kb = kbn;
        __syncthreads();
    }
    { auto rr = __builtin_amdgcn_permlane32_swap(__float_as_uint(l_reg), __float_as_uint(l_reg), false, false); l_out = __uint_as_float(rr[0]) + __uint_as_float(rr[1]); }
#undef KB_CUR
#undef ADVANCE
#undef STAGE
#undef GLDS
}
__device__ __forceinline__ void store_block(bf16* Op  , const f32x16 (&o)[4], float inv_l) {
    const int tid = opaque_tid(), wid = tid >> 6, lane = tid & 63, r32 = lane & 31, hi = lane >> 5;
    bf16* rowp = Op + (unsigned)((wid * 32 + r32) * DM + 4 * hi);
#pragma unroll
    for (int d0 = 0; d0 < 4; ++d0)
#pragma unroll
        for (int g = 0; g < 4; ++g) { v2u w; w.x = cvtpk(o[d0][4 * g] * inv_l, o[d0][4 * g + 1] * inv_l); w.y = cvtpk(o[d0][4 * g + 2] * inv_l, o[d0][4 * g + 3] * inv_l);
            *(v2u*)(rowp + 32 * d0 + 8 * g) = w; }
}
}

template <bool DO_A, bool DO_B>
__device__ __forceinline__ void attn_even_phase(const Args& A, const Frame& F0) {
    Frame F = F0; F.tid = opaque_tid(); F.lane = F.tid & 63; F.wave = __builtin_amdgcn_readfirstlane(F.tid >> 6);
    const bf16* QKV = (const bf16*)(A.ws + WS_QKV); bf16* MRG = (bf16*)(A.ws + WS_MRG);
    if (DO_A) for (int it = F.vcu; it < 256; it += F.G) {
        const int bh = it >> 4, y = it & 15, b = bh >> 3, h = bh & 7;
        const float slope = exp2f(-(2.0f * h + 1.0f) * 0.5f);
        const float lam = *(const float*)(A.ws + WS_LAM);
        float* scr = (float*)(A.ws + WS_SCR) + (size_t)blockIdx.x * 32768;
        for (int pass = 0; pass < 2; ++pass) {
            const int qb = pass ? 31 - y : y, P0 = qb * 256;
            const bf16* rowb = QKV + (size_t)b * SEQ * NQKV;
            f32x16 o[4]; float l;
            att::attn_block<0>(F.lds, rowb + (size_t)P0 * NQKV + h * 128, rowb + 1024 + h * 128, rowb + 2048 + h * 128, P0, slope, nullptr, 0u, 0u, o, l);
            { const float il = 1.0f / l; float* sp = scr + opaque_tid();
#pragma unroll
              for (int d0 = 0; d0 < 4; ++d0)
#pragma unroll
                  for (int r = 0; r < 16; ++r) sp[(d0 * 16 + r) * 512] = o[d0][r] * il; }
            att::attn_block<0>(F.lds, rowb + (size_t)P0 * NQKV + h * 128 + 64, rowb + 1024 + h * 128 + 64, rowb + 2048 + h * 128, P0, slope, nullptr, 0u, 0u, o, l);
            { const float il = lam / l; float ss = 0.f; const float* sp = scr + opaque_tid();
#pragma unroll
              for (int d0 = 0; d0 < 4; ++d0)
#pragma unroll
                  for (int r = 0; r < 16; ++r) { const float v = sp[(d0 * 16 + r) * 512] - o[d0][r] * il; o[d0][r] = v; ss += v * v; }
              { auto rr = __builtin_amdgcn_permlane32_swap(__float_as_uint(ss), __float_as_uint(ss), false, false); ss = __uint_as_float(rr[0]) + __uint_as_float(rr[1]); }
              const float rs = 0.8f / sqrtf(ss * (1.0f / 128.0f) + EPS);
              const float* sg = A.in[I_SUBLN] + 4 * ((opaque_tid() >> 5) & 1);
#pragma unroll
              for (int d0 = 0; d0 < 4; ++d0)
#pragma unroll
                  for (int g = 0; g < 4; ++g) { const f32x4 gv = *(const f32x4*)(sg + 32 * d0 + 8 * g);
#pragma unroll
                      for (int j = 0; j < 4; ++j) o[d0][4 * g + j] *= gv[j]; }
              att::store_block(MRG + (size_t)(b * SEQ + P0) * DM + h * 128, o, rs); }
        }
    }
    if (DO_B) for (int it = F.vcu; it < 256; it += F.G) {
        const int bh = it >> 4, y = it & 15, b = bh >> 3, h = bh & 7;
        const float slope = exp2f(-(float)(h + 1));
        const bf16* rowb = QKV + (size_t)b * SEQ * NQKV;
        const float* KM = (const float*)(A.ws + WS_KMEAN) + (size_t)bh * 32 * 128;
        for (int pass = 0; pass < 2; ++pass) {
            const int qb = pass ? 31 - y : y, P0 = qb * 256;
            const int tid = opaque_tid(), r32 = tid & 31;
            LAS float* km = (LAS float*)(F.lds + att::G_KM); LAS float* gt = (LAS float*)(F.lds + att::G_GT);
            LAS unsigned* sel = (LAS unsigned*)(F.lds + att::G_SEL); LAS unsigned* gor = (LAS unsigned*)(F.lds + att::G_OR);
            if (tid == 0) gor[0] = 0u;
            if (qb >= 4) {
                for (int i = tid; i < qb * 32; i += 512) *(LAS f32x4*)(km + 4 * i) = *(const f32x4*)(KM + 4 * i);
                __syncthreads();
                const int row = tid & 255, half = tid >> 8;
                float acc[16];
#pragma unroll
                for (int k = 0; k < 16; ++k) acc[k] = 0.f;
                const bf16* qrow = rowb + (size_t)(P0 + row) * NQKV + 3072 + h * 128;
#pragma unroll 1
                for (int c = 0; c < 16; ++c) { const v4u w = *(const v4u*)(qrow + 8 * c);
                    const float q0 = bflo(w.x), q1 = bfhi(w.x), q2 = bflo(w.y), q3 = bfhi(w.y), q4 = bflo(w.z), q5 = bfhi(w.z), q6 = bflo(w.w), q7 = bfhi(w.w);
#pragma unroll
                    for (int k = 0; k < 16; ++k) { const int n = 2 * k + half; if (n < qb) { const f32x4 a = *(const LAS f32x4*)(km + n * 128 + 8 * c), bq = *(const LAS f32x4*)(km + n * 128 + 8 * c + 4);
                        acc[k] += (q0 * a.x + q1 * a.y) + (q2 * a.z + q3 * a.w) + (q4 * bq.x + q5 * bq.y) + (q6 * bq.z + q7 * bq.w); } } }
#pragma unroll
                for (int k = 0; k < 16; ++k) { const int n = 2 * k + half; if (n < qb) gt[row * 33 + n] = acc[k]; }
                __syncthreads();
                if (tid < 256) { unsigned msk = 0u;
                    for (int t = 0; t < 3; ++t) { float best = -3.0e38f; int bi = 0;
                        for (int n = 0; n < qb; ++n) { const float v = gt[tid * 33 + n]; if (!((msk >> n) & 1u) && v > best) { best = v; bi = n; } }
                        msk |= 1u << bi; }
                    sel[tid] = msk; atomicOr((unsigned*)gor, msk); }
            } else { if (tid < 256) sel[tid] = (1u << qb) - 1u; if (tid == 0) gor[0] = (1u << qb) - 1u; }
            __syncthreads();
            const unsigned selrow = sel[(tid >> 6) * 32 + r32]; const unsigned wgmask = __builtin_amdgcn_readfirstlane(gor[0]) | (1u << qb);
            __syncthreads();
            f32x16 o[4]; float l;
            att::attn_block<1>(F.lds, rowb + (size_t)P0 * NQKV + 3072 + h * 128, rowb + 4096 + h * 128, rowb + 5120 + h * 128, P0, slope, nullptr, selrow, wgmask, o, l);
            att::store_block(MRG + (size_t)(b * SEQ + P0) * DM + 1024 + h * 128, o, 1.0f / l);
        }
    }
}
__device__ __forceinline__ void attn_odd_phase(const Args& A, const Frame& F0) {
    Frame F = F0; F.tid = opaque_tid(); F.lane = F.tid & 63; F.wave = __builtin_amdgcn_readfirstlane(F.tid >> 6);
    const bf16* QKV = (const bf16*)(A.ws + WS_QKV); bf16* MRG = (bf16*)(A.ws + WS_MRG);
    for (int it = F.vcu; it < 512; it += F.G) {
        const int bh = it >> 4, y = it & 15, b = bh >> 4, h = bh & 15;
        const bf16* rowb = QKV + (size_t)b * SEQ * NQKV;
        const float* cumrow = (const float*)(A.ws + WS_CUM) + (size_t)bh * SEQ;
        for (int pass = 0; pass < 2; ++pass) {
            const int qb = pass ? 31 - y : y, P0 = qb * 256;
            f32x16 o[4]; float l;
            att::attn_block<2>(F.lds, rowb + (size_t)P0 * NQKV + h * 128, rowb + 2048 + h * 128, rowb + 4096 + h * 128, P0, 0.f, cumrow, 0u, 0u, o, l);
            att::store_block(MRG + (size_t)(b * SEQ + P0) * DM + h * 128, o, 1.0f / l);
        }
    }
}
#ifndef ONE_LAUNCH
#define ONE_LAUNCH 0
#endif
constexpr int N_PHASES = 20;
#define IN(k) (lo <= (k) && (k) < hi)
#define SEAM(k) do { if (IN(k) && IN((k) + 1)) xcd_barrier(bar); } while (0)
template <int l>
__device__ __forceinline__ void layer_phases(const Args& args, const Frame& F, const XcdBarrier& bar, const int lo, const int hi) {
    unsigned char* ws = args.ws;
        const int pb = 1 + 9 * l;
        const float* modl = (const float*)(ws + WS_MOD) + (size_t)l * 2 * MODW;
        if (IN(pb + 0)) { if (l == 0) norm_phase<0>(args, F, l); else norm_phase<2>(args, F, l); SEAM(pb + 0); }
        if (IN(pb + 1)) {
            if (l == 1) { scan_phase(args, F); }
            pg8::Gemm g{(const bf16*)(ws + WS_H), (const bf16*)(ws + WS_WIN) + (size_t)l * NQKV * DM, M, NQKV, DM}; pg8::StaticOrder S; S.init(M, NQKV, F.G, (int)blockIdx.x);
            pg8::EpiBf16<0> E{(bf16*)(ws + WS_QKV), NQKV, nullptr, 0, 0, 1.f};
            pg8::gemm_phase<pg8::EpiBf16<0>, pg8::StaticOrder, PG8_ALIGN, PG8_SP2>(F.lds + RING_OFF, g, S, E);
            SEAM(pb + 1);
        }
        if (IN(pb + 2)) { if (l == 0) { kmean_phase(args, F); SEAM(pb + 2); } }
        if (IN(pb + 3)) {
            if (l == 0) attn_even_phase<!(NAIVE_ATTN & 1), !(NAIVE_ATTN & 2)>(args, F); else { if (!(NAIVE_ATTN & 4)) attn_odd_phase(args, F); }
            SEAM(pb + 3);
        }
        if (IN(pb + 4)) {
            pg8::Gemm g{(const bf16*)(ws + WS_MRG), (const bf16*)(ws + WS_WOUT) + (size_t)l * DM * DM, M, DM, DM}; pg8::StaticOrder S; S.init(M, DM, F.G, (int)blockIdx.x);
            pg8::EpiResid E{l == 0 ? args.in[I_X] : args.out, args.out, modl + 2 * DM, MODW, SEQ};
            pg8::gemm_phase<pg8::EpiResid, pg8::StaticOrder, PG8_ALIGN, PG8_SP2>(F.lds + RING_OFF, g, S, E);
            SEAM(pb + 4);
        }
        if (IN(pb + 5)) { norm_phase<1>(args, F, l); SEAM(pb + 5); }
        if (IN(pb + 6)) { gather_phase(args, F, l); SEAM(pb + 6); }
        if (IN(pb + 7)) {
            pg8::Gemm g{(const bf16*)(ws + WS_QKV), (const bf16*)(ws + WS_W13) + (size_t)l * 16384 * DM, MAXROWS, 16384, DM};
            pg8::MoeOrder S; S.init((const unsigned*)(F.ctl + CW_CNT + 64 * l), 2, F.G, (int)blockIdx.x);
            pg8::EpiSwiGLU E{(bf16*)(ws + WS_ACT)};
            pg8::gemm_phase<pg8::EpiSwiGLU, pg8::MoeOrder, PG8_ALIGN, PG8_SP2>(F.lds + RING_OFF, g, S, E);
            SEAM(pb + 7);
        }
        if (IN(pb + 8)) {
            pg8::Gemm g{(const bf16*)(ws + WS_ACT), (const bf16*)(ws + WS_W2) + (size_t)l * 32768 * FFE, MAXROWS, 32768, FFE};
            pg8::MoeOrder S; S.init((const unsigned*)(F.ctl + CW_CNT + 64 * l), 3, F.G, (int)blockIdx.x);
            pg8::EpiBf16<0> E{(bf16*)(ws + WS_OSL), DM, nullptr, DM, 0, 1.f};
            pg8::gemm_phase<pg8::EpiBf16<0>, pg8::MoeOrder, PG8_ALIGN, PG8_SP2>(F.lds + RING_OFF, g, S, E);
            SEAM(pb + 8);
        }
}
#undef IN
#undef SEAM
__global__ void __launch_bounds__(NWAVES * 64, 2) skel_fwd(Args args) {
    extern __shared__ __attribute__((aligned(16))) unsigned char lds[];
    Frame F;
    F.lds = (LAS unsigned char*)lds;
    F.MISC = (volatile LAS unsigned*)(F.lds + MISC_OFF);
    F.tid = threadIdx.x; F.lane = F.tid & 63; F.wave = __builtin_amdgcn_readfirstlane(F.tid >> 6);
    F.G = gridDim.x; { const int bx = blockIdx.x; F.vcu = (F.G % 8 == 0) ? (bx % 8) * (F.G / 8) + bx / 8 : bx; }
    unsigned char* ws = args.ws;
    F.ctl = (gu32*)(ws + WS_CTL);
    for (int u = F.tid; u < (LDS_BYTES - LDSCTL_OFF) / 4; u += NWAVES * 64) ((LAS unsigned*)(F.lds + LDSCTL_OFF))[u] = 0u;
    __syncthreads();
    const int lo = args.ph_lo, hi = args.ph_hi;
    XcdBarrier bar; bar.bar = (unsigned*)(F.ctl + CW_BAR); bar.x = 0; bar.st = nullptr;
    if (hi - lo > 1) bar = xcd_barrier_post((unsigned*)(F.ctl + CW_BAR), F.MISC + 8);
#define IN(k) (lo <= (k) && (k) < hi)
#define SEAM(k) do { if (IN(k) && IN((k) + 1)) xcd_barrier(bar); } while (0)

    if (IN(0)) { p0_prologue(args, F); SEAM(0); }
    layer_phases<0>(args, F, bar, lo, hi);
    layer_phases<1>(args, F, bar, lo, hi);
    if (IN(19)) norm_phase<3>(args, F, 1);
#undef IN
#undef SEAM
}

extern "C" void kernel_launch(void* const* d_in, const int* in_sizes, int n_in, void* d_out, int out_size, void* d_ws, size_t ws_size, hipStream_t stream) {
    static int grid = 0;
    if (grid == 0) {
        if (n_in != 22 || in_sizes[0] != M * DM || out_size != M * DM || ws_size < WS_END) { fprintf(stderr, "kernel_launch: unexpected shapes (n_in %d, in0 %d, out %d, ws %zu; need ws >= %zu); nothing launched\n", n_in, n_in > 0 ? in_sizes[0] : -1, out_size, ws_size, (size_t)WS_END); grid = -1; return; }
        int dev = 0, cus = 0, per_cu = 0;
        if (hipGetDevice(&dev) != hipSuccess || hipDeviceGetAttribute(&cus, hipDeviceAttributeMultiprocessorCount, dev) != hipSuccess) { grid = -1; return; }
        if (hipFuncSetAttribute((const void*)skel_fwd, hipFuncAttributeMaxDynamicSharedMemorySize, LDS_BYTES) != hipSuccess) { fprintf(stderr, "kernel_launch: hipFuncSetAttribute failed\n"); grid = -1; return; }
        if (hipOccupancyMaxActiveBlocksPerMultiprocessor(&per_cu, (const void*)skel_fwd, NWAVES * 64, LDS_BYTES) != hipSuccess || per_cu < 1) { fprintf(stderr, "kernel_launch: occupancy query says %d blocks per CU\n", per_cu); }
        (void)hipGetLastError();
        grid = cus;
    }
    if (grid < 0) return;
    if (hipMemsetAsync((char*)d_ws + WS_CTL, 0, CTL_ZERO_BYTES, stream) != hipSuccess) return;
    Args a{};
    for (int i = 0; i < 22; ++i) a.in[i] = (const float*)d_in[i];
    a.out = (float*)d_out; a.ws = (unsigned char*)d_ws;
#if ONE_LAUNCH
    a.ph_lo = 0; a.ph_hi = N_PHASES;
    hipLaunchKernelGGL(skel_fwd, dim3(grid), dim3(NWAVES * 64), LDS_BYTES, stream, a);
#else
    unsigned char* ws = (unsigned char*)d_ws;
    for (int p = 0; p < N_PHASES; ++p) {
        if (p == 12) continue;
#if NAIVE_ATTN
        if (p == 4) {
            if (NAIVE_ATTN & 1) naive_attn<0><<<M * 8 / 4, 256, 0, stream>>>((const bf16*)(ws + WS_QKV), (bf16*)(ws + WS_MRG), nullptr, nullptr, (const float*)(ws + WS_LAM), (const float*)d_in[I_SUBLN]);
            if (NAIVE_ATTN & 2) naive_attn<1><<<M * 8 / 4, 256, 0, stream>>>((const bf16*)(ws + WS_QKV), (bf16*)(ws + WS_MRG), nullptr, (const float*)(ws + WS_KMEAN), nullptr, nullptr);
            if ((NAIVE_ATTN & 3) == 3) continue; }
        if (p == 13 && (NAIVE_ATTN & 4)) { naive_attn<2><<<M * 16 / 4, 256, 0, stream>>>((const bf16*)(ws + WS_QKV), (bf16*)(ws + WS_MRG), (const float*)(ws + WS_CUM), nullptr, nullptr, nullptr); continue; }
#endif
        a.ph_lo = p; a.ph_hi = p + 1;
        hipLaunchKernelGGL(skel_fwd, dim3(grid), dim3(NWAVES * 64), LDS_BYTES, stream, a);
    }
#endif
}
```

```cpp
#include <hip/hip_runtime.h>
#include <cstdio>
#include <cstdint>
namespace pg8 {
#define PG8_LAS __attribute__((address_space(3)))
typedef unsigned short bf16_t;
typedef short bf16x8 __attribute__((ext_vector_type(8)));
typedef float f32x4 __attribute__((ext_vector_type(4)));
typedef unsigned u32x4 __attribute__((ext_vector_type(4)));
constexpr int BM = 256, BK = 64, HALF = 128, HTB = HALF * BK * 2  , STAGE_BYTES = 8 * HTB, NXCD = 8, WGM = 8;

__host__ __device__ __forceinline__ int lds_byte(int r, int c) { const int st = (r >> 4) * 2 + (c >> 5), rr = r & 15, cc = c & 31, ob = rr * 64 + cc * 2; return st * 1024 + (ob ^ (((ob >> 9) & 1) << 5)); }
__host__ __device__ __forceinline__ void stage_rc(int b, int& R, int& C) { const int st = b / 1024, sb = b % 1024, swz = sb ^ (((sb >> 9) & 1) << 5); R = (st >> 1) * 16 + swz / 64; C = (st & 1) * 32 + (swz % 64) / 2; }
__host__ __device__ __forceinline__ int perm32(int rho) { const int n = rho >> 4, i = rho & 15; return 8 * (i >> 2) + 4 * n + (i & 3); }

struct Unit { int pm, pn; };
struct Gemm { const bf16_t* A; const bf16_t* Bt; int M, N, K; };

struct StaticOrder {
    int nM, nN, nwg, G, c;
    __host__ __device__ void init(int M, int N, int G_, int c_) { nM = M / BM; nN = N / BM; nwg = nM * nN; G = G_; c = c_; }
    __host__ __device__ bool next(int i, Unit& u) const {
        const long L = (long)i * G + c; if (L >= nwg) return false;
        int wgid = (int)L; { const int q = nwg / NXCD, r = nwg % NXCD, xcd = wgid % NXCD, off = wgid / NXCD; wgid = (xcd < r ? xcd * (q + 1) : r * (q + 1) + (xcd - r) * q) + off; }
        const int nig = WGM * nN, gid = wgid / nig, fm = gid * WGM, gsz = (nM - fm) < WGM ? (nM - fm) : WGM;
        u.pm = fm + ((wgid % nig) % gsz); u.pn = (wgid % nig) / gsz; return true;
    }
    __device__ __forceinline__ void a_ready(const Unit&) const {}
    __device__ __forceinline__ void done(const Unit&) const {}
};

__device__ __forceinline__ unsigned cvt_pk_bf16(float lo, float hi) { unsigned r; asm volatile("v_cvt_pk_bf16_f32 %0, %1, %2" : "=v"(r) : "v"(lo), "v"(hi)); return r; }
typedef float f32x2 __attribute__((ext_vector_type(2)));
__device__ __forceinline__ f32x2 gelu_pk(f32x2 v) {
    const f32x2 av = __builtin_elementwise_abs(v), d = av * 0.2316418882f + 1.0f;
    f32x2 t; t.x = __builtin_amdgcn_rcpf(d.x); t.y = __builtin_amdgcn_rcpf(d.y);
    f32x2 q = t * 0.5307027145f + (-0.7265760135f); q = q * t + 0.7107068705f; q = q * t + (-0.142248368f); q = q * t + 0.127414796f; q = q * t;
    const f32x2 s = (v * v) * (-0.72134752044f);
    f32x2 e; e.x = __builtin_amdgcn_exp2f(s.x); e.y = __builtin_amdgcn_exp2f(s.y);
    const f32x2 m = v * (q * e), r = v - m;
    f32x2 o; o.x = v.x < 0.f ? m.x : r.x; o.y = v.y < 0.f ? m.y : r.y; return o;
}

template <int ACT  > struct EpiBf16 {
    static constexpr bool PERM = true, AFTER_DRAIN = false; static_assert(ACT == 0 || ACT == 1, "EpiBf16: ACT is 0 (none) or 1 (gelu_pk)");
    bf16_t* O; int ldc; const float* bias; int split_cols; size_t split_stride; float scale0;
    __device__ __forceinline__ void operator()(const f32x4 (&acc)[2][2][4][2], const Unit& u, int wr, int wc, int fr, int fq) const {
        const int row0 = u.pm * BM + wr * 64 + fr; int colt = u.pn * BM; bf16_t* base = O;
        float sc = 1.f; if (split_cols) { const int t = colt / split_cols; base += (size_t)t * split_stride; colt -= t * split_cols; if (t == 0) sc = scale0; }
        const int col0 = colt + wc * 32 + 8 * fq, bcol0 = u.pn * BM + wc * 32 + 8 * fq;
        f32x4 bv[2][2];
#pragma unroll
        for (int bj = 0; bj < 2; ++bj)
#pragma unroll
            for (int n = 0; n < 2; ++n) bv[bj][n] = bias ? *(const f32x4*)(bias + bcol0 + bj * HALF + 4 * n) : (f32x4){0.f, 0.f, 0.f, 0.f};
#pragma unroll
        for (int ai = 0; ai < 2; ++ai)
#pragma unroll
            for (int m = 0; m < 4; ++m) { bf16_t* rowp = base + (size_t)(row0 + ai * HALF + m * 16) * ldc + col0;
#pragma unroll
                for (int bj = 0; bj < 2; ++bj) { f32x4 v0 = acc[ai][bj][m][0] + bv[bj][0], v1 = acc[ai][bj][m][1] + bv[bj][1];
                    if (ACT == 1) { f32x2 a = gelu_pk((f32x2){v0[0], v0[1]}), b = gelu_pk((f32x2){v0[2], v0[3]}), c = gelu_pk((f32x2){v1[0], v1[1]}), d = gelu_pk((f32x2){v1[2], v1[3]});
                        v0 = (f32x4){a.x, a.y, b.x, b.y}; v1 = (f32x4){c.x, c.y, d.x, d.y}; }
                    v0 = v0 * sc; v1 = v1 * sc; u32x4 w; w.x = cvt_pk_bf16(v0[0], v0[1]); w.y = cvt_pk_bf16(v0[2], v0[3]); w.z = cvt_pk_bf16(v1[0], v1[1]); w.w = cvt_pk_bf16(v1[2], v1[3]);
                    *(u32x4*)(rowp + bj * HALF) = w; } }
    }
};

struct EpiResid {
    static constexpr bool PERM = false, AFTER_DRAIN = false;
    const float* base; float* out; const float* gate; int gate_bstride; int rows_per_batch;
    __device__ __forceinline__ void operator()(const f32x4 (&acc)[2][2][4][2], const Unit& u, int wr, int wc, int fr, int fq) const {
        const int row0 = u.pm * BM + wr * 64 + fr, col0 = u.pn * BM + wc * 32 + 4 * fq;
        const float* gp = gate + (size_t)((u.pm * BM) / rows_per_batch) * gate_bstride + col0;
        f32x4 gv[2][2];
#pragma unroll
        for (int bj = 0; bj < 2; ++bj)
#pragma unroll
            for (int n = 0; n < 2; ++n) gv[bj][n] = *(const f32x4*)(gp + bj * HALF + n * 16);
#pragma unroll
        for (int ai = 0; ai < 2; ++ai)
#pragma unroll
            for (int m = 0; m < 4; ++m) { const size_t off = (size_t)(row0 + ai * HALF + m * 16) * 2048 + col0;
#pragma unroll
                for (int bj = 0; bj < 2; ++bj)
#pragma unroll
                    for (int n = 0; n < 2; ++n) { const f32x4 bs = *(const f32x4*)(base + off + bj * HALF + n * 16);
                        *(f32x4*)(out + off + bj * HALF + n * 16) = bs + gv[bj][n] * acc[ai][bj][m][n]; }
                if (m & 1) asm volatile("" ::: "memory"); }
    }
};
struct EpiSwiGLU {
    static constexpr bool PERM = true, AFTER_DRAIN = false;
    bf16_t* O;
    __device__ __forceinline__ void operator()(const f32x4 (&acc)[2][2][4][2], const Unit& u, int wr, int wc, int fr, int fq) const {
        const int row0 = u.pm * BM + wr * 64 + fr; const int f0 = (u.pn & 3) * 128 + wc * 16 + 4 * fq;
#pragma unroll
        for (int ai = 0; ai < 2; ++ai)
#pragma unroll
            for (int m = 0; m < 4; ++m) { bf16_t* rowp = O + (size_t)(row0 + ai * HALF + m * 16) * 512 + f0;
#pragma unroll
                for (int bj = 0; bj < 2; ++bj) { const f32x4 v0 = acc[ai][bj][m][0], v1 = acc[ai][bj][m][1];
                    float r[4]; const float a[4] = {v0[0], v0[2], v1[0], v1[2]}, b[4] = {v0[1], v0[3], v1[1], v1[3]};
#pragma unroll
                    for (int q = 0; q < 4; ++q) r[q] = a[q] * b[q] * __builtin_amdgcn_rcpf(1.0f + __builtin_amdgcn_exp2f(-1.4426950408889634f * a[q]));
                    typedef unsigned u32x2 __attribute__((ext_vector_type(2)));
                    u32x2 w; w.x = cvt_pk_bf16(r[0], r[1]); w.y = cvt_pk_bf16(r[2], r[3]);
                    *(u32x2*)(rowp + bj * 64) = w; } }
    }
};
struct MoeOrder {
    unsigned pk[4]; int njs, G, c;
    __device__ __forceinline__ void init(const unsigned* cnt, int njs_, int G_, int c_) {
        njs = njs_; G = G_; c = c_; unsigned t = 0; pk[0] = pk[1] = pk[2] = pk[3] = 0u;
#pragma unroll
        for (int e = 0; e < 16; ++e) { t += (__builtin_amdgcn_readfirstlane(cnt[e]) + 255u) >> 8; pk[e >> 2] |= t << (8 * (e & 3)); }
    }
    __device__ __forceinline__ bool next(int i, Unit& u) const {
        const int L = i * G + c, rt = L >> njs, j = L & ((1 << njs) - 1);
        if (rt >= (int)(pk[3] >> 24)) return false;
        int e = 0;
#pragma unroll
        for (int q = 0; q < 16; ++q) e += ((int)((pk[q >> 2] >> (8 * (q & 3))) & 255u) <= rt) ? 1 : 0;
        u.pm = rt; u.pn = (e << njs) + j; return true;
    }
    __device__ __forceinline__ void a_ready(const Unit&) const {}
    __device__ __forceinline__ void done(const Unit&) const {}
};

template <class Epi, class Sched, bool ALIGN_EPI = false, bool SP2 = false>
__device__ __forceinline__ void gemm_phase(PG8_LAS unsigned char* lds, const Gemm g, const Sched& S, const Epi& E) {
    int tid_ = threadIdx.x; asm volatile("" : "+v"(tid_));
    const int tid = tid_, wid = __builtin_amdgcn_readfirstlane(tid >> 6), lane = tid & 63, wr = wid >> 2, wc = wid & 3, fr = lane & 15, fq = lane >> 4;
    const int K = g.K, nt = K / BK;
    unsigned voffA[2], voffB[2];
#pragma unroll
    for (int i = 0; i < 2; ++i) { int R, C; stage_rc(tid * 16 + i * 8192, R, C); const int Rb = Epi::PERM ? ((R & ~31) + perm32(R & 31)) : R;
        voffA[i] = (unsigned)(R * K + C) * 2u; voffB[i] = (unsigned)(Rb * K + C) * 2u; }
    const size_t kstep = (size_t)(BK * 2);
    const size_t hstep = (size_t)HALF * K * 2;
    const size_t tstep = 2 * hstep;
    const unsigned ldsw = (unsigned)wid * 1024u;
    const int aoff = lds_byte(wr * 64 + fr, fq * 8), boff = lds_byte(wc * 32 + fr, fq * 8);
#define PG8_SA(b, h) (((b) * 2 + (h)) * HTB)
#define PG8_SB(b, h) ((4 + (b) * 2 + (h)) * HTB)
#define PG8_STAGE(bufoff, gbase, voff) do { _Pragma("unroll") for (int _i = 0; _i < 2; ++_i) \
        __builtin_amdgcn_global_load_lds((const unsigned*)((const char*)(gbase) + (voff)[_i]), (PG8_LAS unsigned*)(lds + (bufoff) + ldsw + _i * 8192), 16, 0, 0); } while (0)
#define PG8_LDA(dst, b, h) do { _Pragma("unroll") for (int m = 0; m < 4; ++m) _Pragma("unroll") for (int k = 0; k < 2; ++k) dst[m][k] = *(const PG8_LAS bf16x8*)(lds + PG8_SA(b, h) + aoff + m * 2048 + k * 1024); } while (0)
#define PG8_LDB(dst, b, h) do { _Pragma("unroll") for (int n = 0; n < 2; ++n) _Pragma("unroll") for (int k = 0; k < 2; ++k) dst[n][k] = *(const PG8_LAS bf16x8*)(lds + PG8_SB(b, h) + boff + n * 2048 + k * 1024); } while (0)
#define PG8_MMA(ai, bj, At, Bt) do { __builtin_amdgcn_s_setprio(1); _Pragma("unroll") for (int m = 0; m < 4; ++m) _Pragma("unroll") for (int n = 0; n < 2; ++n) _Pragma("unroll") for (int k = 0; k < 2; ++k) \
        acc[ai][bj][m][n] = __builtin_amdgcn_mfma_f32_16x16x32_bf16(Bt[n][k], At[m][k], acc[ai][bj][m][n], 0, 0, 0); __builtin_amdgcn_s_setprio(0); } while (0)
#define PG8_WAIT_V(n) asm volatile("s_waitcnt vmcnt(" #n ")" ::: "memory")
#define PG8_WAIT_L(n) asm volatile("s_waitcnt lgkmcnt(" #n ")" ::: "memory")
#define PG8_BAR __builtin_amdgcn_s_barrier()
#define PG8_SCHED __builtin_amdgcn_sched_barrier(0)
    Unit cur, nxt; int ui = 0;
    if (!S.next(0, cur)) return;
    f32x4 acc[2][2][4][2];
#pragma unroll
    for (int a = 0; a < 2; ++a)
#pragma unroll
        for (int b = 0; b < 2; ++b)
#pragma unroll
            for (int m = 0; m < 4; ++m)
#pragma unroll
                for (int n = 0; n < 2; ++n) acc[a][b][m][n] = (f32x4){0.f, 0.f, 0.f, 0.f};
    bf16x8 At[4][2], B0[2][2], B1[2][2];
    const char* cA = (const char*)g.A + (size_t)cur.pm * tstep; const char* cB = (const char*)g.Bt + (size_t)cur.pn * tstep;
    S.a_ready(cur);
    if constexpr (SP2) {
        PG8_STAGE(PG8_SB(0, 0), cB, voffB); PG8_STAGE(PG8_SB(0, 1), cB + hstep, voffB); PG8_STAGE(PG8_SA(0, 0), cA, voffA); PG8_STAGE(PG8_SA(0, 1), cA + hstep, voffA);
        if (wr == 1) PG8_BAR;
        PG8_WAIT_V(2); PG8_BAR;
        PG8_STAGE(PG8_SB(1, 0), cB + kstep, voffB); PG8_STAGE(PG8_SA(1, 0), cA + kstep, voffA); PG8_STAGE(PG8_SB(1, 1), cB + hstep + kstep, voffB);
        PG8_WAIT_V(6); PG8_BAR;
    } else {
        PG8_STAGE(PG8_SB(0, 0), cB, voffB); PG8_STAGE(PG8_SA(0, 0), cA, voffA); PG8_STAGE(PG8_SB(0, 1), cB + hstep, voffB); PG8_STAGE(PG8_SA(0, 1), cA + hstep, voffA);
        if (wr == 1) PG8_BAR;
        PG8_WAIT_V(4); PG8_BAR;
        PG8_STAGE(PG8_SB(1, 0), cB + kstep, voffB); PG8_STAGE(PG8_SA(1, 0), cA + kstep, voffA); PG8_STAGE(PG8_SB(1, 1), cB + hstep + kstep, voffB);
        PG8_WAIT_V(6); PG8_BAR;
    }
    for (;;) {
        const bool has_next = S.next(ui + 1, nxt);
        const char* nA = has_next ? (const char*)g.A + (size_t)nxt.pm * tstep : cA; const char* nB = has_next ? (const char*)g.Bt + (size_t)nxt.pn * tstep : cB;
        for (int t = 0; t < nt; t += 2) {
            const bool last = (t == nt - 2);
            const char* a1 = cA + (size_t)(t + 1) * kstep;
            const char* a2 = last ? nA : cA + (size_t)(t + 2) * kstep; const char* b2 = last ? nB : cB + (size_t)(t + 2) * kstep;
            const char* a3 = a2 + kstep; const char* b3 = b2 + kstep;
            if (last && has_next) S.a_ready(nxt);
            if constexpr (SP2) {
            PG8_LDB(B0, 0, 0); PG8_LDB(B1, 0, 1); PG8_SCHED; PG8_LDA(At, 0, 0); PG8_STAGE(PG8_SA(1, 1), a1 + hstep, voffA);
            PG8_WAIT_V(8); PG8_WAIT_L(0); PG8_BAR; PG8_MMA(0, 0, At, B0); PG8_MMA(0, 1, At, B1); PG8_BAR; PG8_SCHED;
            PG8_LDA(At, 0, 1); PG8_STAGE(PG8_SB(0, 0), b2, voffB); PG8_STAGE(PG8_SB(0, 1), b2 + hstep, voffB); PG8_STAGE(PG8_SA(0, 0), a2, voffA);
            PG8_WAIT_V(8); PG8_WAIT_L(0); PG8_BAR; PG8_MMA(1, 0, At, B0); PG8_MMA(1, 1, At, B1); PG8_BAR; PG8_SCHED;
            PG8_LDB(B0, 1, 0); PG8_LDB(B1, 1, 1); PG8_SCHED; PG8_LDA(At, 1, 0); PG8_STAGE(PG8_SA(0, 1), a2 + hstep, voffA);
            PG8_WAIT_V(8); PG8_WAIT_L(0); PG8_BAR; PG8_MMA(0, 0, At, B0); PG8_MMA(0, 1, At, B1); PG8_BAR; PG8_SCHED;
            PG8_LDA(At, 1, 1); PG8_STAGE(PG8_SB(1, 0), b3, voffB); PG8_STAGE(PG8_SB(1, 1), b3 + hstep, voffB); PG8_STAGE(PG8_SA(1, 0), a3, voffA);
            PG8_WAIT_V(8); PG8_WAIT_L(0); PG8_BAR; PG8_MMA(1, 0, At, B0); PG8_MMA(1, 1, At, B1); PG8_BAR; PG8_SCHED;
            } else {
            PG8_LDB(B0, 0, 0); PG8_SCHED; PG8_LDA(At, 0, 0); PG8_STAGE(PG8_SA(1, 1), a1 + hstep, voffA);
            PG8_WAIT_L(8); PG8_BAR; PG8_WAIT_L(0); PG8_MMA(0, 0, At, B0); PG8_BAR; PG8_SCHED;
            PG8_LDB(B1, 0, 1); PG8_STAGE(PG8_SB(0, 0), b2, voffB);
            PG8_BAR; PG8_WAIT_L(0); PG8_MMA(0, 1, At, B1); PG8_BAR;
            PG8_LDA(At, 0, 1); PG8_STAGE(PG8_SA(0, 0), a2, voffA);
            PG8_BAR; PG8_WAIT_L(0); PG8_MMA(1, 0, At, B0); PG8_BAR; PG8_SCHED;
            PG8_STAGE(PG8_SB(0, 1), b2 + hstep, voffB);
            PG8_WAIT_V(6); PG8_BAR; PG8_MMA(1, 1, At, B1); PG8_BAR;
            PG8_LDB(B0, 1, 0); PG8_SCHED; PG8_LDA(At, 1, 0); PG8_STAGE(PG8_SA(0, 1), a2 + hstep, voffA);
            PG8_WAIT_L(8); PG8_BAR; PG8_WAIT_L(0); PG8_MMA(0, 0, At, B0); PG8_BAR; PG8_SCHED;
            PG8_LDB(B1, 1, 1); PG8_STAGE(PG8_SB(1, 0), b3, voffB);
            PG8_BAR; PG8_WAIT_L(0); PG8_MMA(0, 1, At, B1); PG8_BAR;
            PG8_LDA(At, 1, 1); PG8_STAGE(PG8_SA(1, 0), a3, voffA);
            PG8_BAR; PG8_WAIT_L(0); PG8_MMA(1, 0, At, B0); PG8_BAR; PG8_SCHED;
            PG8_STAGE(PG8_SB(1, 1), b3 + hstep, voffB);
            PG8_WAIT_V(6); PG8_BAR; PG8_MMA(1, 1, At, B1); PG8_BAR;
            }
        }
        if constexpr (ALIGN_EPI) { if (wr == 0) PG8_BAR; }
        if constexpr (!Epi::AFTER_DRAIN) { E(acc, cur, wr, wc, fr, fq); S.done(cur); }
        if (!has_next) break;
#pragma unroll
        for (int a = 0; a < 2; ++a)
#pragma unroll
            for (int b = 0; b < 2; ++b)
#pragma unroll
                for (int m = 0; m < 4; ++m)
#pragma unroll
                    for (int n = 0; n < 2; ++n) acc[a][b][m][n] = (f32x4){0.f, 0.f, 0.f, 0.f};
        cur = nxt; cA = nA; cB = nB; ++ui;
        if constexpr (ALIGN_EPI) { if (wr == 1) PG8_BAR; }
    }
    PG8_WAIT_V(0);
    if constexpr (!ALIGN_EPI) { if (wr == 0) PG8_BAR; }
    PG8_BAR;
    if constexpr (Epi::AFTER_DRAIN) { E.fused(acc, cur, wr, wc, fr, fq, lds, wid, lane); S.done(cur); }
#undef PG8_SA
#undef PG8_SB
#undef PG8_STAGE
#undef PG8_LDA
#undef PG8_LDB
#undef PG8_MMA
#undef PG8_WAIT_V
#undef PG8_WAIT_L
#undef PG8_BAR
#undef PG8_SCHED
}
}

#ifndef PG8_SP2
#define PG8_SP2 true
#endif
#ifndef PG8_ALIGN
#define PG8_ALIGN true
#endif
constexpr int NWAVES = 8;
constexpr int BATCH = 2, SEQ = 8192, DM = 2048, M = BATCH * SEQ;
constexpr int NQKV = 6144, NQKV_ODD = 6160;
constexpr int NE = 16, FFE = 512;
constexpr int MODW = 6 * DM;
constexpr float EPS = 1e-6f;
constexpr int MAXROWS = 36864;

constexpr size_t MiB = 1u << 20;
constexpr size_t WS_CTL = 0, CTL_ZERO_BYTES = 1 * MiB;
constexpr size_t WS_MOD = 1 * MiB;
constexpr size_t WS_LAM = WS_MOD + 2 * 2 * MODW * 4;
constexpr size_t WS_KMEAN = 2 * MiB;
constexpr size_t WS_WFG = 3 * MiB;
constexpr size_t WS_WRT = 3 * MiB + 128 * 1024;
constexpr size_t WS_ROUTE = 4 * MiB;
constexpr size_t WS_LOGF = 5 * MiB;
constexpr size_t WS_CUM = 6 * MiB;
constexpr size_t WS_SCR = 8 * MiB;
constexpr size_t WS_WIN = 40 * MiB;
constexpr size_t WS_WOUT = 88 * MiB;
constexpr size_t WS_W13 = 104 * MiB;
constexpr size_t WS_W2 = 232 * MiB;
constexpr size_t WS_H = 296 * MiB;
constexpr size_t WS_QKV = 360 * MiB;
constexpr size_t WS_MRG = 552 * MiB;
constexpr size_t WS_ACT = 616 * MiB;
constexpr size_t WS_OSL = 652 * MiB;
constexpr size_t WS_END = 796 * MiB;
constexpr int CW_TMO = 0;
constexpr int CW_CNT = 1024;
constexpr int CW_BAR = 4096;

constexpr int RING_OFF = 0, RING_BYTES = 131072;
constexpr int LDSCTL_OFF = RING_BYTES, MISC_OFF = LDSCTL_OFF + 320;
constexpr int LDS_BYTES = 147456;

#define GAS __attribute__((address_space(1)))
#define LAS __attribute__((address_space(3)))
typedef unsigned short bf16;
typedef unsigned v4u __attribute__((ext_vector_type(4)));
typedef unsigned v2u __attribute__((ext_vector_type(2)));
typedef float f32x4 __attribute__((ext_vector_type(4)));
typedef float f32x16 __attribute__((ext_vector_type(16)));
typedef short bf16x8 __attribute__((ext_vector_type(8)));
typedef short s16x4 __attribute__((ext_vector_type(4)));
typedef GAS unsigned gu32;
#define RLX_AGENT __ATOMIC_RELAXED, __HIP_MEMORY_SCOPE_AGENT
#define LDS_WAIT() asm volatile("s_waitcnt lgkmcnt(0)" ::: "memory")
#define VM_WAIT() asm volatile("s_waitcnt vmcnt(0)" ::: "memory")
__device__ __forceinline__ unsigned f2bf(float f) { unsigned u = __builtin_bit_cast(unsigned, f); return (u + 0x7fffu + ((u >> 16) & 1u)) >> 16; }
__device__ __forceinline__ unsigned pk2(float lo, float hi) { return f2bf(lo) | (f2bf(hi) << 16); }
__device__ __forceinline__ float bflo(unsigned w) { return __builtin_bit_cast(float, w << 16); }
__device__ __forceinline__ float bfhi(unsigned w) { return __builtin_bit_cast(float, w & 0xffff0000u); }
__device__ __forceinline__ int opaque_tid() { int t = threadIdx.x; asm volatile("" : "+v"(t)); return t; }
__device__ __forceinline__ float wave_sum(float v) {
#pragma unroll
    for (int o = 1; o < 64; o <<= 1) v += __shfl_xor(v, o);
    return v;
}
__device__ __forceinline__ float wave_max(float v) {
#pragma unroll
    for (int o = 1; o < 64; o <<= 1) v = fmaxf(v, __shfl_xor(v, o));
    return v;
}
#define XB_TMO      128
#define XB_XCNT(j)  (256  + 64 * (j))
#define XB_XSUB(j)  (1280 + 64 * (j))
#define XB_XGEN(j)  (2304 + 64 * (j))
#define XB_TOP      3328
#define XB_TOPGEN   3392
#define XCD_BAR_WORDS 3456
#define XB_SPIN_CAP (1u << 18)

__device__ __forceinline__ unsigned xb_ld(unsigned* p)              { return __hip_atomic_load(p, __ATOMIC_RELAXED, __HIP_MEMORY_SCOPE_AGENT); }
__device__ __forceinline__ unsigned xb_add(unsigned* p, unsigned v) { return __hip_atomic_fetch_add(p, v, __ATOMIC_RELAXED, __HIP_MEMORY_SCOPE_AGENT); }
__device__ __forceinline__ unsigned xb_xcc_id() { return (unsigned)__builtin_amdgcn_s_getreg((3 << 11) | 20) & 0xFu; }
#define XB_SPIN(cond, bar) do { unsigned _sp = 0; while (cond) { __builtin_amdgcn_s_sleep(1); \
    if ((++_sp & 255u) == 0u) { if (xb_ld(&(bar)[XB_TMO])) break; if (_sp > XB_SPIN_CAP) { atomicAdd(&(bar)[XB_TMO], 1u); break; } } } } while (0)

struct XcdBarrier {
    unsigned* bar; unsigned x;
    volatile LAS unsigned* st;
};

__device__ __forceinline__ XcdBarrier xcd_barrier_post(unsigned* bar, volatile LAS unsigned* st) {
    XcdBarrier b; b.bar = bar; b.x = xb_xcc_id(); b.st = st;
    if (threadIdx.x == 0) (void)xb_add(&bar[XB_XCNT(b.x)], 1u);
    return b;
}
__device__ __forceinline__ void xcd_barrier_complete(unsigned* bar, unsigned x, unsigned& nloc, unsigned& nx) {
    const unsigned G = gridDim.x * gridDim.y * gridDim.z;
    unsigned sum, cnt, mine, sp = 0u;
    for (;;) {
        sum = 0u; cnt = 0u; mine = 0u;
#pragma unroll
        for (unsigned j = 0; j < 16; ++j) { const unsigned c = xb_ld(&bar[XB_XCNT(j)]); sum += c; cnt += (c > 0u) ? 1u : 0u; mine = (j == x) ? c : mine; }
        if (sum == G) break;
        __builtin_amdgcn_s_sleep(1);
        if ((++sp & 255u) == 0u) { if (xb_ld(&bar[XB_TMO])) break; if (sp > XB_SPIN_CAP) { atomicAdd(&bar[XB_TMO], 1u); break; } }
    }
    nloc = mine > 0u ? mine : 1u; nx = cnt > 0u ? cnt : 1u;
}

__device__ __forceinline__ void xcd_barrier(const XcdBarrier& b) {
    asm volatile("s_waitcnt vmcnt(0)" ::: "memory");
    __syncthreads();
    if (threadIdx.x == 0) {
        unsigned* bar = b.bar;
        __builtin_amdgcn_s_waitcnt(0);
        unsigned nloc = b.st[0], nx = b.st[1];
        if (nloc == 0u) { xcd_barrier_complete(bar, b.x, nloc, nx); b.st[0] = nloc; b.st[1] = nx; }
        const unsigned old = xb_add(&bar[XB_XSUB(b.x)], 1u);
        const unsigned gen = old / nloc;
        if (old + 1u == (gen + 1u) * nloc) {
            __builtin_amdgcn_fence(__ATOMIC_RELEASE, "agent");
            asm volatile("s_waitcnt vmcnt(0)" ::: "memory");
            const unsigned og = xb_add(&bar[XB_TOP], 1u);
            const unsigned tg = og / nx;
            if (og + 1u == (tg + 1u) * nx) xb_add(&bar[XB_TOPGEN], 1u);
            else XB_SPIN(xb_ld(&bar[XB_TOPGEN]) == tg, bar);
            __builtin_amdgcn_fence(__ATOMIC_ACQUIRE, "agent");
            xb_add(&bar[XB_XGEN(b.x)], 1u);
            asm volatile("s_waitcnt vmcnt(0)" ::: "memory");
        } else {
            XB_SPIN(xb_ld(&bar[XB_XGEN(b.x)]) == gen, bar);
            __builtin_amdgcn_fence(__ATOMIC_ACQUIRE, "agent");
            asm volatile("s_waitcnt vmcnt(0)" ::: "memory");
        }
    }
    __syncthreads();
}
struct Args { const float* in[22]; float* out; unsigned char* ws; int ph_lo, ph_hi; };
struct Frame { LAS unsigned char* lds; volatile LAS unsigned* MISC; gu32* ctl; int tid, lane, wave, vcu, G; };
enum { I_X = 0, I_C = 1, I_ADAW = 2, I_ADAB = 3, I_ANG = 4, I_FNG = 5, I_WINE = 6, I_WOUTE = 7, I_LQ1 = 8, I_LK1 = 9, I_LQ2 = 10, I_LK2 = 11, I_SUBLN = 12,
       I_WINO = 13, I_BF = 14, I_WOUTO = 15, I_RW = 16, I_RB = 17, I_W1 = 18, I_W3 = 19, I_W2 = 20, I_FING = 21 };

__device__ __forceinline__ void transpose_item(const float* W, int ldw, int K, int ncols, bf16* WT, int row_off, int rs, LAS float* scr, int item, int lane) {
    const int nblk = ncols / 32, kb = item / nblk, nb = item % nblk, k0 = 64 * kb, n0 = 32 * nb;
#pragma unroll 8
    for (int i = 0; i < 32; ++i) { const int kk = 2 * i + (lane >> 5); scr[kk * 33 + (lane & 31)] = W[(size_t)(k0 + kk) * ldw + n0 + (lane & 31)]; }
    LDS_WAIT(); asm volatile("" ::: "memory");
    const int c = lane & 7;
#pragma unroll
    for (int j = 0; j < 4; ++j) { const int n = (lane >> 3) + 8 * j; const LAS float* s = scr + (8 * c) * 33 + n;
        v4u o; o.x = pk2(s[0 * 33], s[1 * 33]); o.y = pk2(s[2 * 33], s[3 * 33]); o.z = pk2(s[4 * 33], s[5 * 33]); o.w = pk2(s[6 * 33], s[7 * 33]);
        *(GAS v4u*)(WT + (size_t)(row_off + (n0 + n) * rs) * K + k0 + 8 * c) = o; }
    LDS_WAIT(); asm volatile("" ::: "memory");
}
__device__ __forceinline__ void p0_prologue(const Args& A, const Frame& F0) {
    Frame F = F0; F.tid = opaque_tid(); F.lane = F.tid & 63; F.wave = __builtin_amdgcn_readfirstlane(F.tid >> 6);
    unsigned char* ws = A.ws;
    for (int it = blockIdx.x; it < 96; it += F.G) {
        LAS float* cond = (LAS float*)(F.lds); LAS float* red = (LAS float*)(F.lds + 16384);
        for (int i = F.tid; i < 4096; i += 512) { const float cv = A.in[I_C][i]; cond[i] = cv / (1.0f + __expf(-cv)); }
        __syncthreads();
        const int l = it / 48, cg = it % 48;
        const float* W = A.in[I_ADAW] + (size_t)l * DM * MODW + cg * 256 + 4 * F.lane;
        f32x4 a0 = {0.f, 0.f, 0.f, 0.f}, a1 = {0.f, 0.f, 0.f, 0.f};
        const int kb = 256 * F.wave;
#pragma unroll 8
        for (int k = 0; k < 256; ++k) { const f32x4 w = *(const f32x4*)(W + (size_t)(kb + k) * MODW); a0 += cond[kb + k] * w; a1 += cond[2048 + kb + k] * w; }
        *(LAS f32x4*)(red + (F.wave * 2 + 0) * 256 + 4 * F.lane) = a0; *(LAS f32x4*)(red + (F.wave * 2 + 1) * 256 + 4 * F.lane) = a1;
        __syncthreads();
        { const int b = F.tid >> 8, n = F.tid & 255; float s = A.in[I_ADAB][l * MODW + cg * 256 + n];
#pragma unroll
          for (int w = 0; w < 8; ++w) s += red[(w * 2 + b) * 256 + n];
          ((float*)(ws + WS_MOD))[(l * 2 + b) * MODW + cg * 256 + n] = s; }
        __syncthreads();
    }
    if (blockIdx.x == 0 && F.tid == 0) { float s1 = 0.f, s2 = 0.f;
        for (int i = 0; i < 64; ++i) { s1 += A.in[I_LQ1][i] * A.in[I_LK1][i]; s2 += A.in[I_LQ2][i] * A.in[I_LK2][i]; }
        *(float*)(ws + WS_LAM) = __expf(s1) - __expf(s2) + 0.2f; }
    for (int i = blockIdx.x * 512 + F.tid; i < 16 * DM; i += F.G * 512) { const int j = i >> 11, k = i & 2047;
        ((float*)(ws + WS_WFG))[i] = A.in[I_WINO][(size_t)k * NQKV_ODD + NQKV + j]; ((float*)(ws + WS_WRT))[i] = A.in[I_RW][k * 16 + j]; }
    LAS float* scr = (LAS float*)(F.lds + F.wave * 16384);
    const int gw = F.vcu * NWAVES + F.wave, NGW = F.G * NWAVES;
    constexpr int I_IN = 32 * 192, I_OUT = 32 * 64, I_MOE = 32 * 512;
    for (int it = gw; it < 2 * I_IN + 2 * I_OUT + 3 * I_MOE; it += NGW) {
        int r = it;
        if (r < I_IN) { transpose_item(A.in[I_WINE], NQKV, DM, NQKV, (bf16*)(ws + WS_WIN), 0, 1, scr, r, F.lane); continue; } r -= I_IN;
        if (r < I_IN) { transpose_item(A.in[I_WINO], NQKV_ODD, DM, NQKV, (bf16*)(ws + WS_WIN) + (size_t)NQKV * DM, 0, 1, scr, r, F.lane); continue; } r -= I_IN;
        if (r < I_OUT) { transpose_item(A.in[I_WOUTE], DM, DM, DM, (bf16*)(ws + WS_WOUT), 0, 1, scr, r, F.lane); continue; } r -= I_OUT;
        if (r < I_OUT) { transpose_item(A.in[I_WOUTO], DM, DM, DM, (bf16*)(ws + WS_WOUT) + (size_t)DM * DM, 0, 1, scr, r, F.lane); continue; } r -= I_OUT;
        if (r < 2 * I_MOE) { const int which = r / I_MOE; r -= which * I_MOE; const int le = r >> 9, l = le >> 4, e = le & 15;
            transpose_item(A.in[which ? I_W3 : I_W1] + (size_t)le * DM * FFE, FFE, DM, FFE, (bf16*)(ws + WS_W13) + (size_t)l * 16384 * DM, e * 1024 + which, 2, scr, r & 511, F.lane); continue; }
        r -= 2 * I_MOE;
        { const int le = r >> 9, l = le >> 4, e = le & 15;
          transpose_item(A.in[I_W2] + (size_t)le * FFE * DM, DM, FFE, DM, (bf16*)(ws + WS_W2) + (size_t)l * 32768 * FFE, e * 2048, 1, scr, r & 511, F.lane); }
    }
}

template <int MODE>
__device__ __forceinline__ void norm_phase(const Args& A, const Frame& F0, int l) {
    Frame F = F0; F.tid = opaque_tid(); F.lane = F.tid & 63; F.wave = __builtin_amdgcn_readfirstlane(F.tid >> 6);
    unsigned char* ws = A.ws;
    constexpr bool SIDE = (MODE == 1 || MODE == 2), COMB = (MODE == 2 || MODE == 3);
    LAS float* WT = (LAS float*)F.lds;
    if (SIDE) { const f32x4* src = (const f32x4*)(ws + (MODE == 1 ? WS_WRT : WS_WFG));
        for (int i = F.tid; i < 16 * DM / 4; i += 512) *(LAS f32x4*)(WT + 4 * i) = src[i];
        __syncthreads(); }
    const float* modl = (const float*)(ws + WS_MOD) + (size_t)l * 2 * MODW;
    const float* gain = MODE == 3 ? A.in[I_FING] : (MODE == 1 ? A.in[I_FNG] + l * DM : A.in[I_ANG] + l * DM);
    const float* xsrc = MODE == 0 ? A.in[I_X] : A.out;
    const float* modprev = (const float*)(ws + WS_MOD) + (size_t)(MODE == 3 ? 1 : 0) * 2 * MODW;
    const unsigned* route = (const unsigned*)(ws + WS_ROUTE);
    const bf16* OSL = (const bf16*)(ws + WS_OSL);
    bf16* H = (bf16*)(ws + WS_H);
    const int gw = F.vcu * NWAVES + F.wave, NGW = F.G * NWAVES, lane = F.lane;
    for (int m = gw; m < M; m += NGW) {
        const int b = m >> 13;
        f32x4 v[8];
        { const f32x4* xr = (const f32x4*)(xsrc + (size_t)m * DM) + lane;
#pragma unroll
          for (int j = 0; j < 8; ++j) v[j] = xr[64 * j]; }
        if (COMB) {
            const unsigned* rt = route + (size_t)m * 6;
            const float w0 = __builtin_bit_cast(float, rt[2]), w1 = __builtin_bit_cast(float, rt[3]);
            const v2u* o0 = (const v2u*)(OSL + (size_t)rt[4] * DM) + lane; const v2u* o1 = (const v2u*)(OSL + (size_t)rt[5] * DM) + lane;
            const f32x4* g2 = (const f32x4*)(modprev + (size_t)b * MODW + 5 * DM) + lane;
#pragma unroll
            for (int j = 0; j < 8; ++j) { const v2u a = o0[64 * j], c = o1[64 * j]; const f32x4 g = g2[64 * j];
                v[j].x += g.x * (w0 * bflo(a.x) + w1 * bflo(c.x)); v[j].y += g.y * (w0 * bfhi(a.x) + w1 * bfhi(c.x));
                v[j].z += g.z * (w0 * bflo(a.y) + w1 * bflo(c.y)); v[j].w += g.w * (w0 * bfhi(a.y) + w1 * bfhi(c.y)); }
            if (MODE == 2) { f32x4* xw = (f32x4*)(A.out + (size_t)m * DM) + lane;
#pragma unroll
                for (int j = 0; j < 8; ++j) xw[64 * j] = v[j]; }
        }
        float ss = 0.f;
#pragma unroll
        for (int j = 0; j < 8; ++j) ss += (v[j].x * v[j].x + v[j].y * v[j].y) + (v[j].z * v[j].z + v[j].w * v[j].w);
        const float rstd = 1.0f / sqrtf(wave_sum(ss) * (1.0f / DM) + EPS);
        if (MODE == 3) {
            f32x4* ow = (f32x4*)(A.out + (size_t)m * DM) + lane; const f32x4* gp = (const f32x4*)gain + lane;
#pragma unroll
            for (int j = 0; j < 8; ++j) ow[64 * j] = v[j] * rstd * gp[64 * j];
            continue;
        }
        { const f32x4* gp = (const f32x4*)gain + lane;
          const f32x4* shp = (const f32x4*)(modl + (size_t)b * MODW + (MODE == 1 ? 3 : 0) * DM) + lane;
          const f32x4* scp = (const f32x4*)(modl + (size_t)b * MODW + (MODE == 1 ? 4 : 1) * DM) + lane;
          v2u* hw = (v2u*)(H + (size_t)m * DM) + lane;
#pragma unroll
          for (int j = 0; j < 8; ++j) { v[j] = v[j] * rstd * gp[64 * j] * (1.0f + scp[64 * j]) + shp[64 * j];
              v2u o; o.x = pk2(v[j].x, v[j].y); o.y = pk2(v[j].z, v[j].w); hw[64 * j] = o; } }
        if (SIDE) {
            float z = 0.f;
#pragma unroll 1
            for (int q = 0; q < 16; ++q) { float d = 0.f;
#pragma unroll
                for (int j = 0; j < 8; ++j) { const f32x4 w = *(const LAS f32x4*)(WT + q * DM + 256 * j + 4 * lane); d += (v[j].x * w.x + v[j].y * w.y) + (v[j].z * w.z + v[j].w * w.w); }
                d = wave_sum(d); if (lane == q) z = d; }
            if (MODE == 2) {
                if (lane < 16) { z += A.in[I_BF][lane]; const float r = z >= 0.f ? -log1pf(__expf(-z)) : z - log1pf(__expf(z));
                    ((float*)(ws + WS_LOGF))[(size_t)m * 16 + lane] = r; }
            } else {
                float aff[16], sel[16];
#pragma unroll
                for (int q = 0; q < 16; ++q) { const float lgq = __shfl(z, q); aff[q] = 1.0f / (1.0f + __expf(-lgq)); sel[q] = aff[q] + A.in[I_RB][q]; }
                int best = 0; float bs = -3.0e38f;
#pragma unroll
                for (int g = 0; g < 4; ++g) { const float a = sel[4 * g], bq = sel[4 * g + 1], c = sel[4 * g + 2], d = sel[4 * g + 3];
                    const float t2 = fmaxf(fmaxf(fmaxf(a + bq, a + c), fmaxf(a + d, bq + c)), fmaxf(bq + d, c + d));
                    if (t2 > bs) { bs = t2; best = g; } }
                float cs[4], ca[4];
#pragma unroll
                for (int i = 0; i < 4; ++i) { cs[i] = sel[i]; ca[i] = aff[i]; }
#pragma unroll
                for (int g = 1; g < 4; ++g) if (best == g) {
#pragma unroll
                    for (int i = 0; i < 4; ++i) { cs[i] = sel[4 * g + i]; ca[i] = aff[4 * g + i]; } }
                int i1 = 0; float s1 = cs[0], a1 = ca[0];
#pragma unroll
                for (int i = 1; i < 4; ++i) if (cs[i] > s1) { s1 = cs[i]; a1 = ca[i]; i1 = i; }
                int i2 = -1; float s2 = -3.0e38f, a2 = 0.f;
#pragma unroll
                for (int i = 0; i < 4; ++i) if (i != i1 && cs[i] > s2) { s2 = cs[i]; a2 = ca[i]; i2 = i; }
                const int e0 = best * 4 + i1, e1 = best * 4 + i2; const float inv = 1.0f / (a1 + a2);
                if (lane == 0) { unsigned* cnt = (unsigned*)(F.ctl + CW_CNT + 64 * l);
                    const unsigned p0 = __hip_atomic_fetch_add(cnt + e0, 1u, RLX_AGENT), p1 = __hip_atomic_fetch_add(cnt + e1, 1u, RLX_AGENT);
                    unsigned* rt = (unsigned*)(ws + WS_ROUTE) + (size_t)m * 6;
                    rt[0] = (unsigned)e0; rt[1] = (unsigned)e1; rt[2] = __builtin_bit_cast(unsigned, a1 * inv); rt[3] = __builtin_bit_cast(unsigned, a2 * inv); rt[4] = p0; rt[5] = p1; }
            }
        }
    }
}
__device__ __forceinline__ void scan_phase(const Args& A, const Frame& F0) {
    Frame F = F0; F.tid = opaque_tid(); F.lane = F.tid & 63; F.wave = __builtin_amdgcn_readfirstlane(F.tid >> 6);
    const float* LOGF = (const float*)(A.ws + WS_LOGF); float* CUM = (float*)(A.ws + WS_CUM);
    LAS float* wt = (LAS float*)F.lds;
    for (int u = blockIdx.x; u < BATCH * 16; u += F.G) {
        const int b = u >> 4, h = u & 15, s0 = F.tid * 16;
        float v[16]; float run = 0.f;
#pragma unroll
        for (int i = 0; i < 16; ++i) { run += LOGF[(size_t)(b * SEQ + s0 + i) * 16 + h]; v[i] = run; }
        float inc = run;
#pragma unroll
        for (int o = 1; o < 64; o <<= 1) { const float t = __shfl_up(inc, o); if (F.lane >= o) inc += t; }
        if (F.lane == 63) wt[F.wave] = inc;
        __syncthreads();
        float base = inc - run;
        for (int w = 0; w < F.wave; ++w) base += wt[w];
        float* dst = CUM + (size_t)(b * 16 + h) * SEQ + s0;
#pragma unroll
        for (int i = 0; i < 16; ++i) dst[i] = -(base + v[i]) * 11.313708498984761f;
        __syncthreads();
    }
}
__device__ __forceinline__ void kmean_phase(const Args& A, const Frame& F0) {
    Frame F = F0; F.tid = opaque_tid(); F.lane = F.tid & 63; F.wave = __builtin_amdgcn_readfirstlane(F.tid >> 6);
    const bf16* QKV = (const bf16*)(A.ws + WS_QKV); float* KM = (float*)(A.ws + WS_KMEAN);
    LAS float* red = (LAS float*)F.lds;
    for (int u = blockIdx.x; u < BATCH * 8 * 32; u += F.G) {
        const int b = u >> 8, h = (u >> 5) & 7, blk = u & 31, c = F.tid & 15, rg = F.tid >> 4;
        float s[8] = {0.f, 0.f, 0.f, 0.f, 0.f, 0.f, 0.f, 0.f};
#pragma unroll
        for (int i = 0; i < 8; ++i) { const v4u w = *(const v4u*)(QKV + (size_t)(b * SEQ + blk * 256 + rg + 32 * i) * NQKV + 4096 + h * 128 + 8 * c);
            s[0] += bflo(w.x); s[1] += bfhi(w.x); s[2] += bflo(w.y); s[3] += bfhi(w.y); s[4] += bflo(w.z); s[5] += bfhi(w.z); s[6] += bflo(w.w); s[7] += bfhi(w.w); }
#pragma unroll
        for (int i = 0; i < 8; ++i) red[rg * 128 + 8 * c + i] = s[i];
        __syncthreads();
        if (F.tid < 128) { float t = 0.f;
#pragma unroll
            for (int r = 0; r < 32; ++r) t += red[r * 128 + F.tid];
            KM[(size_t)u * 128 + F.tid] = t * (1.0f / 256.0f); }
        __syncthreads();
    }
}
__device__ __forceinline__ void gather_phase(const Args& A, const Frame& F0, int l) {
    Frame F = F0; F.tid = opaque_tid(); F.lane = F.tid & 63; F.wave = __builtin_amdgcn_readfirstlane(F.tid >> 6);
    const unsigned* cnt = (const unsigned*)(F.ctl + CW_CNT + 64 * l);
    unsigned basev = 0;
    { unsigned t = 0;
#pragma unroll
      for (int e = 0; e < 16; ++e) { if (F.lane == e) basev = t * 256u; t += (cnt[e] + 255u) >> 8; } }
    unsigned* route = (unsigned*)(A.ws + WS_ROUTE); const bf16* H = (const bf16*)(A.ws + WS_H); bf16* HS = (bf16*)(A.ws + WS_QKV);
    const int gw = F.vcu * NWAVES + F.wave, NGW = F.G * NWAVES;
    for (int m = gw; m < M; m += NGW) {
        unsigned* rt = route + (size_t)m * 6;
        const unsigned e0 = rt[0], e1 = rt[1], p0 = rt[4], p1 = rt[5];
        const unsigned s0 = __shfl(basev, (int)e0) + p0, s1 = __shfl(basev, (int)e1) + p1;
        const v4u* src = (const v4u*)(H + (size_t)m * DM) + F.lane; v4u* d0 = (v4u*)(HS + (size_t)s0 * DM) + F.lane; v4u* d1 = (v4u*)(HS + (size_t)s1 * DM) + F.lane;
        v4u x[4];
#pragma unroll
        for (int j = 0; j < 4; ++j) x[j] = src[64 * j];
#pragma unroll
        for (int j = 0; j < 4; ++j) { d0[64 * j] = x[j]; d1[64 * j] = x[j]; }
        asm volatile("" ::: "memory");
        if (F.lane == 0) { rt[4] = s0; rt[5] = s1; }
    }
}
#ifndef NAIVE_ATTN
#define NAIVE_ATTN 0
#endif
#if NAIVE_ATTN
template <int DQ>
__device__ __forceinline__ void naive_span(const bf16* Kp, const bf16* Vp, const LAS float* q, int kb, int ke, int pos, float scale, float slope, const float* CUMrow, float cq,
                                           float& mrun, float& lrun, float& o0, float& o1, int lane) {
    for (int kc = kb; kc < ke; kc += 64) {
        const int key = kc + lane;
        float s = 0.f;
        { const bf16* kr = Kp + (size_t)key * NQKV;
#pragma unroll
          for (int c = 0; c < DQ / 8; ++c) { const v4u w = *(const v4u*)(kr + 8 * c); const f32x4 qa = *(const LAS f32x4*)(q + 8 * c), qb = *(const LAS f32x4*)(q + 8 * c + 4);
              s += (qa.x * bflo(w.x) + qa.y * bfhi(w.x)) + (qa.z * bflo(w.y) + qa.w * bfhi(w.y)) + (qb.x * bflo(w.z) + qb.y * bfhi(w.z)) + (qb.z * bflo(w.w) + qb.w * bfhi(w.w)); } }
        s = s * scale + (CUMrow ? (CUMrow[key] - cq) * scale : slope * (float)(key - pos));
        if (key > pos || key >= ke) s = -__builtin_inff();
        const float cm = wave_max(s);
        if (cm == -__builtin_inff()) continue;
        const float mn = fmaxf(mrun, cm), al = __expf(mrun - mn), p = __expf(s - mn);
        lrun = lrun * al + wave_sum(p); o0 *= al; o1 *= al; mrun = mn;
        for (int j = 0; j < 64; ++j) { const float pj = __shfl(p, j); const unsigned vv = *(const unsigned*)(Vp + (size_t)(kc + j) * NQKV + 2 * lane); o0 += pj * bflo(vv); o1 += pj * bfhi(vv); }
    }
}
template <int VAR>
__global__ void __launch_bounds__(256) naive_attn(const bf16* __restrict__ QKV, bf16* __restrict__ MRG, const float* __restrict__ CUM, const float* __restrict__ KMEAN,
                                                  const float* __restrict__ lamp, const float* __restrict__ subg) {
    __shared__ float qs[4][128];
    constexpr int NH = VAR == 2 ? 16 : 8;
    const int wave = threadIdx.x >> 6, lane = threadIdx.x & 63;
    const long id = (long)blockIdx.x * 4 + wave; const int m = (int)(id / NH), hh = (int)(id % NH), b = m >> 13, pos = m & 8191;
    const bf16* row = QKV + (size_t)m * NQKV; const bf16* base = QKV + (size_t)b * SEQ * NQKV;
    LAS float* q = (LAS float*)qs[wave];
    if (VAR == 0) {
        const float slope = exp2f(-(2.0f * hh + 1.0f) * 0.5f);
        float O0[2], O1[2];
#pragma unroll
        for (int mp = 0; mp < 2; ++mp) {
            q[lane] = bflo((unsigned)row[hh * 128 + mp * 64 + lane]); __builtin_amdgcn_wave_barrier(); LDS_WAIT();
            float mr = -1e30f, lr = 0.f, o0 = 0.f, o1 = 0.f;
            naive_span<64>(base + 1024 + hh * 128 + mp * 64, base + 2048 + hh * 128, q, 0, pos + 1, pos, 0.125f, slope, nullptr, 0.f, mr, lr, o0, o1, lane);
            O0[mp] = o0 / lr; O1[mp] = o1 / lr; __builtin_amdgcn_wave_barrier();
        }
        const float lam = *lamp; const float a0 = O0[0] - lam * O0[1], a1 = O1[0] - lam * O1[1];
        const float r = 1.0f / sqrtf(wave_sum(a0 * a0 + a1 * a1) * (1.0f / 128.0f) + EPS);
        *(unsigned*)(MRG + (size_t)m * DM + hh * 128 + 2 * lane) = pk2(a0 * r * subg[2 * lane] * 0.8f, a1 * r * subg[2 * lane + 1] * 0.8f);
    } else if (VAR == 1) {
        const float slope = exp2f(-(float)(hh + 1));
        q[lane] = bflo((unsigned)row[3072 + hh * 128 + lane]); q[64 + lane] = bflo((unsigned)row[3072 + hh * 128 + 64 + lane]); __builtin_amdgcn_wave_barrier(); LDS_WAIT();
        const int own = pos >> 8;
        float g = -3.0e38f;
        if (lane < own) { const float* km = KMEAN + ((size_t)(b * 8 + hh) * 32 + lane) * 128; float s = 0.f;
            for (int d = 0; d < 128; ++d) s += q[d] * km[d]; g = s; }
        unsigned long long selm = 0ull;
        for (int t = 0; t < 3 && t < own; ++t) { const float mx = wave_max(g); const unsigned long long bal = __ballot(g == mx); const int pick = __ffsll((long long)bal) - 1;
            selm |= 1ull << pick; if (lane == pick) g = -3.0e38f; }
        float mr = -1e30f, lr = 0.f, o0 = 0.f, o1 = 0.f;
        for (int n = 0; n < own; ++n) if ((selm >> n) & 1ull)
            naive_span<128>(base + 4096 + hh * 128, base + 5120 + hh * 128, q, n * 256, n * 256 + 256, pos, 0.08838834764831845f, slope, nullptr, 0.f, mr, lr, o0, o1, lane);
        naive_span<128>(base + 4096 + hh * 128, base + 5120 + hh * 128, q, own * 256, pos + 1, pos, 0.08838834764831845f, slope, nullptr, 0.f, mr, lr, o0, o1, lane);
        *(unsigned*)(MRG + (size_t)m * DM + 1024 + hh * 128 + 2 * lane) = pk2(o0 / lr, o1 / lr);
    } else {
        q[lane] = bflo((unsigned)row[hh * 128 + lane]); q[64 + lane] = bflo((unsigned)row[hh * 128 + 64 + lane]); __builtin_amdgcn_wave_barrier(); LDS_WAIT();
        const float* cr = CUM + (size_t)(b * 16 + hh) * SEQ;
        float mr = -1e30f, lr = 0.f, o0 = 0.f, o1 = 0.f;
        naive_span<128>(base + 2048 + hh * 128, base + 4096 + hh * 128, q, 0, pos + 1, pos, 0.08838834764831845f, 0.f, cr, cr[pos], mr, lr, o0, o1, lane);
        *(unsigned*)(MRG + (size_t)m * DM + hh * 128 + 2 * lane) = pk2(o0 / lr, o1 / lr);
    }
}
#endif
namespace att {
constexpr int V_OFF = 0, K_OFF = 32768, C_OFF = 65536, G_KM = 66560, G_GT = G_KM + 16384, G_SEL = G_GT + 256 * 33 * 4, G_OR = G_SEL + 1024, ATT_LDS = G_OR + 16;
static_assert(ATT_LDS <= RING_BYTES, "attention LDS");
constexpr float THR = 8.f;
#define SBAR() __builtin_amdgcn_sched_barrier(0)
__device__ __forceinline__ int v_st(int k, int c) { const int kk = (k & ~0xC) | ((k & 4) << 1) | ((k & 8) >> 1); return ((kk >> 3) * 4 + (c >> 5)) * 512 + ((kk & 7) * 32 + (c & 31)) * 2; }
__device__ __forceinline__ int v_rd_base(int lane) { return ((lane & 3) << 3) | (((lane >> 2) & 3) << 6) | (((lane >> 4) & 1) << 5) | (((lane >> 5) & 1) << 8); }
__device__ __forceinline__ unsigned cvtpk(float lo, float hi) { unsigned r; asm volatile("v_cvt_pk_bf16_f32 %0, %1, %2" : "=v"(r) : "v"(lo), "v"(hi)); return r; }

template <int VAR>
__device__ __forceinline__ void attn_block(LAS unsigned char* lds, const bf16* __restrict__ Qp, const bf16* __restrict__ Kp, const bf16* __restrict__ Vp, const int P0,
                                           const float slope, const float* __restrict__ cumrow, const unsigned selrow, unsigned wgmask, f32x16 (&o)[4], float& l_out) {
    constexpr int DQK = VAR == 0 ? 64 : 128, NQ = DQK / 16;
    constexpr float SCALE = VAR == 0 ? 0.125f : 0.08838834764831845f, C2 = SCALE * 1.4426950408889634f, ISC = 1.0f / SCALE;
    const int tid = opaque_tid(), wid = __builtin_amdgcn_readfirstlane(tid >> 6), lane = tid & 63, r32 = lane & 31, hi = lane >> 5;
    const int qb = P0 >> 8, qlo = P0 + wid * 32, qpos = qlo + r32;
    LAS unsigned char* V_lds = lds + V_OFF; LAS unsigned char* K_lds = lds + K_OFF; LAS float* C_lds = (LAS float*)(lds + C_OFF);
    bf16x8 qr[NQ];
#pragma unroll
    for (int d0 = 0; d0 < NQ; ++d0) qr[d0] = *(const bf16x8*)(Qp + (unsigned)((wid * 32 + r32) * NQKV + hi * 8) + d0 * 16);
    unsigned offK, offV;
    if (VAR == 0) { const int row = wid * 8 + (lane >> 3), c = (lane & 7) ^ ((row >> 1) & 7); offK = (unsigned)(row * NQKV + c * 8); }
    else { const int row = wid * 4 + (lane >> 4), c = (lane & 15) ^ (row & 7); offK = (unsigned)(row * NQKV + c * 8); }
    { const int t = (lane & 31) >> 2, k = (wid >> 2) * 16 + (t >> 2) * 8 + ((wid >> 1) & 1) * 4 + (t & 3), c = ((wid & 1) * 2 + (lane >> 5)) * 32 + (lane & 3) * 8; offV = (unsigned)(k * NQKV + c); }
    const unsigned vb0 = (unsigned)(uintptr_t)(V_lds) + (unsigned)v_rd_base(lane);
    int ti_blk = 0, ti_sub = 0; unsigned rem = wgmask;
    if (VAR == 1) ti_blk = __builtin_ctz(rem);
    const int NT = VAR == 1 ? 4 * __builtin_popcount(wgmask) : 4 * (qb + 1);
#define KB_CUR() (VAR == 1 ? ti_blk * 256 + ti_sub * 64 : ti_sub * 64)
#define ADVANCE() do { if (VAR == 1) { if (++ti_sub == 4) { ti_sub = 0; rem &= rem - 1u; ti_blk = rem ? __builtin_ctz(rem) : 0; } } else ++ti_sub; } while (0)
#define GLDS(src, dstoff) __builtin_amdgcn_global_load_lds((const unsigned*)(src), (LAS unsigned*)(lds + (dstoff)), 16, 0, 0)
#define STAGE(kb, bf) do { const bf16* vb_ = Vp + (size_t)(kb) * NQKV + offV; const bf16* kb_ = Kp + (size_t)(kb) * NQKV + offK; \
        GLDS(vb_, V_OFF + (bf) * 16384 + wid * 1024); GLDS(vb_ + 32 * NQKV, V_OFF + (bf) * 16384 + 8192 + wid * 1024); \
        GLDS(kb_, K_OFF + (bf) * 16384 + wid * 1024); if (VAR != 0) GLDS(kb_ + 32 * NQKV, K_OFF + (bf) * 16384 + 8192 + wid * 1024); \
        if (VAR == 2) { if (wid == 0) __builtin_amdgcn_global_load_lds((const unsigned*)(cumrow + (kb) + lane), (LAS unsigned*)(lds + C_OFF + (bf) * 256), 4, 0, 0); } } while (0)
    float m_reg = -1e30f, l_reg = 0.f;
#pragma unroll
    for (int d0 = 0; d0 < 4; ++d0)
#pragma unroll
        for (int r = 0; r < 16; ++r) o[d0][r] = 0.f;
    const float sl = slope * ISC;
    int kb = KB_CUR();
    STAGE(kb, 0); VM_WAIT();
    __syncthreads();
    for (int i = 0; i < NT; ++i) {
        const int buf = i & 1; const int blk_cur = ti_blk;
        ADVANCE();
        const int kbn = KB_CUR(); const bool has_next = i + 1 < NT;
        if (has_next) STAGE(kbn, buf ^ 1);
        bool act = kb <= qlo + 31;
        bool selok = true;
        if (VAR == 1) { selok = (blk_cur == qb) || ((selrow >> blk_cur) & 1u); act = act && (__ballot(selok) != 0ull); }
        if (act) {
            f32x16 p0, p1;
            if (VAR == 2) {
                const LAS float* cp = C_lds + buf * 64 + 4 * hi;
                const f32x4 c0 = *(const LAS f32x4*)(cp), c1 = *(const LAS f32x4*)(cp + 8), c2 = *(const LAS f32x4*)(cp + 16), c3 = *(const LAS f32x4*)(cp + 24);
                const f32x4 e0 = *(const LAS f32x4*)(cp + 32), e1 = *(const LAS f32x4*)(cp + 40), e2 = *(const LAS f32x4*)(cp + 48), e3 = *(const LAS f32x4*)(cp + 56);
                p0 = (f32x16){c0[0], c0[1], c0[2], c0[3], c1[0], c1[1], c1[2], c1[3], c2[0], c2[1], c2[2], c2[3], c3[0], c3[1], c3[2], c3[3]};
                p1 = (f32x16){e0[0], e0[1], e0[2], e0[3], e1[0], e1[1], e1[2], e1[3], e2[0], e2[1], e2[2], e2[3], e3[0], e3[1], e3[2], e3[3]};
            } else {
                const float t0 = sl * (float)(kb - P0 + 4 * hi);
#pragma unroll
                for (int r = 0; r < 16; ++r) { p0[r] = __builtin_fmaf(sl, (float)((r & 3) + 8 * (r >> 2)), t0); p1[r] = __builtin_fmaf(sl, (float)(32 + (r & 3) + 8 * (r >> 2)), t0); }
            }
            if (VAR == 0) {
                const LAS unsigned char* ka = K_lds + buf * 16384 + r32 * 128;
                const int sw = ((r32 >> 1) & 7) << 4;
#pragma unroll
                for (int d0 = 0; d0 < 4; ++d0) { const int cb = ((2 * d0 + hi) * 16) ^ sw;
                    const bf16x8 b0 = *(const LAS bf16x8*)(ka + cb), b1 = *(const LAS bf16x8*)(ka + cb + 32 * 128);
                    p0 = __builtin_amdgcn_mfma_f32_32x32x16_bf16(b0, qr[d0], p0, 0, 0, 0); p1 = __builtin_amdgcn_mfma_f32_32x32x16_bf16(b1, qr[d0], p1, 0, 0, 0); }
            } else {
                const LAS unsigned char* kbp[4];
#pragma unroll
                for (int dd = 0; dd < 4; ++dd) kbp[dd] = K_lds + buf * 16384 + r32 * 256 + (((dd * 16 + hi * 8) * 2) ^ ((r32 & 7) << 4));
#pragma unroll
                for (int d0 = 0; d0 < NQ; ++d0) { const LAS unsigned char* a = kbp[d0 & 3] + (d0 >> 2) * 128;
                    const bf16x8 b0 = *(const LAS bf16x8*)(a), b1 = *(const LAS bf16x8*)(a + 32 * 256);
                    p0 = __builtin_amdgcn_mfma_f32_32x32x16_bf16(b0, qr[d0], p0, 0, 0, 0); p1 = __builtin_amdgcn_mfma_f32_32x32x16_bf16(b1, qr[d0], p1, 0, 0, 0); }
            }
            const float NEG = -__builtin_inff();
            if (kb + 63 > qlo) {
                const int dq = qpos - kb - 4 * hi;
#pragma unroll
                for (int r = 0; r < 16; ++r) { const int c = (r & 3) + 8 * (r >> 2); if (c > dq) p0[r] = NEG; if (c + 32 > dq) p1[r] = NEG; }
            }
            if (VAR == 1) { if (!selok) {
#pragma unroll
                for (int r = 0; r < 16; ++r) { p0[r] = NEG; p1[r] = NEG; } } }
            float pmax = p0[0];
#pragma unroll
            for (int r = 1; r < 16; ++r) pmax = fmaxf(pmax, p0[r]);
#pragma unroll
            for (int r = 0; r < 16; ++r) pmax = fmaxf(pmax, p1[r]);
            { auto rr = __builtin_amdgcn_permlane32_swap(__float_as_uint(pmax), __float_as_uint(pmax), false, false);
              pmax = fmaxf(__uint_as_float(rr[0]), __uint_as_float(rr[1])); }
            float mn, alpha;
            if (__builtin_expect(__all((pmax - m_reg) * SCALE <= THR), 1)) { mn = m_reg; alpha = 1.f; }
            else { mn = fmaxf(m_reg, pmax); alpha = __builtin_amdgcn_exp2f((m_reg - mn) * C2); m_reg = mn; }
            const float mnL = -mn * C2;
            float ps = 0.f;
#pragma unroll
            for (int r = 0; r < 16; ++r) { p0[r] = __builtin_amdgcn_exp2f(fmaf(p0[r], C2, mnL)); p1[r] = __builtin_amdgcn_exp2f(fmaf(p1[r], C2, mnL)); }
#pragma unroll
            for (int r = 0; r < 16; ++r) ps += p0[r] + p1[r];
            l_reg = l_reg * alpha + ps;
            if (__any(alpha < 1.f)) {
#pragma unroll
                for (int d0 = 0; d0 < 4; ++d0)
#pragma unroll
                    for (int r = 0; r < 16; ++r) o[d0][r] *= alpha;
            }
            bf16x8 pa0, pa1, pa2, pa3;
#define PK4(P, B_, OUT) do { unsigned a0 = cvtpk(P[B_ + 0], P[B_ + 1]), a1 = cvtpk(P[B_ + 2], P[B_ + 3]); unsigned b0 = cvtpk(P[B_ + 4], P[B_ + 5]), b1 = cvtpk(P[B_ + 6], P[B_ + 7]); \
        auto r0 = __builtin_amdgcn_permlane32_swap(a0, b0, false, false); auto r1 = __builtin_amdgcn_permlane32_swap(a1, b1, false, false); \
        v4u w = {r0[0], r1[0], r0[1], r1[1]}; OUT = __builtin_bit_cast(bf16x8, w); } while (0)
            PK4(p0, 0, pa0); PK4(p0, 8, pa1); PK4(p1, 0, pa2); PK4(p1, 8, pa3);
#undef PK4
#define TRRD(dst, off) asm volatile("ds_read_b64_tr_b16 %0, %1 offset:%2" : "=&v"(dst) : "v"(vb0), "i"(off) : "memory")
#define PV_D0(d0, VB) do { s16x4 l0, l1, l2, l3, h0, h1, h2, h3; constexpr int b_ = (VB) * 16384 + (d0) * 512; \
        TRRD(l0, b_); TRRD(h0, b_ + 2048); TRRD(l1, b_ + 4096); TRRD(h1, b_ + 6144); TRRD(l2, b_ + 8192); TRRD(h2, b_ + 10240); TRRD(l3, b_ + 12288); TRRD(h3, b_ + 14336); \
        asm volatile("s_waitcnt lgkmcnt(0)" ::: "memory"); SBAR(); \
        o[d0] = __builtin_amdgcn_mfma_f32_32x32x16_bf16((bf16x8){l0[0], l0[1], l0[2], l0[3], h0[0], h0[1], h0[2], h0[3]}, pa0, o[d0], 0, 0, 0); \
        o[d0] = __builtin_amdgcn_mfma_f32_32x32x16_bf16((bf16x8){l1[0], l1[1], l1[2], l1[3], h1[0], h1[1], h1[2], h1[3]}, pa1, o[d0], 0, 0, 0); \
        o[d0] = __builtin_amdgcn_mfma_f32_32x32x16_bf16((bf16x8){l2[0], l2[1], l2[2], l2[3], h2[0], h2[1], h2[2], h2[3]}, pa2, o[d0], 0, 0, 0); \
        o[d0] = __builtin_amdgcn_mfma_f32_32x32x16_bf16((bf16x8){l3[0], l3[1], l3[2], l3[3], h3[0], h3[1], h3[2], h3[3]}, pa3, o[d0], 0, 0, 0); } while (0)
            if (buf == 0) { PV_D0(0, 0); PV_D0(1, 0); PV_D0(2, 0); PV_D0(3, 0); } else { PV_D0(0, 1); PV_D0(1, 1); PV_D0(2, 1); PV_D0(3, 1); }
#undef PV_D0
#undef TRRD
        }
        VM_WAIT();
        kb = kbn;
        __syncthreads();
    }
    { auto rr = __builtin_amdgcn_permlane32_swap(__float_as_uint(l_reg), __float_as_uint(l_reg), false, false); l_out = __uint_as_float(rr[0]) + __uint_as_float(rr[1]); }
#undef KB_CUR
#undef ADVANCE
#undef STAGE
#undef GLDS
}
__device__ __forceinline__ void store_block(bf16* Op  , const f32x16 (&o)[4], float inv_l) {
    const int tid = opaque_tid(), wid = tid >> 6, lane = tid & 63, r32 = lane & 31, hi = lane >> 5;
    bf16* rowp = Op + (unsigned)((wid * 32 + r32) * DM + 4 * hi);
#pragma unroll
    for (int d0 = 0; d0 < 4; ++d0)
#pragma unroll
        for (int g = 0; g < 4; ++g) { v2u w; w.x = cvtpk(o[d0][4 * g] * inv_l, o[d0][4 * g + 1] * inv_l); w.y = cvtpk(o[d0][4 * g + 2] * inv_l, o[d0][4 * g + 3] * inv_l);
            *(v2u*)(rowp + 32 * d0 + 8 * g) = w; }
}
}

template <bool DO_A, bool DO_B>
__device__ __forceinline__ void attn_even_phase(const Args& A, const Frame& F0) {
    Frame F = F0; F.tid = opaque_tid(); F.lane = F.tid & 63; F.wave = __builtin_amdgcn_readfirstlane(F.tid >> 6);
    const bf16* QKV = (const bf16*)(A.ws + WS_QKV); bf16* MRG = (bf16*)(A.ws + WS_MRG);
    if (DO_A) for (int it = F.vcu; it < 256; it += F.G) {
        const int bh = it >> 4, y = it & 15, b = bh >> 3, h = bh & 7;
        const float slope = exp2f(-(2.0f * h + 1.0f) * 0.5f);
        const float lam = *(const float*)(A.ws + WS_LAM);
        float* scr = (float*)(A.ws + WS_SCR) + (size_t)blockIdx.x * 32768;
        for (int pass = 0; pass < 2; ++pass) {
            const int qb = pass ? 31 - y : y, P0 = qb * 256;
            const bf16* rowb = QKV + (size_t)b * SEQ * NQKV;
            f32x16 o[4]; float l;
            att::attn_block<0>(F.lds, rowb + (size_t)P0 * NQKV + h * 128, rowb + 1024 + h * 128, rowb + 2048 + h * 128, P0, slope, nullptr, 0u, 0u, o, l);
            { const float il = 1.0f / l; float* sp = scr + opaque_tid();
#pragma unroll
              for (int d0 = 0; d0 < 4; ++d0)
#pragma unroll
                  for (int r = 0; r < 16; ++r) sp[(d0 * 16 + r) * 512] = o[d0][r] * il; }
            att::attn_block<0>(F.lds, rowb + (size_t)P0 * NQKV + h * 128 + 64, rowb + 1024 + h * 128 + 64, rowb + 2048 + h * 128, P0, slope, nullptr, 0u, 0u, o, l);
            { const float il = lam / l; float ss = 0.f; const float* sp = scr + opaque_tid();
#pragma unroll
              for (int d0 = 0; d0 < 4; ++d0)
#pragma unroll
                  for (int r = 0; r < 16; ++r) { const float v = sp[(d0 * 16 + r) * 512] - o[d0][r] * il; o[d0][r] = v; ss += v * v; }
              { auto rr = __builtin_amdgcn_permlane32_swap(__float_as_uint(ss), __float_as_uint(ss), false, false); ss = __uint_as_float(rr[0]) + __uint_as_float(rr[1]); }
              const float rs = 0.8f / sqrtf(ss * (1.0f / 128.0f) + EPS);
              const float* sg = A.in[I_SUBLN] + 4 * ((opaque_tid() >> 5) & 1);
#pragma unroll
              for (int d0 = 0; d0 < 4; ++d0)
#pragma unroll
                  for (int g = 0; g < 4; ++g) { const f32x4 gv = *(const f32x4*)(sg + 32 * d0 + 8 * g);
#pragma unroll
                      for (int j = 0; j < 4; ++j) o[d0][4 * g + j] *= gv[j]; }
              att::store_block(MRG + (size_t)(b * SEQ + P0) * DM + h * 128, o, rs); }
        }
    }
    if (DO_B) for (int it = F.vcu; it < 256; it += F.G) {
        const int bh = it >> 4, y = it & 15, b = bh >> 3, h = bh & 7;
        const float slope = exp2f(-(float)(h + 1));
        const bf16* rowb = QKV + (size_t)b * SEQ * NQKV;
        const float* KM = (const float*)(A.ws + WS_KMEAN) + (size_t)bh * 32 * 128;
        for (int pass = 0; pass < 2; ++pass) {
            const int qb = pass ? 31 - y : y, P0 = qb * 256;
            const int tid = opaque_tid(), r32 = tid & 31;
            LAS float* km = (LAS float*)(F.lds + att::G_KM); LAS float* gt = (LAS float*)(F.lds + att::G_GT);
            LAS unsigned* sel = (LAS unsigned*)(F.lds + att::G_SEL); LAS unsigned* gor = (LAS unsigned*)(F.lds + att::G_OR);
            if (tid == 0) gor[0] = 0u;
            if (qb >= 4) {
                for (int i = tid; i < qb * 32; i += 512) *(LAS f32x4*)(km + 4 * i) = *(const f32x4*)(KM + 4 * i);
                __syncthreads();
                const int row = tid & 255, half = tid >> 8;
                float acc[16];
#pragma unroll
                for (int k = 0; k < 16; ++k) acc[k] = 0.f;
                const bf16* qrow = rowb + (size_t)(P0 + row) * NQKV + 3072 + h * 128;
#pragma unroll 1
                for (int c = 0; c < 16; ++c) { const v4u w = *(const v4u*)(qrow + 8 * c);
                    const float q0 = bflo(w.x), q1 = bfhi(w.x), q2 = bflo(w.y), q3 = bfhi(w.y), q4 = bflo(w.z), q5 = bfhi(w.z), q6 = bflo(w.w), q7 = bfhi(w.w);
#pragma unroll
                    for (int k = 0; k < 16; ++k) { const int n = 2 * k + half; if (n < qb) { const f32x4 a = *(const LAS f32x4*)(km + n * 128 + 8 * c), bq = *(const LAS f32x4*)(km + n * 128 + 8 * c + 4);
                        acc[k] += (q0 * a.x + q1 * a.y) + (q2 * a.z + q3 * a.w) + (q4 * bq.x + q5 * bq.y) + (q6 * bq.z + q7 * bq.w); } } }
#pragma unroll
                for (int k = 0; k < 16; ++k) { const int n = 2 * k + half; if (n < qb) gt[row * 33 + n] = acc[k]; }
                __syncthreads();
                if (tid < 256) { unsigned msk = 0u;
                    for (int t = 0; t < 3; ++t) { float best = -3.0e38f; int bi = 0;
                        for (int n = 0; n < qb; ++n) { const float v = gt[tid * 33 + n]; if (!((msk >> n) & 1u) && v > best) { best = v; bi = n; } }
                        msk |= 1u << bi; }
                    sel[tid] = msk; atomicOr((unsigned*)gor, msk); }
            } else { if (tid < 256) sel[tid] = (1u << qb) - 1u; if (tid == 0) gor[0] = (1u << qb) - 1u; }
            __syncthreads();
            const unsigned selrow = sel[(tid >> 6) * 32 + r32]; const unsigned wgmask = __builtin_amdgcn_readfirstlane(gor[0]) | (1u << qb);
            __syncthreads();
            f32x16 o[4]; float l;
            att::attn_block<1>(F.lds, rowb + (size_t)P0 * NQKV + 3072 + h * 128, rowb + 4096 + h * 128, rowb + 5120 + h * 128, P0, slope, nullptr, selrow, wgmask, o, l);
            att::store_block(MRG + (size_t)(b * SEQ + P0) * DM + 1024 + h * 128, o, 1.0f / l);
        }
    }
}
__device__ __forceinline__ void attn_odd_phase(const Args& A, const Frame& F0) {
    Frame F = F0; F.tid = opaque_tid(); F.lane = F.tid & 63; F.wave = __builtin_amdgcn_readfirstlane(F.tid >> 6);
    const bf16* QKV = (const bf16*)(A.ws + WS_QKV); bf16* MRG = (bf16*)(A.ws + WS_MRG);
    for (int it = F.vcu; it < 512; it += F.G) {
        const int bh = it >> 4, y = it & 15, b = bh >> 4, h = bh & 15;
        const bf16* rowb = QKV + (size_t)b * SEQ * NQKV;
        const float* cumrow = (const float*)(A.ws + WS_CUM) + (size_t)bh * SEQ;
        for (int pass = 0; pass < 2; ++pass) {
            const int qb = pass ? 31 - y : y, P0 = qb * 256;
            f32x16 o[4]; float l;
            att::attn_block<2>(F.lds, rowb + (size_t)P0 * NQKV + h * 128, rowb + 2048 + h * 128, rowb + 4096 + h * 128, P0, 0.f, cumrow, 0u, 0u, o, l);
            att::store_block(MRG + (size_t)(b * SEQ + P0) * DM + h * 128, o, 1.0f / l);
        }
    }
}
#ifndef ONE_LAUNCH
#define ONE_LAUNCH 1
#endif
constexpr int N_PHASES = 20;
#define IN(k) (lo <= (k) && (k) < hi)
#define SEAM(k) do { if (IN(k) && IN((k) + 1)) xcd_barrier(bar); } while (0)
template <int l>
__device__ __forceinline__ void layer_phases(const Args& args, const Frame& F, const XcdBarrier& bar, const int lo, const int hi) {
    unsigned char* ws = args.ws;
        const int pb = 1 + 9 * l;
        const float* modl = (const float*)(ws + WS_MOD) + (size_t)l * 2 * MODW;
        if (IN(pb + 0)) { if (l == 0) norm_phase<0>(args, F, l); else norm_phase<2>(args, F, l); SEAM(pb + 0); }
        if (IN(pb + 1)) {
            if (l == 1) { scan_phase(args, F); }
            pg8::Gemm g{(const bf16*)(ws + WS_H), (const bf16*)(ws + WS_WIN) + (size_t)l * NQKV * DM, M, NQKV, DM}; pg8::StaticOrder S; S.init(M, NQKV, F.G, (int)blockIdx.x);
            pg8::EpiBf16<0> E{(bf16*)(ws + WS_QKV), NQKV, nullptr, 0, 0, 1.f};
            pg8::gemm_phase<pg8::EpiBf16<0>, pg8::StaticOrder, PG8_ALIGN, PG8_SP2>(F.lds + RING_OFF, g, S, E);
            SEAM(pb + 1);
        }
        if (IN(pb + 2)) { if (l == 0) { kmean_phase(args, F); SEAM(pb + 2); } }
        if (IN(pb + 3)) {
            if (l == 0) attn_even_phase<!(NAIVE_ATTN & 1), !(NAIVE_ATTN & 2)>(args, F); else { if (!(NAIVE_ATTN & 4)) attn_odd_phase(args, F); }
            SEAM(pb + 3);
        }
        if (IN(pb + 4)) {
            pg8::Gemm g{(const bf16*)(ws + WS_MRG), (const bf16*)(ws + WS_WOUT) + (size_t)l * DM * DM, M, DM, DM}; pg8::StaticOrder S; S.init(M, DM, F.G, (int)blockIdx.x);
            pg8::EpiResid E{l == 0 ? args.in[I_X] : args.out, args.out, modl + 2 * DM, MODW, SEQ};
            pg8::gemm_phase<pg8::EpiResid, pg8::StaticOrder, PG8_ALIGN, PG8_SP2>(F.lds + RING_OFF, g, S, E);
            SEAM(pb + 4);
        }
        if (IN(pb + 5)) { norm_phase<1>(args, F, l); SEAM(pb + 5); }
        if (IN(pb + 6)) { gather_phase(args, F, l); SEAM(pb + 6); }
        if (IN(pb + 7)) {
            pg8::Gemm g{(const bf16*)(ws + WS_QKV), (const bf16*)(ws + WS_W13) + (size_t)l * 16384 * DM, MAXROWS, 16384, DM};
            pg8::MoeOrder S; S.init((const unsigned*)(F.ctl + CW_CNT + 64 * l), 2, F.G, (int)blockIdx.x);
            pg8::EpiSwiGLU E{(bf16*)(ws + WS_ACT)};
            pg8::gemm_phase<pg8::EpiSwiGLU, pg8::MoeOrder, PG8_ALIGN, PG8_SP2>(F.lds + RING_OFF, g, S, E);
            SEAM(pb + 7);
        }
        if (IN(pb + 8)) {
            pg8::Gemm g{(const bf16*)(ws + WS_ACT), (const bf16*)(ws + WS_W2) + (size_t)l * 32768 * FFE, MAXROWS, 32768, FFE};
            pg8::MoeOrder S; S.init((const unsigned*)(F.ctl + CW_CNT + 64 * l), 3, F.G, (int)blockIdx.x);
            pg8::EpiBf16<0> E{(bf16*)(ws + WS_OSL), DM, nullptr, DM, 0, 1.f};
            pg8::gemm_phase<pg8::EpiBf16<0>, pg8::MoeOrder, PG8_ALIGN, PG8_SP2>(F.lds + RING_OFF, g, S, E);
            SEAM(pb + 8);
        }
}
#undef IN
#undef SEAM
__global__ void __launch_bounds__(NWAVES * 64, 2) skel_fwd(Args args) {
    extern __shared__ __attribute__((aligned(16))) unsigned char lds[];
    Frame F;
    F.lds = (LAS unsigned char*)lds;
    F.MISC = (volatile LAS unsigned*)(F.lds + MISC_OFF);
    F.tid = threadIdx.x; F.lane = F.tid & 63; F.wave = __builtin_amdgcn_readfirstlane(F.tid >> 6);
    F.G = gridDim.x; { const int bx = blockIdx.x; F.vcu = (F.G % 8 == 0) ? (bx % 8) * (F.G / 8) + bx / 8 : bx; }
    unsigned char* ws = args.ws;
    F.ctl = (gu32*)(ws + WS_CTL);
    for (int u = F.tid; u < (LDS_BYTES - LDSCTL_OFF) / 4; u += NWAVES * 64) ((LAS unsigned*)(F.lds + LDSCTL_OFF))[u] = 0u;
    __syncthreads();
    const int lo = args.ph_lo, hi = args.ph_hi;
    XcdBarrier bar; bar.bar = (unsigned*)(F.ctl + CW_BAR); bar.x = 0; bar.st = nullptr;
    if (hi - lo > 1) bar = xcd_barrier_post((unsigned*)(F.ctl + CW_BAR), F.MISC + 8);
#define IN(k) (lo <= (k) && (k) < hi)
#define SEAM(k) do { if (IN(k) && IN((k) + 1)) xcd_barrier(bar); } while (0)

    if (IN(0)) { p0_prologue(args, F); SEAM(0); }
    layer_phases<0>(args, F, bar, lo, hi);
    layer_phases<1>(args, F, bar, lo, hi);
    if (IN(19)) norm_phase<3>(args, F, 1);
#undef IN
#undef SEAM
}

extern "C" void kernel_launch(void* const* d_in, const int* in_sizes, int n_in, void* d_out, int out_size, void* d_ws, size_t ws_size, hipStream_t stream) {
    static int grid = 0;
    if (grid == 0) {
        if (n_in != 22 || in_sizes[0] != M * DM || out_size != M * DM || ws_size < WS_END) { fprintf(stderr, "kernel_launch: unexpected shapes (n_in %d, in0 %d, out %d, ws %zu; need ws >= %zu); nothing launched\n", n_in, n_in > 0 ? in_sizes[0] : -1, out_size, ws_size, (size_t)WS_END); grid = -1; return; }
        int dev = 0, cus = 0, per_cu = 0;
        if (hipGetDevice(&dev) != hipSuccess || hipDeviceGetAttribute(&cus, hipDeviceAttributeMultiprocessorCount, dev) != hipSuccess) { grid = -1; return; }
        if (hipFuncSetAttribute((const void*)skel_fwd, hipFuncAttributeMaxDynamicSharedMemorySize, LDS_BYTES) != hipSuccess) { fprintf(stderr, "kernel_launch: hipFuncSetAttribute failed\n"); grid = -1; return; }
        if (hipOccupancyMaxActiveBlocksPerMultiprocessor(&per_cu, (const void*)skel_fwd, NWAVES * 64, LDS_BYTES) != hipSuccess || per_cu < 1) { fprintf(stderr, "kernel_launch: occupancy query says %d blocks per CU\n", per_cu); }
        (void)hipGetLastError();
        grid = cus;
    }
    if (grid < 0) return;
    if (hipMemsetAsync((char*)d_ws + WS_CTL, 0, CTL_ZERO_BYTES, stream) != hipSuccess) return;
    Args a{};
    for (int i = 0; i < 22; ++i) a.in[i] = (const float*)d_in[i];
    a.out = (float*)d_out; a.ws = (unsigned char*)d_ws;
#if ONE_LAUNCH
    a.ph_lo = 0; a.ph_hi = N_PHASES;
    hipLaunchKernelGGL(skel_fwd, dim3(grid), dim3(NWAVES * 64), LDS_BYTES, stream, a);
#else
    unsigned char* ws = (unsigned char*)d_ws;
    for (int p = 0; p < N_PHASES; ++p) {
        if (p == 12) continue;
#if NAIVE_ATTN
        if (p == 4) {
            if (NAIVE_ATTN & 1) naive_attn<0><<<M * 8 / 4, 256, 0, stream>>>((const bf16*)(ws + WS_QKV), (bf16*)(ws + WS_MRG), nullptr, nullptr, (const float*)(ws + WS_LAM), (const float*)d_in[I_SUBLN]);
            if (NAIVE_ATTN & 2) naive_attn<1><<<M * 8 / 4, 256, 0, stream>>>((const bf16*)(ws + WS_QKV), (bf16*)(ws + WS_MRG), nullptr, (const float*)(ws + WS_KMEAN), nullptr, nullptr);
            if ((NAIVE_ATTN & 3) == 3) continue; }
        if (p == 13 && (NAIVE_ATTN & 4)) { naive_attn<2><<<M * 16 / 4, 256, 0, stream>>>((const bf16*)(ws + WS_QKV), (bf16*)(ws + WS_MRG), (const float*)(ws + WS_CUM), nullptr, nullptr, nullptr); continue; }
#endif
        a.ph_lo = p; a.ph_hi = p + 1;
        hipLaunchKernelGGL(skel_fwd, dim3(grid), dim3(NWAVES * 64), LDS_BYTES, stream, a);
    }
#endif
}
```

```cpp
#include <hip/hip_runtime.h>
#include <cstdio>
#include <cstdint>
namespace pg8 {
#define PG8_LAS __attribute__((address_space(3)))
typedef unsigned short bf16_t;
typedef short bf16x8 __attribute__((ext_vector_type(8)));
typedef float f32x4 __attribute__((ext_vector_type(4)));
typedef unsigned u32x4 __attribute__((ext_vector_type(4)));
constexpr int BM = 256, BK = 64, HALF = 128, HTB = HALF * BK * 2  , STAGE_BYTES = 8 * HTB, NXCD = 8, WGM = 8;

__host__ __device__ __forceinline__ int lds_byte(int r, int c) { const int st = (r >> 4) * 2 + (c >> 5), rr = r & 15, cc = c & 31, ob = rr * 64 + cc * 2; return st * 1024 + (ob ^ (((ob >> 9) & 1) << 5)); }
__host__ __device__ __forceinline__ void stage_rc(int b, int& R, int& C) { const int st = b / 1024, sb = b % 1024, swz = sb ^ (((sb >> 9) & 1) << 5); R = (st >> 1) * 16 + swz / 64; C = (st & 1) * 32 + (swz % 64) / 2; }
__host__ __device__ __forceinline__ int perm32(int rho) { const int n = rho >> 4, i = rho & 15; return 8 * (i >> 2) + 4 * n + (i & 3); }

struct Unit { int pm, pn; };
struct Gemm { const bf16_t* A; const bf16_t* Bt; int M, N, K; };

struct StaticOrder {
    int nM, nN, nwg, G, c;
    __host__ __device__ void init(int M, int N, int G_, int c_) { nM = M / BM; nN = N / BM; nwg = nM * nN; G = G_; c = c_; }
    __host__ __device__ bool next(int i, Unit& u) const {
        const long L = (long)i * G + c; if (L >= nwg) return false;
        int wgid = (int)L; { const int q = nwg / NXCD, r = nwg % NXCD, xcd = wgid % NXCD, off = wgid / NXCD; wgid = (xcd < r ? xcd * (q + 1) : r * (q + 1) + (xcd - r) * q) + off; }
        const int nig = WGM * nN, gid = wgid / nig, fm = gid * WGM, gsz = (nM - fm) < WGM ? (nM - fm) : WGM;
        u.pm = fm + ((wgid % nig) % gsz); u.pn = (wgid % nig) / gsz; return true;
    }
    __device__ __forceinline__ void a_ready(const Unit&) const {}
    __device__ __forceinline__ void done(const Unit&) const {}
};

__device__ __forceinline__ unsigned cvt_pk_bf16(float lo, float hi) { unsigned r; asm volatile("v_cvt_pk_bf16_f32 %0, %1, %2" : "=v"(r) : "v"(lo), "v"(hi)); return r; }
typedef float f32x2 __attribute__((ext_vector_type(2)));
__device__ __forceinline__ f32x2 gelu_pk(f32x2 v) {
    const f32x2 av = __builtin_elementwise_abs(v), d = av * 0.2316418882f + 1.0f;
    f32x2 t; t.x = __builtin_amdgcn_rcpf(d.x); t.y = __builtin_amdgcn_rcpf(d.y);
    f32x2 q = t * 0.5307027145f + (-0.7265760135f); q = q * t + 0.7107068705f; q = q * t + (-0.142248368f); q = q * t + 0.127414796f; q = q * t;
    const f32x2 s = (v * v) * (-0.72134752044f);
    f32x2 e; e.x = __builtin_amdgcn_exp2f(s.x); e.y = __builtin_amdgcn_exp2f(s.y);
    const f32x2 m = v * (q * e), r = v - m;
    f32x2 o; o.x = v.x < 0.f ? m.x : r.x; o.y = v.y < 0.f ? m.y : r.y; return o;
}

template <int ACT  > struct EpiBf16 {
    static constexpr bool PERM = true, AFTER_DRAIN = false; static_assert(ACT == 0 || ACT == 1, "EpiBf16: ACT is 0 (none) or 1 (gelu_pk)");
    bf16_t* O; int ldc; const float* bias; int split_cols; size_t split_stride; float scale0;
    __device__ __forceinline__ void operator()(const f32x4 (&acc)[2][2][4][2], const Unit& u, int wr, int wc, int fr, int fq) const {
        const int row0 = u.pm * BM + wr * 64 + fr; int colt = u.pn * BM; bf16_t* base = O;
        float sc = 1.f; if (split_cols) { const int t = colt / split_cols; base += (size_t)t * split_stride; colt -= t * split_cols; if (t == 0) sc = scale0; }
        const int col0 = colt + wc * 32 + 8 * fq, bcol0 = u.pn * BM + wc * 32 + 8 * fq;
        f32x4 bv[2][2];
#pragma unroll
        for (int bj = 0; bj < 2; ++bj)
#pragma unroll
            for (int n = 0; n < 2; ++n) bv[bj][n] = bias ? *(const f32x4*)(bias + bcol0 + bj * HALF + 4 * n) : (f32x4){0.f, 0.f, 0.f, 0.f};
#pragma unroll
        for (int ai = 0; ai < 2; ++ai)
#pragma unroll
            for (int m = 0; m < 4; ++m) { bf16_t* rowp = base + (size_t)(row0 + ai * HALF + m * 16) * ldc + col0;
#pragma unroll
                for (int bj = 0; bj < 2; ++bj) { f32x4 v0 = acc[ai][bj][m][0] + bv[bj][0], v1 = acc[ai][bj][m][1] + bv[bj][1];
                    if (ACT == 1) { f32x2 a = gelu_pk((f32x2){v0[0], v0[1]}), b = gelu_pk((f32x2){v0[2], v0[3]}), c = gelu_pk((f32x2){v1[0], v1[1]}), d = gelu_pk((f32x2){v1[2], v1[3]});
                        v0 = (f32x4){a.x, a.y, b.x, b.y}; v1 = (f32x4){c.x, c.y, d.x, d.y}; }
                    v0 = v0 * sc; v1 = v1 * sc; u32x4 w; w.x = cvt_pk_bf16(v0[0], v0[1]); w.y = cvt_pk_bf16(v0[2], v0[3]); w.z = cvt_pk_bf16(v1[0], v1[1]); w.w = cvt_pk_bf16(v1[2], v1[3]);
                    *(u32x4*)(rowp + bj * HALF) = w; } }
    }
};

struct EpiResid {
    static constexpr bool PERM = false, AFTER_DRAIN = false;
    const float* base; float* out; const float* gate; int gate_bstride; int rows_per_batch;
    __device__ __forceinline__ void operator()(const f32x4 (&acc)[2][2][4][2], const Unit& u, int wr, int wc, int fr, int fq) const {
        const int row0 = u.pm * BM + wr * 64 + fr, col0 = u.pn * BM + wc * 32 + 4 * fq;
        const float* gp = gate + (size_t)((u.pm * BM) / rows_per_batch) * gate_bstride + col0;
        f32x4 gv[2][2];
#pragma unroll
        for (int bj = 0; bj < 2; ++bj)
#pragma unroll
            for (int n = 0; n < 2; ++n) gv[bj][n] = *(const f32x4*)(gp + bj * HALF + n * 16);
#pragma unroll
        for (int ai = 0; ai < 2; ++ai)
#pragma unroll
            for (int m = 0; m < 4; ++m) { const size_t off = (size_t)(row0 + ai * HALF + m * 16) * 2048 + col0;
#pragma unroll
                for (int bj = 0; bj < 2; ++bj)
#pragma unroll
                    for (int n = 0; n < 2; ++n) { const f32x4 bs = *(const f32x4*)(base + off + bj * HALF + n * 16);
                        *(f32x4*)(out + off + bj * HALF + n * 16) = bs + gv[bj][n] * acc[ai][bj][m][n]; }
                if (m & 1) asm volatile("" ::: "memory"); }
    }
};
struct EpiSwiGLU {
    static constexpr bool PERM = true, AFTER_DRAIN = false;
    bf16_t* O;
    __device__ __forceinline__ void operator()(const f32x4 (&acc)[2][2][4][2], const Unit& u, int wr, int wc, int fr, int fq) const {
        const int row0 = u.pm * BM + wr * 64 + fr; const int f0 = (u.pn & 3) * 128 + wc * 16 + 4 * fq;
#pragma unroll
        for (int ai = 0; ai < 2; ++ai)
#pragma unroll
            for (int m = 0; m < 4; ++m) { bf16_t* rowp = O + (size_t)(row0 + ai * HALF + m * 16) * 512 + f0;
#pragma unroll
                for (int bj = 0; bj < 2; ++bj) { const f32x4 v0 = acc[ai][bj][m][0], v1 = acc[ai][bj][m][1];
                    float r[4]; const float a[4] = {v0[0], v0[2], v1[0], v1[2]}, b[4] = {v0[1], v0[3], v1[1], v1[3]};
#pragma unroll
                    for (int q = 0; q < 4; ++q) r[q] = a[q] * b[q] * __builtin_amdgcn_rcpf(1.0f + __builtin_amdgcn_exp2f(-1.4426950408889634f * a[q]));
                    typedef unsigned u32x2 __attribute__((ext_vector_type(2)));
                    u32x2 w; w.x = cvt_pk_bf16(r[0], r[1]); w.y = cvt_pk_bf16(r[2], r[3]);
                    *(u32x2*)(rowp + bj * 64) = w; } }
    }
};
struct MoeOrder {
    unsigned pk[4]; int njs, G, c;
    __device__ __forceinline__ void init(const unsigned* cnt, int njs_, int G_, int c_) {
        njs = njs_; G = G_; c = c_; unsigned t = 0; pk[0] = pk[1] = pk[2] = pk[3] = 0u;
#pragma unroll
        for (int e = 0; e < 16; ++e) { t += (__builtin_amdgcn_readfirstlane(cnt[e]) + 255u) >> 8; pk[e >> 2] |= t << (8 * (e & 3)); }
    }
    __device__ __forceinline__ bool next(int i, Unit& u) const {
        const int L = i * G + c, rt = L >> njs, j = L & ((1 << njs) - 1);
        if (rt >= (int)(pk[3] >> 24)) return false;
        int e = 0;
#pragma unroll
        for (int q = 0; q < 16; ++q) e += ((int)((pk[q >> 2] >> (8 * (q & 3))) & 255u) <= rt) ? 1 : 0;
        u.pm = rt; u.pn = (e << njs) + j; return true;
    }
    __device__ __forceinline__ void a_ready(const Unit&) const {}
    __device__ __forceinline__ void done(const Unit&) const {}
};

template <class Epi, class Sched, bool ALIGN_EPI = false, bool SP2 = false>
__device__ __forceinline__ void gemm_phase(const int wave_id  , PG8_LAS unsigned char* lds, const Gemm g, const Sched& S, const Epi& E) {
    int lid_; asm volatile("v_mbcnt_lo_u32_b32 %0, -1, 0\n\tv_mbcnt_hi_u32_b32 %0, -1, %0" : "=v"(lid_)); const int tid_ = (wave_id << 6) + lid_;
    const int tid = tid_, wid = wave_id, lane = tid & 63, wr = wid >> 2, wc = wid & 3, fr = lane & 15, fq = lane >> 4;
    const int K = g.K, nt = K / BK;
    unsigned voffA[2], voffB[2];
#pragma unroll
    for (int i = 0; i < 2; ++i) { int R, C; stage_rc(tid * 16 + i * 8192, R, C); const int Rb = Epi::PERM ? ((R & ~31) + perm32(R & 31)) : R;
        voffA[i] = (unsigned)(R * K + C) * 2u; voffB[i] = (unsigned)(Rb * K + C) * 2u; }
    const size_t kstep = (size_t)(BK * 2);
    const size_t hstep = (size_t)HALF * K * 2;
    const size_t tstep = 2 * hstep;
    const unsigned ldsw = (unsigned)wid * 1024u;
    const int aoff = lds_byte(wr * 64 + fr, fq * 8), boff = lds_byte(wc * 32 + fr, fq * 8);
#define PG8_SA(b, h) (((b) * 2 + (h)) * HTB)
#define PG8_SB(b, h) ((4 + (b) * 2 + (h)) * HTB)
#define PG8_STAGE(bufoff, gbase, voff) do { _Pragma("unroll") for (int _i = 0; _i < 2; ++_i) \
        __builtin_amdgcn_global_load_lds((const unsigned*)((const char*)(gbase) + (voff)[_i]), (PG8_LAS unsigned*)(lds + (bufoff) + ldsw + _i * 8192), 16, 0, 0); } while (0)
#define PG8_LDA(dst, b, h) do { _Pragma("unroll") for (int m = 0; m < 4; ++m) _Pragma("unroll") for (int k = 0; k < 2; ++k) dst[m][k] = *(const PG8_LAS bf16x8*)(lds + PG8_SA(b, h) + aoff + m * 2048 + k * 1024); } while (0)
#define PG8_LDB(dst, b, h) do { _Pragma("unroll") for (int n = 0; n < 2; ++n) _Pragma("unroll") for (int k = 0; k < 2; ++k) dst[n][k] = *(const PG8_LAS bf16x8*)(lds + PG8_SB(b, h) + boff + n * 2048 + k * 1024); } while (0)
#define PG8_MMA(ai, bj, At, Bt) do { __builtin_amdgcn_s_setprio(1); _Pragma("unroll") for (int m = 0; m < 4; ++m) _Pragma("unroll") for (int n = 0; n < 2; ++n) _Pragma("unroll") for (int k = 0; k < 2; ++k) \
        acc[ai][bj][m][n] = __builtin_amdgcn_mfma_f32_16x16x32_bf16(Bt[n][k], At[m][k], acc[ai][bj][m][n], 0, 0, 0); __builtin_amdgcn_s_setprio(0); } while (0)
#define PG8_WAIT_V(n) asm volatile("s_waitcnt vmcnt(" #n ")" ::: "memory")
#define PG8_WAIT_L(n) asm volatile("s_waitcnt lgkmcnt(" #n ")" ::: "memory")
#define PG8_BAR __builtin_amdgcn_s_barrier()
#define PG8_SCHED __builtin_amdgcn_sched_barrier(0)
    Unit cur, nxt; int ui = 0;
    if (!S.next(0, cur)) return;
    f32x4 acc[2][2][4][2];
#pragma unroll
    for (int a = 0; a < 2; ++a)
#pragma unroll
        for (int b = 0; b < 2; ++b)
#pragma unroll
            for (int m = 0; m < 4; ++m)
#pragma unroll
                for (int n = 0; n < 2; ++n) acc[a][b][m][n] = (f32x4){0.f, 0.f, 0.f, 0.f};
    bf16x8 At[4][2], B0[2][2], B1[2][2];
    const char* cA = (const char*)g.A + (size_t)cur.pm * tstep; const char* cB = (const char*)g.Bt + (size_t)cur.pn * tstep;
    S.a_ready(cur);
    if constexpr (SP2) {
        PG8_STAGE(PG8_SB(0, 0), cB, voffB); PG8_STAGE(PG8_SB(0, 1), cB + hstep, voffB); PG8_STAGE(PG8_SA(0, 0), cA, voffA); PG8_STAGE(PG8_SA(0, 1), cA + hstep, voffA);
        if (wr == 1) PG8_BAR;
        PG8_WAIT_V(2); PG8_BAR;
        PG8_STAGE(PG8_SB(1, 0), cB + kstep, voffB); PG8_STAGE(PG8_SA(1, 0), cA + kstep, voffA); PG8_STAGE(PG8_SB(1, 1), cB + hstep + kstep, voffB);
        PG8_WAIT_V(6); PG8_BAR;
    } else {
        PG8_STAGE(PG8_SB(0, 0), cB, voffB); PG8_STAGE(PG8_SA(0, 0), cA, voffA); PG8_STAGE(PG8_SB(0, 1), cB + hstep, voffB); PG8_STAGE(PG8_SA(0, 1), cA + hstep, voffA);
        if (wr == 1) PG8_BAR;
        PG8_WAIT_V(4); PG8_BAR;
        PG8_STAGE(PG8_SB(1, 0), cB + kstep, voffB); PG8_STAGE(PG8_SA(1, 0), cA + kstep, voffA); PG8_STAGE(PG8_SB(1, 1), cB + hstep + kstep, voffB);
        PG8_WAIT_V(6); PG8_BAR;
    }
    for (;;) {
        const bool has_next = S.next(ui + 1, nxt);
        const char* nA = has_next ? (const char*)g.A + (size_t)nxt.pm * tstep : cA; const char* nB = has_next ? (const char*)g.Bt + (size_t)nxt.pn * tstep : cB;
        for (int t = 0; t < nt; t += 2) {
            const bool last = (t == nt - 2);
            const char* a1 = cA + (size_t)(t + 1) * kstep;
            const char* a2 = last ? nA : cA + (size_t)(t + 2) * kstep; const char* b2 = last ? nB : cB + (size_t)(t + 2) * kstep;
            const char* a3 = a2 + kstep; const char* b3 = b2 + kstep;
            if (last && has_next) S.a_ready(nxt);
            if constexpr (SP2) {
            PG8_LDB(B0, 0, 0); PG8_LDB(B1, 0, 1); PG8_SCHED; PG8_LDA(At, 0, 0); PG8_STAGE(PG8_SA(1, 1), a1 + hstep, voffA);
            PG8_WAIT_V(8); PG8_WAIT_L(0); PG8_BAR; PG8_MMA(0, 0, At, B0); PG8_MMA(0, 1, At, B1); PG8_BAR; PG8_SCHED;
            PG8_LDA(At, 0, 1); PG8_STAGE(PG8_SB(0, 0), b2, voffB); PG8_STAGE(PG8_SB(0, 1), b2 + hstep, voffB); PG8_STAGE(PG8_SA(0, 0), a2, voffA);
            PG8_WAIT_V(8); PG8_WAIT_L(0); PG8_BAR; PG8_MMA(1, 0, At, B0); PG8_MMA(1, 1, At, B1); PG8_BAR; PG8_SCHED;
            PG8_LDB(B0, 1, 0); PG8_LDB(B1, 1, 1); PG8_SCHED; PG8_LDA(At, 1, 0); PG8_STAGE(PG8_SA(0, 1), a2 + hstep, voffA);
            PG8_WAIT_V(8); PG8_WAIT_L(0); PG8_BAR; PG8_MMA(0, 0, At, B0); PG8_MMA(0, 1, At, B1); PG8_BAR; PG8_SCHED;
            PG8_LDA(At, 1, 1); PG8_STAGE(PG8_SB(1, 0), b3, voffB); PG8_STAGE(PG8_SB(1, 1), b3 + hstep, voffB); PG8_STAGE(PG8_SA(1, 0), a3, voffA);
            PG8_WAIT_V(8); PG8_WAIT_L(0); PG8_BAR; PG8_MMA(1, 0, At, B0); PG8_MMA(1, 1, At, B1); PG8_BAR; PG8_SCHED;
            } else {
            PG8_LDB(B0, 0, 0); PG8_SCHED; PG8_LDA(At, 0, 0); PG8_STAGE(PG8_SA(1, 1), a1 + hstep, voffA);
            PG8_WAIT_L(8); PG8_BAR; PG8_WAIT_L(0); PG8_MMA(0, 0, At, B0); PG8_BAR; PG8_SCHED;
            PG8_LDB(B1, 0, 1); PG8_STAGE(PG8_SB(0, 0), b2, voffB);
            PG8_BAR; PG8_WAIT_L(0); PG8_MMA(0, 1, At, B1); PG8_BAR;
            PG8_LDA(At, 0, 1); PG8_STAGE(PG8_SA(0, 0), a2, voffA);
            PG8_BAR; PG8_WAIT_L(0); PG8_MMA(1, 0, At, B0); PG8_BAR; PG8_SCHED;
            PG8_STAGE(PG8_SB(0, 1), b2 + hstep, voffB);
            PG8_WAIT_V(6); PG8_BAR; PG8_MMA(1, 1, At, B1); PG8_BAR;
            PG8_LDB(B0, 1, 0); PG8_SCHED; PG8_LDA(At, 1, 0); PG8_STAGE(PG8_SA(0, 1), a2 + hstep, voffA);
            PG8_WAIT_L(8); PG8_BAR; PG8_WAIT_L(0); PG8_MMA(0, 0, At, B0); PG8_BAR; PG8_SCHED;
            PG8_LDB(B1, 1, 1); PG8_STAGE(PG8_SB(1, 0), b3, voffB);
            PG8_BAR; PG8_WAIT_L(0); PG8_MMA(0, 1, At, B1); PG8_BAR;
            PG8_LDA(At, 1, 1); PG8_STAGE(PG8_SA(1, 0), a3, voffA);
            PG8_BAR; PG8_WAIT_L(0); PG8_MMA(1, 0, At, B0); PG8_BAR; PG8_SCHED;
            PG8_STAGE(PG8_SB(1, 1), b3 + hstep, voffB);
            PG8_WAIT_V(6); PG8_BAR; PG8_MMA(1, 1, At, B1); PG8_BAR;
            }
        }
        if constexpr (ALIGN_EPI) { if (wr == 0) PG8_BAR; }
        if constexpr (!Epi::AFTER_DRAIN) { E(acc, cur, wr, wc, fr, fq); S.done(cur); }
        if (!has_next) break;
#pragma unroll
        for (int a = 0; a < 2; ++a)
#pragma unroll
            for (int b = 0; b < 2; ++b)
#pragma unroll
                for (int m = 0; m < 4; ++m)
#pragma unroll
                    for (int n = 0; n < 2; ++n) acc[a][b][m][n] = (f32x4){0.f, 0.f, 0.f, 0.f};
        cur = nxt; cA = nA; cB = nB; ++ui;
        if constexpr (ALIGN_EPI) { if (wr == 1) PG8_BAR; }
    }
    PG8_WAIT_V(0);
    if constexpr (!ALIGN_EPI) { if (wr == 0) PG8_BAR; }
    PG8_BAR;
    if constexpr (Epi::AFTER_DRAIN) { E.fused(acc, cur, wr, wc, fr, fq, lds, wid, lane); S.done(cur); }
#undef PG8_SA
#undef PG8_SB
#undef PG8_STAGE
#undef PG8_LDA
#undef PG8_LDB
#undef PG8_MMA
#undef PG8_WAIT_V
#undef PG8_WAIT_L
#undef PG8_BAR
#undef PG8_SCHED
}
}

#ifndef PG8_SP2
#define PG8_SP2 true
#endif
#ifndef PG8_ALIGN
#define PG8_ALIGN true
#endif
constexpr int NWAVES = 8;
constexpr int BATCH = 2, SEQ = 8192, DM = 2048, M = BATCH * SEQ;
constexpr int NQKV = 6144, NQKV_ODD = 6160;
constexpr int NE = 16, FFE = 512;
constexpr int MODW = 6 * DM;
constexpr float EPS = 1e-6f;
constexpr int MAXROWS = 36864;

constexpr size_t MiB = 1u << 20;
constexpr size_t WS_CTL = 0, CTL_ZERO_BYTES = 1 * MiB;
constexpr size_t WS_MOD = 1 * MiB;
constexpr size_t WS_LAM = WS_MOD + 2 * 2 * MODW * 4;
constexpr size_t WS_KMEAN = 2 * MiB;
constexpr size_t WS_WFG = 3 * MiB;
constexpr size_t WS_WRT = 3 * MiB + 128 * 1024;
constexpr size_t WS_ROUTE = 4 * MiB;
constexpr size_t WS_LOGF = 5 * MiB;
constexpr size_t WS_CUM = 6 * MiB;
constexpr size_t WS_KN = 7 * MiB;
constexpr size_t WS_SCR = 8 * MiB;
constexpr size_t WS_WIN = 40 * MiB;
constexpr size_t WS_WOUT = 88 * MiB;
constexpr size_t WS_W13 = 104 * MiB;
constexpr size_t WS_W2 = 232 * MiB;
constexpr size_t WS_H = 296 * MiB;
constexpr size_t WS_QKV = 360 * MiB;
constexpr size_t WS_MRG = 552 * MiB;
constexpr size_t WS_ACT = 616 * MiB;
constexpr size_t WS_OSL = 652 * MiB;
constexpr size_t WS_END = 796 * MiB;
constexpr int CW_TMO = 0;
constexpr int CW_CNT = 1024;
constexpr int CW_Q = 2048;
constexpr int CW_BAR = 4096;

constexpr int RING_OFF = 0, RING_BYTES = 131072;
constexpr int LDSCTL_OFF = RING_BYTES, MISC_OFF = LDSCTL_OFF + 320;
constexpr int LDS_BYTES = 147456;

#define GAS __attribute__((address_space(1)))
#define LAS __attribute__((address_space(3)))
typedef unsigned short bf16;
typedef unsigned v4u __attribute__((ext_vector_type(4)));
typedef unsigned v2u __attribute__((ext_vector_type(2)));
typedef float f32x4 __attribute__((ext_vector_type(4)));
typedef float f32x16 __attribute__((ext_vector_type(16)));
typedef short bf16x8 __attribute__((ext_vector_type(8)));
typedef short s16x4 __attribute__((ext_vector_type(4)));
typedef GAS unsigned gu32;
#define RLX_AGENT __ATOMIC_RELAXED, __HIP_MEMORY_SCOPE_AGENT
#define LDS_WAIT() asm volatile("s_waitcnt lgkmcnt(0)" ::: "memory")
#define VM_WAIT() asm volatile("s_waitcnt vmcnt(0)" ::: "memory")
__device__ __forceinline__ unsigned f2bf(float f) { unsigned u = __builtin_bit_cast(unsigned, f); return (u + 0x7fffu + ((u >> 16) & 1u)) >> 16; }
__device__ __forceinline__ unsigned pk2(float lo, float hi) { return f2bf(lo) | (f2bf(hi) << 16); }
__device__ __forceinline__ float bflo(unsigned w) { return __builtin_bit_cast(float, w << 16); }
__device__ __forceinline__ float bfhi(unsigned w) { return __builtin_bit_cast(float, w & 0xffff0000u); }
#define ARGS_T const __attribute__((address_space(4))) Args&
__device__ __forceinline__ int lane_id_asm() { int l; asm volatile("v_mbcnt_lo_u32_b32 %0, -1, 0\n\tv_mbcnt_hi_u32_b32 %0, -1, %0" : "=v"(l)); return l; }
__device__ __forceinline__ int opaque_tid(int wave) { return (wave << 6) + lane_id_asm(); }
__device__ __forceinline__ float wave_sum(float v) {
#pragma unroll
    for (int o = 1; o < 64; o <<= 1) v += __shfl_xor(v, o);
    return v;
}
__device__ __forceinline__ float wave_max(float v) {
#pragma unroll
    for (int o = 1; o < 64; o <<= 1) v = fmaxf(v, __shfl_xor(v, o));
    return v;
}
#define XB_TMO      128
#define XB_XCNT(j)  (256  + 64 * (j))
#define XB_XSUB(j)  (1280 + 64 * (j))
#define XB_XGEN(j)  (2304 + 64 * (j))
#define XB_TOP      3328
#define XB_TOPGEN   3392
#define XCD_BAR_WORDS 3456
#define XB_SPIN_CAP (1u << 18)

__device__ __forceinline__ unsigned xb_ld(unsigned* p)              { return __hip_atomic_load(p, __ATOMIC_RELAXED, __HIP_MEMORY_SCOPE_AGENT); }
__device__ __forceinline__ unsigned xb_add(unsigned* p, unsigned v) { return __hip_atomic_fetch_add(p, v, __ATOMIC_RELAXED, __HIP_MEMORY_SCOPE_AGENT); }
__device__ __forceinline__ unsigned xb_xcc_id() { return (unsigned)__builtin_amdgcn_s_getreg((3 << 11) | 20) & 0xFu; }
#define XB_SPIN(cond, bar) do { unsigned _sp = 0; while (cond) { __builtin_amdgcn_s_sleep(1); \
    if ((++_sp & 255u) == 0u) { if (xb_ld(&(bar)[XB_TMO])) break; if (_sp > XB_SPIN_CAP) { atomicAdd(&(bar)[XB_TMO], 1u); break; } } } } while (0)

struct XcdBarrier {
    unsigned* bar; unsigned x;
    volatile LAS unsigned* st;
    int w;
};

__device__ __forceinline__ XcdBarrier xcd_barrier_post(unsigned* bar, volatile LAS unsigned* st) {
    XcdBarrier b; b.bar = bar; b.x = xb_xcc_id(); b.st = st;
    if (threadIdx.x == 0) (void)xb_add(&bar[XB_XCNT(b.x)], 1u);
    return b;
}
__device__ __forceinline__ void xcd_barrier_complete(unsigned* bar, unsigned x, unsigned& nloc, unsigned& nx) {
    const unsigned G = gridDim.x * gridDim.y * gridDim.z;
    unsigned sum, cnt, mine, sp = 0u;
    for (;;) {
        sum = 0u; cnt = 0u; mine = 0u;
#pragma unroll
        for (unsigned j = 0; j < 16; ++j) { const unsigned c = xb_ld(&bar[XB_XCNT(j)]); sum += c; cnt += (c > 0u) ? 1u : 0u; mine = (j == x) ? c : mine; }
        if (sum == G) break;
        __builtin_amdgcn_s_sleep(1);
        if ((++sp & 255u) == 0u) { if (xb_ld(&bar[XB_TMO])) break; if (sp > XB_SPIN_CAP) { atomicAdd(&bar[XB_TMO], 1u); break; } }
    }
    nloc = mine > 0u ? mine : 1u; nx = cnt > 0u ? cnt : 1u;
}

__device__ __forceinline__ void xcd_barrier(const XcdBarrier& b) {
    asm volatile("s_waitcnt vmcnt(0)" ::: "memory");
    __syncthreads();
    if (b.w == 0 && lane_id_asm() == 0) {
        unsigned* bar = b.bar;
        __builtin_amdgcn_s_waitcnt(0);
        unsigned nloc = b.st[0], nx = b.st[1];
        if (nloc == 0u) { xcd_barrier_complete(bar, b.x, nloc, nx); b.st[0] = nloc; b.st[1] = nx; }
        const unsigned old = xb_add(&bar[XB_XSUB(b.x)], 1u);
        const unsigned gen = old / nloc;
        if (old + 1u == (gen + 1u) * nloc) {
            __builtin_amdgcn_fence(__ATOMIC_RELEASE, "agent");
            asm volatile("s_waitcnt vmcnt(0)" ::: "memory");
            const unsigned og = xb_add(&bar[XB_TOP], 1u);
            const unsigned tg = og / nx;
            if (og + 1u == (tg + 1u) * nx) xb_add(&bar[XB_TOPGEN], 1u);
            else XB_SPIN(xb_ld(&bar[XB_TOPGEN]) == tg, bar);
            __builtin_amdgcn_fence(__ATOMIC_ACQUIRE, "agent");
            xb_add(&bar[XB_XGEN(b.x)], 1u);
            asm volatile("s_waitcnt vmcnt(0)" ::: "memory");
        } else {
            XB_SPIN(xb_ld(&bar[XB_XGEN(b.x)]) == gen, bar);
            __builtin_amdgcn_fence(__ATOMIC_ACQUIRE, "agent");
            asm volatile("s_waitcnt vmcnt(0)" ::: "memory");
        }
    }
    __syncthreads();
}
struct Args { const float* in[22]; float* out; unsigned char* ws; int ph_lo, ph_hi; };
struct Frame { LAS unsigned char* lds; volatile LAS unsigned* MISC; gu32* ctl; int tid, lane, wave, vcu, G; };
enum { I_X = 0, I_C = 1, I_ADAW = 2, I_ADAB = 3, I_ANG = 4, I_FNG = 5, I_WINE = 6, I_WOUTE = 7, I_LQ1 = 8, I_LK1 = 9, I_LQ2 = 10, I_LK2 = 11, I_SUBLN = 12,
       I_WINO = 13, I_BF = 14, I_WOUTO = 15, I_RW = 16, I_RB = 17, I_W1 = 18, I_W3 = 19, I_W2 = 20, I_FING = 21 };

__device__ __forceinline__ void transpose_item(const float* W, int ldw, int K, int ncols, bf16* WT, int row_off, int rs, LAS float* scr, int item, int lane) {
    const int nblk = ncols / 32, kb = item / nblk, nb = item % nblk, k0 = 64 * kb, n0 = 32 * nb;
#pragma unroll 8
    for (int i = 0; i < 32; ++i) { const int kk = 2 * i + (lane >> 5); scr[kk * 33 + (lane & 31)] = W[(size_t)(k0 + kk) * ldw + n0 + (lane & 31)]; }
    LDS_WAIT(); asm volatile("" ::: "memory");
    const int c = lane & 7;
#pragma unroll
    for (int j = 0; j < 4; ++j) { const int n = (lane >> 3) + 8 * j; const LAS float* s = scr + (8 * c) * 33 + n;
        v4u o; o.x = pk2(s[0 * 33], s[1 * 33]); o.y = pk2(s[2 * 33], s[3 * 33]); o.z = pk2(s[4 * 33], s[5 * 33]); o.w = pk2(s[6 * 33], s[7 * 33]);
        *(GAS v4u*)(WT + (size_t)(row_off + (n0 + n) * rs) * K + k0 + 8 * c) = o; }
    LDS_WAIT(); asm volatile("" ::: "memory");
}
__device__ __forceinline__ void p0_prologue(ARGS_T A, const Frame& F0) {
    Frame F = F0; F.tid = opaque_tid(F0.wave); F.lane = F.tid & 63; F.wave = __builtin_amdgcn_readfirstlane(F.tid >> 6);
    unsigned char* ws = A.ws;
    for (int it = blockIdx.x; it < 96; it += F.G) {
        LAS float* cond = (LAS float*)(F.lds); LAS float* red = (LAS float*)(F.lds + 16384);
        for (int i = F.tid; i < 4096; i += 512) { const float cv = A.in[I_C][i]; cond[i] = cv / (1.0f + __expf(-cv)); }
        __syncthreads();
        const int l = it / 48, cg = it % 48;
        const float* W = A.in[I_ADAW] + (size_t)l * DM * MODW + cg * 256 + 4 * F.lane;
        f32x4 a0 = {0.f, 0.f, 0.f, 0.f}, a1 = {0.f, 0.f, 0.f, 0.f};
        const int kb = 256 * F.wave;
#pragma unroll 8
        for (int k = 0; k < 256; ++k) { const f32x4 w = *(const f32x4*)(W + (size_t)(kb + k) * MODW); a0 += cond[kb + k] * w; a1 += cond[2048 + kb + k] * w; }
        *(LAS f32x4*)(red + (F.wave * 2 + 0) * 256 + 4 * F.lane) = a0; *(LAS f32x4*)(red + (F.wave * 2 + 1) * 256 + 4 * F.lane) = a1;
        __syncthreads();
        { const int b = F.tid >> 8, n = F.tid & 255; float s = A.in[I_ADAB][l * MODW + cg * 256 + n];
#pragma unroll
          for (int w = 0; w < 8; ++w) s += red[(w * 2 + b) * 256 + n];
          ((float*)(ws + WS_MOD))[(l * 2 + b) * MODW + cg * 256 + n] = s; }
        __syncthreads();
    }
    if (blockIdx.x == 0 && F.tid == 0) { float s1 = 0.f, s2 = 0.f;
        for (int i = 0; i < 64; ++i) { s1 += A.in[I_LQ1][i] * A.in[I_LK1][i]; s2 += A.in[I_LQ2][i] * A.in[I_LK2][i]; }
        *(float*)(ws + WS_LAM) = __expf(s1) - __expf(s2) + 0.2f; }
    for (int i = blockIdx.x * 512 + F.tid; i < 16 * DM; i += F.G * 512) { const int j = i >> 11, k = i & 2047;
        ((float*)(ws + WS_WFG))[i] = A.in[I_WINO][(size_t)k * NQKV_ODD + NQKV + j]; ((float*)(ws + WS_WRT))[i] = A.in[I_RW][k * 16 + j]; }
    LAS float* scr = (LAS float*)(F.lds + F.wave * 16384);
    const int gw = F.vcu * NWAVES + F.wave, NGW = F.G * NWAVES;
    constexpr int I_IN = 32 * 192, I_OUT = 32 * 64, I_MOE = 32 * 512;
    for (int it = gw; it < 2 * I_IN + 2 * I_OUT + 3 * I_MOE; it += NGW) {
        int r = it;
        if (r < I_IN) { transpose_item(A.in[I_WINE], NQKV, DM, NQKV, (bf16*)(ws + WS_WIN), 0, 1, scr, r, F.lane); continue; } r -= I_IN;
        if (r < I_IN) { transpose_item(A.in[I_WINO], NQKV_ODD, DM, NQKV, (bf16*)(ws + WS_WIN) + (size_t)NQKV * DM, 0, 1, scr, r, F.lane); continue; } r -= I_IN;
        if (r < I_OUT) { transpose_item(A.in[I_WOUTE], DM, DM, DM, (bf16*)(ws + WS_WOUT), 0, 1, scr, r, F.lane); continue; } r -= I_OUT;
        if (r < I_OUT) { transpose_item(A.in[I_WOUTO], DM, DM, DM, (bf16*)(ws + WS_WOUT) + (size_t)DM * DM, 0, 1, scr, r, F.lane); continue; } r -= I_OUT;
        if (r < 2 * I_MOE) { const int which = r / I_MOE; r -= which * I_MOE; const int le = r >> 9, l = le >> 4, e = le & 15;
            transpose_item(A.in[which ? I_W3 : I_W1] + (size_t)le * DM * FFE, FFE, DM, FFE, (bf16*)(ws + WS_W13) + (size_t)l * 16384 * DM, e * 1024 + which, 2, scr, r & 511, F.lane); continue; }
        r -= 2 * I_MOE;
        { const int le = r >> 9, l = le >> 4, e = le & 15;
          transpose_item(A.in[I_W2] + (size_t)le * FFE * DM, DM, FFE, DM, (bf16*)(ws + WS_W2) + (size_t)l * 32768 * FFE, e * 2048, 1, scr, r & 511, F.lane); }
    }
}

template <int MODE>
__device__ __forceinline__ void norm_phase(ARGS_T A, const Frame& F0, int l) {
    Frame F = F0; F.tid = opaque_tid(F0.wave); F.lane = F.tid & 63; F.wave = __builtin_amdgcn_readfirstlane(F.tid >> 6);
    unsigned char* ws = A.ws;
    constexpr bool SIDE = (MODE == 1 || MODE == 2), COMB = (MODE == 2 || MODE == 3);
    LAS float* WT = (LAS float*)F.lds;
    if (SIDE) { const f32x4* src = (const f32x4*)(ws + (MODE == 1 ? WS_WRT : WS_WFG));
        for (int i = F.tid; i < 16 * DM / 4; i += 512) *(LAS f32x4*)(WT + 4 * i) = src[i];
        __syncthreads(); }
    const float* modl = (const float*)(ws + WS_MOD) + (size_t)l * 2 * MODW;
    const float* gain = MODE == 3 ? A.in[I_FING] : (MODE == 1 ? A.in[I_FNG] + l * DM : A.in[I_ANG] + l * DM);
    const float* xsrc = MODE == 0 ? A.in[I_X] : A.out;
    const float* modprev = (const float*)(ws + WS_MOD) + (size_t)(MODE == 3 ? 1 : 0) * 2 * MODW;
    const unsigned* route = (const unsigned*)(ws + WS_ROUTE);
    const bf16* OSL = (const bf16*)(ws + WS_OSL);
    bf16* H = (bf16*)(ws + WS_H);
    const int gw = F.vcu * NWAVES + F.wave, NGW = F.G * NWAVES, lane = F.lane;
    for (int m = gw; m < M; m += NGW) {
        const int b = m >> 13;
        f32x4 v[8];
        { const f32x4* xr = (const f32x4*)(xsrc + (size_t)m * DM) + lane;
#pragma unroll
          for (int j = 0; j < 8; ++j) v[j] = xr[64 * j]; }
        if (COMB) {
            const unsigned* rt = route + (size_t)m * 6;
            const float w0 = __builtin_bit_cast(float, rt[2]), w1 = __builtin_bit_cast(float, rt[3]);
            const v2u* o0 = (const v2u*)(OSL + (size_t)rt[4] * DM) + lane; const v2u* o1 = (const v2u*)(OSL + (size_t)rt[5] * DM) + lane;
            const f32x4* g2 = (const f32x4*)(modprev + (size_t)b * MODW + 5 * DM) + lane;
#pragma unroll
            for (int j = 0; j < 8; ++j) { const v2u a = o0[64 * j], c = o1[64 * j]; const f32x4 g = g2[64 * j];
                v[j].x += g.x * (w0 * bflo(a.x) + w1 * bflo(c.x)); v[j].y += g.y * (w0 * bfhi(a.x) + w1 * bfhi(c.x));
                v[j].z += g.z * (w0 * bflo(a.y) + w1 * bflo(c.y)); v[j].w += g.w * (w0 * bfhi(a.y) + w1 * bfhi(c.y)); }
            if (MODE == 2) { f32x4* xw = (f32x4*)(A.out + (size_t)m * DM) + lane;
#pragma unroll
                for (int j = 0; j < 8; ++j) xw[64 * j] = v[j]; }
        }
        float ss = 0.f;
#pragma unroll
        for (int j = 0; j < 8; ++j) ss += (v[j].x * v[j].x + v[j].y * v[j].y) + (v[j].z * v[j].z + v[j].w * v[j].w);
        const float rstd = 1.0f / sqrtf(wave_sum(ss) * (1.0f / DM) + EPS);
        if (MODE == 3) {
            f32x4* ow = (f32x4*)(A.out + (size_t)m * DM) + lane; const f32x4* gp = (const f32x4*)gain + lane;
#pragma unroll
            for (int j = 0; j < 8; ++j) ow[64 * j] = v[j] * rstd * gp[64 * j];
            continue;
        }
        { const f32x4* gp = (const f32x4*)gain + lane;
          const f32x4* shp = (const f32x4*)(modl + (size_t)b * MODW + (MODE == 1 ? 3 : 0) * DM) + lane;
          const f32x4* scp = (const f32x4*)(modl + (size_t)b * MODW + (MODE == 1 ? 4 : 1) * DM) + lane;
          v2u* hw = (v2u*)(H + (size_t)m * DM) + lane;
#pragma unroll
          for (int j = 0; j < 8; ++j) { v[j] = v[j] * rstd * gp[64 * j] * (1.0f + scp[64 * j]) + shp[64 * j];
              v2u o; o.x = pk2(v[j].x, v[j].y); o.y = pk2(v[j].z, v[j].w); hw[64 * j] = o; } }
        if (SIDE) {
            float z = 0.f;
#pragma unroll 1
            for (int q = 0; q < 16; ++q) { float d = 0.f;
#pragma unroll
                for (int j = 0; j < 8; ++j) { const f32x4 w = *(const LAS f32x4*)(WT + q * DM + 256 * j + 4 * lane); d += (v[j].x * w.x + v[j].y * w.y) + (v[j].z * w.z + v[j].w * w.w); }
                d = wave_sum(d); if (lane == q) z = d; }
            if (MODE == 2) {
                if (lane < 16) { z += A.in[I_BF][lane]; const float r = z >= 0.f ? -log1pf(__expf(-z)) : z - log1pf(__expf(z));
                    ((float*)(ws + WS_LOGF))[(size_t)m * 16 + lane] = r; }
            } else {
                float aff[16], sel[16];
#pragma unroll
                for (int q = 0; q < 16; ++q) { const float lgq = __shfl(z, q); aff[q] = 1.0f / (1.0f + __expf(-lgq)); sel[q] = aff[q] + A.in[I_RB][q]; }
                int best = 0; float bs = -3.0e38f;
#pragma unroll
                for (int g = 0; g < 4; ++g) { const float a = sel[4 * g], bq = sel[4 * g + 1], c = sel[4 * g + 2], d = sel[4 * g + 3];
                    const float t2 = fmaxf(fmaxf(fmaxf(a + bq, a + c), fmaxf(a + d, bq + c)), fmaxf(bq + d, c + d));
                    if (t2 > bs) { bs = t2; best = g; } }
                float cs[4], ca[4];
#pragma unroll
                for (int i = 0; i < 4; ++i) { cs[i] = sel[i]; ca[i] = aff[i]; }
#pragma unroll
                for (int g = 1; g < 4; ++g) if (best == g) {
#pragma unroll
                    for (int i = 0; i < 4; ++i) { cs[i] = sel[4 * g + i]; ca[i] = aff[4 * g + i]; } }
                int i1 = 0; float s1 = cs[0], a1 = ca[0];
#pragma unroll
                for (int i = 1; i < 4; ++i) if (cs[i] > s1) { s1 = cs[i]; a1 = ca[i]; i1 = i; }
                int i2 = -1; float s2 = -3.0e38f, a2 = 0.f;
#pragma unroll
                for (int i = 0; i < 4; ++i) if (i != i1 && cs[i] > s2) { s2 = cs[i]; a2 = ca[i]; i2 = i; }
                const int e0 = best * 4 + i1, e1 = best * 4 + i2; const float inv = 1.0f / (a1 + a2);
                if (lane == 0) { unsigned* cnt = (unsigned*)(F.ctl + CW_CNT + 64 * l);
                    const unsigned p0 = __hip_atomic_fetch_add(cnt + e0, 1u, RLX_AGENT), p1 = __hip_atomic_fetch_add(cnt + e1, 1u, RLX_AGENT);
                    unsigned* rt = (unsigned*)(ws + WS_ROUTE) + (size_t)m * 6;
                    rt[0] = (unsigned)e0; rt[1] = (unsigned)e1; rt[2] = __builtin_bit_cast(unsigned, a1 * inv); rt[3] = __builtin_bit_cast(unsigned, a2 * inv); rt[4] = p0; rt[5] = p1; }
            }
        }
    }
}
__device__ __forceinline__ void scan_phase(ARGS_T A, const Frame& F0) {
    Frame F = F0; F.tid = opaque_tid(F0.wave); F.lane = F.tid & 63; F.wave = __builtin_amdgcn_readfirstlane(F.tid >> 6);
    const float* LOGF = (const float*)(A.ws + WS_LOGF); float* CUM = (float*)(A.ws + WS_CUM);
    LAS float* wt = (LAS float*)F.lds;
    for (int u = blockIdx.x; u < BATCH * 16; u += F.G) {
        const int b = u >> 4, h = u & 15, s0 = F.tid * 16;
        float v[16]; float run = 0.f;
#pragma unroll
        for (int i = 0; i < 16; ++i) { run += LOGF[(size_t)(b * SEQ + s0 + i) * 16 + h]; v[i] = run; }
        float inc = run;
#pragma unroll
        for (int o = 1; o < 64; o <<= 1) { const float t = __shfl_up(inc, o); if (F.lane >= o) inc += t; }
        if (F.lane == 63) wt[F.wave] = inc;
        __syncthreads();
        float base = inc - run;
        for (int w = 0; w < F.wave; ++w) base += wt[w];
        float* dst = CUM + (size_t)(b * 16 + h) * SEQ + s0;
#pragma unroll
        for (int i = 0; i < 16; ++i) dst[i] = -(base + v[i]) * 11.313708498984761f;
        __syncthreads();
    }
}
__device__ __forceinline__ void kmean_phase(ARGS_T A, const Frame& F0) {
    Frame F = F0; F.tid = opaque_tid(F0.wave); F.lane = F.tid & 63; F.wave = __builtin_amdgcn_readfirstlane(F.tid >> 6);
    const bf16* QKV = (const bf16*)(A.ws + WS_QKV); float* KM = (float*)(A.ws + WS_KMEAN);
    LAS float* red = (LAS float*)F.lds;
    for (int u = blockIdx.x; u < BATCH * 8 * 32; u += F.G) {
        const int b = u >> 8, h = (u >> 5) & 7, blk = u & 31, c = F.tid & 15, rg = F.tid >> 4;
        float s[8] = {0.f, 0.f, 0.f, 0.f, 0.f, 0.f, 0.f, 0.f};
#pragma unroll
        for (int i = 0; i < 8; ++i) { const v4u w = *(const v4u*)(QKV + (size_t)(b * SEQ + blk * 256 + rg + 32 * i) * NQKV + 4096 + h * 128 + 8 * c);
            s[0] += bflo(w.x); s[1] += bfhi(w.x); s[2] += bflo(w.y); s[3] += bfhi(w.y); s[4] += bflo(w.z); s[5] += bfhi(w.z); s[6] += bflo(w.w); s[7] += bfhi(w.w); }
#pragma unroll
        for (int i = 0; i < 8; ++i) red[rg * 128 + 8 * c + i] = s[i];
        __syncthreads();
        if (F.tid < 128) { float t = 0.f;
#pragma unroll
            for (int r = 0; r < 32; ++r) t += red[r * 128 + F.tid];
            KM[(size_t)u * 128 + F.tid] = t * (1.0f / 256.0f); }
        __syncthreads();
    }
}
__device__ __forceinline__ void gather_phase(ARGS_T A, const Frame& F0, int l) {
    Frame F = F0; F.tid = opaque_tid(F0.wave); F.lane = F.tid & 63; F.wave = __builtin_amdgcn_readfirstlane(F.tid >> 6);
    const unsigned* cnt = (const unsigned*)(F.ctl + CW_CNT + 64 * l);
    unsigned basev = 0;
    { unsigned t = 0;
#pragma unroll
      for (int e = 0; e < 16; ++e) { if (F.lane == e) basev = t * 256u; t += (cnt[e] + 255u) >> 8; } }
    unsigned* route = (unsigned*)(A.ws + WS_ROUTE); const bf16* H = (const bf16*)(A.ws + WS_H); bf16* HS = (bf16*)(A.ws + WS_QKV);
    const int gw = F.vcu * NWAVES + F.wave, NGW = F.G * NWAVES;
    for (int m = gw; m < M; m += NGW) {
        unsigned* rt = route + (size_t)m * 6;
        const unsigned e0 = rt[0], e1 = rt[1], p0 = rt[4], p1 = rt[5];
        const unsigned s0 = __shfl(basev, (int)e0) + p0, s1 = __shfl(basev, (int)e1) + p1;
        const v4u* src = (const v4u*)(H + (size_t)m * DM) + F.lane; v4u* d0 = (v4u*)(HS + (size_t)s0 * DM) + F.lane; v4u* d1 = (v4u*)(HS + (size_t)s1 * DM) + F.lane;
        v4u x[4];
#pragma unroll
        for (int j = 0; j < 4; ++j) x[j] = src[64 * j];
#pragma unroll
        for (int j = 0; j < 4; ++j) { d0[64 * j] = x[j]; d1[64 * j] = x[j]; }
        asm volatile("" ::: "memory");
        if (F.lane == 0) { rt[4] = s0; rt[5] = s1; }
    }
}
template <int L>
__device__ __forceinline__ void knorm_phase(ARGS_T A, const Frame& F0) {
    Frame F = F0; F.tid = opaque_tid(F0.wave); F.lane = F.tid & 63; F.wave = __builtin_amdgcn_readfirstlane(F.tid >> 6);
    const bf16* QKV = (const bf16*)(A.ws + WS_QKV); float* KN = (float*)(A.ws + WS_KN);
    constexpr int DQ = L == 0 ? 64 : 128;
    for (int it = blockIdx.x; it < 256; it += F.G) {
        const int u = it >> 3, tg = it & 7;
        int b, col;
        if (L == 0) { b = u >> 4; col = 1024 + ((u >> 1) & 7) * 128 + (u & 1) * 64; } else { b = u >> 4; col = 2048 + (u & 15) * 128; }
        float mx = 0.f;
#pragma unroll
        for (int kk = 0; kk < 2; ++kk) { const bf16* kr = QKV + (size_t)(b * SEQ + tg * 1024 + 2 * F.tid + kk) * NQKV + col; float s2 = 0.f;
#pragma unroll
            for (int c = 0; c < DQ / 8; ++c) { const v4u w = *(const v4u*)(kr + 8 * c);
                s2 += (bflo(w.x) * bflo(w.x) + bfhi(w.x) * bfhi(w.x)) + (bflo(w.y) * bflo(w.y) + bfhi(w.y) * bfhi(w.y)) + (bflo(w.z) * bflo(w.z) + bfhi(w.z) * bfhi(w.z)) + (bflo(w.w) * bflo(w.w) + bfhi(w.w) * bfhi(w.w)); }
            mx = fmaxf(mx, s2); }
#pragma unroll
        for (int o = 1; o < 32; o <<= 1) mx = fmaxf(mx, __shfl_xor(mx, o));
        if ((F.tid & 31) == 0) KN[(size_t)u * 128 + tg * 16 + (F.tid >> 5)] = sqrtf(mx) * 1.001f;
    }
}
#ifndef NAIVE_ATTN
#define NAIVE_ATTN 0
#endif
#if NAIVE_ATTN
template <int DQ>
__device__ __forceinline__ void naive_span(const bf16* Kp, const bf16* Vp, const LAS float* q, int kb, int ke, int pos, float scale, float slope, const float* CUMrow, float cq,
                                           float& mrun, float& lrun, float& o0, float& o1, int lane) {
    for (int kc = kb; kc < ke; kc += 64) {
        const int key = kc + lane;
        float s = 0.f;
        { const bf16* kr = Kp + (size_t)key * NQKV;
#pragma unroll
          for (int c = 0; c < DQ / 8; ++c) { const v4u w = *(const v4u*)(kr + 8 * c); const f32x4 qa = *(const LAS f32x4*)(q + 8 * c), qb = *(const LAS f32x4*)(q + 8 * c + 4);
              s += (qa.x * bflo(w.x) + qa.y * bfhi(w.x)) + (qa.z * bflo(w.y) + qa.w * bfhi(w.y)) + (qb.x * bflo(w.z) + qb.y * bfhi(w.z)) + (qb.z * bflo(w.w) + qb.w * bfhi(w.w)); } }
        s = s * scale + (CUMrow ? (CUMrow[key] - cq) * scale : slope * (float)(key - pos));
        if (key > pos || key >= ke) s = -__builtin_inff();
        const float cm = wave_max(s);
        if (cm == -__builtin_inff()) continue;
        const float mn = fmaxf(mrun, cm), al = __expf(mrun - mn), p = __expf(s - mn);
        lrun = lrun * al + wave_sum(p); o0 *= al; o1 *= al; mrun = mn;
        for (int j = 0; j < 64; ++j) { const float pj = __shfl(p, j); const unsigned vv = *(const unsigned*)(Vp + (size_t)(kc + j) * NQKV + 2 * lane); o0 += pj * bflo(vv); o1 += pj * bfhi(vv); }
    }
}
template <int VAR>
__global__ void __launch_bounds__(256) naive_attn(const bf16* __restrict__ QKV, bf16* __restrict__ MRG, const float* __restrict__ CUM, const float* __restrict__ KMEAN,
                                                  const float* __restrict__ lamp, const float* __restrict__ subg) {
    __shared__ float qs[4][128];
    constexpr int NH = VAR == 2 ? 16 : 8;
    const int wave = threadIdx.x >> 6, lane = threadIdx.x & 63;
    const long id = (long)blockIdx.x * 4 + wave; const int m = (int)(id / NH), hh = (int)(id % NH), b = m >> 13, pos = m & 8191;
    const bf16* row = QKV + (size_t)m * NQKV; const bf16* base = QKV + (size_t)b * SEQ * NQKV;
    LAS float* q = (LAS float*)qs[wave];
    if (VAR == 0) {
        const float slope = exp2f(-(2.0f * hh + 1.0f) * 0.5f);
        float O0[2], O1[2];
#pragma unroll
        for (int mp = 0; mp < 2; ++mp) {
            q[lane] = bflo((unsigned)row[hh * 128 + mp * 64 + lane]); __builtin_amdgcn_wave_barrier(); LDS_WAIT();
            float mr = -1e30f, lr = 0.f, o0 = 0.f, o1 = 0.f;
            naive_span<64>(base + 1024 + hh * 128 + mp * 64, base + 2048 + hh * 128, q, 0, pos + 1, pos, 0.125f, slope, nullptr, 0.f, mr, lr, o0, o1, lane);
            O0[mp] = o0 / lr; O1[mp] = o1 / lr; __builtin_amdgcn_wave_barrier();
        }
        const float lam = *lamp; const float a0 = O0[0] - lam * O0[1], a1 = O1[0] - lam * O1[1];
        const float r = 1.0f / sqrtf(wave_sum(a0 * a0 + a1 * a1) * (1.0f / 128.0f) + EPS);
        *(unsigned*)(MRG + (size_t)m * DM + hh * 128 + 2 * lane) = pk2(a0 * r * subg[2 * lane] * 0.8f, a1 * r * subg[2 * lane + 1] * 0.8f);
    } else if (VAR == 1) {
        const float slope = exp2f(-(float)(hh + 1));
        q[lane] = bflo((unsigned)row[3072 + hh * 128 + lane]); q[64 + lane] = bflo((unsigned)row[3072 + hh * 128 + 64 + lane]); __builtin_amdgcn_wave_barrier(); LDS_WAIT();
        const int own = pos >> 8;
        float g = -3.0e38f;
        if (lane < own) { const float* km = KMEAN + ((size_t)(b * 8 + hh) * 32 + lane) * 128; float s = 0.f;
            for (int d = 0; d < 128; ++d) s += q[d] * km[d]; g = s; }
        unsigned long long selm = 0ull;
        for (int t = 0; t < 3 && t < own; ++t) { const float mx = wave_max(g); const unsigned long long bal = __ballot(g == mx); const int pick = __ffsll((long long)bal) - 1;
            selm |= 1ull << pick; if (lane == pick) g = -3.0e38f; }
        float mr = -1e30f, lr = 0.f, o0 = 0.f, o1 = 0.f;
        for (int n = 0; n < own; ++n) if ((selm >> n) & 1ull)
            naive_span<128>(base + 4096 + hh * 128, base + 5120 + hh * 128, q, n * 256, n * 256 + 256, pos, 0.08838834764831845f, slope, nullptr, 0.f, mr, lr, o0, o1, lane);
        naive_span<128>(base + 4096 + hh * 128, base + 5120 + hh * 128, q, own * 256, pos + 1, pos, 0.08838834764831845f, slope, nullptr, 0.f, mr, lr, o0, o1, lane);
        *(unsigned*)(MRG + (size_t)m * DM + 1024 + hh * 128 + 2 * lane) = pk2(o0 / lr, o1 / lr);
    } else {
        q[lane] = bflo((unsigned)row[hh * 128 + lane]); q[64 + lane] = bflo((unsigned)row[hh * 128 + 64 + lane]); __builtin_amdgcn_wave_barrier(); LDS_WAIT();
        const float* cr = CUM + (size_t)(b * 16 + hh) * SEQ;
        float mr = -1e30f, lr = 0.f, o0 = 0.f, o1 = 0.f;
        naive_span<128>(base + 2048 + hh * 128, base + 4096 + hh * 128, q, 0, pos + 1, pos, 0.08838834764831845f, 0.f, cr, cr[pos], mr, lr, o0, o1, lane);
        *(unsigned*)(MRG + (size_t)m * DM + hh * 128 + 2 * lane) = pk2(o0 / lr, o1 / lr);
    }
}
#endif
namespace att {
constexpr int V_OFF = 0, K_OFF = 49152, C_OFF = 98304, T_OFF = 99328  , G_KM = 0, G_GT = G_KM + 16384, G_SEL = G_GT + 256 * 33 * 4, G_OR = G_SEL + 1024, ATT_LDS = G_OR + 16;
static_assert(ATT_LDS <= RING_BYTES, "attention LDS");
constexpr float THR = 8.f;
#define SBAR() __builtin_amdgcn_sched_barrier(0)
__device__ __forceinline__ int v_st(int k, int c) { const int kk = (k & ~0xC) | ((k & 4) << 1) | ((k & 8) >> 1); return ((kk >> 3) * 4 + (c >> 5)) * 512 + ((kk & 7) * 32 + (c & 31)) * 2; }
__device__ __forceinline__ int v_rd_base(int lane) { return ((lane & 3) << 3) | (((lane >> 2) & 3) << 6) | (((lane >> 4) & 1) << 5) | (((lane >> 5) & 1) << 8); }
__device__ __forceinline__ unsigned cvtpk(float lo, float hi) { unsigned r; asm volatile("v_cvt_pk_bf16_f32 %0, %1, %2" : "=v"(r) : "v"(lo), "v"(hi)); return r; }

template <int VAR>
__device__ __forceinline__ void attn_block_s(const int wv, LAS unsigned char* lds, const bf16* __restrict__ Qp, const bf16* __restrict__ Kp, const bf16* __restrict__ Vp, const int P0,
                                           const float slope, const float* __restrict__ cumrow, const unsigned selrow, unsigned wgmask, f32x16 (&o)[4], float& l_out) {
    constexpr int DQK = VAR == 0 ? 64 : 128, NQ = DQK / 16;
    constexpr float SCALE = VAR == 0 ? 0.125f : 0.08838834764831845f, C2 = SCALE * 1.4426950408889634f, ISC = 1.0f / SCALE;
    const int tid = opaque_tid(wv), wid = wv, lane = tid & 63, r32 = lane & 31, hi = lane >> 5;
    const int qb = P0 >> 8, qlo = P0 + wid * 32, qpos = qlo + r32;
    LAS unsigned char* V_lds = lds + V_OFF; LAS unsigned char* K_lds = lds + K_OFF; LAS float* C_lds = (LAS float*)(lds + C_OFF);
    bf16x8 qr[NQ];
#pragma unroll
    for (int d0 = 0; d0 < NQ; ++d0) qr[d0] = *(const bf16x8*)(Qp + (unsigned)((wid * 32 + r32) * NQKV + hi * 8) + d0 * 16);
    unsigned offK, offV;
    if (VAR == 0) { const int row = wid * 8 + (lane >> 3), c = (lane & 7) ^ ((row >> 1) & 7); offK = (unsigned)(row * NQKV + c * 8); }
    else { const int row = wid * 4 + (lane >> 4), c = (lane & 15) ^ (row & 7); offK = (unsigned)(row * NQKV + c * 8); }
    { const int t = (lane & 31) >> 2, k = (wid >> 2) * 16 + (t >> 2) * 8 + ((wid >> 1) & 1) * 4 + (t & 3), c = ((wid & 1) * 2 + (lane >> 5)) * 32 + (lane & 3) * 8; offV = (unsigned)(k * NQKV + c); }
    const unsigned vb0 = (unsigned)(uintptr_t)(V_lds) + (unsigned)v_rd_base(lane);
    int ti_blk = 0, ti_sub = 0; unsigned rem = wgmask;
    if (VAR == 1) ti_blk = __builtin_ctz(rem);
    const int NT = VAR == 1 ? 4 * __builtin_popcount(wgmask) : 4 * (qb + 1);
#define KB_CUR() (VAR == 1 ? ti_blk * 256 + ti_sub * 64 : ti_sub * 64)
#define ADVANCE() do { if (VAR == 1) { if (++ti_sub == 4) { ti_sub = 0; rem &= rem - 1u; ti_blk = rem ? __builtin_ctz(rem) : 0; } } else ++ti_sub; } while (0)
#define GLDS(src, dstoff) __builtin_amdgcn_global_load_lds((const unsigned*)(src), (LAS unsigned*)(lds + (dstoff)), 16, 0, 0)
#define STAGE(kb, bf) do { const bf16* vb_ = Vp + (size_t)(kb) * NQKV + offV; const bf16* kb_ = Kp + (size_t)(kb) * NQKV + offK; \
        GLDS(vb_, V_OFF + (bf) * 16384 + wid * 1024); GLDS(vb_ + 32 * NQKV, V_OFF + (bf) * 16384 + 8192 + wid * 1024); \
        GLDS(kb_, K_OFF + (bf) * 16384 + wid * 1024); if (VAR != 0) GLDS(kb_ + 32 * NQKV, K_OFF + (bf) * 16384 + 8192 + wid * 1024); \
        if (VAR == 2) { if (wid == 0) __builtin_amdgcn_global_load_lds((const unsigned*)(cumrow + (kb) + lane), (LAS unsigned*)(lds + C_OFF + (bf) * 256), 4, 0, 0); } } while (0)
    float m_reg = -1e30f, l_reg = 0.f;
#pragma unroll
    for (int d0 = 0; d0 < 4; ++d0)
#pragma unroll
        for (int r = 0; r < 16; ++r) o[d0][r] = 0.f;
    const float sl = slope * ISC;
    int kb = KB_CUR();
    STAGE(kb, 0); VM_WAIT();
    __syncthreads();
    for (int i = 0; i < NT; ++i) {
        const int buf = i & 1; const int blk_cur = ti_blk;
        ADVANCE();
        const int kbn = KB_CUR(); const bool has_next = i + 1 < NT;
        if (has_next) STAGE(kbn, buf ^ 1);
        bool act = kb <= qlo + 31;
        bool selok = true;
        if (VAR == 1) { selok = (blk_cur == qb) || ((selrow >> blk_cur) & 1u); act = act && (__ballot(selok) != 0ull); }
        if (act) {
            f32x16 p0, p1;
            if (VAR == 2) {
                const LAS float* cp = C_lds + buf * 64 + 4 * hi;
                const f32x4 c0 = *(const LAS f32x4*)(cp), c1 = *(const LAS f32x4*)(cp + 8), c2 = *(const LAS f32x4*)(cp + 16), c3 = *(const LAS f32x4*)(cp + 24);
                const f32x4 e0 = *(const LAS f32x4*)(cp + 32), e1 = *(const LAS f32x4*)(cp + 40), e2 = *(const LAS f32x4*)(cp + 48), e3 = *(const LAS f32x4*)(cp + 56);
                p0 = (f32x16){c0[0], c0[1], c0[2], c0[3], c1[0], c1[1], c1[2], c1[3], c2[0], c2[1], c2[2], c2[3], c3[0], c3[1], c3[2], c3[3]};
                p1 = (f32x16){e0[0], e0[1], e0[2], e0[3], e1[0], e1[1], e1[2], e1[3], e2[0], e2[1], e2[2], e2[3], e3[0], e3[1], e3[2], e3[3]};
            } else {
                const float t0 = sl * (float)(kb - P0 + 4 * hi);
#pragma unroll
                for (int r = 0; r < 16; ++r) { p0[r] = __builtin_fmaf(sl, (float)((r & 3) + 8 * (r >> 2)), t0); p1[r] = __builtin_fmaf(sl, (float)(32 + (r & 3) + 8 * (r >> 2)), t0); }
            }
            if (VAR == 0) {
                const LAS unsigned char* ka = K_lds + buf * 16384 + r32 * 128;
                const int sw = ((r32 >> 1) & 7) << 4;
#pragma unroll
                for (int d0 = 0; d0 < 4; ++d0) { const int cb = ((2 * d0 + hi) * 16) ^ sw;
                    const bf16x8 b0 = *(const LAS bf16x8*)(ka + cb), b1 = *(const LAS bf16x8*)(ka + cb + 32 * 128);
                    p0 = __builtin_amdgcn_mfma_f32_32x32x16_bf16(b0, qr[d0], p0, 0, 0, 0); p1 = __builtin_amdgcn_mfma_f32_32x32x16_bf16(b1, qr[d0], p1, 0, 0, 0); }
            } else {
                const LAS unsigned char* kbp[4];
#pragma unroll
                for (int dd = 0; dd < 4; ++dd) kbp[dd] = K_lds + buf * 16384 + r32 * 256 + (((dd * 16 + hi * 8) * 2) ^ ((r32 & 7) << 4));
#pragma unroll
                for (int d0 = 0; d0 < NQ; ++d0) { const LAS unsigned char* a = kbp[d0 & 3] + (d0 >> 2) * 128;
                    const bf16x8 b0 = *(const LAS bf16x8*)(a), b1 = *(const LAS bf16x8*)(a + 32 * 256);
                    p0 = __builtin_amdgcn_mfma_f32_32x32x16_bf16(b0, qr[d0], p0, 0, 0, 0); p1 = __builtin_amdgcn_mfma_f32_32x32x16_bf16(b1, qr[d0], p1, 0, 0, 0); }
            }
            const float NEG = -__builtin_inff();
            if (kb + 63 > qlo) {
                const int dq = qpos - kb - 4 * hi;
#pragma unroll
                for (int r = 0; r < 16; ++r) { const int c = (r & 3) + 8 * (r >> 2); if (c > dq) p0[r] = NEG; if (c + 32 > dq) p1[r] = NEG; }
            }
            if (VAR == 1) { if (!selok) {
#pragma unroll
                for (int r = 0; r < 16; ++r) { p0[r] = NEG; p1[r] = NEG; } } }
            float pmax = p0[0];
#pragma unroll
            for (int r = 1; r < 16; ++r) pmax = fmaxf(pmax, p0[r]);
#pragma unroll
            for (int r = 0; r < 16; ++r) pmax = fmaxf(pmax, p1[r]);
            { auto rr = __builtin_amdgcn_permlane32_swap(__float_as_uint(pmax), __float_as_uint(pmax), false, false);
              pmax = fmaxf(__uint_as_float(rr[0]), __uint_as_float(rr[1])); }
            float mn, alpha;
            if (__builtin_expect(__all((pmax - m_reg) * SCALE <= THR), 1)) { mn = m_reg; alpha = 1.f; }
            else { mn = fmaxf(m_reg, pmax); alpha = __builtin_amdgcn_exp2f((m_reg - mn) * C2); m_reg = mn; }
            const float mnL = -mn * C2;
            float ps = 0.f;
#pragma unroll
            for (int r = 0; r < 16; ++r) { p0[r] = __builtin_amdgcn_exp2f(fmaf(p0[r], C2, mnL)); p1[r] = __builtin_amdgcn_exp2f(fmaf(p1[r], C2, mnL)); }
#pragma unroll
            for (int r = 0; r < 16; ++r) ps += p0[r] + p1[r];
            l_reg = l_reg * alpha + ps;
            if (__any(alpha < 1.f)) {
#pragma unroll
                for (int d0 = 0; d0 < 4; ++d0)
#pragma unroll
                    for (int r = 0; r < 16; ++r) o[d0][r] *= alpha;
            }
            bf16x8 pa0, pa1, pa2, pa3;
#define PK4(P, B_, OUT) do { unsigned a0 = cvtpk(P[B_ + 0], P[B_ + 1]), a1 = cvtpk(P[B_ + 2], P[B_ + 3]); unsigned b0 = cvtpk(P[B_ + 4], P[B_ + 5]), b1 = cvtpk(P[B_ + 6], P[B_ + 7]); \
        auto r0 = __builtin_amdgcn_permlane32_swap(a0, b0, false, false); auto r1 = __builtin_amdgcn_permlane32_swap(a1, b1, false, false); \
        v4u w = {r0[0], r1[0], r0[1], r1[1]}; OUT = __builtin_bit_cast(bf16x8, w); } while (0)
            PK4(p0, 0, pa0); PK4(p0, 8, pa1); PK4(p1, 0, pa2); PK4(p1, 8, pa3);
#undef PK4
#define TRRD(dst, off) asm volatile("ds_read_b64_tr_b16 %0, %1 offset:%2" : "=&v"(dst) : "v"(vb0), "i"(off) : "memory")
#define PV_D0(d0, VB) do { s16x4 l0, l1, l2, l3, h0, h1, h2, h3; constexpr int b_ = (VB) * 16384 + (d0) * 512; \
        TRRD(l0, b_); TRRD(h0, b_ + 2048); TRRD(l1, b_ + 4096); TRRD(h1, b_ + 6144); TRRD(l2, b_ + 8192); TRRD(h2, b_ + 10240); TRRD(l3, b_ + 12288); TRRD(h3, b_ + 14336); \
        asm volatile("s_waitcnt lgkmcnt(0)" ::: "memory"); SBAR(); \
        o[d0] = __builtin_amdgcn_mfma_f32_32x32x16_bf16((bf16x8){l0[0], l0[1], l0[2], l0[3], h0[0], h0[1], h0[2], h0[3]}, pa0, o[d0], 0, 0, 0); \
        o[d0] = __builtin_amdgcn_mfma_f32_32x32x16_bf16((bf16x8){l1[0], l1[1], l1[2], l1[3], h1[0], h1[1], h1[2], h1[3]}, pa1, o[d0], 0, 0, 0); \
        o[d0] = __builtin_amdgcn_mfma_f32_32x32x16_bf16((bf16x8){l2[0], l2[1], l2[2], l2[3], h2[0], h2[1], h2[2], h2[3]}, pa2, o[d0], 0, 0, 0); \
        o[d0] = __builtin_amdgcn_mfma_f32_32x32x16_bf16((bf16x8){l3[0], l3[1], l3[2], l3[3], h3[0], h3[1], h3[2], h3[3]}, pa3, o[d0], 0, 0, 0); } while (0)
            if (buf == 0) { PV_D0(0, 0); PV_D0(1, 0); PV_D0(2, 0); PV_D0(3, 0); } else { PV_D0(0, 1); PV_D0(1, 1); PV_D0(2, 1); PV_D0(3, 1); }
#undef PV_D0
#undef TRRD
        }
        VM_WAIT();
        kb = kbn;
        __syncthreads();
    }
    { auto rr = __builtin_amdgcn_permlane32_swap(__float_as_uint(l_reg), __float_as_uint(l_reg), false, false); l_out = __uint_as_float(rr[0]) + __uint_as_float(rr[1]); }
#undef KB_CUR
#undef ADVANCE
#undef STAGE
#undef GLDS
}
struct TileIt { unsigned rem; int blk, sub; };
template <int VAR> __device__ __forceinline__ void ti_init(TileIt& it, unsigned mask) { it.rem = mask; it.sub = 0; it.blk = VAR == 1 ? __builtin_ctz(mask) : 0; }
template <int VAR> __device__ __forceinline__ int ti_kb(const TileIt& it) { return VAR == 1 ? it.blk * 256 + it.sub * 64 : it.sub * 64; }
template <int VAR> __device__ __forceinline__ void ti_adv(TileIt& it) { if (VAR == 1) { if (++it.sub == 4) { it.sub = 0; it.rem &= it.rem - 1u; it.blk = it.rem ? __builtin_ctz(it.rem) : 0; } } else ++it.sub; }
#define ATT_VMW(n) asm volatile("s_waitcnt vmcnt(%0)" :: "i"(n) : "memory")
#define ATT_BAR() do { asm volatile("s_waitcnt lgkmcnt(0)" ::: "memory"); __builtin_amdgcn_s_barrier(); asm volatile("" ::: "memory"); } while (0)
template <int VAR>
__device__ __forceinline__ void attn_block(const int wv, LAS unsigned char* lds, const bf16* __restrict__ Qp, const bf16* __restrict__ Kp, const bf16* __restrict__ Vp, const int P0,
                                           const float slope, const float* __restrict__ cumrow, const float* __restrict__ knrow, f32x16 (&o)[4], float& l_out) {
    constexpr int DQK = VAR == 0 ? 64 : 128, NQ = DQK / 16;
    constexpr int NKL = (VAR == 0 ? 1 : 2) + (VAR == 2 ? 1 : 0), NVL = 2;
    constexpr float SCALE = VAR == 0 ? 0.125f : 0.08838834764831845f, C2 = SCALE * 1.4426950408889634f, ISC = 1.0f / SCALE;
    const int tid = opaque_tid(wv), wid = wv, lane = tid & 63, r32 = lane & 31, hi = lane >> 5;
    const int qb = P0 >> 8, qlo = P0 + wid * 32, qpos = qlo + r32;
    bf16x8 qr[NQ];
#pragma unroll
    for (int d0 = 0; d0 < NQ; ++d0) qr[d0] = *(const bf16x8*)(Qp + (unsigned)((wid * 32 + r32) * NQKV + hi * 8) + d0 * 16);
    unsigned offK, offV;
    if (VAR == 0) { const int row = wid * 8 + (lane >> 3), c = (lane & 7) ^ ((row >> 1) & 7); offK = (unsigned)(row * NQKV + c * 8); }
    else { const int row = wid * 4 + (lane >> 4), c = (lane & 15) ^ (row & 7); offK = (unsigned)(row * NQKV + c * 8); }
    { const int t = (lane & 31) >> 2, k = (wid >> 2) * 16 + (t >> 2) * 8 + ((wid >> 1) & 1) * 4 + (t & 3), c = ((wid & 1) * 2 + (lane >> 5)) * 32 + (lane & 3) * 8; offV = (unsigned)(k * NQKV + c); }
    const unsigned vb0 = (unsigned)(uintptr_t)(lds + V_OFF) + (unsigned)v_rd_base(lane);
    const unsigned kofs0 = VAR == 0 ? (unsigned)(r32 * 128) : (unsigned)(r32 * 256 + ((hi * 16) ^ ((r32 & 7) << 4)));
    const int sw64 = ((r32 >> 1) & 7) << 4;
    static_assert(VAR != 1, "the pipelined body walks plain causal tiles (MoBA uses attn_block_s)");
    const int NT = 4 * (qb + 1);
    const float sl = slope * ISC;
    constexpr float TSKIP = 110.0f;
    LAS float* tbK = (LAS float*)(lds + T_OFF);
    LAS float* tbC = tbK + 128;
    LAS unsigned* votes = (LAS unsigned*)(tbK + 256);
    if (tid < 128) { tbK[tid] = tid < NT ? knrow[tid] : 0.f; if (VAR == 2) tbC[tid] = tid < NT ? cumrow[64 * tid + 63] : 0.f; }
    float qn;
    { float s2 = 0.f;
#pragma unroll
      for (int d0 = 0; d0 < NQ; ++d0) { const v4u w = __builtin_bit_cast(v4u, qr[d0]);
          s2 += (bflo(w.x) * bflo(w.x) + bfhi(w.x) * bfhi(w.x)) + (bflo(w.y) * bflo(w.y) + bfhi(w.y) * bfhi(w.y)) + (bflo(w.z) * bflo(w.z) + bfhi(w.z) * bfhi(w.z)) + (bflo(w.w) * bflo(w.w) + bfhi(w.w) * bfhi(w.w)); }
      auto rr = __builtin_amdgcn_permlane32_swap(__float_as_uint(s2), __float_as_uint(s2), false, false);
      qn = sqrtf(__uint_as_float(rr[0]) + __uint_as_float(rr[1])) * 1.001f; }
    __syncthreads();
    if (tid < 128) { float mx = 0.f; for (int i = 0; i <= tid; ++i) mx = fmaxf(mx, tbK[i]); asm volatile("s_waitcnt lgkmcnt(0)" ::: "memory"); __builtin_amdgcn_s_barrier(); tbK[tid] = mx; }
    else { __builtin_amdgcn_s_barrier(); }
#define KBT(t_) (64 * (NT - 1 - (t_)))
#define GLDS(src, dstoff) __builtin_amdgcn_global_load_lds((const unsigned*)(src), (LAS unsigned*)(lds + (dstoff)), 16, 0, 0)
#define STAGE_K(kb, sl_) do { const bf16* kb_ = Kp + (size_t)(kb) * NQKV + offK; GLDS(kb_, K_OFF + (sl_) * 16384 + wid * 1024); if (VAR != 0) GLDS(kb_ + 32 * NQKV, K_OFF + (sl_) * 16384 + 8192 + wid * 1024); \
        if (VAR == 2) __builtin_amdgcn_global_load_lds((const unsigned*)(cumrow + (kb) + lane), (LAS unsigned*)(lds + C_OFF + (sl_) * 256), 4, 0, 0); } while (0)
#define STAGE_V(kb, sl_) do { const bf16* vb_ = Vp + (size_t)(kb) * NQKV + offV; GLDS(vb_, V_OFF + (sl_) * 16384 + wid * 1024); GLDS(vb_ + 32 * NQKV, V_OFF + (sl_) * 16384 + 8192 + wid * 1024); } while (0)
    float m_reg = -1e30f, l_reg = 0.f;
#pragma unroll
    for (int d0 = 0; d0 < 4; ++d0)
#pragma unroll
        for (int r = 0; r < 16; ++r) o[d0][r] = 0.f;
#define QKT(P0_, P1_, kbx, ks_) do { \
        if (VAR == 2) { const LAS float* cp = (const LAS float*)(lds + C_OFF + (ks_) * 256) + 4 * hi; \
            const f32x4 c0 = *(const LAS f32x4*)(cp), c1 = *(const LAS f32x4*)(cp + 8), c2 = *(const LAS f32x4*)(cp + 16), c3 = *(const LAS f32x4*)(cp + 24); \
            const f32x4 e0 = *(const LAS f32x4*)(cp + 32), e1 = *(const LAS f32x4*)(cp + 40), e2 = *(const LAS f32x4*)(cp + 48), e3 = *(const LAS f32x4*)(cp + 56); \
            P0_ = (f32x16){c0[0], c0[1], c0[2], c0[3], c1[0], c1[1], c1[2], c1[3], c2[0], c2[1], c2[2], c2[3], c3[0], c3[1], c3[2], c3[3]}; \
            P1_ = (f32x16){e0[0], e0[1], e0[2], e0[3], e1[0], e1[1], e1[2], e1[3], e2[0], e2[1], e2[2], e2[3], e3[0], e3[1], e3[2], e3[3]}; \
        } else { const float t0_ = sl * (float)((kbx) - P0 + 4 * hi); \
            _Pragma("unroll") for (int r = 0; r < 16; ++r) { P0_[r] = __builtin_fmaf(sl, (float)((r & 3) + 8 * (r >> 2)), t0_); P1_[r] = __builtin_fmaf(sl, (float)(32 + (r & 3) + 8 * (r >> 2)), t0_); } } \
        const LAS unsigned char* kt_ = lds + K_OFF + (ks_) * 16384; \
        if (VAR == 0) { const LAS unsigned char* ka = kt_ + kofs0; \
            _Pragma("unroll") for (int d0 = 0; d0 < 4; ++d0) { const int cb = ((2 * d0 + hi) * 16) ^ sw64; \
                const bf16x8 b0 = *(const LAS bf16x8*)(ka + cb), b1 = *(const LAS bf16x8*)(ka + cb + 32 * 128); \
                P0_ = __builtin_amdgcn_mfma_f32_32x32x16_bf16(b0, qr[d0], P0_, 0, 0, 0); P1_ = __builtin_amdgcn_mfma_f32_32x32x16_bf16(b1, qr[d0], P1_, 0, 0, 0); } \
        } else { \
            const unsigned kb0_ = (unsigned)(uintptr_t)kt_ + kofs0; \
            _Pragma("unroll") for (int d0 = 0; d0 < NQ; ++d0) { const LAS unsigned char* a = (const LAS unsigned char*)(uintptr_t)(kb0_ ^ (unsigned)((d0 & 3) << 5)) + (d0 >> 2) * 128; \
                const bf16x8 b0 = *(const LAS bf16x8*)(a), b1 = *(const LAS bf16x8*)(a + 32 * 256); \
                P0_ = __builtin_amdgcn_mfma_f32_32x32x16_bf16(b0, qr[d0], P0_, 0, 0, 0); P1_ = __builtin_amdgcn_mfma_f32_32x32x16_bf16(b1, qr[d0], P1_, 0, 0, 0); } } } while (0)
#define MASKX(P0_, P1_, kbx, blkx) do { const float NEG = -__builtin_inff(); \
        if ((kbx) + 63 > qlo) { const int dq = qpos - (kbx) - 4 * hi; \
            _Pragma("unroll") for (int r = 0; r < 16; ++r) { const int c = (r & 3) + 8 * (r >> 2); if (c > dq) P0_[r] = NEG; if (c + 32 > dq) P1_[r] = NEG; } } \
        } while (0)
#define PARTSM(P0_, P1_, alX) do { float pmax = P0_[0]; \
        _Pragma("unroll") for (int r = 1; r < 16; ++r) pmax = fmaxf(pmax, P0_[r]); \
        _Pragma("unroll") for (int r = 0; r < 16; ++r) pmax = fmaxf(pmax, P1_[r]); \
        { auto rr = __builtin_amdgcn_permlane32_swap(__float_as_uint(pmax), __float_as_uint(pmax), false, false); pmax = fmaxf(__uint_as_float(rr[0]), __uint_as_float(rr[1])); } \
        float mn_; \
        if (__builtin_expect(__all((pmax - m_reg) * SCALE <= THR), 1)) { mn_ = m_reg; alX = 1.f; } \
        else { mn_ = fmaxf(m_reg, pmax); alX = __builtin_amdgcn_exp2f((m_reg - mn_) * C2); m_reg = mn_; } \
        const float mnL = -mn_ * C2; \
        _Pragma("unroll") for (int r = 0; r < 16; ++r) { P0_[r] = __builtin_amdgcn_exp2f(fmaf(P0_[r], C2, mnL)); P1_[r] = fmaf(P1_[r], C2, mnL); } } while (0)
#define PK4(P, B_, OUT) do { unsigned a0 = cvtpk(P[B_ + 0], P[B_ + 1]), a1 = cvtpk(P[B_ + 2], P[B_ + 3]); unsigned b0 = cvtpk(P[B_ + 4], P[B_ + 5]), b1 = cvtpk(P[B_ + 6], P[B_ + 7]); \
        auto r0 = __builtin_amdgcn_permlane32_swap(a0, b0, false, false); auto r1 = __builtin_amdgcn_permlane32_swap(a1, b1, false, false); \
        v4u w = {r0[0], r1[0], r0[1], r1[1]}; OUT = __builtin_bit_cast(bf16x8, w); } while (0)
#define FINSM(P0_, P1_, alY) do { \
        _Pragma("unroll") for (int r = 0; r < 16; ++r) P1_[r] = __builtin_amdgcn_exp2f(P1_[r]); \
        float ps = 0.f; \
        _Pragma("unroll") for (int r = 0; r < 16; ++r) ps += P0_[r] + P1_[r]; \
        l_reg = l_reg * alY + ps; \
        PK4(P0_, 0, pa0); PK4(P0_, 8, pa1); PK4(P1_, 0, pa2); PK4(P1_, 8, pa3); } while (0)
#define TRRD(dst, off) asm volatile("ds_read_b64_tr_b16 %0, %1 offset:%2" : "=&v"(dst) : "v"(vbs_), "i"(off) : "memory")
#define PV_D0(d0) do { s16x4 l0, l1, l2, l3, h0, h1, h2, h3; constexpr int b_ = (d0) * 512; \
        TRRD(l0, b_); TRRD(h0, b_ + 2048); TRRD(l1, b_ + 4096); TRRD(h1, b_ + 6144); TRRD(l2, b_ + 8192); TRRD(h2, b_ + 10240); TRRD(l3, b_ + 12288); TRRD(h3, b_ + 14336); \
        asm volatile("s_waitcnt lgkmcnt(0)" ::: "memory"); SBAR(); \
        o[d0] = __builtin_amdgcn_mfma_f32_32x32x16_bf16((bf16x8){l0[0], l0[1], l0[2], l0[3], h0[0], h0[1], h0[2], h0[3]}, pa0, o[d0], 0, 0, 0); \
        o[d0] = __builtin_amdgcn_mfma_f32_32x32x16_bf16((bf16x8){l1[0], l1[1], l1[2], l1[3], h1[0], h1[1], h1[2], h1[3]}, pa1, o[d0], 0, 0, 0); \
        o[d0] = __builtin_amdgcn_mfma_f32_32x32x16_bf16((bf16x8){l2[0], l2[1], l2[2], l2[3], h2[0], h2[1], h2[2], h2[3]}, pa2, o[d0], 0, 0, 0); \
        o[d0] = __builtin_amdgcn_mfma_f32_32x32x16_bf16((bf16x8){l3[0], l3[1], l3[2], l3[3], h3[0], h3[1], h3[2], h3[3]}, pa3, o[d0], 0, 0, 0); } while (0)
#define PVT(vs_) do { const unsigned vbs_ = vb0 + (unsigned)(vs_) * 16384u; PV_D0(0); PV_D0(1); PV_D0(2); PV_D0(3); } while (0)
#define RESC(alX) do { if (__any((alX) < 1.f)) { \
        _Pragma("unroll") for (int d0 = 0; d0 < 4; ++d0) _Pragma("unroll") for (int r = 0; r < 16; ++r) o[d0][r] *= (alX); } } while (0)
    f32x16 pA0, pA1, pB0, pB1; float alA = 1.f, alB = 1.f; bf16x8 pa0, pa1, pa2, pa3;
    int ks = 0, vs = 2;
    STAGE_K(KBT(0), 0); STAGE_V(KBT(0), 0);
    STAGE_K(KBT(1), 1);
    ATT_VMW(NKL); ATT_BAR();
    { const int kbx = KBT(0);
      SBAR(); QKT(pA0, pA1, kbx, 0); SBAR();
      STAGE_K(KBT(2), 2); STAGE_V(KBT(1), 1);
      MASKX(pA0, pA1, kbx, 0); PARTSM(pA0, pA1, alA);
      ATT_VMW(NKL + NVL); ATT_BAR(); ks = 1; vs = 0; }
    bool stop = false; int nvotes = 0;
#define HALF_STEP(PX0, PX1, alX, PY0, PY1, alY, t, VOTE) do { \
        const int kbx = KBT(t); \
        SBAR(); QKT(PX0, PX1, kbx, ks); \
        FINSM(PY0, PY1, alY); SBAR(); \
        const bool moreK = (t) + 2 < NT, moreV = (t) + 1 < NT; \
        if (moreK) { const int ksn = ks == 0 ? 2 : ks - 1; STAGE_K(KBT((t) + 2), ksn); } \
        if (moreV) { const int vsn = vs == 0 ? 2 : vs - 1; STAGE_V(KBT((t) + 1), vsn); } \
        SBAR(); PVT(vs); \
        MASKX(PX0, PX1, kbx, 0); PARTSM(PX0, PX1, alX); \
        RESC(alX); \
          \
        if (VOTE) { if (moreV) { const int jn = NT - 2 - (t); const float bmax = VAR == 2 ? tbC[jn] : sl * (float)(64 * jn + 63 - P0); \
            const bool dn = __all((qn * tbK[jn] + bmax - m_reg) * SCALE < -TSKIP); if (lane == 0) votes[(nvotes & 1) * 8 + wid] = dn ? 1u : 0u; } } \
        if (moreK) ATT_VMW(NKL + NVL); else if (moreV) ATT_VMW(NVL); else ATT_VMW(0); \
        ATT_BAR(); ks = ks == 2 ? 0 : ks + 1; vs = vs == 2 ? 0 : vs + 1; \
        if (VOTE) { if (moreV) { const LAS unsigned* vp = votes + (nvotes & 1) * 8; const unsigned all8 = vp[0] & vp[1] & vp[2] & vp[3] & vp[4] & vp[5] & vp[6] & vp[7]; \
            stop = __builtin_amdgcn_readfirstlane(all8) != 0u; ++nvotes; } } } while (0)
    HALF_STEP(pB0, pB1, alB, pA0, pA1, alA, 1, false);
    for (int t = 2; t < NT && !stop; t += 2) {
        HALF_STEP(pA0, pA1, alA, pB0, pB1, alB, t, false);
        HALF_STEP(pB0, pB1, alB, pA0, pA1, alA, t + 1, true);
    }
    FINSM(pB0, pB1, alB); SBAR(); PVT(vs);
    ATT_VMW(0);
    { auto rr = __builtin_amdgcn_permlane32_swap(__float_as_uint(l_reg), __float_as_uint(l_reg), false, false); l_out = __uint_as_float(rr[0]) + __uint_as_float(rr[1]); }
    ATT_BAR();
#undef GLDS
#undef STAGE_K
#undef STAGE_V
#undef QKT
#undef MASKX
#undef PARTSM
#undef PK4
#undef FINSM
#undef TRRD
#undef PV_D0
#undef PVT
#undef RESC
#undef HALF_STEP
#undef KBT
}
__device__ __forceinline__ void store_block(const int wv, bf16* Op  , const f32x16 (&o)[4], float inv_l) {
    const int tid = opaque_tid(wv), wid = wv, lane = tid & 63, r32 = lane & 31, hi = lane >> 5;
    bf16* rowp = Op + (unsigned)((wid * 32 + r32) * DM + 4 * hi);
#pragma unroll
    for (int d0 = 0; d0 < 4; ++d0)
#pragma unroll
        for (int g = 0; g < 4; ++g) { v2u w; w.x = cvtpk(o[d0][4 * g] * inv_l, o[d0][4 * g + 1] * inv_l); w.y = cvtpk(o[d0][4 * g + 2] * inv_l, o[d0][4 * g + 3] * inv_l);
            *(v2u*)(rowp + 32 * d0 + 8 * g) = w; }
}
}

template <bool DO_A, bool DO_B>
__device__ __forceinline__ void attn_even_phase(ARGS_T A, const Frame& F0) {
    Frame F = F0; F.tid = opaque_tid(F0.wave); F.lane = F.tid & 63; F.wave = __builtin_amdgcn_readfirstlane(F.tid >> 6);
    const bf16* QKV = (const bf16*)(A.ws + WS_QKV); bf16* MRG = (bf16*)(A.ws + WS_MRG);
    if (DO_A) for (;;) {
        int it = 0; if (F.tid == 0) F.MISC[16] = __hip_atomic_fetch_add(F.ctl + CW_Q + 0, 1u, RLX_AGENT);
        __syncthreads(); it = __builtin_amdgcn_readfirstlane((int)F.MISC[16]); __syncthreads();
        if (it >= 512) break;
        const int bh = it & 15, qb = 31 - (it >> 4), b = bh >> 3, h = bh & 7;
        const float slope = exp2f(-(2.0f * h + 1.0f) * 0.5f);
        const float lam = *(const float*)(A.ws + WS_LAM); const float* KN = (const float*)(A.ws + WS_KN);
        float* scr = (float*)(A.ws + WS_SCR) + (size_t)blockIdx.x * 32768;
        {
            const int P0 = qb * 256;
            const bf16* rowb = QKV + (size_t)b * SEQ * NQKV;
            f32x16 o[4]; float l;
            att::attn_block<0>(F.wave, F.lds, rowb + (size_t)P0 * NQKV + h * 128, rowb + 1024 + h * 128, rowb + 2048 + h * 128, P0, slope, nullptr, KN + (size_t)(bh * 2 + 0) * 128, o, l);
            { const float il = 1.0f / l; float* sp = scr + opaque_tid(F.wave);
#pragma unroll
              for (int d0 = 0; d0 < 4; ++d0)
#pragma unroll
                  for (int r = 0; r < 16; ++r) sp[(d0 * 16 + r) * 512] = o[d0][r] * il; }
            att::attn_block<0>(F.wave, F.lds, rowb + (size_t)P0 * NQKV + h * 128 + 64, rowb + 1024 + h * 128 + 64, rowb + 2048 + h * 128, P0, slope, nullptr, KN + (size_t)(bh * 2 + 1) * 128, o, l);
            { const float il = lam / l; float ss = 0.f; const float* sp = scr + opaque_tid(F.wave);
#pragma unroll
              for (int d0 = 0; d0 < 4; ++d0)
#pragma unroll
                  for (int r = 0; r < 16; ++r) { const float v = sp[(d0 * 16 + r) * 512] - o[d0][r] * il; o[d0][r] = v; ss += v * v; }
              { auto rr = __builtin_amdgcn_permlane32_swap(__float_as_uint(ss), __float_as_uint(ss), false, false); ss = __uint_as_float(rr[0]) + __uint_as_float(rr[1]); }
              const float rs = 0.8f / sqrtf(ss * (1.0f / 128.0f) + EPS);
              const float* sg = A.in[I_SUBLN] + 4 * ((opaque_tid(F.wave) >> 5) & 1);
#pragma unroll
              for (int d0 = 0; d0 < 4; ++d0)
#pragma unroll
                  for (int g = 0; g < 4; ++g) { const f32x4 gv = *(const f32x4*)(sg + 32 * d0 + 8 * g);
#pragma unroll
                      for (int j = 0; j < 4; ++j) o[d0][4 * g + j] *= gv[j]; }
              att::store_block(F.wave, MRG + (size_t)(b * SEQ + P0) * DM + h * 128, o, rs); }
        }
    }
    if (DO_B) for (;;) {
        int it = 0; if (F.tid == 0) F.MISC[17] = __hip_atomic_fetch_add(F.ctl + CW_Q + 64, 1u, RLX_AGENT);
        __syncthreads(); it = __builtin_amdgcn_readfirstlane((int)F.MISC[17]); __syncthreads();
        if (it >= 512) break;
        const int bh = it & 15, qb = 31 - (it >> 4), b = bh >> 3, h = bh & 7;
        const float slope = exp2f(-(float)(h + 1));
        const bf16* rowb = QKV + (size_t)b * SEQ * NQKV;
        const float* KM = (const float*)(A.ws + WS_KMEAN) + (size_t)bh * 32 * 128;
        {
            const int P0 = qb * 256;
            const int tid = opaque_tid(F.wave), r32 = tid & 31;
            LAS float* km = (LAS float*)(F.lds + att::G_KM); LAS float* gt = (LAS float*)(F.lds + att::G_GT);
            LAS unsigned* sel = (LAS unsigned*)(F.lds + att::G_SEL); LAS unsigned* gor = (LAS unsigned*)(F.lds + att::G_OR);
            if (tid == 0) gor[0] = 0u;
            if (qb >= 4) {
                for (int i = tid; i < qb * 32; i += 512) *(LAS f32x4*)(km + 4 * i) = *(const f32x4*)(KM + 4 * i);
                __syncthreads();
                const int row = tid & 255, half = tid >> 8;
                float acc[16];
#pragma unroll
                for (int k = 0; k < 16; ++k) acc[k] = 0.f;
                const bf16* qrow = rowb + (size_t)(P0 + row) * NQKV + 3072 + h * 128;
#pragma unroll 1
                for (int c = 0; c < 16; ++c) { const v4u w = *(const v4u*)(qrow + 8 * c);
                    const float q0 = bflo(w.x), q1 = bfhi(w.x), q2 = bflo(w.y), q3 = bfhi(w.y), q4 = bflo(w.z), q5 = bfhi(w.z), q6 = bflo(w.w), q7 = bfhi(w.w);
#pragma unroll
                    for (int k = 0; k < 16; ++k) { const int n = 2 * k + half; if (n < qb) { const f32x4 a = *(const LAS f32x4*)(km + n * 128 + 8 * c), bq = *(const LAS f32x4*)(km + n * 128 + 8 * c + 4);
                        acc[k] += (q0 * a.x + q1 * a.y) + (q2 * a.z + q3 * a.w) + (q4 * bq.x + q5 * bq.y) + (q6 * bq.z + q7 * bq.w); } } }
#pragma unroll
                for (int k = 0; k < 16; ++k) { const int n = 2 * k + half; if (n < qb) gt[row * 33 + n] = acc[k]; }
                __syncthreads();
                if (tid < 256) { unsigned msk = 0u;
                    for (int t = 0; t < 3; ++t) { float best = -3.0e38f; int bi = 0;
                        for (int n = 0; n < qb; ++n) { const float v = gt[tid * 33 + n]; if (!((msk >> n) & 1u) && v > best) { best = v; bi = n; } }
                        msk |= 1u << bi; }
                    sel[tid] = msk; atomicOr((unsigned*)gor, msk); }
            } else { if (tid < 256) sel[tid] = (1u << qb) - 1u; if (tid == 0) gor[0] = (1u << qb) - 1u; }
            __syncthreads();
            const unsigned selrow = sel[(tid >> 6) * 32 + r32]; const unsigned wgmask = __builtin_amdgcn_readfirstlane(gor[0]) | (1u << qb);
            __syncthreads();
            f32x16 o[4]; float l;
            att::attn_block_s<1>(F.wave, F.lds, rowb + (size_t)P0 * NQKV + 3072 + h * 128, rowb + 4096 + h * 128, rowb + 5120 + h * 128, P0, slope, nullptr, selrow, wgmask, o, l);
            att::store_block(F.wave, MRG + (size_t)(b * SEQ + P0) * DM + 1024 + h * 128, o, 1.0f / l);
        }
    }
}
__device__ __forceinline__ void attn_odd_phase(ARGS_T A, const Frame& F0) {
    Frame F = F0; F.tid = opaque_tid(F0.wave); F.lane = F.tid & 63; F.wave = __builtin_amdgcn_readfirstlane(F.tid >> 6);
    const bf16* QKV = (const bf16*)(A.ws + WS_QKV); bf16* MRG = (bf16*)(A.ws + WS_MRG);
    for (;;) {
        int it = 0; if (F.tid == 0) F.MISC[18] = __hip_atomic_fetch_add(F.ctl + CW_Q + 128, 1u, RLX_AGENT);
        __syncthreads(); it = __builtin_amdgcn_readfirstlane((int)F.MISC[18]); __syncthreads();
        if (it >= 1024) break;
        const int bh = it & 31, qb = 31 - (it >> 5), b = bh >> 4, h = bh & 15;
        const bf16* rowb = QKV + (size_t)b * SEQ * NQKV;
        const float* cumrow = (const float*)(A.ws + WS_CUM) + (size_t)bh * SEQ; const float* KN = (const float*)(A.ws + WS_KN);
        {
            const int P0 = qb * 256;
            f32x16 o[4]; float l;
            att::attn_block<2>(F.wave, F.lds, rowb + (size_t)P0 * NQKV + h * 128, rowb + 2048 + h * 128, rowb + 4096 + h * 128, P0, 0.f, cumrow, KN + (size_t)bh * 128, o, l);
            att::store_block(F.wave, MRG + (size_t)(b * SEQ + P0) * DM + h * 128, o, 1.0f / l);
        }
    }
}
#ifndef REP_PRO
#define REP_PRO 1
#endif
#ifndef REP_INPROJ
#define REP_INPROJ 1
#endif
#ifndef REP_ATTA
#define REP_ATTA 1
#endif
#ifndef REP_ATTB
#define REP_ATTB 1
#endif
#ifndef REP_ATTC
#define REP_ATTC 1
#endif
#ifndef REP_MOEUP
#define REP_MOEUP 1
#endif
#ifndef REP_MOEDN
#define REP_MOEDN 1
#endif
#ifndef REP_OUTP0
#define REP_OUTP0 1
#endif
#ifndef ONE_LAUNCH
#define ONE_LAUNCH 1
#endif
constexpr int N_PHASES = 20;
__device__ __forceinline__ const __attribute__((address_space(4))) Args* opaque_args() {
    const __attribute__((address_space(4))) Args* p = (const __attribute__((address_space(4))) Args*)__builtin_amdgcn_kernarg_segment_ptr(); asm volatile("" : "+s"(p)); return p; }
#define IN(k) (lo <= (k) && (k) < hi)
#define SEAM(k) do { if (IN(k) && IN((k) + 1)) xcd_barrier(bar); } while (0)
template <int l>
__device__ __forceinline__ void layer_phases(const Frame& F, const XcdBarrier& bar, const int lo, const int hi) {
#define args (*opaque_args())
        const int pb = 1 + 9 * l;
        const float* modl = (const float*)(args.ws + WS_MOD) + (size_t)l * 2 * MODW;
        if (IN(pb + 0)) { if (l == 0) norm_phase<0>(args, F, l); else norm_phase<2>(args, F, l); SEAM(pb + 0); }
        if (IN(pb + 1)) {
            if (l == 1) { scan_phase(args, F); }
            pg8::Gemm g{(const bf16*)(args.ws + WS_H), (const bf16*)(args.ws + WS_WIN) + (size_t)l * NQKV * DM, M, NQKV, DM}; pg8::StaticOrder S; S.init(M, NQKV, F.G, (int)blockIdx.x);
            pg8::EpiBf16<0> E{(bf16*)(args.ws + WS_QKV), NQKV, nullptr, 0, 0, 1.f};
            for (int rep = 0; rep < (l == 0 ? REP_INPROJ : 1); ++rep) { pg8::gemm_phase<pg8::EpiBf16<0>, pg8::StaticOrder, PG8_ALIGN, PG8_SP2>(F.wave, F.lds + RING_OFF, g, S, E); if (rep + 1 < (l == 0 ? REP_INPROJ : 1)) xcd_barrier(bar); }
            SEAM(pb + 1);
        }
        if (IN(pb + 2)) { if (l == 0) kmean_phase(args, F); knorm_phase<l>(args, F); SEAM(pb + 2); }
        if (IN(pb + 3)) {
            if (l == 0) { for (int rep = 0; rep < REP_ATTA; ++rep) { attn_even_phase<!(NAIVE_ATTN & 1), false>(args, F); if (rep + 1 < REP_ATTA) xcd_barrier(bar); }
                          for (int rep = 0; rep < REP_ATTB; ++rep) { attn_even_phase<false, !(NAIVE_ATTN & 2)>(args, F); if (rep + 1 < REP_ATTB) xcd_barrier(bar); } }
            else { for (int rep = 0; rep < REP_ATTC; ++rep) { if (!(NAIVE_ATTN & 4)) attn_odd_phase(args, F); if (rep + 1 < REP_ATTC) xcd_barrier(bar); } }
            SEAM(pb + 3);
        }
        if (IN(pb + 4)) {
            pg8::Gemm g{(const bf16*)(args.ws + WS_MRG), (const bf16*)(args.ws + WS_WOUT) + (size_t)l * DM * DM, M, DM, DM}; pg8::StaticOrder S; S.init(M, DM, F.G, (int)blockIdx.x);
            pg8::EpiResid E{l == 0 ? args.in[I_X] : args.out, args.out, modl + 2 * DM, MODW, SEQ};
            for (int rep = 0; rep < (l == 0 ? REP_OUTP0 : 1); ++rep) { pg8::gemm_phase<pg8::EpiResid, pg8::StaticOrder, PG8_ALIGN, PG8_SP2>(F.wave, F.lds + RING_OFF, g, S, E); if (rep + 1 < (l == 0 ? REP_OUTP0 : 1)) xcd_barrier(bar); }
            SEAM(pb + 4);
        }
        if (IN(pb + 5)) { norm_phase<1>(args, F, l); SEAM(pb + 5); }
        if (IN(pb + 6)) { gather_phase(args, F, l); SEAM(pb + 6); }
        if (IN(pb + 7)) {
            pg8::Gemm g{(const bf16*)(args.ws + WS_QKV), (const bf16*)(args.ws + WS_W13) + (size_t)l * 16384 * DM, MAXROWS, 16384, DM};
            pg8::MoeOrder S; S.init((const unsigned*)(F.ctl + CW_CNT + 64 * l), 2, F.G, (int)blockIdx.x);
            pg8::EpiSwiGLU E{(bf16*)(args.ws + WS_ACT)};
            for (int rep = 0; rep < (l == 0 ? REP_MOEUP : 1); ++rep) { pg8::gemm_phase<pg8::EpiSwiGLU, pg8::MoeOrder, PG8_ALIGN, PG8_SP2>(F.wave, F.lds + RING_OFF, g, S, E); if (rep + 1 < (l == 0 ? REP_MOEUP : 1)) xcd_barrier(bar); }
            SEAM(pb + 7);
        }
        if (IN(pb + 8)) {
            pg8::Gemm g{(const bf16*)(args.ws + WS_ACT), (const bf16*)(args.ws + WS_W2) + (size_t)l * 32768 * FFE, MAXROWS, 32768, FFE};
            pg8::MoeOrder S; S.init((const unsigned*)(F.ctl + CW_CNT + 64 * l), 3, F.G, (int)blockIdx.x);
            pg8::EpiBf16<0> E{(bf16*)(args.ws + WS_OSL), DM, nullptr, DM, 0, 1.f};
            for (int rep = 0; rep < (l == 0 ? REP_MOEDN : 1); ++rep) { pg8::gemm_phase<pg8::EpiBf16<0>, pg8::MoeOrder, PG8_ALIGN, PG8_SP2>(F.wave, F.lds + RING_OFF, g, S, E); if (rep + 1 < (l == 0 ? REP_MOEDN : 1)) xcd_barrier(bar); }
            SEAM(pb + 8);
        }
}
#undef args
#undef IN
#undef SEAM
__global__ void __launch_bounds__(NWAVES * 64, 2) skel_fwd(Args args) {
    extern __shared__ __attribute__((aligned(16))) unsigned char lds[];
    Frame F;
    F.lds = (LAS unsigned char*)lds;
    F.MISC = (volatile LAS unsigned*)(F.lds + MISC_OFF);
    F.tid = threadIdx.x; F.lane = F.tid & 63; F.wave = __builtin_amdgcn_readfirstlane(F.tid >> 6);
    F.G = gridDim.x; { const int bx = blockIdx.x; F.vcu = (F.G % 8 == 0) ? (bx % 8) * (F.G / 8) + bx / 8 : bx; }
    unsigned char* ws = args.ws;
    F.ctl = (gu32*)(ws + WS_CTL);
    for (int u = F.tid; u < (LDS_BYTES - LDSCTL_OFF) / 4; u += NWAVES * 64) ((LAS unsigned*)(F.lds + LDSCTL_OFF))[u] = 0u;
    __syncthreads();
    const int lo = args.ph_lo, hi = args.ph_hi;
    XcdBarrier bar; bar.bar = (unsigned*)(F.ctl + CW_BAR); bar.x = 0; bar.st = nullptr;
    if (hi - lo > 1) bar = xcd_barrier_post((unsigned*)(F.ctl + CW_BAR), F.MISC + 8);
    bar.w = F.wave;
#define IN(k) (lo <= (k) && (k) < hi)
#define SEAM(k) do { if (IN(k) && IN((k) + 1)) xcd_barrier(bar); } while (0)

    if (IN(0)) { for (int rep = 0; rep < REP_PRO; ++rep) { p0_prologue(*opaque_args(), F); if (rep + 1 < REP_PRO) xcd_barrier(bar); } SEAM(0); }
    layer_phases<0>(F, bar, lo, hi);
    layer_phases<1>(F, bar, lo, hi);
    if (IN(19)) norm_phase<3>(*opaque_args(), F, 1);
#undef IN
#undef SEAM
}

extern "C" void kernel_launch(void* const* d_in, const int* in_sizes, int n_in, void* d_out, int out_size, void* d_ws, size_t ws_size, hipStream_t stream) {
    static int grid = 0;
    if (grid == 0) {
        if (n_in != 22 || in_sizes[0] != M * DM || out_size != M * DM || ws_size < WS_END) { fprintf(stderr, "kernel_launch: unexpected shapes (n_in %d, in0 %d, out %d, ws %zu; need ws >= %zu); nothing launched\n", n_in, n_in > 0 ? in_sizes[0] : -1, out_size, ws_size, (size_t)WS_END); grid = -1; return; }
        int dev = 0, cus = 0, per_cu = 0;
        if (hipGetDevice(&dev) != hipSuccess || hipDeviceGetAttribute(&cus, hipDeviceAttributeMultiprocessorCount, dev) != hipSuccess) { grid = -1; return; }
        if (hipFuncSetAttribute((const void*)skel_fwd, hipFuncAttributeMaxDynamicSharedMemorySize, LDS_BYTES) != hipSuccess) { fprintf(stderr, "kernel_launch: hipFuncSetAttribute failed\n"); grid = -1; return; }
        if (hipOccupancyMaxActiveBlocksPerMultiprocessor(&per_cu, (const void*)skel_fwd, NWAVES * 64, LDS_BYTES) != hipSuccess || per_cu < 1) { fprintf(stderr, "kernel_launch: occupancy query says %d blocks per CU\n", per_cu); }
        (void)hipGetLastError();
        grid = cus;
    }
    if (grid < 0) return;
    if (hipMemsetAsync((char*)d_ws + WS_CTL, 0, CTL_ZERO_BYTES, stream) != hipSuccess) return;
    Args a{};
    for (int i = 0; i < 22; ++i) a.in[i] = (const float*)d_in[i];
    a.out = (float*)d_out; a.ws = (unsigned char*)d_ws;
#if ONE_LAUNCH
    a.ph_lo = 0; a.ph_hi = N_PHASES;
    hipLaunchKernelGGL(skel_fwd, dim3(grid), dim3(NWAVES * 64), LDS_BYTES, stream, a);
#else
    unsigned char* ws = (unsigned char*)d_ws;
    for (int p = 0; p < N_PHASES; ++p) {
#if NAIVE_ATTN
        if (p == 4) {
            if (NAIVE_ATTN & 1) naive_attn<0><<<M * 8 / 4, 256, 0, stream>>>((const bf16*)(ws + WS_QKV), (bf16*)(ws + WS_MRG), nullptr, nullptr, (const float*)(ws + WS_LAM), (const float*)d_in[I_SUBLN]);
            if (NAIVE_ATTN & 2) naive_attn<1><<<M * 8 / 4, 256, 0, stream>>>((const bf16*)(ws + WS_QKV), (bf16*)(ws + WS_MRG), nullptr, (const float*)(ws + WS_KMEAN), nullptr, nullptr);
            if ((NAIVE_ATTN & 3) == 3) continue; }
        if (p == 13 && (NAIVE_ATTN & 4)) { naive_attn<2><<<M * 16 / 4, 256, 0, stream>>>((const bf16*)(ws + WS_QKV), (bf16*)(ws + WS_MRG), (const float*)(ws + WS_CUM), nullptr, nullptr, nullptr); continue; }
#endif
        a.ph_lo = p; a.ph_hi = p + 1;
        hipLaunchKernelGGL(skel_fwd, dim3(grid), dim3(NWAVES * 64), LDS_BYTES, stream, a);
    }
#endif
}
```

```cpp
#include <hip/hip_runtime.h>
#include <cstdio>
#include <cstdint>
namespace pg8 {
#define PG8_LAS __attribute__((address_space(3)))
typedef unsigned short bf16_t;
typedef short bf16x8 __attribute__((ext_vector_type(8)));
typedef float f32x4 __attribute__((ext_vector_type(4)));
typedef unsigned u32x4 __attribute__((ext_vector_type(4)));
constexpr int BM = 256, BK = 64, HALF = 128, HTB = HALF * BK * 2  , STAGE_BYTES = 8 * HTB, NXCD = 8, WGM = 8;

__host__ __device__ __forceinline__ int lds_byte(int r, int c) { const int st = (r >> 4) * 2 + (c >> 5), rr = r & 15, cc = c & 31, ob = rr * 64 + cc * 2; return st * 1024 + (ob ^ (((ob >> 9) & 1) << 5)); }
__host__ __device__ __forceinline__ void stage_rc(int b, int& R, int& C) { const int st = b / 1024, sb = b % 1024, swz = sb ^ (((sb >> 9) & 1) << 5); R = (st >> 1) * 16 + swz / 64; C = (st & 1) * 32 + (swz % 64) / 2; }
__host__ __device__ __forceinline__ int perm32(int rho) { const int n = rho >> 4, i = rho & 15; return 8 * (i >> 2) + 4 * n + (i & 3); }

struct Unit { int pm, pn; };
struct Gemm { const bf16_t* A; const bf16_t* Bt; int M, N, K; };

struct StaticOrder {
    int nM, nN, nwg, G, c;
    __host__ __device__ void init(int M, int N, int G_, int c_) { nM = M / BM; nN = N / BM; nwg = nM * nN; G = G_; c = c_; }
    __host__ __device__ bool next(int i, Unit& u) const {
        const long L = (long)i * G + c; if (L >= nwg) return false;
        int wgid = (int)L; { const int q = nwg / NXCD, r = nwg % NXCD, xcd = wgid % NXCD, off = wgid / NXCD; wgid = (xcd < r ? xcd * (q + 1) : r * (q + 1) + (xcd - r) * q) + off; }
        const int nig = WGM * nN, gid = wgid / nig, fm = gid * WGM, gsz = (nM - fm) < WGM ? (nM - fm) : WGM;
        u.pm = fm + ((wgid % nig) % gsz); u.pn = (wgid % nig) / gsz; return true;
    }
    __device__ __forceinline__ void a_ready(const Unit&) const {}
    __device__ __forceinline__ void done(const Unit&) const {}
};

__device__ __forceinline__ unsigned cvt_pk_bf16(float lo, float hi) { unsigned r; asm volatile("v_cvt_pk_bf16_f32 %0, %1, %2" : "=v"(r) : "v"(lo), "v"(hi)); return r; }
typedef float f32x2 __attribute__((ext_vector_type(2)));
__device__ __forceinline__ f32x2 gelu_pk(f32x2 v) {
    const f32x2 av = __builtin_elementwise_abs(v), d = av * 0.2316418882f + 1.0f;
    f32x2 t; t.x = __builtin_amdgcn_rcpf(d.x); t.y = __builtin_amdgcn_rcpf(d.y);
    f32x2 q = t * 0.5307027145f + (-0.7265760135f); q = q * t + 0.7107068705f; q = q * t + (-0.142248368f); q = q * t + 0.127414796f; q = q * t;
    const f32x2 s = (v * v) * (-0.72134752044f);
    f32x2 e; e.x = __builtin_amdgcn_exp2f(s.x); e.y = __builtin_amdgcn_exp2f(s.y);
    const f32x2 m = v * (q * e), r = v - m;
    f32x2 o; o.x = v.x < 0.f ? m.x : r.x; o.y = v.y < 0.f ? m.y : r.y; return o;
}

template <int ACT  > struct EpiBf16 {
    static constexpr bool PERM = true, AFTER_DRAIN = false; static_assert(ACT == 0 || ACT == 1, "EpiBf16: ACT is 0 (none) or 1 (gelu_pk)");
    bf16_t* O; int ldc; const float* bias; int split_cols; size_t split_stride; float scale0;
    __device__ __forceinline__ void operator()(const f32x4 (&acc)[2][2][4][2], const Unit& u, int wr, int wc, int fr, int fq) const {
        const int row0 = u.pm * BM + wr * 64 + fr; int colt = u.pn * BM; bf16_t* base = O;
        float sc = 1.f; if (split_cols) { const int t = colt / split_cols; base += (size_t)t * split_stride; colt -= t * split_cols; if (t == 0) sc = scale0; }
        const int col0 = colt + wc * 32 + 8 * fq, bcol0 = u.pn * BM + wc * 32 + 8 * fq;
        f32x4 bv[2][2];
#pragma unroll
        for (int bj = 0; bj < 2; ++bj)
#pragma unroll
            for (int n = 0; n < 2; ++n) bv[bj][n] = bias ? *(const f32x4*)(bias + bcol0 + bj * HALF + 4 * n) : (f32x4){0.f, 0.f, 0.f, 0.f};
#pragma unroll
        for (int ai = 0; ai < 2; ++ai)
#pragma unroll
            for (int m = 0; m < 4; ++m) { bf16_t* rowp = base + (size_t)(row0 + ai * HALF + m * 16) * ldc + col0;
#pragma unroll
                for (int bj = 0; bj < 2; ++bj) { f32x4 v0 = acc[ai][bj][m][0] + bv[bj][0], v1 = acc[ai][bj][m][1] + bv[bj][1];
                    if (ACT == 1) { f32x2 a = gelu_pk((f32x2){v0[0], v0[1]}), b = gelu_pk((f32x2){v0[2], v0[3]}), c = gelu_pk((f32x2){v1[0], v1[1]}), d = gelu_pk((f32x2){v1[2], v1[3]});
                        v0 = (f32x4){a.x, a.y, b.x, b.y}; v1 = (f32x4){c.x, c.y, d.x, d.y}; }
                    v0 = v0 * sc; v1 = v1 * sc; u32x4 w; w.x = cvt_pk_bf16(v0[0], v0[1]); w.y = cvt_pk_bf16(v0[2], v0[3]); w.z = cvt_pk_bf16(v1[0], v1[1]); w.w = cvt_pk_bf16(v1[2], v1[3]);
                    *(u32x4*)(rowp + bj * HALF) = w; } }
    }
};

struct EpiResid {
    static constexpr bool PERM = false, AFTER_DRAIN = false;
    const float* base; float* out; const float* gate; int gate_bstride; int rows_per_batch;
    __device__ __forceinline__ void operator()(const f32x4 (&acc)[2][2][4][2], const Unit& u, int wr, int wc, int fr, int fq) const {
        const int row0 = u.pm * BM + wr * 64 + fr, col0 = u.pn * BM + wc * 32 + 4 * fq;
        const float* gp = gate + (size_t)((u.pm * BM) / rows_per_batch) * gate_bstride + col0;
        f32x4 gv[2][2];
#pragma unroll
        for (int bj = 0; bj < 2; ++bj)
#pragma unroll
            for (int n = 0; n < 2; ++n) gv[bj][n] = *(const f32x4*)(gp + bj * HALF + n * 16);
#pragma unroll
        for (int ai = 0; ai < 2; ++ai)
#pragma unroll
            for (int m = 0; m < 4; ++m) { const size_t off = (size_t)(row0 + ai * HALF + m * 16) * 2048 + col0;
#pragma unroll
                for (int bj = 0; bj < 2; ++bj)
#pragma unroll
                    for (int n = 0; n < 2; ++n) { const f32x4 bs = *(const f32x4*)(base + off + bj * HALF + n * 16);
                        *(f32x4*)(out + off + bj * HALF + n * 16) = bs + gv[bj][n] * acc[ai][bj][m][n]; }
                if (m & 1) asm volatile("" ::: "memory"); }
    }
};
struct EpiSwiGLU {
    static constexpr bool PERM = true, AFTER_DRAIN = false;
    bf16_t* O;
    __device__ __forceinline__ void operator()(const f32x4 (&acc)[2][2][4][2], const Unit& u, int wr, int wc, int fr, int fq) const {
        const int row0 = u.pm * BM + wr * 64 + fr; const int f0 = (u.pn & 3) * 128 + wc * 16 + 4 * fq;
#pragma unroll
        for (int ai = 0; ai < 2; ++ai)
#pragma unroll
            for (int m = 0; m < 4; ++m) { bf16_t* rowp = O + (size_t)(row0 + ai * HALF + m * 16) * 512 + f0;
#pragma unroll
                for (int bj = 0; bj < 2; ++bj) { const f32x4 v0 = acc[ai][bj][m][0], v1 = acc[ai][bj][m][1];
                    float r[4]; const float a[4] = {v0[0], v0[2], v1[0], v1[2]}, b[4] = {v0[1], v0[3], v1[1], v1[3]};
#pragma unroll
                    for (int q = 0; q < 4; ++q) r[q] = a[q] * b[q] * __builtin_amdgcn_rcpf(1.0f + __builtin_amdgcn_exp2f(-1.4426950408889634f * a[q]));
                    typedef unsigned u32x2 __attribute__((ext_vector_type(2)));
                    u32x2 w; w.x = cvt_pk_bf16(r[0], r[1]); w.y = cvt_pk_bf16(r[2], r[3]);
                    *(u32x2*)(rowp + bj * 64) = w; } }
    }
};
struct MoeOrder {
    unsigned pk[4]; int njs, G, c;
    __device__ __forceinline__ void init(const unsigned* cnt, int njs_, int G_, int c_) {
        njs = njs_; G = G_; c = c_; unsigned t = 0; pk[0] = pk[1] = pk[2] = pk[3] = 0u;
#pragma unroll
        for (int e = 0; e < 16; ++e) { t += (__builtin_amdgcn_readfirstlane(cnt[e]) + 255u) >> 8; pk[e >> 2] |= t << (8 * (e & 3)); }
    }
    __device__ __forceinline__ bool next(int i, Unit& u) const {
        const int L = i * G + c, rt = L >> njs, j = L & ((1 << njs) - 1);
        if (rt >= (int)(pk[3] >> 24)) return false;
        int e = 0;
#pragma unroll
        for (int q = 0; q < 16; ++q) e += ((int)((pk[q >> 2] >> (8 * (q & 3))) & 255u) <= rt) ? 1 : 0;
        u.pm = rt; u.pn = (e << njs) + j; return true;
    }
    __device__ __forceinline__ void a_ready(const Unit&) const {}
    __device__ __forceinline__ void done(const Unit&) const {}
};

template <class Epi, class Sched, bool ALIGN_EPI = false, bool SP2 = false>
__device__ __forceinline__ void gemm_phase(const int wave_id  , PG8_LAS unsigned char* lds, const Gemm g, const Sched& S, const Epi& E) {
    int lid_; asm volatile("v_mbcnt_lo_u32_b32 %0, -1, 0\n\tv_mbcnt_hi_u32_b32 %0, -1, %0" : "=v"(lid_)); const int tid_ = (wave_id << 6) + lid_;
    const int tid = tid_, wid = wave_id, lane = tid & 63, wr = wid >> 2, wc = wid & 3, fr = lane & 15, fq = lane >> 4;
    const int K = g.K, nt = K / BK;
    unsigned voffA[2], voffB[2];
#pragma unroll
    for (int i = 0; i < 2; ++i) { int R, C; stage_rc(tid * 16 + i * 8192, R, C); const int Rb = Epi::PERM ? ((R & ~31) + perm32(R & 31)) : R;
        voffA[i] = (unsigned)(R * K + C) * 2u; voffB[i] = (unsigned)(Rb * K + C) * 2u; }
    const size_t kstep = (size_t)(BK * 2);
    const size_t hstep = (size_t)HALF * K * 2;
    const size_t tstep = 2 * hstep;
    const unsigned ldsw = (unsigned)wid * 1024u;
    const int aoff = lds_byte(wr * 64 + fr, fq * 8), boff = lds_byte(wc * 32 + fr, fq * 8);
#define PG8_SA(b, h) (((b) * 2 + (h)) * HTB)
#define PG8_SB(b, h) ((4 + (b) * 2 + (h)) * HTB)
#define PG8_STAGE(bufoff, gbase, voff) do { _Pragma("unroll") for (int _i = 0; _i < 2; ++_i) \
        __builtin_amdgcn_global_load_lds((const unsigned*)((const char*)(gbase) + (voff)[_i]), (PG8_LAS unsigned*)(lds + (bufoff) + ldsw + _i * 8192), 16, 0, 0); } while (0)
#define PG8_LDA(dst, b, h) do { _Pragma("unroll") for (int m = 0; m < 4; ++m) _Pragma("unroll") for (int k = 0; k < 2; ++k) dst[m][k] = *(const PG8_LAS bf16x8*)(lds + PG8_SA(b, h) + aoff + m * 2048 + k * 1024); } while (0)
#define PG8_LDB(dst, b, h) do { _Pragma("unroll") for (int n = 0; n < 2; ++n) _Pragma("unroll") for (int k = 0; k < 2; ++k) dst[n][k] = *(const PG8_LAS bf16x8*)(lds + PG8_SB(b, h) + boff + n * 2048 + k * 1024); } while (0)
#define PG8_MMA(ai, bj, At, Bt) do { __builtin_amdgcn_s_setprio(1); _Pragma("unroll") for (int m = 0; m < 4; ++m) _Pragma("unroll") for (int n = 0; n < 2; ++n) _Pragma("unroll") for (int k = 0; k < 2; ++k) \
        acc[ai][bj][m][n] = __builtin_amdgcn_mfma_f32_16x16x32_bf16(Bt[n][k], At[m][k], acc[ai][bj][m][n], 0, 0, 0); __builtin_amdgcn_s_setprio(0); } while (0)
#define PG8_WAIT_V(n) asm volatile("s_waitcnt vmcnt(" #n ")" ::: "memory")
#define PG8_WAIT_L(n) asm volatile("s_waitcnt lgkmcnt(" #n ")" ::: "memory")
#define PG8_BAR __builtin_amdgcn_s_barrier()
#define PG8_SCHED __builtin_amdgcn_sched_barrier(0)
    Unit cur, nxt; int ui = 0;
    if (!S.next(0, cur)) return;
    f32x4 acc[2][2][4][2];
#pragma unroll
    for (int a = 0; a < 2; ++a)
#pragma unroll
        for (int b = 0; b < 2; ++b)
#pragma unroll
            for (int m = 0; m < 4; ++m)
#pragma unroll
                for (int n = 0; n < 2; ++n) acc[a][b][m][n] = (f32x4){0.f, 0.f, 0.f, 0.f};
    bf16x8 At[4][2], B0[2][2], B1[2][2];
    const char* cA = (const char*)g.A + (size_t)cur.pm * tstep; const char* cB = (const char*)g.Bt + (size_t)cur.pn * tstep;
    S.a_ready(cur);
    if constexpr (SP2) {
        PG8_STAGE(PG8_SB(0, 0), cB, voffB); PG8_STAGE(PG8_SB(0, 1), cB + hstep, voffB); PG8_STAGE(PG8_SA(0, 0), cA, voffA); PG8_STAGE(PG8_SA(0, 1), cA + hstep, voffA);
        if (wr == 1) PG8_BAR;
        PG8_WAIT_V(2); PG8_BAR;
        PG8_STAGE(PG8_SB(1, 0), cB + kstep, voffB); PG8_STAGE(PG8_SA(1, 0), cA + kstep, voffA); PG8_STAGE(PG8_SB(1, 1), cB + hstep + kstep, voffB);
        PG8_WAIT_V(6); PG8_BAR;
    } else {
        PG8_STAGE(PG8_SB(0, 0), cB, voffB); PG8_STAGE(PG8_SA(0, 0), cA, voffA); PG8_STAGE(PG8_SB(0, 1), cB + hstep, voffB); PG8_STAGE(PG8_SA(0, 1), cA + hstep, voffA);
        if (wr == 1) PG8_BAR;
        PG8_WAIT_V(4); PG8_BAR;
        PG8_STAGE(PG8_SB(1, 0), cB + kstep, voffB); PG8_STAGE(PG8_SA(1, 0), cA + kstep, voffA); PG8_STAGE(PG8_SB(1, 1), cB + hstep + kstep, voffB);
        PG8_WAIT_V(6); PG8_BAR;
    }
    for (;;) {
        const bool has_next = S.next(ui + 1, nxt);
        const char* nA = has_next ? (const char*)g.A + (size_t)nxt.pm * tstep : cA; const char* nB = has_next ? (const char*)g.Bt + (size_t)nxt.pn * tstep : cB;
        for (int t = 0; t < nt; t += 2) {
            const bool last = (t == nt - 2);
            const char* a1 = cA + (size_t)(t + 1) * kstep;
            const char* a2 = last ? nA : cA + (size_t)(t + 2) * kstep; const char* b2 = last ? nB : cB + (size_t)(t + 2) * kstep;
            const char* a3 = a2 + kstep; const char* b3 = b2 + kstep;
            if (last && has_next) S.a_ready(nxt);
            if constexpr (SP2) {
            PG8_LDB(B0, 0, 0); PG8_LDB(B1, 0, 1); PG8_SCHED; PG8_LDA(At, 0, 0); PG8_STAGE(PG8_SA(1, 1), a1 + hstep, voffA);
            PG8_WAIT_V(8); PG8_WAIT_L(0); PG8_BAR; PG8_MMA(0, 0, At, B0); PG8_MMA(0, 1, At, B1); PG8_BAR; PG8_SCHED;
            PG8_LDA(At, 0, 1); PG8_STAGE(PG8_SB(0, 0), b2, voffB); PG8_STAGE(PG8_SB(0, 1), b2 + hstep, voffB); PG8_STAGE(PG8_SA(0, 0), a2, voffA);
            PG8_WAIT_V(8); PG8_WAIT_L(0); PG8_BAR; PG8_MMA(1, 0, At, B0); PG8_MMA(1, 1, At, B1); PG8_BAR; PG8_SCHED;
            PG8_LDB(B0, 1, 0); PG8_LDB(B1, 1, 1); PG8_SCHED; PG8_LDA(At, 1, 0); PG8_STAGE(PG8_SA(0, 1), a2 + hstep, voffA);
            PG8_WAIT_V(8); PG8_WAIT_L(0); PG8_BAR; PG8_MMA(0, 0, At, B0); PG8_MMA(0, 1, At, B1); PG8_BAR; PG8_SCHED;
            PG8_LDA(At, 1, 1); PG8_STAGE(PG8_SB(1, 0), b3, voffB); PG8_STAGE(PG8_SB(1, 1), b3 + hstep, voffB); PG8_STAGE(PG8_SA(1, 0), a3, voffA);
            PG8_WAIT_V(8); PG8_WAIT_L(0); PG8_BAR; PG8_MMA(1, 0, At, B0); PG8_MMA(1, 1, At, B1); PG8_BAR; PG8_SCHED;
            } else {
            PG8_LDB(B0, 0, 0); PG8_SCHED; PG8_LDA(At, 0, 0); PG8_STAGE(PG8_SA(1, 1), a1 + hstep, voffA);
            PG8_WAIT_L(8); PG8_BAR; PG8_WAIT_L(0); PG8_MMA(0, 0, At, B0); PG8_BAR; PG8_SCHED;
            PG8_LDB(B1, 0, 1); PG8_STAGE(PG8_SB(0, 0), b2, voffB);
            PG8_BAR; PG8_WAIT_L(0); PG8_MMA(0, 1, At, B1); PG8_BAR;
            PG8_LDA(At, 0, 1); PG8_STAGE(PG8_SA(0, 0), a2, voffA);
            PG8_BAR; PG8_WAIT_L(0); PG8_MMA(1, 0, At, B0); PG8_BAR; PG8_SCHED;
            PG8_STAGE(PG8_SB(0, 1), b2 + hstep, voffB);
            PG8_WAIT_V(6); PG8_BAR; PG8_MMA(1, 1, At, B1); PG8_BAR;
            PG8_LDB(B0, 1, 0); PG8_SCHED; PG8_LDA(At, 1, 0); PG8_STAGE(PG8_SA(0, 1), a2 + hstep, voffA);
            PG8_WAIT_L(8); PG8_BAR; PG8_WAIT_L(0); PG8_MMA(0, 0, At, B0); PG8_BAR; PG8_SCHED;
            PG8_LDB(B1, 1, 1); PG8_STAGE(PG8_SB(1, 0), b3, voffB);
            PG8_BAR; PG8_WAIT_L(0); PG8_MMA(0, 1, At, B1); PG8_BAR;
            PG8_LDA(At, 1, 1); PG8_STAGE(PG8_SA(1, 0), a3, voffA);
            PG8_BAR; PG8_WAIT_L(0); PG8_MMA(1, 0, At, B0); PG8_BAR; PG8_SCHED;
            PG8_STAGE(PG8_SB(1, 1), b3 + hstep, voffB);
            PG8_WAIT_V(6); PG8_BAR; PG8_MMA(1, 1, At, B1); PG8_BAR;
            }
        }
        if constexpr (ALIGN_EPI) { if (wr == 0) PG8_BAR; }
        if constexpr (!Epi::AFTER_DRAIN) { E(acc, cur, wr, wc, fr, fq); S.done(cur); }
        if (!has_next) break;
#pragma unroll
        for (int a = 0; a < 2; ++a)
#pragma unroll
            for (int b = 0; b < 2; ++b)
#pragma unroll
                for (int m = 0; m < 4; ++m)
#pragma unroll
                    for (int n = 0; n < 2; ++n) acc[a][b][m][n] = (f32x4){0.f, 0.f, 0.f, 0.f};
        cur = nxt; cA = nA; cB = nB; ++ui;
        if constexpr (ALIGN_EPI) { if (wr == 1) PG8_BAR; }
    }
    PG8_WAIT_V(0);
    if constexpr (!ALIGN_EPI) { if (wr == 0) PG8_BAR; }
    PG8_BAR;
    if constexpr (Epi::AFTER_DRAIN) { E.fused(acc, cur, wr, wc, fr, fq, lds, wid, lane); S.done(cur); }
#undef PG8_SA
#undef PG8_SB
#undef PG8_STAGE
#undef PG8_LDA
#undef PG8_LDB
#undef PG8_MMA
#undef PG8_WAIT_V
#undef PG8_WAIT_L
#undef PG8_BAR
#undef PG8_SCHED
}
}

#ifndef PG8_SP2
#define PG8_SP2 true
#endif
#ifndef PG8_ALIGN
#define PG8_ALIGN true
#endif
constexpr int NWAVES = 8;
constexpr int BATCH = 2, SEQ = 8192, DM = 2048, M = BATCH * SEQ;
constexpr int NQKV = 6144, NQKV_ODD = 6160;
constexpr int NE = 16, FFE = 512;
constexpr int MODW = 6 * DM;
constexpr float EPS = 1e-6f;
constexpr int MAXROWS = 36864;

constexpr size_t MiB = 1u << 20;
constexpr size_t WS_CTL = 0, CTL_ZERO_BYTES = 1 * MiB;
constexpr size_t WS_MOD = 1 * MiB;
constexpr size_t WS_LAM = WS_MOD + 2 * 2 * MODW * 4;
constexpr size_t WS_KMEAN = 2 * MiB;
constexpr size_t WS_WFG = 3 * MiB;
constexpr size_t WS_WRT = 3 * MiB + 128 * 1024;
constexpr size_t WS_ROUTE = 4 * MiB;
constexpr size_t WS_LOGF = 5 * MiB;
constexpr size_t WS_CUM = 6 * MiB;
constexpr size_t WS_KN = 7 * MiB;
constexpr size_t WS_OA0 = 8 * MiB;
constexpr size_t WS_MLO = 4 * MiB + 512 * 1024;
constexpr size_t WS_VM = 6 * MiB;
constexpr size_t WS_WIN = 40 * MiB;
constexpr size_t WS_WOUT = 88 * MiB;
constexpr size_t WS_W13 = 104 * MiB;
constexpr size_t WS_W2 = 232 * MiB;
constexpr size_t WS_H = 296 * MiB;
constexpr size_t WS_QKV = 360 * MiB;
constexpr size_t WS_MRG = 552 * MiB;
constexpr size_t WS_ACT = 616 * MiB;
constexpr size_t WS_OSL = 652 * MiB;
constexpr size_t WS_OA1 = WS_ACT;
constexpr size_t WS_PART = WS_OSL;
constexpr size_t WS_MLP = WS_OSL + 96 * MiB;
constexpr size_t WS_LIST = WS_OSL + 100 * MiB;
constexpr size_t WS_END = 796 * MiB;
constexpr int CW_TMO = 0;
constexpr int CW_CNT = 1024;
constexpr int CW_LC = 1536;
constexpr int CW_Q = 2048;
constexpr int CW_BAR = 4096;

constexpr int RING_OFF = 0, RING_BYTES = 131072;
constexpr int LDSCTL_OFF = RING_BYTES, MISC_OFF = LDSCTL_OFF + 320;
constexpr int LDS_BYTES = 147456;

#define GAS __attribute__((address_space(1)))
#define LAS __attribute__((address_space(3)))
typedef unsigned short bf16;
typedef unsigned v4u __attribute__((ext_vector_type(4)));
typedef unsigned v2u __attribute__((ext_vector_type(2)));
typedef float f32x4 __attribute__((ext_vector_type(4)));
typedef float f32x16 __attribute__((ext_vector_type(16)));
typedef short bf16x8 __attribute__((ext_vector_type(8)));
typedef short s16x4 __attribute__((ext_vector_type(4)));
typedef GAS unsigned gu32;
#define RLX_AGENT __ATOMIC_RELAXED, __HIP_MEMORY_SCOPE_AGENT
#define LDS_WAIT() asm volatile("s_waitcnt lgkmcnt(0)" ::: "memory")
#define VM_WAIT() asm volatile("s_waitcnt vmcnt(0)" ::: "memory")
__device__ __forceinline__ unsigned f2bf(float f) { unsigned u = __builtin_bit_cast(unsigned, f); return (u + 0x7fffu + ((u >> 16) & 1u)) >> 16; }
__device__ __forceinline__ unsigned pk2(float lo, float hi) { return f2bf(lo) | (f2bf(hi) << 16); }
__device__ __forceinline__ float bflo(unsigned w) { return __builtin_bit_cast(float, w << 16); }
__device__ __forceinline__ float bfhi(unsigned w) { return __builtin_bit_cast(float, w & 0xffff0000u); }
#define ARGS_T const __attribute__((address_space(4))) Args&
__device__ __forceinline__ int lane_id_asm() { int l; asm volatile("v_mbcnt_lo_u32_b32 %0, -1, 0\n\tv_mbcnt_hi_u32_b32 %0, -1, %0" : "=v"(l)); return l; }
__device__ __forceinline__ int opaque_tid(int wave) { return (wave << 6) + lane_id_asm(); }
__device__ __forceinline__ float wave_sum(float v) {
#pragma unroll
    for (int o = 1; o < 64; o <<= 1) v += __shfl_xor(v, o);
    return v;
}
__device__ __forceinline__ float wave_max(float v) {
#pragma unroll
    for (int o = 1; o < 64; o <<= 1) v = fmaxf(v, __shfl_xor(v, o));
    return v;
}
#define XB_TMO      128
#define XB_XCNT(j)  (256  + 64 * (j))
#define XB_XSUB(j)  (1280 + 64 * (j))
#define XB_XGEN(j)  (2304 + 64 * (j))
#define XB_TOP      3328
#define XB_TOPGEN   3392
#define XCD_BAR_WORDS 3456
#define XB_SPIN_CAP (1u << 18)

__device__ __forceinline__ unsigned xb_ld(unsigned* p)              { return __hip_atomic_load(p, __ATOMIC_RELAXED, __HIP_MEMORY_SCOPE_AGENT); }
__device__ __forceinline__ unsigned xb_add(unsigned* p, unsigned v) { return __hip_atomic_fetch_add(p, v, __ATOMIC_RELAXED, __HIP_MEMORY_SCOPE_AGENT); }
__device__ __forceinline__ unsigned xb_xcc_id() { return (unsigned)__builtin_amdgcn_s_getreg((3 << 11) | 20) & 0xFu; }
#define XB_SPIN(cond, bar) do { unsigned _sp = 0; while (cond) { __builtin_amdgcn_s_sleep(1); \
    if ((++_sp & 255u) == 0u) { if (xb_ld(&(bar)[XB_TMO])) break; if (_sp > XB_SPIN_CAP) { atomicAdd(&(bar)[XB_TMO], 1u); break; } } } } while (0)

struct XcdBarrier {
    unsigned* bar; unsigned x;
    volatile LAS unsigned* st;
    int w;
};

__device__ __forceinline__ XcdBarrier xcd_barrier_post(unsigned* bar, volatile LAS unsigned* st) {
    XcdBarrier b; b.bar = bar; b.x = xb_xcc_id(); b.st = st;
    if (threadIdx.x == 0) (void)xb_add(&bar[XB_XCNT(b.x)], 1u);
    return b;
}
__device__ __forceinline__ void xcd_barrier_complete(unsigned* bar, unsigned x, unsigned& nloc, unsigned& nx) {
    const unsigned G = gridDim.x * gridDim.y * gridDim.z;
    unsigned sum, cnt, mine, sp = 0u;
    for (;;) {
        sum = 0u; cnt = 0u; mine = 0u;
#pragma unroll
        for (unsigned j = 0; j < 16; ++j) { const unsigned c = xb_ld(&bar[XB_XCNT(j)]); sum += c; cnt += (c > 0u) ? 1u : 0u; mine = (j == x) ? c : mine; }
        if (sum == G) break;
        __builtin_amdgcn_s_sleep(1);
        if ((++sp & 255u) == 0u) { if (xb_ld(&bar[XB_TMO])) break; if (sp > XB_SPIN_CAP) { atomicAdd(&bar[XB_TMO], 1u); break; } }
    }
    nloc = mine > 0u ? mine : 1u; nx = cnt > 0u ? cnt : 1u;
}

__device__ __forceinline__ void xcd_barrier(const XcdBarrier& b) {
    asm volatile("s_waitcnt vmcnt(0)" ::: "memory");
    __syncthreads();
    if (b.w == 0 && lane_id_asm() == 0) {
        unsigned* bar = b.bar;
        __builtin_amdgcn_s_waitcnt(0);
        unsigned nloc = b.st[0], nx = b.st[1];
        if (nloc == 0u) { xcd_barrier_complete(bar, b.x, nloc, nx); b.st[0] = nloc; b.st[1] = nx; }
        const unsigned old = xb_add(&bar[XB_XSUB(b.x)], 1u);
        const unsigned gen = old / nloc;
        if (old + 1u == (gen + 1u) * nloc) {
            __builtin_amdgcn_fence(__ATOMIC_RELEASE, "agent");
            asm volatile("s_waitcnt vmcnt(0)" ::: "memory");
            const unsigned og = xb_add(&bar[XB_TOP], 1u);
            const unsigned tg = og / nx;
            if (og + 1u == (tg + 1u) * nx) xb_add(&bar[XB_TOPGEN], 1u);
            else XB_SPIN(xb_ld(&bar[XB_TOPGEN]) == tg, bar);
            __builtin_amdgcn_fence(__ATOMIC_ACQUIRE, "agent");
            xb_add(&bar[XB_XGEN(b.x)], 1u);
            asm volatile("s_waitcnt vmcnt(0)" ::: "memory");
        } else {
            XB_SPIN(xb_ld(&bar[XB_XGEN(b.x)]) == gen, bar);
            __builtin_amdgcn_fence(__ATOMIC_ACQUIRE, "agent");
            asm volatile("s_waitcnt vmcnt(0)" ::: "memory");
        }
    }
    __syncthreads();
}
struct Args { const float* in[22]; float* out; unsigned char* ws; int ph_lo, ph_hi; };
struct Frame { LAS unsigned char* lds; volatile LAS unsigned* MISC; gu32* ctl; int tid, lane, wave, vcu, G; };
enum { I_X = 0, I_C = 1, I_ADAW = 2, I_ADAB = 3, I_ANG = 4, I_FNG = 5, I_WINE = 6, I_WOUTE = 7, I_LQ1 = 8, I_LK1 = 9, I_LQ2 = 10, I_LK2 = 11, I_SUBLN = 12,
       I_WINO = 13, I_BF = 14, I_WOUTO = 15, I_RW = 16, I_RB = 17, I_W1 = 18, I_W3 = 19, I_W2 = 20, I_FING = 21 };

__device__ __forceinline__ void transpose_item(const float* W, int ldw, int K, int ncols, bf16* WT, int row_off, int rs, LAS float* scr, int item, int lane) {
    const int nblk = ncols / 32, kb = item / nblk, nb = item % nblk, k0 = 64 * kb, n0 = 32 * nb;
#pragma unroll 8
    for (int i = 0; i < 32; ++i) { const int kk = 2 * i + (lane >> 5); scr[kk * 33 + (lane & 31)] = W[(size_t)(k0 + kk) * ldw + n0 + (lane & 31)]; }
    LDS_WAIT(); asm volatile("" ::: "memory");
    const int c = lane & 7;
#pragma unroll
    for (int j = 0; j < 4; ++j) { const int n = (lane >> 3) + 8 * j; const LAS float* s = scr + (8 * c) * 33 + n;
        v4u o; o.x = pk2(s[0 * 33], s[1 * 33]); o.y = pk2(s[2 * 33], s[3 * 33]); o.z = pk2(s[4 * 33], s[5 * 33]); o.w = pk2(s[6 * 33], s[7 * 33]);
        *(GAS v4u*)(WT + (size_t)(row_off + (n0 + n) * rs) * K + k0 + 8 * c) = o; }
    LDS_WAIT(); asm volatile("" ::: "memory");
}
__device__ __forceinline__ void p0_prologue(ARGS_T A, const Frame& F0) {
    Frame F = F0; F.tid = opaque_tid(F0.wave); F.lane = F.tid & 63; F.wave = __builtin_amdgcn_readfirstlane(F.tid >> 6);
    unsigned char* ws = A.ws;
    for (int it = blockIdx.x; it < 96; it += F.G) {
        LAS float* cond = (LAS float*)(F.lds); LAS float* red = (LAS float*)(F.lds + 16384);
        for (int i = F.tid; i < 4096; i += 512) { const float cv = A.in[I_C][i]; cond[i] = cv / (1.0f + __expf(-cv)); }
        __syncthreads();
        const int l = it / 48, cg = it % 48;
        const float* W = A.in[I_ADAW] + (size_t)l * DM * MODW + cg * 256 + 4 * F.lane;
        f32x4 a0 = {0.f, 0.f, 0.f, 0.f}, a1 = {0.f, 0.f, 0.f, 0.f};
        const int kb = 256 * F.wave;
#pragma unroll 8
        for (int k = 0; k < 256; ++k) { const f32x4 w = *(const f32x4*)(W + (size_t)(kb + k) * MODW); a0 += cond[kb + k] * w; a1 += cond[2048 + kb + k] * w; }
        *(LAS f32x4*)(red + (F.wave * 2 + 0) * 256 + 4 * F.lane) = a0; *(LAS f32x4*)(red + (F.wave * 2 + 1) * 256 + 4 * F.lane) = a1;
        __syncthreads();
        { const int b = F.tid >> 8, n = F.tid & 255; float s = A.in[I_ADAB][l * MODW + cg * 256 + n];
#pragma unroll
          for (int w = 0; w < 8; ++w) s += red[(w * 2 + b) * 256 + n];
          ((float*)(ws + WS_MOD))[(l * 2 + b) * MODW + cg * 256 + n] = s; }
        __syncthreads();
    }
    if (blockIdx.x == 0 && F.tid == 0) { float s1 = 0.f, s2 = 0.f;
        for (int i = 0; i < 64; ++i) { s1 += A.in[I_LQ1][i] * A.in[I_LK1][i]; s2 += A.in[I_LQ2][i] * A.in[I_LK2][i]; }
        *(float*)(ws + WS_LAM) = __expf(s1) - __expf(s2) + 0.2f; }
    for (int i = blockIdx.x * 512 + F.tid; i < 16 * DM; i += F.G * 512) { const int j = i >> 11, k = i & 2047;
        ((float*)(ws + WS_WFG))[i] = A.in[I_WINO][(size_t)k * NQKV_ODD + NQKV + j]; ((float*)(ws + WS_WRT))[i] = A.in[I_RW][k * 16 + j]; }
    LAS float* scr = (LAS float*)(F.lds + F.wave * 16384);
    const int gw = F.vcu * NWAVES + F.wave, NGW = F.G * NWAVES;
    constexpr int I_IN = 32 * 192, I_OUT = 32 * 64, I_MOE = 32 * 512;
    for (int it = gw; it < 2 * I_IN + 2 * I_OUT + 3 * I_MOE; it += NGW) {
        int r = it;
        if (r < I_IN) { transpose_item(A.in[I_WINE], NQKV, DM, NQKV, (bf16*)(ws + WS_WIN), 0, 1, scr, r, F.lane); continue; } r -= I_IN;
        if (r < I_IN) { transpose_item(A.in[I_WINO], NQKV_ODD, DM, NQKV, (bf16*)(ws + WS_WIN) + (size_t)NQKV * DM, 0, 1, scr, r, F.lane); continue; } r -= I_IN;
        if (r < I_OUT) { transpose_item(A.in[I_WOUTE], DM, DM, DM, (bf16*)(ws + WS_WOUT), 0, 1, scr, r, F.lane); continue; } r -= I_OUT;
        if (r < I_OUT) { transpose_item(A.in[I_WOUTO], DM, DM, DM, (bf16*)(ws + WS_WOUT) + (size_t)DM * DM, 0, 1, scr, r, F.lane); continue; } r -= I_OUT;
        if (r < 2 * I_MOE) { const int which = r / I_MOE; r -= which * I_MOE; const int le = r >> 9, l = le >> 4, e = le & 15;
            transpose_item(A.in[which ? I_W3 : I_W1] + (size_t)le * DM * FFE, FFE, DM, FFE, (bf16*)(ws + WS_W13) + (size_t)l * 16384 * DM, e * 1024 + which, 2, scr, r & 511, F.lane); continue; }
        r -= 2 * I_MOE;
        { const int le = r >> 9, l = le >> 4, e = le & 15;
          transpose_item(A.in[I_W2] + (size_t)le * FFE * DM, DM, FFE, DM, (bf16*)(ws + WS_W2) + (size_t)l * 32768 * FFE, e * 2048, 1, scr, r & 511, F.lane); }
    }
}

template <int MODE>
__device__ __forceinline__ void norm_phase(ARGS_T A, const Frame& F0, int l) {
    Frame F = F0; F.tid = opaque_tid(F0.wave); F.lane = F.tid & 63; F.wave = __builtin_amdgcn_readfirstlane(F.tid >> 6);
    unsigned char* ws = A.ws;
    constexpr bool SIDE = (MODE == 1 || MODE == 2), COMB = (MODE == 2 || MODE == 3);
    LAS float* WT = (LAS float*)F.lds;
    LAS unsigned* lcnt = (LAS unsigned*)(F.lds + RING_BYTES + 1024); LAS unsigned* lbase = lcnt + 16; LAS unsigned* rinfo = lcnt + 32;
    if (MODE == 1 && F.tid < 16) lcnt[F.tid] = 0u;
    if (SIDE) { const f32x4* src = (const f32x4*)(ws + (MODE == 1 ? WS_WRT : WS_WFG));
        for (int i = F.tid; i < 16 * DM / 4; i += 512) *(LAS f32x4*)(WT + 4 * i) = src[i];
        __syncthreads(); }
    int krow = 0;
    const float* modl = (const float*)(ws + WS_MOD) + (size_t)l * 2 * MODW;
    const float* gain = MODE == 3 ? A.in[I_FING] : (MODE == 1 ? A.in[I_FNG] + l * DM : A.in[I_ANG] + l * DM);
    const int lprev = MODE == 1 ? l : (MODE == 3 ? 1 : 0);
    const float* xsrc = (MODE == 0 || lprev == 0) ? A.in[I_X] : A.out;
    const float* modprev = (const float*)(ws + WS_MOD) + (size_t)lprev * 2 * MODW;
    const bf16* Y = (const bf16*)(ws + WS_H);
    const unsigned* route = (const unsigned*)(ws + WS_ROUTE);
    const bf16* OSL = (const bf16*)(ws + WS_OSL);
    bf16* H = (bf16*)(ws + (MODE == 1 ? WS_MRG : WS_H));
    const int gw = F.vcu * NWAVES + F.wave, NGW = F.G * NWAVES, lane = F.lane;
    for (int m = gw; m < M; m += NGW) {
        const int b = m >> 13;
        f32x4 v[8];
        { const f32x4* xr = (const f32x4*)(xsrc + (size_t)m * DM) + lane;
#pragma unroll
          for (int j = 0; j < 8; ++j) v[j] = xr[64 * j]; }
        if (MODE != 0) {
            const v2u* yp = (const v2u*)(Y + (size_t)m * DM) + lane; const f32x4* g1 = (const f32x4*)(modprev + (size_t)b * MODW + 2 * DM) + lane;
#pragma unroll
            for (int j = 0; j < 8; ++j) { const v2u a = yp[64 * j]; const f32x4 g = g1[64 * j];
                v[j].x += g.x * bflo(a.x); v[j].y += g.y * bfhi(a.x); v[j].z += g.z * bflo(a.y); v[j].w += g.w * bfhi(a.y); }
        }
        if (COMB) {
            const unsigned* rt = route + (size_t)m * 6;
            const float w0 = __builtin_bit_cast(float, rt[2]), w1 = __builtin_bit_cast(float, rt[3]);
            const v2u* o0 = (const v2u*)(OSL + (size_t)rt[4] * DM) + lane; const v2u* o1 = (const v2u*)(OSL + (size_t)rt[5] * DM) + lane;
            const f32x4* g2 = (const f32x4*)(modprev + (size_t)b * MODW + 5 * DM) + lane;
#pragma unroll
            for (int j = 0; j < 8; ++j) { const v2u a = o0[64 * j], c = o1[64 * j]; const f32x4 g = g2[64 * j];
                v[j].x += g.x * (w0 * bflo(a.x) + w1 * bflo(c.x)); v[j].y += g.y * (w0 * bfhi(a.x) + w1 * bfhi(c.x));
                v[j].z += g.z * (w0 * bflo(a.y) + w1 * bflo(c.y)); v[j].w += g.w * (w0 * bfhi(a.y) + w1 * bfhi(c.y)); }
            if (MODE == 2) { f32x4* xw = (f32x4*)(A.out + (size_t)m * DM) + lane;
#pragma unroll
                for (int j = 0; j < 8; ++j) xw[64 * j] = v[j]; }
        }
        float ss = 0.f;
#pragma unroll
        for (int j = 0; j < 8; ++j) ss += (v[j].x * v[j].x + v[j].y * v[j].y) + (v[j].z * v[j].z + v[j].w * v[j].w);
        const float rstd = 1.0f / sqrtf(wave_sum(ss) * (1.0f / DM) + EPS);
        if (MODE == 3) {
            f32x4* ow = (f32x4*)(A.out + (size_t)m * DM) + lane; const f32x4* gp = (const f32x4*)gain + lane;
#pragma unroll
            for (int j = 0; j < 8; ++j) ow[64 * j] = v[j] * rstd * gp[64 * j];
            continue;
        }
        { const f32x4* gp = (const f32x4*)gain + lane;
          const f32x4* shp = (const f32x4*)(modl + (size_t)b * MODW + (MODE == 1 ? 3 : 0) * DM) + lane;
          const f32x4* scp = (const f32x4*)(modl + (size_t)b * MODW + (MODE == 1 ? 4 : 1) * DM) + lane;
          v2u* hw = (v2u*)(H + (size_t)m * DM) + lane;
#pragma unroll
          for (int j = 0; j < 8; ++j) { v[j] = v[j] * rstd * gp[64 * j] * (1.0f + scp[64 * j]) + shp[64 * j];
              v2u o; o.x = pk2(v[j].x, v[j].y); o.y = pk2(v[j].z, v[j].w); hw[64 * j] = o; } }
        if (SIDE) {
            float z = 0.f;
#pragma unroll 1
            for (int q = 0; q < 16; ++q) { float d = 0.f;
#pragma unroll
                for (int j = 0; j < 8; ++j) { const f32x4 w = *(const LAS f32x4*)(WT + q * DM + 256 * j + 4 * lane); d += (v[j].x * w.x + v[j].y * w.y) + (v[j].z * w.z + v[j].w * w.w); }
                d = wave_sum(d); if (lane == q) z = d; }
            if (MODE == 2) {
                if (lane < 16) { z += A.in[I_BF][lane]; const float r = z >= 0.f ? -log1pf(__expf(-z)) : z - log1pf(__expf(z));
                    ((float*)(ws + WS_LOGF))[(size_t)m * 16 + lane] = r; }
            } else {
                float aff[16], sel[16];
#pragma unroll
                for (int q = 0; q < 16; ++q) { const float lgq = __shfl(z, q); aff[q] = 1.0f / (1.0f + __expf(-lgq)); sel[q] = aff[q] + A.in[I_RB][q]; }
                int best = 0; float bs = -3.0e38f;
#pragma unroll
                for (int g = 0; g < 4; ++g) { const float a = sel[4 * g], bq = sel[4 * g + 1], c = sel[4 * g + 2], d = sel[4 * g + 3];
                    const float t2 = fmaxf(fmaxf(fmaxf(a + bq, a + c), fmaxf(a + d, bq + c)), fmaxf(bq + d, c + d));
                    if (t2 > bs) { bs = t2; best = g; } }
                float cs[4], ca[4];
#pragma unroll
                for (int i = 0; i < 4; ++i) { cs[i] = sel[i]; ca[i] = aff[i]; }
#pragma unroll
                for (int g = 1; g < 4; ++g) if (best == g) {
#pragma unroll
                    for (int i = 0; i < 4; ++i) { cs[i] = sel[4 * g + i]; ca[i] = aff[4 * g + i]; } }
                int i1 = 0; float s1 = cs[0], a1 = ca[0];
#pragma unroll
                for (int i = 1; i < 4; ++i) if (cs[i] > s1) { s1 = cs[i]; a1 = ca[i]; i1 = i; }
                int i2 = -1; float s2 = -3.0e38f, a2 = 0.f;
#pragma unroll
                for (int i = 0; i < 4; ++i) if (i != i1 && cs[i] > s2) { s2 = cs[i]; a2 = ca[i]; i2 = i; }
                const int e0 = best * 4 + i1, e1 = best * 4 + i2; const float inv = 1.0f / (a1 + a2);
                if (lane == 0) {
                    const unsigned p0 = __hip_atomic_fetch_add((unsigned*)(lcnt + e0), 1u, __ATOMIC_RELAXED, __HIP_MEMORY_SCOPE_WORKGROUP), p1 = __hip_atomic_fetch_add((unsigned*)(lcnt + e1), 1u, __ATOMIC_RELAXED, __HIP_MEMORY_SCOPE_WORKGROUP);
                    unsigned* rt = (unsigned*)(ws + WS_ROUTE) + (size_t)m * 6;
                    rt[0] = (unsigned)e0; rt[1] = (unsigned)e1; rt[2] = __builtin_bit_cast(unsigned, a1 * inv); rt[3] = __builtin_bit_cast(unsigned, a2 * inv);
                    LAS unsigned* ri = rinfo + (F.wave * 16 + (krow & 15)) * 4; ri[0] = (unsigned)e0; ri[1] = (unsigned)e1; ri[2] = p0; ri[3] = p1; }
                ++krow;
            }
        }
    }
    if (MODE == 1) {
        __syncthreads();
        if (F.tid < 16) lbase[F.tid] = __hip_atomic_fetch_add((unsigned*)(F.ctl + CW_CNT + 64 * l) + F.tid, lcnt[F.tid], RLX_AGENT);
        __syncthreads();
        if (F.tid < 128) { const int w = F.tid >> 4, k = F.tid & 15; const int m = (F.vcu * NWAVES + w) + k * NGW;
            if (m < M) { const LAS unsigned* ri = rinfo + (w * 16 + k) * 4; unsigned* rt = (unsigned*)(ws + WS_ROUTE) + (size_t)m * 6; rt[4] = lbase[ri[0]] + ri[2]; rt[5] = lbase[ri[1]] + ri[3]; } }
    }
}
__device__ __forceinline__ void scan_phase(ARGS_T A, const Frame& F0) {
    Frame F = F0; F.tid = opaque_tid(F0.wave); F.lane = F.tid & 63; F.wave = __builtin_amdgcn_readfirstlane(F.tid >> 6);
    const float* LOGF = (const float*)(A.ws + WS_LOGF); float* CUM = (float*)(A.ws + WS_CUM);
    LAS float* wt = (LAS float*)F.lds;
    for (int u = blockIdx.x; u < BATCH * 16; u += F.G) {
        const int b = u >> 4, h = u & 15, s0 = F.tid * 16;
        float v[16]; float run = 0.f;
#pragma unroll
        for (int i = 0; i < 16; ++i) { run += LOGF[(size_t)(b * SEQ + s0 + i) * 16 + h]; v[i] = run; }
        float inc = run;
#pragma unroll
        for (int o = 1; o < 64; o <<= 1) { const float t = __shfl_up(inc, o); if (F.lane >= o) inc += t; }
        if (F.lane == 63) wt[F.wave] = inc;
        __syncthreads();
        float base = inc - run;
        for (int w = 0; w < F.wave; ++w) base += wt[w];
        float* dst = CUM + (size_t)(b * 16 + h) * SEQ + s0;
#pragma unroll
        for (int i = 0; i < 16; ++i) dst[i] = -(base + v[i]) * 11.313708498984761f;
        __syncthreads();
    }
}
__device__ __forceinline__ void kmean_phase(ARGS_T A, const Frame& F0) {
    Frame F = F0; F.tid = opaque_tid(F0.wave); F.lane = F.tid & 63; F.wave = __builtin_amdgcn_readfirstlane(F.tid >> 6);
    const bf16* QKV = (const bf16*)(A.ws + WS_QKV); float* KM = (float*)(A.ws + WS_KMEAN);
    LAS float* red = (LAS float*)F.lds;
    for (int u = blockIdx.x; u < BATCH * 8 * 32; u += F.G) {
        const int b = u >> 8, h = (u >> 5) & 7, blk = u & 31, c = F.tid & 15, rg = F.tid >> 4;
        float s[8] = {0.f, 0.f, 0.f, 0.f, 0.f, 0.f, 0.f, 0.f};
#pragma unroll
        for (int i = 0; i < 8; ++i) { const v4u w = *(const v4u*)(QKV + (size_t)(b * SEQ + blk * 256 + rg + 32 * i) * NQKV + 4096 + h * 128 + 8 * c);
            s[0] += bflo(w.x); s[1] += bfhi(w.x); s[2] += bflo(w.y); s[3] += bfhi(w.y); s[4] += bflo(w.z); s[5] += bfhi(w.z); s[6] += bflo(w.w); s[7] += bfhi(w.w); }
#pragma unroll
        for (int i = 0; i < 8; ++i) red[rg * 128 + 8 * c + i] = s[i];
        __syncthreads();
        if (F.tid < 128) { float t = 0.f;
#pragma unroll
            for (int r = 0; r < 32; ++r) t += red[r * 128 + F.tid];
            KM[(size_t)u * 128 + F.tid] = t * (1.0f / 256.0f); }
        __syncthreads();
    }
}
__device__ __forceinline__ void gather_phase(ARGS_T A, const Frame& F0, int l) {
    Frame F = F0; F.tid = opaque_tid(F0.wave); F.lane = F.tid & 63; F.wave = __builtin_amdgcn_readfirstlane(F.tid >> 6);
    const unsigned* cnt = (const unsigned*)(F.ctl + CW_CNT + 64 * l);
    unsigned basev = 0;
    { unsigned t = 0;
#pragma unroll
      for (int e = 0; e < 16; ++e) { if (F.lane == e) basev = t * 256u; t += (cnt[e] + 255u) >> 8; } }
    unsigned* route = (unsigned*)(A.ws + WS_ROUTE); const bf16* H = (const bf16*)(A.ws + WS_MRG); bf16* HS = (bf16*)(A.ws + WS_QKV);
    const int gw = F.vcu * NWAVES + F.wave, NGW = F.G * NWAVES;
    for (int m = gw; m < M; m += NGW) {
        unsigned* rt = route + (size_t)m * 6;
        const unsigned e0 = rt[0], e1 = rt[1], p0 = rt[4], p1 = rt[5];
        const unsigned s0 = __shfl(basev, (int)e0) + p0, s1 = __shfl(basev, (int)e1) + p1;
        const v4u* src = (const v4u*)(H + (size_t)m * DM) + F.lane; v4u* d0 = (v4u*)(HS + (size_t)s0 * DM) + F.lane; v4u* d1 = (v4u*)(HS + (size_t)s1 * DM) + F.lane;
        v4u x[4];
#pragma unroll
        for (int j = 0; j < 4; ++j) x[j] = src[64 * j];
#pragma unroll
        for (int j = 0; j < 4; ++j) { d0[64 * j] = x[j]; d1[64 * j] = x[j]; }
        asm volatile("" ::: "memory");
        if (F.lane == 0) { rt[4] = s0; rt[5] = s1; }
    }
}
template <int L>
__device__ __forceinline__ void knorm_phase(ARGS_T A, const Frame& F0) {
    Frame F = F0; F.tid = opaque_tid(F0.wave); F.lane = F.tid & 63; F.wave = __builtin_amdgcn_readfirstlane(F.tid >> 6);
    const bf16* QKV = (const bf16*)(A.ws + WS_QKV); float* KN = (float*)(A.ws + WS_KN);
    constexpr int DQ = L == 0 ? 64 : 128;
    for (int it = blockIdx.x; it < (L == 0 ? 384 : 256); it += F.G) {
        const int u = it >> 3, tg = it & 7;
        int b, col, nch = DQ / 8;
        if (L == 0) { if (u < 32) { b = u >> 4; col = 1024 + ((u >> 1) & 7) * 128 + (u & 1) * 64; } else { b = (u - 32) >> 3; col = 4096 + ((u - 32) & 7) * 128; nch = 16; } }
        else { b = u >> 4; col = 2048 + (u & 15) * 128; }
        float mx = 0.f;
#pragma unroll
        for (int kk = 0; kk < 2; ++kk) { const bf16* kr = QKV + (size_t)(b * SEQ + tg * 1024 + 2 * F.tid + kk) * NQKV + col; float s2 = 0.f;
#pragma unroll 8
            for (int c = 0; c < nch; ++c) { const v4u w = *(const v4u*)(kr + 8 * c);
                s2 += (bflo(w.x) * bflo(w.x) + bfhi(w.x) * bfhi(w.x)) + (bflo(w.y) * bflo(w.y) + bfhi(w.y) * bfhi(w.y)) + (bflo(w.z) * bflo(w.z) + bfhi(w.z) * bfhi(w.z)) + (bflo(w.w) * bflo(w.w) + bfhi(w.w) * bfhi(w.w)); }
            mx = fmaxf(mx, s2); }
#pragma unroll
        for (int o = 1; o < 32; o <<= 1) mx = fmaxf(mx, __shfl_xor(mx, o));
        if ((F.tid & 31) == 0) KN[(size_t)u * 128 + tg * 16 + (F.tid >> 5)] = sqrtf(mx) * 1.001f;
    }
}
#ifndef NAIVE_ATTN
#define NAIVE_ATTN 0
#endif
#if NAIVE_ATTN
template <int DQ>
__device__ __forceinline__ void naive_span(const bf16* Kp, const bf16* Vp, const LAS float* q, int kb, int ke, int pos, float scale, float slope, const float* CUMrow, float cq,
                                           float& mrun, float& lrun, float& o0, float& o1, int lane) {
    for (int kc = kb; kc < ke; kc += 64) {
        const int key = kc + lane;
        float s = 0.f;
        { const bf16* kr = Kp + (size_t)key * NQKV;
#pragma unroll
          for (int c = 0; c < DQ / 8; ++c) { const v4u w = *(const v4u*)(kr + 8 * c); const f32x4 qa = *(const LAS f32x4*)(q + 8 * c), qb = *(const LAS f32x4*)(q + 8 * c + 4);
              s += (qa.x * bflo(w.x) + qa.y * bfhi(w.x)) + (qa.z * bflo(w.y) + qa.w * bfhi(w.y)) + (qb.x * bflo(w.z) + qb.y * bfhi(w.z)) + (qb.z * bflo(w.w) + qb.w * bfhi(w.w)); } }
        s = s * scale + (CUMrow ? (CUMrow[key] - cq) * scale : slope * (float)(key - pos));
        if (key > pos || key >= ke) s = -__builtin_inff();
        const float cm = wave_max(s);
        if (cm == -__builtin_inff()) continue;
        const float mn = fmaxf(mrun, cm), al = __expf(mrun - mn), p = __expf(s - mn);
        lrun = lrun * al + wave_sum(p); o0 *= al; o1 *= al; mrun = mn;
        for (int j = 0; j < 64; ++j) { const float pj = __shfl(p, j); const unsigned vv = *(const unsigned*)(Vp + (size_t)(kc + j) * NQKV + 2 * lane); o0 += pj * bflo(vv); o1 += pj * bfhi(vv); }
    }
}
template <int VAR>
__global__ void __launch_bounds__(256) naive_attn(const bf16* __restrict__ QKV, bf16* __restrict__ MRG, const float* __restrict__ CUM, const float* __restrict__ KMEAN,
                                                  const float* __restrict__ lamp, const float* __restrict__ subg) {
    __shared__ float qs[4][128];
    constexpr int NH = VAR == 2 ? 16 : 8;
    const int wave = threadIdx.x >> 6, lane = threadIdx.x & 63;
    const long id = (long)blockIdx.x * 4 + wave; const int m = (int)(id / NH), hh = (int)(id % NH), b = m >> 13, pos = m & 8191;
    const bf16* row = QKV + (size_t)m * NQKV; const bf16* base = QKV + (size_t)b * SEQ * NQKV;
    LAS float* q = (LAS float*)qs[wave];
    if (VAR == 0) {
        const float slope = exp2f(-(2.0f * hh + 1.0f) * 0.5f);
        float O0[2], O1[2];
#pragma unroll
        for (int mp = 0; mp < 2; ++mp) {
            q[lane] = bflo((unsigned)row[hh * 128 + mp * 64 + lane]); __builtin_amdgcn_wave_barrier(); LDS_WAIT();
            float mr = -1e30f, lr = 0.f, o0 = 0.f, o1 = 0.f;
            naive_span<64>(base + 1024 + hh * 128 + mp * 64, base + 2048 + hh * 128, q, 0, pos + 1, pos, 0.125f, slope, nullptr, 0.f, mr, lr, o0, o1, lane);
            O0[mp] = o0 / lr; O1[mp] = o1 / lr; __builtin_amdgcn_wave_barrier();
        }
        const float lam = *lamp; const float a0 = O0[0] - lam * O0[1], a1 = O1[0] - lam * O1[1];
        const float r = 1.0f / sqrtf(wave_sum(a0 * a0 + a1 * a1) * (1.0f / 128.0f) + EPS);
        *(unsigned*)(MRG + (size_t)m * DM + hh * 128 + 2 * lane) = pk2(a0 * r * subg[2 * lane] * 0.8f, a1 * r * subg[2 * lane + 1] * 0.8f);
    } else if (VAR == 1) {
        const float slope = exp2f(-(float)(hh + 1));
        q[lane] = bflo((unsigned)row[3072 + hh * 128 + lane]); q[64 + lane] = bflo((unsigned)row[3072 + hh * 128 + 64 + lane]); __builtin_amdgcn_wave_barrier(); LDS_WAIT();
        const int own = pos >> 8;
        float g = -3.0e38f;
        if (lane < own) { const float* km = KMEAN + ((size_t)(b * 8 + hh) * 32 + lane) * 128; float s = 0.f;
            for (int d = 0; d < 128; ++d) s += q[d] * km[d]; g = s; }
        unsigned long long selm = 0ull;
        for (int t = 0; t < 3 && t < own; ++t) { const float mx = wave_max(g); const unsigned long long bal = __ballot(g == mx); const int pick = __ffsll((long long)bal) - 1;
            selm |= 1ull << pick; if (lane == pick) g = -3.0e38f; }
        float mr = -1e30f, lr = 0.f, o0 = 0.f, o1 = 0.f;
        for (int n = 0; n < own; ++n) if ((selm >> n) & 1ull)
            naive_span<128>(base + 4096 + hh * 128, base + 5120 + hh * 128, q, n * 256, n * 256 + 256, pos, 0.08838834764831845f, slope, nullptr, 0.f, mr, lr, o0, o1, lane);
        naive_span<128>(base + 4096 + hh * 128, base + 5120 + hh * 128, q, own * 256, pos + 1, pos, 0.08838834764831845f, slope, nullptr, 0.f, mr, lr, o0, o1, lane);
        *(unsigned*)(MRG + (size_t)m * DM + 1024 + hh * 128 + 2 * lane) = pk2(o0 / lr, o1 / lr);
    } else {
        q[lane] = bflo((unsigned)row[hh * 128 + lane]); q[64 + lane] = bflo((unsigned)row[hh * 128 + 64 + lane]); __builtin_amdgcn_wave_barrier(); LDS_WAIT();
        const float* cr = CUM + (size_t)(b * 16 + hh) * SEQ;
        float mr = -1e30f, lr = 0.f, o0 = 0.f, o1 = 0.f;
        naive_span<128>(base + 2048 + hh * 128, base + 4096 + hh * 128, q, 0, pos + 1, pos, 0.08838834764831845f, 0.f, cr, cr[pos], mr, lr, o0, o1, lane);
        *(unsigned*)(MRG + (size_t)m * DM + hh * 128 + 2 * lane) = pk2(o0 / lr, o1 / lr);
    }
}
#endif
namespace att {
constexpr int V_OFF = 0, K_OFF = 49152, C_OFF = 98304, T_OFF = 99328  , G_KM = 0, G_GT = G_KM + 16384, G_SEL = G_GT + 256 * 33 * 4, G_OR = G_SEL + 1024, ATT_LDS = G_OR + 16;
static_assert(ATT_LDS <= RING_BYTES, "attention LDS");
constexpr float THR = 8.f;
#define SBAR() __builtin_amdgcn_sched_barrier(0)
__device__ __forceinline__ int v_st(int k, int c) { const int kk = (k & ~0xC) | ((k & 4) << 1) | ((k & 8) >> 1); return ((kk >> 3) * 4 + (c >> 5)) * 512 + ((kk & 7) * 32 + (c & 31)) * 2; }
__device__ __forceinline__ int v_rd_base(int lane) { return ((lane & 3) << 3) | (((lane >> 2) & 3) << 6) | (((lane >> 4) & 1) << 5) | (((lane >> 5) & 1) << 8); }
__device__ __forceinline__ unsigned cvtpk(float lo, float hi) { unsigned r; asm volatile("v_cvt_pk_bf16_f32 %0, %1, %2" : "=v"(r) : "v"(lo), "v"(hi)); return r; }

struct TileIt { unsigned rem; int blk, sub; };
template <int VAR> __device__ __forceinline__ void ti_init(TileIt& it, unsigned mask) { it.rem = mask; it.sub = 0; it.blk = VAR == 1 ? __builtin_ctz(mask) : 0; }
template <int VAR> __device__ __forceinline__ int ti_kb(const TileIt& it) { return VAR == 1 ? it.blk * 256 + it.sub * 64 : it.sub * 64; }
template <int VAR> __device__ __forceinline__ void ti_adv(TileIt& it) { if (VAR == 1) { if (++it.sub == 4) { it.sub = 0; it.rem &= it.rem - 1u; it.blk = it.rem ? __builtin_ctz(it.rem) : 0; } } else ++it.sub; }
#define ATT_VMW(n) asm volatile("s_waitcnt vmcnt(%0)" :: "i"(n) : "memory")
#define ATT_BAR() do { asm volatile("s_waitcnt lgkmcnt(0)" ::: "memory"); __builtin_amdgcn_s_barrier(); asm volatile("" ::: "memory"); } while (0)
template <int VAR>
__device__ __forceinline__ void attn_block(const int wv, LAS unsigned char* lds, const bf16* __restrict__ Qp, const bf16* __restrict__ Kp, const bf16* __restrict__ Vp, const int P0,
                                           const float slope, const float* __restrict__ cumrow, const float* __restrict__ knrow, f32x16 (&o)[4], float& l_out) {
    constexpr int DQK = VAR == 0 ? 64 : 128, NQ = DQK / 16;
    constexpr int NKL = (VAR == 0 ? 1 : 2) + (VAR == 2 ? 1 : 0), NVL = 2;
    constexpr float SCALE = VAR == 0 ? 0.125f : 0.08838834764831845f, C2 = SCALE * 1.4426950408889634f, ISC = 1.0f / SCALE;
    const int tid = opaque_tid(wv), wid = wv, lane = tid & 63, r32 = lane & 31, hi = lane >> 5;
    const int qb = P0 >> 8, qlo = P0 + wid * 32, qpos = qlo + r32;
    bf16x8 qr[NQ];
#pragma unroll
    for (int d0 = 0; d0 < NQ; ++d0) qr[d0] = *(const bf16x8*)(Qp + (unsigned)((wid * 32 + r32) * NQKV + hi * 8) + d0 * 16);
    unsigned offK, offV;
    if (VAR == 0) { const int row = wid * 8 + (lane >> 3), c = (lane & 7) ^ ((row >> 1) & 7); offK = (unsigned)(row * NQKV + c * 8); }
    else { const int row = wid * 4 + (lane >> 4), c = (lane & 15) ^ (row & 7); offK = (unsigned)(row * NQKV + c * 8); }
    { const int t = (lane & 31) >> 2, k = (wid >> 2) * 16 + (t >> 2) * 8 + ((wid >> 1) & 1) * 4 + (t & 3), c = ((wid & 1) * 2 + (lane >> 5)) * 32 + (lane & 3) * 8; offV = (unsigned)(k * NQKV + c); }
    const unsigned vb0 = (unsigned)(uintptr_t)(lds + V_OFF) + (unsigned)v_rd_base(lane);
    const unsigned kofs0 = VAR == 0 ? (unsigned)(r32 * 128) : (unsigned)(r32 * 256 + ((hi * 16) ^ ((r32 & 7) << 4)));
    const int sw64 = ((r32 >> 1) & 7) << 4;
    static_assert(VAR != 1, "the pipelined body walks plain causal tiles (MoBA uses attn_block_s)");
    const int NT = 4 * (qb + 1);
    const float sl = slope * ISC;
    constexpr float TSKIP = 110.0f;
    LAS float* tbK = (LAS float*)(lds + T_OFF);
    LAS float* tbC = tbK + 128;
    LAS unsigned* votes = (LAS unsigned*)(tbK + 256);
    if (tid < 128) { tbK[tid] = tid < NT ? knrow[tid] : 0.f; if (VAR == 2) tbC[tid] = tid < NT ? cumrow[64 * tid + 63] : 0.f; }
    float qn;
    { float s2 = 0.f;
#pragma unroll
      for (int d0 = 0; d0 < NQ; ++d0) { const v4u w = __builtin_bit_cast(v4u, qr[d0]);
          s2 += (bflo(w.x) * bflo(w.x) + bfhi(w.x) * bfhi(w.x)) + (bflo(w.y) * bflo(w.y) + bfhi(w.y) * bfhi(w.y)) + (bflo(w.z) * bflo(w.z) + bfhi(w.z) * bfhi(w.z)) + (bflo(w.w) * bflo(w.w) + bfhi(w.w) * bfhi(w.w)); }
      auto rr = __builtin_amdgcn_permlane32_swap(__float_as_uint(s2), __float_as_uint(s2), false, false);
      qn = sqrtf(__uint_as_float(rr[0]) + __uint_as_float(rr[1])) * 1.001f; }
    __syncthreads();
    if (tid < 128) { float mx = 0.f; for (int i = 0; i <= tid; ++i) mx = fmaxf(mx, tbK[i]); asm volatile("s_waitcnt lgkmcnt(0)" ::: "memory"); __builtin_amdgcn_s_barrier(); tbK[tid] = mx; }
    else { __builtin_amdgcn_s_barrier(); }
#define KBT(t_) (64 * (NT - 1 - (t_)))
#define GLDS(src, dstoff) __builtin_amdgcn_global_load_lds((const unsigned*)(src), (LAS unsigned*)(lds + (dstoff)), 16, 0, 0)
#define STAGE_K(kb, sl_) do { const bf16* kb_ = Kp + (size_t)(kb) * NQKV + offK; GLDS(kb_, K_OFF + (sl_) * 16384 + wid * 1024); if (VAR != 0) GLDS(kb_ + 32 * NQKV, K_OFF + (sl_) * 16384 + 8192 + wid * 1024); \
        if (VAR == 2) __builtin_amdgcn_global_load_lds((const unsigned*)(cumrow + (kb) + lane), (LAS unsigned*)(lds + C_OFF + (sl_) * 256), 4, 0, 0); } while (0)
#define STAGE_V(kb, sl_) do { const bf16* vb_ = Vp + (size_t)(kb) * NQKV + offV; GLDS(vb_, V_OFF + (sl_) * 16384 + wid * 1024); GLDS(vb_ + 32 * NQKV, V_OFF + (sl_) * 16384 + 8192 + wid * 1024); } while (0)
    float m_reg = -1e30f, l_reg = 0.f;
#pragma unroll
    for (int d0 = 0; d0 < 4; ++d0)
#pragma unroll
        for (int r = 0; r < 16; ++r) o[d0][r] = 0.f;
#define QKT(P0_, P1_, kbx, ks_) do { \
        if (VAR == 2) { const LAS float* cp = (const LAS float*)(lds + C_OFF + (ks_) * 256) + 4 * hi; \
            const f32x4 c0 = *(const LAS f32x4*)(cp), c1 = *(const LAS f32x4*)(cp + 8), c2 = *(const LAS f32x4*)(cp + 16), c3 = *(const LAS f32x4*)(cp + 24); \
            const f32x4 e0 = *(const LAS f32x4*)(cp + 32), e1 = *(const LAS f32x4*)(cp + 40), e2 = *(const LAS f32x4*)(cp + 48), e3 = *(const LAS f32x4*)(cp + 56); \
            P0_ = (f32x16){c0[0], c0[1], c0[2], c0[3], c1[0], c1[1], c1[2], c1[3], c2[0], c2[1], c2[2], c2[3], c3[0], c3[1], c3[2], c3[3]}; \
            P1_ = (f32x16){e0[0], e0[1], e0[2], e0[3], e1[0], e1[1], e1[2], e1[3], e2[0], e2[1], e2[2], e2[3], e3[0], e3[1], e3[2], e3[3]}; \
        } else { const float t0_ = sl * (float)((kbx) - P0 + 4 * hi); \
            _Pragma("unroll") for (int r = 0; r < 16; ++r) { P0_[r] = __builtin_fmaf(sl, (float)((r & 3) + 8 * (r >> 2)), t0_); P1_[r] = __builtin_fmaf(sl, (float)(32 + (r & 3) + 8 * (r >> 2)), t0_); } } \
        const LAS unsigned char* kt_ = lds + K_OFF + (ks_) * 16384; \
        if (VAR == 0) { const LAS unsigned char* ka = kt_ + kofs0; \
            _Pragma("unroll") for (int d0 = 0; d0 < 4; ++d0) { const int cb = ((2 * d0 + hi) * 16) ^ sw64; \
                const bf16x8 b0 = *(const LAS bf16x8*)(ka + cb), b1 = *(const LAS bf16x8*)(ka + cb + 32 * 128); \
                P0_ = __builtin_amdgcn_mfma_f32_32x32x16_bf16(b0, qr[d0], P0_, 0, 0, 0); P1_ = __builtin_amdgcn_mfma_f32_32x32x16_bf16(b1, qr[d0], P1_, 0, 0, 0); } \
        } else { \
            const unsigned kb0_ = (unsigned)(uintptr_t)kt_ + kofs0; \
            _Pragma("unroll") for (int d0 = 0; d0 < NQ; ++d0) { const LAS unsigned char* a = (const LAS unsigned char*)(uintptr_t)(kb0_ ^ (unsigned)((d0 & 3) << 5)) + (d0 >> 2) * 128; \
                const bf16x8 b0 = *(const LAS bf16x8*)(a), b1 = *(const LAS bf16x8*)(a + 32 * 256); \
                P0_ = __builtin_amdgcn_mfma_f32_32x32x16_bf16(b0, qr[d0], P0_, 0, 0, 0); P1_ = __builtin_amdgcn_mfma_f32_32x32x16_bf16(b1, qr[d0], P1_, 0, 0, 0); } } } while (0)
#define MASKX(P0_, P1_, kbx, blkx) do { const float NEG = -__builtin_inff(); \
        if ((kbx) + 63 > qlo) { const int dq = qpos - (kbx) - 4 * hi; \
            _Pragma("unroll") for (int r = 0; r < 16; ++r) { const int c = (r & 3) + 8 * (r >> 2); if (c > dq) P0_[r] = NEG; if (c + 32 > dq) P1_[r] = NEG; } } \
        } while (0)
#define PARTSM(P0_, P1_, alX) do { float pmax = P0_[0]; \
        _Pragma("unroll") for (int r = 1; r < 16; ++r) pmax = fmaxf(pmax, P0_[r]); \
        _Pragma("unroll") for (int r = 0; r < 16; ++r) pmax = fmaxf(pmax, P1_[r]); \
        { auto rr = __builtin_amdgcn_permlane32_swap(__float_as_uint(pmax), __float_as_uint(pmax), false, false); pmax = fmaxf(__uint_as_float(rr[0]), __uint_as_float(rr[1])); } \
        float mn_; \
        if (__builtin_expect(__all((pmax - m_reg) * SCALE <= THR), 1)) { mn_ = m_reg; alX = 1.f; } \
        else { mn_ = fmaxf(m_reg, pmax); alX = __builtin_amdgcn_exp2f((m_reg - mn_) * C2); m_reg = mn_; } \
        const float mnL = -mn_ * C2; \
        _Pragma("unroll") for (int r = 0; r < 16; ++r) { P0_[r] = __builtin_amdgcn_exp2f(fmaf(P0_[r], C2, mnL)); P1_[r] = fmaf(P1_[r], C2, mnL); } } while (0)
#define PK4(P, B_, OUT) do { unsigned a0 = cvtpk(P[B_ + 0], P[B_ + 1]), a1 = cvtpk(P[B_ + 2], P[B_ + 3]); unsigned b0 = cvtpk(P[B_ + 4], P[B_ + 5]), b1 = cvtpk(P[B_ + 6], P[B_ + 7]); \
        auto r0 = __builtin_amdgcn_permlane32_swap(a0, b0, false, false); auto r1 = __builtin_amdgcn_permlane32_swap(a1, b1, false, false); \
        v4u w = {r0[0], r1[0], r0[1], r1[1]}; OUT = __builtin_bit_cast(bf16x8, w); } while (0)
#define FINSM(P0_, P1_, alY) do { \
        _Pragma("unroll") for (int r = 0; r < 16; ++r) P1_[r] = __builtin_amdgcn_exp2f(P1_[r]); \
        float ps = 0.f; \
        _Pragma("unroll") for (int r = 0; r < 16; ++r) ps += P0_[r] + P1_[r]; \
        l_reg = l_reg * alY + ps; \
        PK4(P0_, 0, pa0); PK4(P0_, 8, pa1); PK4(P1_, 0, pa2); PK4(P1_, 8, pa3); } while (0)
#define TRRD(dst, off) asm volatile("ds_read_b64_tr_b16 %0, %1 offset:%2" : "=&v"(dst) : "v"(vbs_), "i"(off) : "memory")
#define PV_D0(d0) do { s16x4 l0, l1, l2, l3, h0, h1, h2, h3; constexpr int b_ = (d0) * 512; \
        TRRD(l0, b_); TRRD(h0, b_ + 2048); TRRD(l1, b_ + 4096); TRRD(h1, b_ + 6144); TRRD(l2, b_ + 8192); TRRD(h2, b_ + 10240); TRRD(l3, b_ + 12288); TRRD(h3, b_ + 14336); \
        asm volatile("s_waitcnt lgkmcnt(0)" ::: "memory"); SBAR(); \
        o[d0] = __builtin_amdgcn_mfma_f32_32x32x16_bf16((bf16x8){l0[0], l0[1], l0[2], l0[3], h0[0], h0[1], h0[2], h0[3]}, pa0, o[d0], 0, 0, 0); \
        o[d0] = __builtin_amdgcn_mfma_f32_32x32x16_bf16((bf16x8){l1[0], l1[1], l1[2], l1[3], h1[0], h1[1], h1[2], h1[3]}, pa1, o[d0], 0, 0, 0); \
        o[d0] = __builtin_amdgcn_mfma_f32_32x32x16_bf16((bf16x8){l2[0], l2[1], l2[2], l2[3], h2[0], h2[1], h2[2], h2[3]}, pa2, o[d0], 0, 0, 0); \
        o[d0] = __builtin_amdgcn_mfma_f32_32x32x16_bf16((bf16x8){l3[0], l3[1], l3[2], l3[3], h3[0], h3[1], h3[2], h3[3]}, pa3, o[d0], 0, 0, 0); } while (0)
#define PVT(vs_) do { const unsigned vbs_ = vb0 + (unsigned)(vs_) * 16384u; PV_D0(0); PV_D0(1); PV_D0(2); PV_D0(3); } while (0)
#define RESC(alX) do { if (__any((alX) < 1.f)) { \
        _Pragma("unroll") for (int d0 = 0; d0 < 4; ++d0) _Pragma("unroll") for (int r = 0; r < 16; ++r) o[d0][r] *= (alX); } } while (0)
    f32x16 pA0, pA1, pB0, pB1; float alA = 1.f, alB = 1.f; bf16x8 pa0, pa1, pa2, pa3;
    int ks = 0, vs = 2;
    STAGE_K(KBT(0), 0); STAGE_V(KBT(0), 0);
    STAGE_K(KBT(1), 1);
    ATT_VMW(NKL); ATT_BAR();
    { const int kbx = KBT(0);
      SBAR(); QKT(pA0, pA1, kbx, 0); SBAR();
      STAGE_K(KBT(2), 2); STAGE_V(KBT(1), 1);
      MASKX(pA0, pA1, kbx, 0); PARTSM(pA0, pA1, alA);
      ATT_VMW(NKL + NVL); ATT_BAR(); ks = 1; vs = 0; }
    bool stop = false; int nvotes = 0;
#define HALF_STEP(PX0, PX1, alX, PY0, PY1, alY, t, VOTE) do { \
        const int kbx = KBT(t); \
        SBAR(); QKT(PX0, PX1, kbx, ks); \
        FINSM(PY0, PY1, alY); SBAR(); \
        const bool moreK = (t) + 2 < NT, moreV = (t) + 1 < NT; \
        if (moreK) { const int ksn = ks == 0 ? 2 : ks - 1; STAGE_K(KBT((t) + 2), ksn); } \
        if (moreV) { const int vsn = vs == 0 ? 2 : vs - 1; STAGE_V(KBT((t) + 1), vsn); } \
        SBAR(); PVT(vs); \
        MASKX(PX0, PX1, kbx, 0); PARTSM(PX0, PX1, alX); \
        RESC(alX); \
          \
        if (VOTE) { if (moreV) { const int jn = NT - 2 - (t); const float bmax = VAR == 2 ? tbC[jn] : sl * (float)(64 * jn + 63 - P0); \
            const bool dn = __all((qn * tbK[jn] + bmax - m_reg) * SCALE < -TSKIP); if (lane == 0) votes[(nvotes & 1) * 8 + wid] = dn ? 1u : 0u; } } \
        if (moreK) ATT_VMW(NKL + NVL); else if (moreV) ATT_VMW(NVL); else ATT_VMW(0); \
        ATT_BAR(); ks = ks == 2 ? 0 : ks + 1; vs = vs == 2 ? 0 : vs + 1; \
        if (VOTE) { if (moreV) { const LAS unsigned* vp = votes + (nvotes & 1) * 8; const unsigned all8 = vp[0] & vp[1] & vp[2] & vp[3] & vp[4] & vp[5] & vp[6] & vp[7]; \
            stop = __builtin_amdgcn_readfirstlane(all8) != 0u; ++nvotes; } } } while (0)
    HALF_STEP(pB0, pB1, alB, pA0, pA1, alA, 1, false);
    for (int t = 2; t < NT && !stop; t += 2) {
        HALF_STEP(pA0, pA1, alA, pB0, pB1, alB, t, false);
        HALF_STEP(pB0, pB1, alB, pA0, pA1, alA, t + 1, true);
    }
    FINSM(pB0, pB1, alB); SBAR(); PVT(vs);
    ATT_VMW(0);
    { auto rr = __builtin_amdgcn_permlane32_swap(__float_as_uint(l_reg), __float_as_uint(l_reg), false, false); l_out = __uint_as_float(rr[0]) + __uint_as_float(rr[1]); }
    ATT_BAR();
#undef GLDS
#undef STAGE_K
#undef STAGE_V
#undef QKT
#undef MASKX
#undef PARTSM
#undef PK4
#undef FINSM
#undef TRRD
#undef PV_D0
#undef PVT
#undef RESC
#undef HALF_STEP
#undef KBT
}
constexpr int MB_V = 0, MB_K = 65536, EXTRA_OFF = RING_BYTES + 1024;
template <bool GATHER>
__device__ __forceinline__ void moba_block(const int wv, LAS unsigned char* lds, const bf16* __restrict__ rowb, const int h, const int kblk, const int qpos, const float slope,
                                           f32x16 (&o)[4], float& l_out, float& M_out, float& qn_out) {
    constexpr float SCALE = 0.08838834764831845f, C2 = SCALE * 1.4426950408889634f, ISC = 1.0f / SCALE;
    const int tid = opaque_tid(wv), wid = wv, lane = tid & 63, r32 = lane & 31, hi = lane >> 5;
    const bf16* Kp = rowb + (size_t)(kblk * 256) * NQKV + 4096 + h * 128; const bf16* Vp = Kp + 1024;
    unsigned offK, offV;
    { const int row = wid * 4 + (lane >> 4), c = (lane & 15) ^ (row & 7); offK = (unsigned)(row * NQKV + c * 8); }
    { const int t = (lane & 31) >> 2, k = (wid >> 2) * 16 + (t >> 2) * 8 + ((wid >> 1) & 1) * 4 + (t & 3), c = ((wid & 1) * 2 + (lane >> 5)) * 32 + (lane & 3) * 8; offV = (unsigned)(k * NQKV + c); }
#pragma unroll
    for (int t = 0; t < 4; ++t) { const bf16* kb_ = Kp + (size_t)(64 * t) * NQKV + offK; const bf16* vb_ = Vp + (size_t)(64 * t) * NQKV + offV;
        __builtin_amdgcn_global_load_lds((const unsigned*)kb_, (LAS unsigned*)(lds + MB_K + t * 16384 + wid * 1024), 16, 0, 0);
        __builtin_amdgcn_global_load_lds((const unsigned*)(kb_ + 32 * NQKV), (LAS unsigned*)(lds + MB_K + t * 16384 + 8192 + wid * 1024), 16, 0, 0);
        __builtin_amdgcn_global_load_lds((const unsigned*)vb_, (LAS unsigned*)(lds + MB_V + t * 16384 + wid * 1024), 16, 0, 0);
        __builtin_amdgcn_global_load_lds((const unsigned*)(vb_ + 32 * NQKV), (LAS unsigned*)(lds + MB_V + t * 16384 + 8192 + wid * 1024), 16, 0, 0); }
    bf16x8 qr[8];
#pragma unroll
    for (int d0 = 0; d0 < 8; ++d0) qr[d0] = *(const bf16x8*)(rowb + (unsigned)(qpos * NQKV + 3072 + h * 128 + hi * 8) + d0 * 16);
    { float s2 = 0.f;
#pragma unroll
      for (int d0 = 0; d0 < 8; ++d0) { const v4u w = __builtin_bit_cast(v4u, qr[d0]);
          s2 += (bflo(w.x) * bflo(w.x) + bfhi(w.x) * bfhi(w.x)) + (bflo(w.y) * bflo(w.y) + bfhi(w.y) * bfhi(w.y)) + (bflo(w.z) * bflo(w.z) + bfhi(w.z) * bfhi(w.z)) + (bflo(w.w) * bflo(w.w) + bfhi(w.w) * bfhi(w.w)); }
      auto rr = __builtin_amdgcn_permlane32_swap(__float_as_uint(s2), __float_as_uint(s2), false, false);
      qn_out = sqrtf(__uint_as_float(rr[0]) + __uint_as_float(rr[1])) * 1.001f; }
    const float sl = slope * ISC;
    const unsigned vb0 = (unsigned)(uintptr_t)(lds + MB_V) + (unsigned)v_rd_base(lane);
    const unsigned kofs0 = (unsigned)(r32 * 256 + ((hi * 16) ^ ((r32 & 7) << 4)));
    float m_reg = -1e30f, l_reg = 0.f;
#pragma unroll
    for (int d0 = 0; d0 < 4; ++d0)
#pragma unroll
        for (int r = 0; r < 16; ++r) o[d0][r] = 0.f;
    VM_WAIT(); __syncthreads();
#pragma unroll 1
    for (int t = 0; t < 4; ++t) {
        f32x16 p0, p1;
        { const float t0_ = sl * (float)(64 * t + 4 * hi);
#pragma unroll
          for (int r = 0; r < 16; ++r) { p0[r] = __builtin_fmaf(sl, (float)((r & 3) + 8 * (r >> 2)), t0_); p1[r] = __builtin_fmaf(sl, (float)(32 + (r & 3) + 8 * (r >> 2)), t0_); } }
        { const unsigned kb0_ = (unsigned)(uintptr_t)(lds + MB_K) + (unsigned)t * 16384u + kofs0;
#pragma unroll
          for (int d0 = 0; d0 < 8; ++d0) { const LAS unsigned char* a = (const LAS unsigned char*)(uintptr_t)(kb0_ ^ (unsigned)((d0 & 3) << 5)) + (d0 >> 2) * 128;
              const bf16x8 b0 = *(const LAS bf16x8*)(a), b1 = *(const LAS bf16x8*)(a + 32 * 256);
              p0 = __builtin_amdgcn_mfma_f32_32x32x16_bf16(b0, qr[d0], p0, 0, 0, 0); p1 = __builtin_amdgcn_mfma_f32_32x32x16_bf16(b1, qr[d0], p1, 0, 0, 0); } }
        if (!GATHER) { const float NEG = -__builtin_inff(); const int dq = qpos - (kblk * 256 + 64 * t) - 4 * hi;
#pragma unroll
            for (int r = 0; r < 16; ++r) { const int c = (r & 3) + 8 * (r >> 2); if (c > dq) p0[r] = NEG; if (c + 32 > dq) p1[r] = NEG; } }
        float pmax = p0[0];
#pragma unroll
        for (int r = 1; r < 16; ++r) pmax = fmaxf(pmax, p0[r]);
#pragma unroll
        for (int r = 0; r < 16; ++r) pmax = fmaxf(pmax, p1[r]);
        { auto rr = __builtin_amdgcn_permlane32_swap(__float_as_uint(pmax), __float_as_uint(pmax), false, false); pmax = fmaxf(__uint_as_float(rr[0]), __uint_as_float(rr[1])); }
        const bool need = (pmax - m_reg) * SCALE > THR;
        const float mn = need ? fmaxf(m_reg, pmax) : m_reg, alpha = need ? __builtin_amdgcn_exp2f((m_reg - mn) * C2) : 1.f; m_reg = mn;
        const float mnL = -mn * C2; float ps = 0.f;
#pragma unroll
        for (int r = 0; r < 16; ++r) { p0[r] = __builtin_amdgcn_exp2f(fmaf(p0[r], C2, mnL)); p1[r] = __builtin_amdgcn_exp2f(fmaf(p1[r], C2, mnL)); }
#pragma unroll
        for (int r = 0; r < 16; ++r) ps += p0[r] + p1[r];
        l_reg = l_reg * alpha + ps;
        if (__any(alpha < 1.f)) {
#pragma unroll
            for (int d0 = 0; d0 < 4; ++d0)
#pragma unroll
                for (int r = 0; r < 16; ++r) o[d0][r] *= alpha; }
        bf16x8 pa0, pa1, pa2, pa3;
#define PK4(P, B_, OUT) do { unsigned a0 = cvtpk(P[B_ + 0], P[B_ + 1]), a1 = cvtpk(P[B_ + 2], P[B_ + 3]); unsigned b0 = cvtpk(P[B_ + 4], P[B_ + 5]), b1 = cvtpk(P[B_ + 6], P[B_ + 7]); \
        auto r0 = __builtin_amdgcn_permlane32_swap(a0, b0, false, false); auto r1 = __builtin_amdgcn_permlane32_swap(a1, b1, false, false); \
        v4u w = {r0[0], r1[0], r0[1], r1[1]}; OUT = __builtin_bit_cast(bf16x8, w); } while (0)
        PK4(p0, 0, pa0); PK4(p0, 8, pa1); PK4(p1, 0, pa2); PK4(p1, 8, pa3);
#undef PK4
        const unsigned vbs_ = vb0 + (unsigned)t * 16384u;
#define TRRD(dst, off) asm volatile("ds_read_b64_tr_b16 %0, %1 offset:%2" : "=&v"(dst) : "v"(vbs_), "i"(off) : "memory")
#define PV_D0(d0) do { s16x4 l0, l1, l2, l3, h0, h1, h2, h3; constexpr int b_ = (d0) * 512; \
        TRRD(l0, b_); TRRD(h0, b_ + 2048); TRRD(l1, b_ + 4096); TRRD(h1, b_ + 6144); TRRD(l2, b_ + 8192); TRRD(h2, b_ + 10240); TRRD(l3, b_ + 12288); TRRD(h3, b_ + 14336); \
        asm volatile("s_waitcnt lgkmcnt(0)" ::: "memory"); SBAR(); \
        o[d0] = __builtin_amdgcn_mfma_f32_32x32x16_bf16((bf16x8){l0[0], l0[1], l0[2], l0[3], h0[0], h0[1], h0[2], h0[3]}, pa0, o[d0], 0, 0, 0); \
        o[d0] = __builtin_amdgcn_mfma_f32_32x32x16_bf16((bf16x8){l1[0], l1[1], l1[2], l1[3], h1[0], h1[1], h1[2], h1[3]}, pa1, o[d0], 0, 0, 0); \
        o[d0] = __builtin_amdgcn_mfma_f32_32x32x16_bf16((bf16x8){l2[0], l2[1], l2[2], l2[3], h2[0], h2[1], h2[2], h2[3]}, pa2, o[d0], 0, 0, 0); \
        o[d0] = __builtin_amdgcn_mfma_f32_32x32x16_bf16((bf16x8){l3[0], l3[1], l3[2], l3[3], h3[0], h3[1], h3[2], h3[3]}, pa3, o[d0], 0, 0, 0); } while (0)
        PV_D0(0); PV_D0(1); PV_D0(2); PV_D0(3);
#undef PV_D0
#undef TRRD
    }
    { auto rr = __builtin_amdgcn_permlane32_swap(__float_as_uint(l_reg), __float_as_uint(l_reg), false, false); l_out = __uint_as_float(rr[0]) + __uint_as_float(rr[1]); }
    M_out = m_reg + sl * (float)(kblk * 256 - qpos);
    __syncthreads();
}
__device__ __forceinline__ void store_block(const int wv, bf16* Op  , const int pitch, const f32x16 (&o)[4], float inv_l) {
    const int tid = opaque_tid(wv), wid = wv, lane = tid & 63, r32 = lane & 31, hi = lane >> 5;
    bf16* rowp = Op + (unsigned)((wid * 32 + r32) * pitch + 4 * hi);
#pragma unroll
    for (int d0 = 0; d0 < 4; ++d0)
#pragma unroll
        for (int g = 0; g < 4; ++g) { v2u w; w.x = cvtpk(o[d0][4 * g] * inv_l, o[d0][4 * g + 1] * inv_l); w.y = cvtpk(o[d0][4 * g + 2] * inv_l, o[d0][4 * g + 3] * inv_l);
            *(v2u*)(rowp + 32 * d0 + 8 * g) = w; }
}
}

__device__ __forceinline__ void moba_own_phase(ARGS_T A, const Frame& F0, const int rep = 0) {
    Frame F = F0; F.tid = opaque_tid(F0.wave); F.lane = F.tid & 63; F.wave = __builtin_amdgcn_readfirstlane(F.tid >> 6);
    const bf16* QKV = (const bf16*)(A.ws + WS_QKV); bf16* MRG = (bf16*)(A.ws + WS_MRG);
    for (;;) {
        int it = 0; if (F.tid == 0) F.MISC[17] = __hip_atomic_fetch_add(F.ctl + CW_Q + 64 + rep, 1u, RLX_AGENT);
        __syncthreads(); it = __builtin_amdgcn_readfirstlane((int)F.MISC[17]); __syncthreads();
        if (it >= 512) break;
        const int bh = it & 15, qb = 31 - (it >> 4), b = bh >> 3, h = bh & 7, P0 = qb * 256;
        const float slope = exp2f(-(float)(h + 1));
        const bf16* rowb = QKV + (size_t)b * SEQ * NQKV;
        const float* KM = (const float*)(A.ws + WS_KMEAN) + (size_t)bh * 32 * 128;
        const int tid = opaque_tid(F.wave), lane = tid & 63, r32 = lane & 31, hi = lane >> 5;
        LAS float* km = (LAS float*)(F.lds + att::G_KM); LAS float* gt = (LAS float*)(F.lds + att::G_GT);
        LAS unsigned* sel = (LAS unsigned*)(F.lds + att::EXTRA_OFF);
        if (qb >= 4) {
            for (int i = tid; i < qb * 32; i += 512) *(LAS f32x4*)(km + 4 * i) = *(const f32x4*)(KM + 4 * i);
            __syncthreads();
            const int row = tid & 255, half = tid >> 8;
            float acc[16];
#pragma unroll
            for (int k = 0; k < 16; ++k) acc[k] = 0.f;
            const bf16* qrow = rowb + (size_t)(P0 + row) * NQKV + 3072 + h * 128;
#pragma unroll 1
            for (int c = 0; c < 16; ++c) { const v4u w = *(const v4u*)(qrow + 8 * c);
                const float q0 = bflo(w.x), q1 = bfhi(w.x), q2 = bflo(w.y), q3 = bfhi(w.y), q4 = bflo(w.z), q5 = bfhi(w.z), q6 = bflo(w.w), q7 = bfhi(w.w);
#pragma unroll
                for (int k = 0; k < 16; ++k) { const int n = 2 * k + half; if (n < qb) { const f32x4 a = *(const LAS f32x4*)(km + n * 128 + 8 * c), bq = *(const LAS f32x4*)(km + n * 128 + 8 * c + 4);
                    acc[k] += (q0 * a.x + q1 * a.y) + (q2 * a.z + q3 * a.w) + (q4 * bq.x + q5 * bq.y) + (q6 * bq.z + q7 * bq.w); } } }
#pragma unroll
            for (int k = 0; k < 16; ++k) { const int n = 2 * k + half; if (n < qb) gt[row * 33 + n] = acc[k]; }
            __syncthreads();
            if (tid < 256) { unsigned msk = 0u;
                for (int t = 0; t < 3; ++t) { float best = -3.0e38f; int bi = 0;
                    for (int n = 0; n < qb; ++n) { const float v = gt[tid * 33 + n]; if (!((msk >> n) & 1u) && v > best) { best = v; bi = n; } }
                    msk |= 1u << bi; }
                sel[tid] = msk; }
        } else { if (tid < 256) sel[tid] = (1u << qb) - 1u; }
        __syncthreads();
        const unsigned selrow = sel[(tid >> 6) * 32 + r32];
        __syncthreads();
        const int qpos = P0 + (tid >> 6) * 32 + r32;
        f32x16 o[4]; float l, Mo, qn;
        att::moba_block<false>(F.wave, F.lds, rowb, h, qb, qpos, slope, o, l, Mo, qn);
        att::store_block(F.wave, MRG + (size_t)(b * SEQ + P0) * DM + 1024 + h * 128, DM, o, 1.0f / l);
        if (hi == 0) {
            const size_t qh = ((size_t)(b * SEQ + qpos)) * 8 + h;
            float* mlo = (float*)(A.ws + WS_MLO) + qh * 2; mlo[0] = Mo; mlo[1] = l;
            const float* knb = (const float*)(A.ws + WS_KN) + (size_t)(32 + bh) * 128;
            unsigned* lcnt = (unsigned*)(F.ctl + CW_LC + rep * 1024) + bh * 32; unsigned* list = (unsigned*)(A.ws + WS_LIST) + (size_t)bh * 32 * 8192;
            unsigned rem = selrow, vm = 0u; const float sl = slope * 11.313708498984761f;
            for (int s = 0; s < 3; ++s) { if (!rem) break; const int n = __builtin_ctz(rem); rem &= rem - 1u;
                const float kn = fmaxf(fmaxf(knb[4 * n], knb[4 * n + 1]), fmaxf(knb[4 * n + 2], knb[4 * n + 3]));
                const float ub = qn * kn + sl * (float)(256 * n + 255 - qpos);
                if ((ub - Mo) * 0.08838834764831845f < -110.0f) continue;
                const unsigned idx = __hip_atomic_fetch_add(lcnt + n, 1u, RLX_AGENT);
                list[(size_t)n * 8192 + idx] = (unsigned)qpos | ((unsigned)s << 16); vm |= 1u << s; }
            ((unsigned*)(A.ws + WS_VM))[qh] = vm;
        }
    }
}
__device__ __forceinline__ void attn_even_phase(ARGS_T A, const Frame& F0, const int rep = 0, const int lcset = 0) {
    Frame F = F0; F.tid = opaque_tid(F0.wave); F.lane = F.tid & 63; F.wave = __builtin_amdgcn_readfirstlane(F.tid >> 6);
    const bf16* QKV = (const bf16*)(A.ws + WS_QKV);
    LAS unsigned* pre = (LAS unsigned*)(F.lds + att::EXTRA_OFF + 1024);
    { const unsigned* lcnt = (const unsigned*)(F.ctl + CW_LC + lcset * 1024); const unsigned nch = (lcnt[F.tid] + 255u) >> 8;
      unsigned inc = nch;
#pragma unroll
      for (int o = 1; o < 64; o <<= 1) { const unsigned t = __shfl_up(inc, o); if (F.lane >= o) inc += t; }
      LAS unsigned* wt = pre + 512;
      if (F.lane == 63) wt[F.wave] = inc;
      __syncthreads();
      unsigned base = 0; for (int w = 0; w < F.wave; ++w) base += wt[w];
      pre[F.tid] = base + inc;
      __syncthreads(); }
    const int nb1 = (int)pre[511];
    for (;;) {
        int it = 0; if (F.tid == 0) F.MISC[16] = __hip_atomic_fetch_add(F.ctl + CW_Q + 0 + rep, 1u, RLX_AGENT);
        __syncthreads(); it = __builtin_amdgcn_readfirstlane((int)F.MISC[16]); __syncthreads();
        if (it >= 1024 + nb1) break;
        if (it < 1024) {
            const int mp = it & 1, bh = (it >> 1) & 15, qb = 31 - (it >> 5), b = bh >> 3, h = bh & 7, P0 = qb * 256;
            const float slope = exp2f(-(2.0f * h + 1.0f) * 0.5f);
            const float* KN = (const float*)(A.ws + WS_KN);
            const bf16* rowb = QKV + (size_t)b * SEQ * NQKV;
            f32x16 o[4]; float l;
            att::attn_block<0>(F.wave, F.lds, rowb + (size_t)P0 * NQKV + h * 128 + mp * 64, rowb + 1024 + h * 128 + mp * 64, rowb + 2048 + h * 128, P0, slope, nullptr, KN + (size_t)(bh * 2 + mp) * 128, o, l);
            att::store_block(F.wave, (bf16*)(A.ws + (mp ? WS_OA1 : WS_OA0)) + (size_t)(b * SEQ + P0) * 1024 + h * 128, 1024, o, 1.0f / l);
        } else {
            const int c = it - 1024; int lo_ = 0, hi_ = 511;
            while (lo_ < hi_) { const int mid = (lo_ + hi_) >> 1; if ((int)pre[mid] > c) hi_ = mid; else lo_ = mid + 1; }
            const int bhn = __builtin_amdgcn_readfirstlane(lo_), chunk = c - (bhn ? (int)pre[bhn - 1] : 0), bh = bhn >> 5, n = bhn & 31, b = bh >> 3, h = bh & 7;
            const float slope = exp2f(-(float)(h + 1));
            const bf16* rowb = QKV + (size_t)b * SEQ * NQKV;
            const int cnt = (int)((const unsigned*)(F.ctl + CW_LC + lcset * 1024))[bhn];
            const int tid = opaque_tid(F.wave), lane = tid & 63, r32 = lane & 31, hi = lane >> 5;
            const int idx = chunk * 256 + (tid >> 6) * 32 + r32; const bool valid = idx < cnt;
            const unsigned e = ((const unsigned*)(A.ws + WS_LIST))[(size_t)bhn * 8192 + (valid ? idx : cnt - 1)];
            const int qpos = (int)(e & 0xffffu), slot = (int)(e >> 16);
            f32x16 o[4]; float l, Mo, qn;
            att::moba_block<true>(F.wave, F.lds, rowb, h, n, qpos, slope, o, l, Mo, qn);
            if (valid) { const size_t qhs = (((size_t)(b * SEQ + qpos)) * 8 + h) * 3 + slot; const float il = 1.0f / l;
                bf16* rowp = (bf16*)(A.ws + WS_PART) + qhs * 128 + 4 * hi;
#pragma unroll
                for (int d0 = 0; d0 < 4; ++d0)
#pragma unroll
                    for (int g = 0; g < 4; ++g) { v2u w; w.x = att::cvtpk(o[d0][4 * g] * il, o[d0][4 * g + 1] * il); w.y = att::cvtpk(o[d0][4 * g + 2] * il, o[d0][4 * g + 3] * il);
                        *(v2u*)(rowp + 32 * d0 + 8 * g) = w; }
                if (hi == 0) { float* mlp = (float*)(A.ws + WS_MLP) + qhs * 2; mlp[0] = Mo; mlp[1] = l; } }
        }
    }
}
__device__ __forceinline__ void even_merge_phase(ARGS_T A, const Frame& F0, const bool dry = false) {
    Frame F = F0; F.tid = opaque_tid(F0.wave); F.lane = F.tid & 63; F.wave = __builtin_amdgcn_readfirstlane(F.tid >> 6);
    bf16* MRG = (bf16*)(A.ws + WS_MRG); const float lam = *(const float*)(A.ws + WS_LAM);
    const unsigned* OA0 = (const unsigned*)(A.ws + WS_OA0); const unsigned* OA1 = (const unsigned*)(A.ws + WS_OA1);
    const float g0 = A.in[I_SUBLN][2 * F.lane] * 0.8f, g1 = A.in[I_SUBLN][2 * F.lane + 1] * 0.8f;
    constexpr float C2 = 0.08838834764831845f * 1.4426950408889634f;
    const int gw = F.vcu * NWAVES + F.wave, NGW = F.G * NWAVES, lane = F.lane;
    const float* MLO = (const float*)(A.ws + WS_MLO); const float* MLP = (const float*)(A.ws + WS_MLP); const unsigned* VMp = (const unsigned*)(A.ws + WS_VM);
    const unsigned* PO = (const unsigned*)(A.ws + WS_PART);
    for (int m = gw; m < M; m += NGW) {
        unsigned* mrow = (unsigned*)(MRG + (size_t)m * DM); unsigned* wrow = dry ? (unsigned*)((bf16*)(A.ws + WS_H) + (size_t)m * DM) : mrow;
        const unsigned vmv = VMp[(size_t)m * 8 + (lane & 7)]; const float mlov = MLO[(size_t)m * 16 + (lane & 15)]; const float mlpv = lane < 48 ? MLP[(size_t)m * 48 + lane] : 0.f;
        unsigned a0w[8], a1w[8], ow[8], pw[8][3];
#pragma unroll
        for (int h = 0; h < 8; ++h) { a0w[h] = OA0[(size_t)m * 512 + h * 64 + lane]; a1w[h] = OA1[(size_t)m * 512 + h * 64 + lane]; ow[h] = mrow[512 + h * 64 + lane];
#pragma unroll
            for (int s = 0; s < 3; ++s) pw[h][s] = PO[((size_t)m * 8 + h) * 192 + s * 64 + lane]; }
        float wn[4];
        { const int hh = lane & 7; const float M0 = __shfl(mlov, 2 * hh), l0 = __shfl(mlov, 2 * hh + 1); float Ms[3], ls[3]; float Mx = M0;
#pragma unroll
          for (int s = 0; s < 3; ++s) { Ms[s] = __shfl(mlpv, 6 * hh + 2 * s); ls[s] = __shfl(mlpv, 6 * hh + 2 * s + 1); if ((vmv >> s) & 1u) Mx = fmaxf(Mx, Ms[s]); }
          wn[0] = l0 * __builtin_amdgcn_exp2f((M0 - Mx) * C2); float L = wn[0];
#pragma unroll
          for (int s = 0; s < 3; ++s) { wn[1 + s] = ((vmv >> s) & 1u) ? ls[s] * __builtin_amdgcn_exp2f((Ms[s] - Mx) * C2) : 0.f; L += wn[1 + s]; }
          const float iL = 1.0f / L;
#pragma unroll
          for (int s = 0; s < 4; ++s) wn[s] *= iL; }
#pragma unroll
        for (int h = 0; h < 8; ++h) {
            const float v0 = bflo(a0w[h]) - lam * bflo(a1w[h]), v1 = bfhi(a0w[h]) - lam * bfhi(a1w[h]);
            const float r = 1.0f / sqrtf(wave_sum(v0 * v0 + v1 * v1) * (1.0f / 128.0f) + EPS);
            wrow[h * 64 + lane] = pk2(v0 * r * g0, v1 * r * g1);
            const float w0 = __shfl(wn[0], h); float b0 = w0 * bflo(ow[h]), b1 = w0 * bfhi(ow[h]);
#pragma unroll
            for (int s = 0; s < 3; ++s) { const float ws_ = __shfl(wn[1 + s], h); const unsigned p = ws_ != 0.f ? pw[h][s] : 0u; b0 += ws_ * bflo(p); b1 += ws_ * bfhi(p); }
            wrow[512 + h * 64 + lane] = pk2(b0, b1); }
    }
}
__device__ __forceinline__ void attn_odd_phase(ARGS_T A, const Frame& F0, const int rep = 0) {
    Frame F = F0; F.tid = opaque_tid(F0.wave); F.lane = F.tid & 63; F.wave = __builtin_amdgcn_readfirstlane(F.tid >> 6);
    const bf16* QKV = (const bf16*)(A.ws + WS_QKV); bf16* MRG = (bf16*)(A.ws + WS_MRG);
    for (;;) {
        int it = 0; if (F.tid == 0) F.MISC[18] = __hip_atomic_fetch_add(F.ctl + CW_Q + 128 + rep, 1u, RLX_AGENT);
        __syncthreads(); it = __builtin_amdgcn_readfirstlane((int)F.MISC[18]); __syncthreads();
        if (it >= 1024) break;
        const int bh = it & 31, qb = 31 - (it >> 5), b = bh >> 4, h = bh & 15;
        const bf16* rowb = QKV + (size_t)b * SEQ * NQKV;
        const float* cumrow = (const float*)(A.ws + WS_CUM) + (size_t)bh * SEQ; const float* KN = (const float*)(A.ws + WS_KN);
        {
            const int P0 = qb * 256;
            f32x16 o[4]; float l;
            att::attn_block<2>(F.wave, F.lds, rowb + (size_t)P0 * NQKV + h * 128, rowb + 2048 + h * 128, rowb + 4096 + h * 128, P0, 0.f, cumrow, KN + (size_t)bh * 128, o, l);
            att::store_block(F.wave, MRG + (size_t)(b * SEQ + P0) * DM + h * 128, DM, o, 1.0f / l);
        }
    }
}
#ifndef REP_PRO
#define REP_PRO 1
#endif
#ifndef REP_BAR
#define REP_BAR 1
#endif
#ifndef REP_NORM0
#define REP_NORM0 1
#endif
#ifndef REP_KN
#define REP_KN 1
#endif
#ifndef REP_MERGE
#define REP_MERGE 1
#endif
#ifndef PROBE_PH
#define PROBE_PH -1
#endif
#ifndef REP_INPROJ
#define REP_INPROJ 1
#endif
#ifndef REP_ATTA
#define REP_ATTA 1
#endif
#ifndef REP_ATTB
#define REP_ATTB 1
#endif
#ifndef REP_ATTC
#define REP_ATTC 1
#endif
#ifndef REP_MOEUP
#define REP_MOEUP 1
#endif
#ifndef REP_MOEDN
#define REP_MOEDN 1
#endif
#ifndef REP_OUTP0
#define REP_OUTP0 1
#endif
#ifndef ONE_LAUNCH
#define ONE_LAUNCH 1
#endif
constexpr int N_PHASES = 20;
__device__ __forceinline__ const __attribute__((address_space(4))) Args* opaque_args() {
    const __attribute__((address_space(4))) Args* p = (const __attribute__((address_space(4))) Args*)__builtin_amdgcn_kernarg_segment_ptr(); asm volatile("" : "+s"(p)); return p; }
#define IN(k) (lo <= (k) && (k) < hi)
#define SEAM(k) do { if (IN(k) && IN((k) + 1)) { for (int rb_ = 0; rb_ < REP_BAR; ++rb_) xcd_barrier(bar); } } while (0)
#define T0(id) do { if (PROBE_PH == (id)) tp0 = __builtin_amdgcn_s_memrealtime(); } while (0)
#define T1(id) do { if (PROBE_PH == (id)) tp1 = __builtin_amdgcn_s_memrealtime(); } while (0)
template <int l>
__device__ __forceinline__ void layer_phases(const Frame& F, const XcdBarrier& bar, const int lo, const int hi, unsigned long long& tp0, unsigned long long& tp1) {
#define args (*opaque_args())
        const int pb = 1 + 9 * l;
        if (IN(pb + 0)) { T0(pb + 0); if (l == 0) { for (int rep = 0; rep < REP_NORM0; ++rep) norm_phase<0>(args, F, l); } else norm_phase<2>(args, F, l); SEAM(pb + 0); T1(pb + 0); }
        if (IN(pb + 1)) { T0(pb + 1);
            if (l == 1) { scan_phase(args, F); }
            pg8::Gemm g{(const bf16*)(args.ws + WS_H), (const bf16*)(args.ws + WS_WIN) + (size_t)l * NQKV * DM, M, NQKV, DM}; pg8::StaticOrder S; S.init(M, NQKV, F.G, (int)blockIdx.x);
            pg8::EpiBf16<0> E{(bf16*)(args.ws + WS_QKV), NQKV, nullptr, 0, 0, 1.f};
            for (int rep = 0; rep < (l == 0 ? REP_INPROJ : 1); ++rep) { pg8::gemm_phase<pg8::EpiBf16<0>, pg8::StaticOrder, PG8_ALIGN, PG8_SP2>(F.wave, F.lds + RING_OFF, g, S, E); if (rep + 1 < (l == 0 ? REP_INPROJ : 1)) xcd_barrier(bar); }
            SEAM(pb + 1); T1(pb + 1);
        }
        if (IN(pb + 2)) { T0(pb + 2); for (int rep = 0; rep < REP_KN; ++rep) { if (l == 0) kmean_phase(args, F); knorm_phase<l>(args, F); } SEAM(pb + 2); T1(pb + 2); }
        if (IN(pb + 3)) { T0(pb + 3);
            if (l == 0) { for (int rep = 0; rep < REP_ATTB; ++rep) { moba_own_phase(args, F, rep); xcd_barrier(bar); }
                          for (int rep = 0; rep < REP_ATTA; ++rep) { attn_even_phase(args, F, rep, REP_ATTB - 1); xcd_barrier(bar); }
                          for (int rep = 1; rep < REP_MERGE; ++rep) even_merge_phase(args, F, true);
                          even_merge_phase(args, F); }
            else { for (int rep = 0; rep < REP_ATTC; ++rep) { if (!(NAIVE_ATTN & 4)) attn_odd_phase(args, F, rep); if (rep + 1 < REP_ATTC) xcd_barrier(bar); } }
            SEAM(pb + 3); T1(pb + 3);
        }
        if (IN(pb + 4)) { T0(pb + 4);
            pg8::Gemm g{(const bf16*)(args.ws + WS_MRG), (const bf16*)(args.ws + WS_WOUT) + (size_t)l * DM * DM, M, DM, DM}; pg8::StaticOrder S; S.init(M, DM, F.G, (int)blockIdx.x);
            pg8::EpiBf16<0> E{(bf16*)(args.ws + WS_H), DM, nullptr, 0, 0, 1.f};
            for (int rep = 0; rep < (l == 0 ? REP_OUTP0 : 1); ++rep) { pg8::gemm_phase<pg8::EpiBf16<0>, pg8::StaticOrder, PG8_ALIGN, PG8_SP2>(F.wave, F.lds + RING_OFF, g, S, E); if (rep + 1 < (l == 0 ? REP_OUTP0 : 1)) xcd_barrier(bar); }
            SEAM(pb + 4); T1(pb + 4);
        }
        if (IN(pb + 5)) { T0(pb + 5); norm_phase<1>(args, F, l); SEAM(pb + 5); T1(pb + 5); }
        if (IN(pb + 6)) { T0(pb + 6); gather_phase(args, F, l); SEAM(pb + 6); T1(pb + 6); }
        if (IN(pb + 7)) { T0(pb + 7);
            pg8::Gemm g{(const bf16*)(args.ws + WS_QKV), (const bf16*)(args.ws + WS_W13) + (size_t)l * 16384 * DM, MAXROWS, 16384, DM};
            pg8::MoeOrder S; S.init((const unsigned*)(F.ctl + CW_CNT + 64 * l), 2, F.G, (int)blockIdx.x);
            pg8::EpiSwiGLU E{(bf16*)(args.ws + WS_ACT)};
            for (int rep = 0; rep < (l == 0 ? REP_MOEUP : 1); ++rep) { pg8::gemm_phase<pg8::EpiSwiGLU, pg8::MoeOrder, PG8_ALIGN, PG8_SP2>(F.wave, F.lds + RING_OFF, g, S, E); if (rep + 1 < (l == 0 ? REP_MOEUP : 1)) xcd_barrier(bar); }
            SEAM(pb + 7); T1(pb + 7);
        }
        if (IN(pb + 8)) { T0(pb + 8);
            pg8::Gemm g{(const bf16*)(args.ws + WS_ACT), (const bf16*)(args.ws + WS_W2) + (size_t)l * 32768 * FFE, MAXROWS, 32768, FFE};
            pg8::MoeOrder S; S.init((const unsigned*)(F.ctl + CW_CNT + 64 * l), 3, F.G, (int)blockIdx.x);
            pg8::EpiBf16<0> E{(bf16*)(args.ws + WS_OSL), DM, nullptr, DM, 0, 1.f};
            for (int rep = 0; rep < (l == 0 ? REP_MOEDN : 1); ++rep) { pg8::gemm_phase<pg8::EpiBf16<0>, pg8::MoeOrder, PG8_ALIGN, PG8_SP2>(F.wave, F.lds + RING_OFF, g, S, E); if (rep + 1 < (l == 0 ? REP_MOEDN : 1)) xcd_barrier(bar); }
            SEAM(pb + 8); T1(pb + 8);
        }
}
#undef args
#undef IN
#undef SEAM
__global__ void __launch_bounds__(NWAVES * 64, 2) skel_fwd(Args args) {
    extern __shared__ __attribute__((aligned(16))) unsigned char lds[];
    Frame F;
    F.lds = (LAS unsigned char*)lds;
    F.MISC = (volatile LAS unsigned*)(F.lds + MISC_OFF);
    F.tid = threadIdx.x; F.lane = F.tid & 63; F.wave = __builtin_amdgcn_readfirstlane(F.tid >> 6);
    F.G = gridDim.x; { const int bx = blockIdx.x; F.vcu = (F.G % 8 == 0) ? (bx % 8) * (F.G / 8) + bx / 8 : bx; }
    unsigned char* ws = args.ws;
    F.ctl = (gu32*)(ws + WS_CTL);
    for (int u = F.tid; u < (LDS_BYTES - LDSCTL_OFF) / 4; u += NWAVES * 64) ((LAS unsigned*)(F.lds + LDSCTL_OFF))[u] = 0u;
    __syncthreads();
    const int lo = args.ph_lo, hi = args.ph_hi;
    XcdBarrier bar; bar.bar = (unsigned*)(F.ctl + CW_BAR); bar.x = 0; bar.st = nullptr;
    if (hi - lo > 1) bar = xcd_barrier_post((unsigned*)(F.ctl + CW_BAR), F.MISC + 8);
    bar.w = F.wave;
#define IN(k) (lo <= (k) && (k) < hi)
#define SEAM(k) do { if (IN(k) && IN((k) + 1)) xcd_barrier(bar); } while (0)

    if (IN(0)) { for (int rep = 0; rep < REP_PRO; ++rep) { p0_prologue(*opaque_args(), F); if (rep + 1 < REP_PRO) xcd_barrier(bar); } SEAM(0); }
    unsigned long long tp0 = 0, tp1 = 0;
    layer_phases<0>(F, bar, lo, hi, tp0, tp1);
    layer_phases<1>(F, bar, lo, hi, tp0, tp1);
    if (IN(19)) { if (PROBE_PH == 19) tp0 = __builtin_amdgcn_s_memrealtime(); norm_phase<3>(*opaque_args(), F, 1); if (PROBE_PH == 19) { asm volatile("s_waitcnt vmcnt(0)" ::: "memory"); tp1 = __builtin_amdgcn_s_memrealtime(); } }
    if (PROBE_PH >= 0 && blockIdx.x == 0) { const unsigned long long t0 = __builtin_amdgcn_s_memrealtime(), dt = 8ull * (tp1 - tp0); while (__builtin_amdgcn_s_memrealtime() - t0 < dt) __builtin_amdgcn_s_sleep(32); }
#undef IN
#undef SEAM
}

extern "C" void kernel_launch(void* const* d_in, const int* in_sizes, int n_in, void* d_out, int out_size, void* d_ws, size_t ws_size, hipStream_t stream) {
    static int grid = 0;
    if (grid == 0) {
        if (n_in != 22 || in_sizes[0] != M * DM || out_size != M * DM || ws_size < WS_END) { fprintf(stderr, "kernel_launch: unexpected shapes (n_in %d, in0 %d, out %d, ws %zu; need ws >= %zu); nothing launched\n", n_in, n_in > 0 ? in_sizes[0] : -1, out_size, ws_size, (size_t)WS_END); grid = -1; return; }
        int dev = 0, cus = 0, per_cu = 0;
        if (hipGetDevice(&dev) != hipSuccess || hipDeviceGetAttribute(&cus, hipDeviceAttributeMultiprocessorCount, dev) != hipSuccess) { grid = -1; return; }
        if (hipFuncSetAttribute((const void*)skel_fwd, hipFuncAttributeMaxDynamicSharedMemorySize, LDS_BYTES) != hipSuccess) { fprintf(stderr, "kernel_launch: hipFuncSetAttribute failed\n"); grid = -1; return; }
        if (hipOccupancyMaxActiveBlocksPerMultiprocessor(&per_cu, (const void*)skel_fwd, NWAVES * 64, LDS_BYTES) != hipSuccess || per_cu < 1) { fprintf(stderr, "kernel_launch: occupancy query says %d blocks per CU\n", per_cu); }
        (void)hipGetLastError();
        grid = cus;
    }
    if (grid < 0) return;
    if (hipMemsetAsync((char*)d_ws + WS_CTL, 0, CTL_ZERO_BYTES, stream) != hipSuccess) return;
    Args a{};
    for (int i = 0; i < 22; ++i) a.in[i] = (const float*)d_in[i];
    a.out = (float*)d_out; a.ws = (unsigned char*)d_ws;
#if ONE_LAUNCH
    a.ph_lo = 0; a.ph_hi = N_PHASES;
    hipLaunchKernelGGL(skel_fwd, dim3(grid), dim3(NWAVES * 64), LDS_BYTES, stream, a);
#else
    unsigned char* ws = (unsigned char*)d_ws;
    for (int p = 0; p < N_PHASES; ++p) {
#if NAIVE_ATTN
        if (p == 4) {
            if (NAIVE_ATTN & 1) naive_attn<0><<<M * 8 / 4, 256, 0, stream>>>((const bf16*)(ws + WS_QKV), (bf16*)(ws + WS_MRG), nullptr, nullptr, (const float*)(ws + WS_LAM), (const float*)d_in[I_SUBLN]);
            if (NAIVE_ATTN & 2) naive_attn<1><<<M * 8 / 4, 256, 0, stream>>>((const bf16*)(ws + WS_QKV), (bf16*)(ws + WS_MRG), nullptr, (const float*)(ws + WS_KMEAN), nullptr, nullptr);
            if ((NAIVE_ATTN & 3) == 3) continue; }
        if (p == 13 && (NAIVE_ATTN & 4)) { naive_attn<2><<<M * 16 / 4, 256, 0, stream>>>((const bf16*)(ws + WS_QKV), (bf16*)(ws + WS_MRG), (const float*)(ws + WS_CUM), nullptr, nullptr, nullptr); continue; }
#endif
        a.ph_lo = p; a.ph_hi = p + 1;
        hipLaunchKernelGGL(skel_fwd, dim3(grid), dim3(NWAVES * 64), LDS_BYTES, stream, a);
    }
#endif
}
```

```cpp
#include <hip/hip_runtime.h>
#include <cstdio>
#include <cstdint>
namespace pg8 {
#define PG8_LAS __attribute__((address_space(3)))
typedef unsigned short bf16_t;
typedef short bf16x8 __attribute__((ext_vector_type(8)));
typedef float f32x4 __attribute__((ext_vector_type(4)));
typedef unsigned u32x4 __attribute__((ext_vector_type(4)));
constexpr int BM = 256, BK = 64, HALF = 128, HTB = HALF * BK * 2  , STAGE_BYTES = 8 * HTB, NXCD = 8, WGM = 8;

__host__ __device__ __forceinline__ int lds_byte(int r, int c) { const int st = (r >> 4) * 2 + (c >> 5), rr = r & 15, cc = c & 31, ob = rr * 64 + cc * 2; return st * 1024 + (ob ^ (((ob >> 9) & 1) << 5)); }
__host__ __device__ __forceinline__ void stage_rc(int b, int& R, int& C) { const int st = b / 1024, sb = b % 1024, swz = sb ^ (((sb >> 9) & 1) << 5); R = (st >> 1) * 16 + swz / 64; C = (st & 1) * 32 + (swz % 64) / 2; }
__host__ __device__ __forceinline__ int perm32(int rho) { const int n = rho >> 4, i = rho & 15; return 8 * (i >> 2) + 4 * n + (i & 3); }

struct Unit { int pm, pn; };
struct Gemm { const bf16_t* A; const bf16_t* Bt; int M, N, K; };

struct StaticOrder {
    int nM, nN, nwg, G, c;
    __host__ __device__ void init(int M, int N, int G_, int c_) { nM = M / BM; nN = N / BM; nwg = nM * nN; G = G_; c = c_; }
    __host__ __device__ bool next(int i, Unit& u) const {
        const long L = (long)i * G + c; if (L >= nwg) return false;
        int wgid = (int)L; { const int q = nwg / NXCD, r = nwg % NXCD, xcd = wgid % NXCD, off = wgid / NXCD; wgid = (xcd < r ? xcd * (q + 1) : r * (q + 1) + (xcd - r) * q) + off; }
        const int nig = WGM * nN, gid = wgid / nig, fm = gid * WGM, gsz = (nM - fm) < WGM ? (nM - fm) : WGM;
        u.pm = fm + ((wgid % nig) % gsz); u.pn = (wgid % nig) / gsz; return true;
    }
    __device__ __forceinline__ void a_ready(const Unit&) const {}
    __device__ __forceinline__ void done(const Unit&) const {}
};

__device__ __forceinline__ unsigned cvt_pk_bf16(float lo, float hi) { unsigned r; asm volatile("v_cvt_pk_bf16_f32 %0, %1, %2" : "=v"(r) : "v"(lo), "v"(hi)); return r; }
typedef float f32x2 __attribute__((ext_vector_type(2)));
__device__ __forceinline__ f32x2 gelu_pk(f32x2 v) {
    const f32x2 av = __builtin_elementwise_abs(v), d = av * 0.2316418882f + 1.0f;
    f32x2 t; t.x = __builtin_amdgcn_rcpf(d.x); t.y = __builtin_amdgcn_rcpf(d.y);
    f32x2 q = t * 0.5307027145f + (-0.7265760135f); q = q * t + 0.7107068705f; q = q * t + (-0.142248368f); q = q * t + 0.127414796f; q = q * t;
    const f32x2 s = (v * v) * (-0.72134752044f);
    f32x2 e; e.x = __builtin_amdgcn_exp2f(s.x); e.y = __builtin_amdgcn_exp2f(s.y);
    const f32x2 m = v * (q * e), r = v - m;
    f32x2 o; o.x = v.x < 0.f ? m.x : r.x; o.y = v.y < 0.f ? m.y : r.y; return o;
}

template <int ACT  > struct EpiBf16 {
    static constexpr bool PERM = true, AFTER_DRAIN = false; static_assert(ACT == 0 || ACT == 1, "EpiBf16: ACT is 0 (none) or 1 (gelu_pk)");
    bf16_t* O; int ldc; const float* bias; int split_cols; size_t split_stride; float scale0;
    __device__ __forceinline__ void operator()(const f32x4 (&acc)[2][2][4][2], const Unit& u, int wr, int wc, int fr, int fq) const {
        const int row0 = u.pm * BM + wr * 64 + fr; int colt = u.pn * BM; bf16_t* base = O;
        float sc = 1.f; if (split_cols) { const int t = colt / split_cols; base += (size_t)t * split_stride; colt -= t * split_cols; if (t == 0) sc = scale0; }
        const int col0 = colt + wc * 32 + 8 * fq, bcol0 = u.pn * BM + wc * 32 + 8 * fq;
        f32x4 bv[2][2];
#pragma unroll
        for (int bj = 0; bj < 2; ++bj)
#pragma unroll
            for (int n = 0; n < 2; ++n) bv[bj][n] = bias ? *(const f32x4*)(bias + bcol0 + bj * HALF + 4 * n) : (f32x4){0.f, 0.f, 0.f, 0.f};
#pragma unroll
        for (int ai = 0; ai < 2; ++ai)
#pragma unroll
            for (int m = 0; m < 4; ++m) { bf16_t* rowp = base + (size_t)(row0 + ai * HALF + m * 16) * ldc + col0;
#pragma unroll
                for (int bj = 0; bj < 2; ++bj) { f32x4 v0 = acc[ai][bj][m][0] + bv[bj][0], v1 = acc[ai][bj][m][1] + bv[bj][1];
                    if (ACT == 1) { f32x2 a = gelu_pk((f32x2){v0[0], v0[1]}), b = gelu_pk((f32x2){v0[2], v0[3]}), c = gelu_pk((f32x2){v1[0], v1[1]}), d = gelu_pk((f32x2){v1[2], v1[3]});
                        v0 = (f32x4){a.x, a.y, b.x, b.y}; v1 = (f32x4){c.x, c.y, d.x, d.y}; }
                    v0 = v0 * sc; v1 = v1 * sc; u32x4 w; w.x = cvt_pk_bf16(v0[0], v0[1]); w.y = cvt_pk_bf16(v0[2], v0[3]); w.z = cvt_pk_bf16(v1[0], v1[1]); w.w = cvt_pk_bf16(v1[2], v1[3]);
                    *(u32x4*)(rowp + bj * HALF) = w; } }
    }
};

struct EpiResid {
    static constexpr bool PERM = false, AFTER_DRAIN = false;
    const float* base; float* out; const float* gate; int gate_bstride; int rows_per_batch;
    __device__ __forceinline__ void operator()(const f32x4 (&acc)[2][2][4][2], const Unit& u, int wr, int wc, int fr, int fq) const {
        const int row0 = u.pm * BM + wr * 64 + fr, col0 = u.pn * BM + wc * 32 + 4 * fq;
        const float* gp = gate + (size_t)((u.pm * BM) / rows_per_batch) * gate_bstride + col0;
        f32x4 gv[2][2];
#pragma unroll
        for (int bj = 0; bj < 2; ++bj)
#pragma unroll
            for (int n = 0; n < 2; ++n) gv[bj][n] = *(const f32x4*)(gp + bj * HALF + n * 16);
#pragma unroll
        for (int ai = 0; ai < 2; ++ai)
#pragma unroll
            for (int m = 0; m < 4; ++m) { const size_t off = (size_t)(row0 + ai * HALF + m * 16) * 2048 + col0;
#pragma unroll
                for (int bj = 0; bj < 2; ++bj)
#pragma unroll
                    for (int n = 0; n < 2; ++n) { const f32x4 bs = *(const f32x4*)(base + off + bj * HALF + n * 16);
                        *(f32x4*)(out + off + bj * HALF + n * 16) = bs + gv[bj][n] * acc[ai][bj][m][n]; }
                if (m & 1) asm volatile("" ::: "memory"); }
    }
};
struct EpiSwiGLU {
    static constexpr bool PERM = true, AFTER_DRAIN = false;
    bf16_t* O;
    __device__ __forceinline__ void operator()(const f32x4 (&acc)[2][2][4][2], const Unit& u, int wr, int wc, int fr, int fq) const {
        const int row0 = u.pm * BM + wr * 64 + fr; const int f0 = (u.pn & 3) * 128 + wc * 16 + 4 * fq;
#pragma unroll
        for (int ai = 0; ai < 2; ++ai)
#pragma unroll
            for (int m = 0; m < 4; ++m) { bf16_t* rowp = O + (size_t)(row0 + ai * HALF + m * 16) * 512 + f0;
#pragma unroll
                for (int bj = 0; bj < 2; ++bj) { const f32x4 v0 = acc[ai][bj][m][0], v1 = acc[ai][bj][m][1];
                    float r[4]; const float a[4] = {v0[0], v0[2], v1[0], v1[2]}, b[4] = {v0[1], v0[3], v1[1], v1[3]};
#pragma unroll
                    for (int q = 0; q < 4; ++q) r[q] = a[q] * b[q] * __builtin_amdgcn_rcpf(1.0f + __builtin_amdgcn_exp2f(-1.4426950408889634f * a[q]));
                    typedef unsigned u32x2 __attribute__((ext_vector_type(2)));
                    u32x2 w; w.x = cvt_pk_bf16(r[0], r[1]); w.y = cvt_pk_bf16(r[2], r[3]);
                    *(u32x2*)(rowp + bj * 64) = w; } }
    }
};
struct MoeOrder {
    unsigned pk[4]; int njs, G, c;
    __device__ __forceinline__ void init(const unsigned* cnt, int njs_, int G_, int c_) {
        njs = njs_; G = G_; c = c_; unsigned t = 0; pk[0] = pk[1] = pk[2] = pk[3] = 0u;
#pragma unroll
        for (int e = 0; e < 16; ++e) { t += (__builtin_amdgcn_readfirstlane(cnt[e]) + 255u) >> 8; pk[e >> 2] |= t << (8 * (e & 3)); }
    }
    __device__ __forceinline__ bool next(int i, Unit& u) const {
        const int L = i * G + c, rt = L >> njs, j = L & ((1 << njs) - 1);
        if (rt >= (int)(pk[3] >> 24)) return false;
        int e = 0;
#pragma unroll
        for (int q = 0; q < 16; ++q) e += ((int)((pk[q >> 2] >> (8 * (q & 3))) & 255u) <= rt) ? 1 : 0;
        u.pm = rt; u.pn = (e << njs) + j; return true;
    }
    __device__ __forceinline__ void a_ready(const Unit&) const {}
    __device__ __forceinline__ void done(const Unit&) const {}
};

template <class Epi, class Sched, bool ALIGN_EPI = false, bool SP2 = false>
__device__ __forceinline__ void gemm_phase(const int wave_id  , PG8_LAS unsigned char* lds, const Gemm g, const Sched& S, const Epi& E) {
    int lid_; asm volatile("v_mbcnt_lo_u32_b32 %0, -1, 0\n\tv_mbcnt_hi_u32_b32 %0, -1, %0" : "=v"(lid_)); const int tid_ = (wave_id << 6) + lid_;
    const int tid = tid_, wid = wave_id, lane = tid & 63, wr = wid >> 2, wc = wid & 3, fr = lane & 15, fq = lane >> 4;
    const int K = g.K, nt = K / BK;
    unsigned voffA[2], voffB[2];
#pragma unroll
    for (int i = 0; i < 2; ++i) { int R, C; stage_rc(tid * 16 + i * 8192, R, C); const int Rb = Epi::PERM ? ((R & ~31) + perm32(R & 31)) : R;
        voffA[i] = (unsigned)(R * K + C) * 2u; voffB[i] = (unsigned)(Rb * K + C) * 2u; }
    const size_t kstep = (size_t)(BK * 2);
    const size_t hstep = (size_t)HALF * K * 2;
    const size_t tstep = 2 * hstep;
    const unsigned ldsw = (unsigned)wid * 1024u;
    const int aoff = lds_byte(wr * 64 + fr, fq * 8), boff = lds_byte(wc * 32 + fr, fq * 8);
#define PG8_SA(b, h) (((b) * 2 + (h)) * HTB)
#define PG8_SB(b, h) ((4 + (b) * 2 + (h)) * HTB)
#define PG8_STAGE(bufoff, gbase, voff) do { _Pragma("unroll") for (int _i = 0; _i < 2; ++_i) \
        __builtin_amdgcn_global_load_lds((const unsigned*)((const char*)(gbase) + (voff)[_i]), (PG8_LAS unsigned*)(lds + (bufoff) + ldsw + _i * 8192), 16, 0, 0); } while (0)
#define PG8_LDA(dst, b, h) do { _Pragma("unroll") for (int m = 0; m < 4; ++m) _Pragma("unroll") for (int k = 0; k < 2; ++k) dst[m][k] = *(const PG8_LAS bf16x8*)(lds + PG8_SA(b, h) + aoff + m * 2048 + k * 1024); } while (0)
#define PG8_LDB(dst, b, h) do { _Pragma("unroll") for (int n = 0; n < 2; ++n) _Pragma("unroll") for (int k = 0; k < 2; ++k) dst[n][k] = *(const PG8_LAS bf16x8*)(lds + PG8_SB(b, h) + boff + n * 2048 + k * 1024); } while (0)
#define PG8_MMA(ai, bj, At, Bt) do { __builtin_amdgcn_s_setprio(1); _Pragma("unroll") for (int m = 0; m < 4; ++m) _Pragma("unroll") for (int n = 0; n < 2; ++n) _Pragma("unroll") for (int k = 0; k < 2; ++k) \
        acc[ai][bj][m][n] = __builtin_amdgcn_mfma_f32_16x16x32_bf16(Bt[n][k], At[m][k], acc[ai][bj][m][n], 0, 0, 0); __builtin_amdgcn_s_setprio(0); } while (0)
#define PG8_WAIT_V(n) asm volatile("s_waitcnt vmcnt(" #n ")" ::: "memory")
#define PG8_WAIT_L(n) asm volatile("s_waitcnt lgkmcnt(" #n ")" ::: "memory")
#define PG8_BAR __builtin_amdgcn_s_barrier()
#define PG8_SCHED __builtin_amdgcn_sched_barrier(0)
    Unit cur, nxt; int ui = 0;
    if (!S.next(0, cur)) return;
    f32x4 acc[2][2][4][2];
#pragma unroll
    for (int a = 0; a < 2; ++a)
#pragma unroll
        for (int b = 0; b < 2; ++b)
#pragma unroll
            for (int m = 0; m < 4; ++m)
#pragma unroll
                for (int n = 0; n < 2; ++n) acc[a][b][m][n] = (f32x4){0.f, 0.f, 0.f, 0.f};
    bf16x8 At[4][2], B0[2][2], B1[2][2];
    const char* cA = (const char*)g.A + (size_t)cur.pm * tstep; const char* cB = (const char*)g.Bt + (size_t)cur.pn * tstep;
    S.a_ready(cur);
    if constexpr (SP2) {
        PG8_STAGE(PG8_SB(0, 0), cB, voffB); PG8_STAGE(PG8_SB(0, 1), cB + hstep, voffB); PG8_STAGE(PG8_SA(0, 0), cA, voffA); PG8_STAGE(PG8_SA(0, 1), cA + hstep, voffA);
        if (wr == 1) PG8_BAR;
        PG8_WAIT_V(2); PG8_BAR;
        PG8_STAGE(PG8_SB(1, 0), cB + kstep, voffB); PG8_STAGE(PG8_SA(1, 0), cA + kstep, voffA); PG8_STAGE(PG8_SB(1, 1), cB + hstep + kstep, voffB);
        PG8_WAIT_V(6); PG8_BAR;
    } else {
        PG8_STAGE(PG8_SB(0, 0), cB, voffB); PG8_STAGE(PG8_SA(0, 0), cA, voffA); PG8_STAGE(PG8_SB(0, 1), cB + hstep, voffB); PG8_STAGE(PG8_SA(0, 1), cA + hstep, voffA);
        if (wr == 1) PG8_BAR;
        PG8_WAIT_V(4); PG8_BAR;
        PG8_STAGE(PG8_SB(1, 0), cB + kstep, voffB); PG8_STAGE(PG8_SA(1, 0), cA + kstep, voffA); PG8_STAGE(PG8_SB(1, 1), cB + hstep + kstep, voffB);
        PG8_WAIT_V(6); PG8_BAR;
    }
    for (;;) {
        const bool has_next = S.next(ui + 1, nxt);
        const char* nA = has_next ? (const char*)g.A + (size_t)nxt.pm * tstep : cA; const char* nB = has_next ? (const char*)g.Bt + (size_t)nxt.pn * tstep : cB;
        for (int t = 0; t < nt; t += 2) {
            const bool last = (t == nt - 2);
            const char* a1 = cA + (size_t)(t + 1) * kstep;
            const char* a2 = last ? nA : cA + (size_t)(t + 2) * kstep; const char* b2 = last ? nB : cB + (size_t)(t + 2) * kstep;
            const char* a3 = a2 + kstep; const char* b3 = b2 + kstep;
            if (last && has_next) S.a_ready(nxt);
            if constexpr (SP2) {
            PG8_LDB(B0, 0, 0); PG8_LDB(B1, 0, 1); PG8_SCHED; PG8_LDA(At, 0, 0); PG8_STAGE(PG8_SA(1, 1), a1 + hstep, voffA);
            PG8_WAIT_V(8); PG8_WAIT_L(0); PG8_BAR; PG8_MMA(0, 0, At, B0); PG8_MMA(0, 1, At, B1); PG8_BAR; PG8_SCHED;
            PG8_LDA(At, 0, 1); PG8_STAGE(PG8_SB(0, 0), b2, voffB); PG8_STAGE(PG8_SB(0, 1), b2 + hstep, voffB); PG8_STAGE(PG8_SA(0, 0), a2, voffA);
            PG8_WAIT_V(8); PG8_WAIT_L(0); PG8_BAR; PG8_MMA(1, 0, At, B0); PG8_MMA(1, 1, At, B1); PG8_BAR; PG8_SCHED;
            PG8_LDB(B0, 1, 0); PG8_LDB(B1, 1, 1); PG8_SCHED; PG8_LDA(At, 1, 0); PG8_STAGE(PG8_SA(0, 1), a2 + hstep, voffA);
            PG8_WAIT_V(8); PG8_WAIT_L(0); PG8_BAR; PG8_MMA(0, 0, At, B0); PG8_MMA(0, 1, At, B1); PG8_BAR; PG8_SCHED;
            PG8_LDA(At, 1, 1); PG8_STAGE(PG8_SB(1, 0), b3, voffB); PG8_STAGE(PG8_SB(1, 1), b3 + hstep, voffB); PG8_STAGE(PG8_SA(1, 0), a3, voffA);
            PG8_WAIT_V(8); PG8_WAIT_L(0); PG8_BAR; PG8_MMA(1, 0, At, B0); PG8_MMA(1, 1, At, B1); PG8_BAR; PG8_SCHED;
            } else {
            PG8_LDB(B0, 0, 0); PG8_SCHED; PG8_LDA(At, 0, 0); PG8_STAGE(PG8_SA(1, 1), a1 + hstep, voffA);
            PG8_WAIT_L(8); PG8_BAR; PG8_WAIT_L(0); PG8_MMA(0, 0, At, B0); PG8_BAR; PG8_SCHED;
            PG8_LDB(B1, 0, 1); PG8_STAGE(PG8_SB(0, 0), b2, voffB);
            PG8_BAR; PG8_WAIT_L(0); PG8_MMA(0, 1, At, B1); PG8_BAR;
            PG8_LDA(At, 0, 1); PG8_STAGE(PG8_SA(0, 0), a2, voffA);
            PG8_BAR; PG8_WAIT_L(0); PG8_MMA(1, 0, At, B0); PG8_BAR; PG8_SCHED;
            PG8_STAGE(PG8_SB(0, 1), b2 + hstep, voffB);
            PG8_WAIT_V(6); PG8_BAR; PG8_MMA(1, 1, At, B1); PG8_BAR;
            PG8_LDB(B0, 1, 0); PG8_SCHED; PG8_LDA(At, 1, 0); PG8_STAGE(PG8_SA(0, 1), a2 + hstep, voffA);
            PG8_WAIT_L(8); PG8_BAR; PG8_WAIT_L(0); PG8_MMA(0, 0, At, B0); PG8_BAR; PG8_SCHED;
            PG8_LDB(B1, 1, 1); PG8_STAGE(PG8_SB(1, 0), b3, voffB);
            PG8_BAR; PG8_WAIT_L(0); PG8_MMA(0, 1, At, B1); PG8_BAR;
            PG8_LDA(At, 1, 1); PG8_STAGE(PG8_SA(1, 0), a3, voffA);
            PG8_BAR; PG8_WAIT_L(0); PG8_MMA(1, 0, At, B0); PG8_BAR; PG8_SCHED;
            PG8_STAGE(PG8_SB(1, 1), b3 + hstep, voffB);
            PG8_WAIT_V(6); PG8_BAR; PG8_MMA(1, 1, At, B1); PG8_BAR;
            }
        }
        if constexpr (ALIGN_EPI) { if (wr == 0) PG8_BAR; }
        if constexpr (!Epi::AFTER_DRAIN) { E(acc, cur, wr, wc, fr, fq); S.done(cur); }
        if (!has_next) break;
#pragma unroll
        for (int a = 0; a < 2; ++a)
#pragma unroll
            for (int b = 0; b < 2; ++b)
#pragma unroll
                for (int m = 0; m < 4; ++m)
#pragma unroll
                    for (int n = 0; n < 2; ++n) acc[a][b][m][n] = (f32x4){0.f, 0.f, 0.f, 0.f};
        cur = nxt; cA = nA; cB = nB; ++ui;
        if constexpr (ALIGN_EPI) { if (wr == 1) PG8_BAR; }
    }
    PG8_WAIT_V(0);
    if constexpr (!ALIGN_EPI) { if (wr == 0) PG8_BAR; }
    PG8_BAR;
    if constexpr (Epi::AFTER_DRAIN) { E.fused(acc, cur, wr, wc, fr, fq, lds, wid, lane); S.done(cur); }
#undef PG8_SA
#undef PG8_SB
#undef PG8_STAGE
#undef PG8_LDA
#undef PG8_LDB
#undef PG8_MMA
#undef PG8_WAIT_V
#undef PG8_WAIT_L
#undef PG8_BAR
#undef PG8_SCHED
}
}

#ifndef PG8_SP2
#define PG8_SP2 true
#endif
#ifndef PG8_ALIGN
#define PG8_ALIGN true
#endif
constexpr int NWAVES = 8;
constexpr int BATCH = 2, SEQ = 8192, DM = 2048, M = BATCH * SEQ;
constexpr int NQKV = 6144, NQKV_ODD = 6160;
constexpr int NE = 16, FFE = 512;
constexpr int MODW = 6 * DM;
constexpr float EPS = 1e-6f;
constexpr int MAXROWS = 36864;

constexpr size_t MiB = 1u << 20;
constexpr size_t WS_CTL = 0, CTL_ZERO_BYTES = 1 * MiB;
constexpr size_t WS_MOD = 1 * MiB;
constexpr size_t WS_LAM = WS_MOD + 2 * 2 * MODW * 4;
constexpr size_t WS_KMEAN = 2 * MiB;
constexpr size_t WS_WFG = 3 * MiB;
constexpr size_t WS_WRT = 3 * MiB + 128 * 1024;
constexpr size_t WS_ROUTE = 4 * MiB;
constexpr size_t WS_LOGF = 5 * MiB;
constexpr size_t WS_CUM = 6 * MiB;
constexpr size_t WS_KN = 7 * MiB;
constexpr size_t WS_OA0 = 8 * MiB;
constexpr size_t WS_MLO = 4 * MiB + 512 * 1024;
constexpr size_t WS_VM = 6 * MiB;
constexpr size_t WS_WIN = 40 * MiB;
constexpr size_t WS_WOUT = 88 * MiB;
constexpr size_t WS_W13 = 104 * MiB;
constexpr size_t WS_W2 = 232 * MiB;
constexpr size_t WS_H = 296 * MiB;
constexpr size_t WS_QKV = 360 * MiB;
constexpr size_t WS_MRG = 552 * MiB;
constexpr size_t WS_ACT = 616 * MiB;
constexpr size_t WS_OSL = 652 * MiB;
constexpr size_t WS_OA1 = WS_ACT;
constexpr size_t WS_PART = WS_OSL;
constexpr size_t WS_MLP = WS_OSL + 96 * MiB;
constexpr size_t WS_LIST = WS_OSL + 100 * MiB;
constexpr size_t WS_END = 796 * MiB;
constexpr int CW_TMO = 0;
constexpr int CW_CNT = 1024;
constexpr int CW_LC = 1536;
constexpr int CW_Q = 2048;
constexpr int CW_BAR = 4096;

constexpr int RING_OFF = 0, RING_BYTES = 131072;
constexpr int LDSCTL_OFF = RING_BYTES, MISC_OFF = LDSCTL_OFF + 320;
constexpr int LDS_BYTES = 147456;

#define GAS __attribute__((address_space(1)))
#define LAS __attribute__((address_space(3)))
typedef unsigned short bf16;
typedef unsigned v4u __attribute__((ext_vector_type(4)));
typedef unsigned v2u __attribute__((ext_vector_type(2)));
typedef float f32x4 __attribute__((ext_vector_type(4)));
typedef float f32x16 __attribute__((ext_vector_type(16)));
typedef short bf16x8 __attribute__((ext_vector_type(8)));
typedef short s16x4 __attribute__((ext_vector_type(4)));
typedef GAS unsigned gu32;
#define RLX_AGENT __ATOMIC_RELAXED, __HIP_MEMORY_SCOPE_AGENT
#define LDS_WAIT() asm volatile("s_waitcnt lgkmcnt(0)" ::: "memory")
#define VM_WAIT() asm volatile("s_waitcnt vmcnt(0)" ::: "memory")
__device__ __forceinline__ unsigned f2bf(float f) { unsigned u = __builtin_bit_cast(unsigned, f); return (u + 0x7fffu + ((u >> 16) & 1u)) >> 16; }
__device__ __forceinline__ unsigned pk2(float lo, float hi) { return f2bf(lo) | (f2bf(hi) << 16); }
__device__ __forceinline__ float bflo(unsigned w) { return __builtin_bit_cast(float, w << 16); }
__device__ __forceinline__ float bfhi(unsigned w) { return __builtin_bit_cast(float, w & 0xffff0000u); }
#define ARGS_T const __attribute__((address_space(4))) Args&
__device__ __forceinline__ int lane_id_asm() { int l; asm volatile("v_mbcnt_lo_u32_b32 %0, -1, 0\n\tv_mbcnt_hi_u32_b32 %0, -1, %0" : "=v"(l)); return l; }
__device__ __forceinline__ int opaque_tid(int wave) { return (wave << 6) + lane_id_asm(); }
__device__ __forceinline__ float wave_sum(float v) {
#pragma unroll
    for (int o = 1; o < 64; o <<= 1) v += __shfl_xor(v, o);
    return v;
}
__device__ __forceinline__ float wave_max(float v) {
#pragma unroll
    for (int o = 1; o < 64; o <<= 1) v = fmaxf(v, __shfl_xor(v, o));
    return v;
}
#define XB_TMO      128
#define XB_XCNT(j)  (256  + 64 * (j))
#define XB_XSUB(j)  (1280 + 64 * (j))
#define XB_XGEN(j)  (2304 + 64 * (j))
#define XB_TOP      3328
#define XB_TOPGEN   3392
#define XCD_BAR_WORDS 3456
#define XB_SPIN_CAP (1u << 18)

__device__ __forceinline__ unsigned xb_ld(unsigned* p)              { return __hip_atomic_load(p, __ATOMIC_RELAXED, __HIP_MEMORY_SCOPE_AGENT); }
__device__ __forceinline__ unsigned xb_add(unsigned* p, unsigned v) { return __hip_atomic_fetch_add(p, v, __ATOMIC_RELAXED, __HIP_MEMORY_SCOPE_AGENT); }
__device__ __forceinline__ unsigned xb_xcc_id() { return (unsigned)__builtin_amdgcn_s_getreg((3 << 11) | 20) & 0xFu; }
#define XB_SPIN(cond, bar) do { unsigned _sp = 0; while (cond) { __builtin_amdgcn_s_sleep(1); \
    if ((++_sp & 255u) == 0u) { if (xb_ld(&(bar)[XB_TMO])) break; if (_sp > XB_SPIN_CAP) { atomicAdd(&(bar)[XB_TMO], 1u); break; } } } } while (0)

struct XcdBarrier {
    unsigned* bar; unsigned x;
    volatile LAS unsigned* st;
    int w;
};

__device__ __forceinline__ XcdBarrier xcd_barrier_post(unsigned* bar, volatile LAS unsigned* st) {
    XcdBarrier b; b.bar = bar; b.x = xb_xcc_id(); b.st = st;
    if (threadIdx.x == 0) (void)xb_add(&bar[XB_XCNT(b.x)], 1u);
    return b;
}
__device__ __forceinline__ void xcd_barrier_complete(unsigned* bar, unsigned x, unsigned& nloc, unsigned& nx) {
    const unsigned G = gridDim.x * gridDim.y * gridDim.z;
    unsigned sum, cnt, mine, sp = 0u;
    for (;;) {
        sum = 0u; cnt = 0u; mine = 0u;
#pragma unroll
        for (unsigned j = 0; j < 16; ++j) { const unsigned c = xb_ld(&bar[XB_XCNT(j)]); sum += c; cnt += (c > 0u) ? 1u : 0u; mine = (j == x) ? c : mine; }
        if (sum == G) break;
        __builtin_amdgcn_s_sleep(1);
        if ((++sp & 255u) == 0u) { if (xb_ld(&bar[XB_TMO])) break; if (sp > XB_SPIN_CAP) { atomicAdd(&bar[XB_TMO], 1u); break; } }
    }
    nloc = mine > 0u ? mine : 1u; nx = cnt > 0u ? cnt : 1u;
}

__device__ __forceinline__ void xcd_barrier(const XcdBarrier& b) {
    asm volatile("s_waitcnt vmcnt(0)" ::: "memory");
    __syncthreads();
    if (b.w == 0 && lane_id_asm() == 0) {
        unsigned* bar = b.bar;
        __builtin_amdgcn_s_waitcnt(0);
        unsigned nloc = b.st[0], nx = b.st[1];
        if (nloc == 0u) { xcd_barrier_complete(bar, b.x, nloc, nx); b.st[0] = nloc; b.st[1] = nx; }
        const unsigned old = xb_add(&bar[XB_XSUB(b.x)], 1u);
        const unsigned gen = old / nloc;
        if (old + 1u == (gen + 1u) * nloc) {
            __builtin_amdgcn_fence(__ATOMIC_RELEASE, "agent");
            asm volatile("s_waitcnt vmcnt(0)" ::: "memory");
            const unsigned og = xb_add(&bar[XB_TOP], 1u);
            const unsigned tg = og / nx;
            if (og + 1u == (tg + 1u) * nx) xb_add(&bar[XB_TOPGEN], 1u);
            else XB_SPIN(xb_ld(&bar[XB_TOPGEN]) == tg, bar);
            __builtin_amdgcn_fence(__ATOMIC_ACQUIRE, "agent");
            xb_add(&bar[XB_XGEN(b.x)], 1u);
            asm volatile("s_waitcnt vmcnt(0)" ::: "memory");
        } else {
            XB_SPIN(xb_ld(&bar[XB_XGEN(b.x)]) == gen, bar);
            __builtin_amdgcn_fence(__ATOMIC_ACQUIRE, "agent");
            asm volatile("s_waitcnt vmcnt(0)" ::: "memory");
        }
    }
    __syncthreads();
}
struct Args { const float* in[22]; float* out; unsigned char* ws; int ph_lo, ph_hi; };
struct Frame { LAS unsigned char* lds; volatile LAS unsigned* MISC; gu32* ctl; int tid, lane, wave, vcu, G; };
enum { I_X = 0, I_C = 1, I_ADAW = 2, I_ADAB = 3, I_ANG = 4, I_FNG = 5, I_WINE = 6, I_WOUTE = 7, I_LQ1 = 8, I_LK1 = 9, I_LQ2 = 10, I_LK2 = 11, I_SUBLN = 12,
       I_WINO = 13, I_BF = 14, I_WOUTO = 15, I_RW = 16, I_RB = 17, I_W1 = 18, I_W3 = 19, I_W2 = 20, I_FING = 21 };

__device__ __forceinline__ void transpose_item(const float* W, int ldw, int K, int ncols, bf16* WT, int row_off, int rs, LAS float* scr, int item, int lane) {
    const int nblk = ncols / 32, kb = item / nblk, nb = item % nblk, k0 = 64 * kb, n0 = 32 * nb;
    float t[32];
    { const float* wp = W + (size_t)(k0 + (lane >> 5)) * ldw + n0 + (lane & 31);
#pragma unroll
      for (int i = 0; i < 32; ++i) t[i] = wp[(size_t)(2 * i) * ldw]; }
#pragma unroll
    for (int i = 0; i < 32; ++i) scr[(2 * i + (lane >> 5)) * 33 + (lane & 31)] = t[i];
    LDS_WAIT(); asm volatile("" ::: "memory");
    const int c = lane & 7;
#pragma unroll
    for (int j = 0; j < 4; ++j) { const int n = (lane >> 3) + 8 * j; const LAS float* s = scr + (8 * c) * 33 + n;
        v4u o; o.x = pk2(s[0 * 33], s[1 * 33]); o.y = pk2(s[2 * 33], s[3 * 33]); o.z = pk2(s[4 * 33], s[5 * 33]); o.w = pk2(s[6 * 33], s[7 * 33]);
        *(GAS v4u*)(WT + (size_t)(row_off + (n0 + n) * rs) * K + k0 + 8 * c) = o; }
    LDS_WAIT(); asm volatile("" ::: "memory");
}
constexpr int CV_IN = 32 * 192, CV_OUT = 32 * 64, CV_MOEL = 16 * 512;
constexpr int CV_A = CV_IN + 2 * CV_OUT + 3 * CV_MOEL, CV_B = 3 * CV_MOEL;
constexpr int CV_PER_WG = 128, CV_A_WG = CV_A / CV_PER_WG, CV_B_WG = CV_B / CV_PER_WG;
static_assert(CV_A % CV_PER_WG == 0 && CV_B % CV_PER_WG == 0, "conversion deal");
__device__ __forceinline__ void convert_moe(ARGS_T A, int l, int r  , LAS float* scr, int lane) {
    unsigned char* ws = A.ws; const int which = r / CV_MOEL, rr = r - which * CV_MOEL, e = rr >> 9, le = l * 16 + e;
    if (which < 2) transpose_item(A.in[which ? I_W3 : I_W1] + (size_t)le * DM * FFE, FFE, DM, FFE, (bf16*)(ws + WS_W13) + (size_t)l * 16384 * DM, e * 1024 + which, 2, scr, rr & 511, lane);
    else transpose_item(A.in[I_W2] + (size_t)le * FFE * DM, DM, FFE, DM, (bf16*)(ws + WS_W2) + (size_t)l * 32768 * FFE, e * 2048, 1, scr, rr & 511, lane);
}
__device__ __forceinline__ void convert_item_A(ARGS_T A, int r, LAS float* scr, int lane) {
    unsigned char* ws = A.ws;
    if (r < CV_IN) { transpose_item(A.in[I_WINO], NQKV_ODD, DM, NQKV, (bf16*)(ws + WS_WIN) + (size_t)NQKV * DM, 0, 1, scr, r, lane); return; } r -= CV_IN;
    if (r < CV_OUT) { transpose_item(A.in[I_WOUTE], DM, DM, DM, (bf16*)(ws + WS_WOUT), 0, 1, scr, r, lane); return; } r -= CV_OUT;
    if (r < CV_OUT) { transpose_item(A.in[I_WOUTO], DM, DM, DM, (bf16*)(ws + WS_WOUT) + (size_t)DM * DM, 0, 1, scr, r, lane); return; } r -= CV_OUT;
    convert_moe(A, 0, r, scr, lane);
}
template <int LIST>
__device__ __forceinline__ void convert_wg_item(ARGS_T A, LAS unsigned char* lds, int wave, int wgitem) {
    const int lane = lane_id_asm();
    LAS float* scr = (LAS float*)(lds + wave * 16384);
    const int base = wgitem * CV_PER_WG + wave * (CV_PER_WG / NWAVES);
    for (int k = 0; k < CV_PER_WG / NWAVES; ++k) { if (LIST == 0) convert_item_A(A, base + k, scr, lane); else convert_moe(A, 1, base + k, scr, lane); }
}
__device__ __forceinline__ void p0_prologue(ARGS_T A, const Frame& F0) {
    Frame F = F0; F.tid = opaque_tid(F0.wave); F.lane = F.tid & 63; F.wave = __builtin_amdgcn_readfirstlane(F.tid >> 6);
    unsigned char* ws = A.ws;
    for (int it = blockIdx.x; it < 96; it += F.G) {
        LAS float* cond = (LAS float*)(F.lds); LAS float* red = (LAS float*)(F.lds + 16384);
        for (int i = F.tid; i < 4096; i += 512) { const float cv = A.in[I_C][i]; cond[i] = cv / (1.0f + __expf(-cv)); }
        __syncthreads();
        const int l = it / 48, cg = it % 48;
        const float* W = A.in[I_ADAW] + (size_t)l * DM * MODW + cg * 256 + 4 * F.lane;
        f32x4 a0 = {0.f, 0.f, 0.f, 0.f}, a1 = {0.f, 0.f, 0.f, 0.f};
        const int kb = 256 * F.wave;
#pragma unroll 8
        for (int k = 0; k < 256; ++k) { const f32x4 w = *(const f32x4*)(W + (size_t)(kb + k) * MODW); a0 += cond[kb + k] * w; a1 += cond[2048 + kb + k] * w; }
        *(LAS f32x4*)(red + (F.wave * 2 + 0) * 256 + 4 * F.lane) = a0; *(LAS f32x4*)(red + (F.wave * 2 + 1) * 256 + 4 * F.lane) = a1;
        __syncthreads();
        { const int b = F.tid >> 8, n = F.tid & 255; float s = A.in[I_ADAB][l * MODW + cg * 256 + n];
#pragma unroll
          for (int w = 0; w < 8; ++w) s += red[(w * 2 + b) * 256 + n];
          ((float*)(ws + WS_MOD))[(l * 2 + b) * MODW + cg * 256 + n] = s; }
        __syncthreads();
    }
    if (blockIdx.x == 0 && F.tid == 0) { float s1 = 0.f, s2 = 0.f;
        for (int i = 0; i < 64; ++i) { s1 += A.in[I_LQ1][i] * A.in[I_LK1][i]; s2 += A.in[I_LQ2][i] * A.in[I_LK2][i]; }
        *(float*)(ws + WS_LAM) = __expf(s1) - __expf(s2) + 0.2f; }
    for (int i = blockIdx.x * 512 + F.tid; i < 16 * DM; i += F.G * 512) { const int j = i >> 11, k = i & 2047;
        ((float*)(ws + WS_WFG))[i] = A.in[I_WINO][(size_t)k * NQKV_ODD + NQKV + j]; ((float*)(ws + WS_WRT))[i] = A.in[I_RW][k * 16 + j]; }
    LAS float* scr = (LAS float*)(F.lds + F.wave * 16384);
    const int gw = F.vcu * NWAVES + F.wave, NGW = F.G * NWAVES;
    for (int it = gw; it < CV_IN; it += NGW) transpose_item(A.in[I_WINE], NQKV, DM, NQKV, (bf16*)(ws + WS_WIN), 0, 1, scr, it, F.lane);
}
template <int MODE>
__device__ __forceinline__ void norm_phase(ARGS_T A, const Frame& F0, int l) {
    Frame F = F0; F.tid = opaque_tid(F0.wave); F.lane = F.tid & 63; F.wave = __builtin_amdgcn_readfirstlane(F.tid >> 6);
    unsigned char* ws = A.ws;
    constexpr bool SIDE = (MODE == 1 || MODE == 2), COMB = (MODE == 2 || MODE == 3);
    LAS float* WT = (LAS float*)F.lds;
    LAS unsigned* lcnt = (LAS unsigned*)(F.lds + RING_BYTES + 1024); LAS unsigned* lbase = lcnt + 16; LAS unsigned* rinfo = lcnt + 32;
    if (MODE == 1 && F.tid < 16) lcnt[F.tid] = 0u;
    if (SIDE) { const f32x4* src = (const f32x4*)(ws + (MODE == 1 ? WS_WRT : WS_WFG));
        for (int i = F.tid; i < 16 * DM / 4; i += 512) *(LAS f32x4*)(WT + 4 * i) = src[i];
        __syncthreads(); }
    int krow = 0;
    const float* modl = (const float*)(ws + WS_MOD) + (size_t)l * 2 * MODW;
    const float* gain = MODE == 3 ? A.in[I_FING] : (MODE == 1 ? A.in[I_FNG] + l * DM : A.in[I_ANG] + l * DM);
    const int lprev = MODE == 1 ? l : (MODE == 3 ? 1 : 0);
    const float* xsrc = (MODE == 0 || lprev == 0) ? A.in[I_X] : A.out;
    const float* modprev = (const float*)(ws + WS_MOD) + (size_t)lprev * 2 * MODW;
    const bf16* Y = (const bf16*)(ws + WS_H);
    const unsigned* route = (const unsigned*)(ws + WS_ROUTE);
    const bf16* OSL = (const bf16*)(ws + WS_OSL);
    bf16* H = (bf16*)(ws + (MODE == 1 ? WS_MRG : WS_H));
    const int gw = F.vcu * NWAVES + F.wave, NGW = F.G * NWAVES, lane = F.lane;
    for (int m = gw; m < M; m += NGW) {
        const int b = m >> 13;
        f32x4 v[8];
        { const f32x4* xr = (const f32x4*)(xsrc + (size_t)m * DM) + lane;
#pragma unroll
          for (int j = 0; j < 8; ++j) v[j] = xr[64 * j]; }
        if (MODE != 0) {
            const v2u* yp = (const v2u*)(Y + (size_t)m * DM) + lane; const f32x4* g1 = (const f32x4*)(modprev + (size_t)b * MODW + 2 * DM) + lane;
#pragma unroll
            for (int j = 0; j < 8; ++j) { const v2u a = yp[64 * j]; const f32x4 g = g1[64 * j];
                v[j].x += g.x * bflo(a.x); v[j].y += g.y * bfhi(a.x); v[j].z += g.z * bflo(a.y); v[j].w += g.w * bfhi(a.y); }
        }
        if (COMB) {
            const unsigned* rt = route + (size_t)m * 6;
            const float w0 = __builtin_bit_cast(float, rt[2]), w1 = __builtin_bit_cast(float, rt[3]);
            const v2u* o0 = (const v2u*)(OSL + (size_t)rt[4] * DM) + lane; const v2u* o1 = (const v2u*)(OSL + (size_t)rt[5] * DM) + lane;
            const f32x4* g2 = (const f32x4*)(modprev + (size_t)b * MODW + 5 * DM) + lane;
#pragma unroll
            for (int j = 0; j < 8; ++j) { const v2u a = o0[64 * j], c = o1[64 * j]; const f32x4 g = g2[64 * j];
                v[j].x += g.x * (w0 * bflo(a.x) + w1 * bflo(c.x)); v[j].y += g.y * (w0 * bfhi(a.x) + w1 * bfhi(c.x));
                v[j].z += g.z * (w0 * bflo(a.y) + w1 * bflo(c.y)); v[j].w += g.w * (w0 * bfhi(a.y) + w1 * bfhi(c.y)); }
            if (MODE == 2) { f32x4* xw = (f32x4*)(A.out + (size_t)m * DM) + lane;
#pragma unroll
                for (int j = 0; j < 8; ++j) xw[64 * j] = v[j]; }
        }
        float ss = 0.f;
#pragma unroll
        for (int j = 0; j < 8; ++j) ss += (v[j].x * v[j].x + v[j].y * v[j].y) + (v[j].z * v[j].z + v[j].w * v[j].w);
        const float rstd = 1.0f / sqrtf(wave_sum(ss) * (1.0f / DM) + EPS);
        if (MODE == 3) {
            f32x4* ow = (f32x4*)(A.out + (size_t)m * DM) + lane; const f32x4* gp = (const f32x4*)gain + lane;
#pragma unroll
            for (int j = 0; j < 8; ++j) ow[64 * j] = v[j] * rstd * gp[64 * j];
            continue;
        }
        { const f32x4* gp = (const f32x4*)gain + lane;
          const f32x4* shp = (const f32x4*)(modl + (size_t)b * MODW + (MODE == 1 ? 3 : 0) * DM) + lane;
          const f32x4* scp = (const f32x4*)(modl + (size_t)b * MODW + (MODE == 1 ? 4 : 1) * DM) + lane;
          v2u* hw = (v2u*)(H + (size_t)m * DM) + lane;
#pragma unroll
          for (int j = 0; j < 8; ++j) { v[j] = v[j] * rstd * gp[64 * j] * (1.0f + scp[64 * j]) + shp[64 * j];
              v2u o; o.x = pk2(v[j].x, v[j].y); o.y = pk2(v[j].z, v[j].w); hw[64 * j] = o; } }
        if (SIDE) {
            float z = 0.f;
#pragma unroll 1
            for (int q = 0; q < 16; ++q) { float d = 0.f;
#pragma unroll
                for (int j = 0; j < 8; ++j) { const f32x4 w = *(const LAS f32x4*)(WT + q * DM + 256 * j + 4 * lane); d += (v[j].x * w.x + v[j].y * w.y) + (v[j].z * w.z + v[j].w * w.w); }
                d = wave_sum(d); if (lane == q) z = d; }
            if (MODE == 2) {
                if (lane < 16) { z += A.in[I_BF][lane]; const float r = z >= 0.f ? -log1pf(__expf(-z)) : z - log1pf(__expf(z));
                    ((float*)(ws + WS_LOGF))[(size_t)m * 16 + lane] = r; }
            } else {
                float aff[16], sel[16];
#pragma unroll
                for (int q = 0; q < 16; ++q) { const float lgq = __shfl(z, q); aff[q] = 1.0f / (1.0f + __expf(-lgq)); sel[q] = aff[q] + A.in[I_RB][q]; }
                int best = 0; float bs = -3.0e38f;
#pragma unroll
                for (int g = 0; g < 4; ++g) { const float a = sel[4 * g], bq = sel[4 * g + 1], c = sel[4 * g + 2], d = sel[4 * g + 3];
                    const float t2 = fmaxf(fmaxf(fmaxf(a + bq, a + c), fmaxf(a + d, bq + c)), fmaxf(bq + d, c + d));
                    if (t2 > bs) { bs = t2; best = g; } }
                float cs[4], ca[4];
#pragma unroll
                for (int i = 0; i < 4; ++i) { cs[i] = sel[i]; ca[i] = aff[i]; }
#pragma unroll
                for (int g = 1; g < 4; ++g) if (best == g) {
#pragma unroll
                    for (int i = 0; i < 4; ++i) { cs[i] = sel[4 * g + i]; ca[i] = aff[4 * g + i]; } }
                int i1 = 0; float s1 = cs[0], a1 = ca[0];
#pragma unroll
                for (int i = 1; i < 4; ++i) if (cs[i] > s1) { s1 = cs[i]; a1 = ca[i]; i1 = i; }
                int i2 = -1; float s2 = -3.0e38f, a2 = 0.f;
#pragma unroll
                for (int i = 0; i < 4; ++i) if (i != i1 && cs[i] > s2) { s2 = cs[i]; a2 = ca[i]; i2 = i; }
                const int e0 = best * 4 + i1, e1 = best * 4 + i2; const float inv = 1.0f / (a1 + a2);
                if (lane == 0) {
                    const unsigned p0 = __hip_atomic_fetch_add((unsigned*)(lcnt + e0), 1u, __ATOMIC_RELAXED, __HIP_MEMORY_SCOPE_WORKGROUP), p1 = __hip_atomic_fetch_add((unsigned*)(lcnt + e1), 1u, __ATOMIC_RELAXED, __HIP_MEMORY_SCOPE_WORKGROUP);
                    unsigned* rt = (unsigned*)(ws + WS_ROUTE) + (size_t)m * 6;
                    rt[0] = (unsigned)e0; rt[1] = (unsigned)e1; rt[2] = __builtin_bit_cast(unsigned, a1 * inv); rt[3] = __builtin_bit_cast(unsigned, a2 * inv);
                    LAS unsigned* ri = rinfo + (F.wave * 16 + (krow & 15)) * 4; ri[0] = (unsigned)e0; ri[1] = (unsigned)e1; ri[2] = p0; ri[3] = p1; }
                ++krow;
            }
        }
    }
    if (MODE == 1) {
        __syncthreads();
        if (F.tid < 16) lbase[F.tid] = __hip_atomic_fetch_add((unsigned*)(F.ctl + CW_CNT + 64 * l) + F.tid, lcnt[F.tid], RLX_AGENT);
        __syncthreads();
        if (F.tid < 128) { const int w = F.tid >> 4, k = F.tid & 15; const int m = (F.vcu * NWAVES + w) + k * NGW;
            if (m < M) { const LAS unsigned* ri = rinfo + (w * 16 + k) * 4; unsigned* rt = (unsigned*)(ws + WS_ROUTE) + (size_t)m * 6; rt[4] = lbase[ri[0]] + ri[2]; rt[5] = lbase[ri[1]] + ri[3]; } }
    }
}
__device__ __forceinline__ void scan_phase(ARGS_T A, const Frame& F0) {
    Frame F = F0; F.tid = opaque_tid(F0.wave); F.lane = F.tid & 63; F.wave = __builtin_amdgcn_readfirstlane(F.tid >> 6);
    const float* LOGF = (const float*)(A.ws + WS_LOGF); float* CUM = (float*)(A.ws + WS_CUM);
    LAS float* wt = (LAS float*)F.lds;
    for (int u = blockIdx.x; u < BATCH * 16; u += F.G) {
        const int b = u >> 4, h = u & 15, s0 = F.tid * 16;
        float v[16]; float run = 0.f;
#pragma unroll
        for (int i = 0; i < 16; ++i) { run += LOGF[(size_t)(b * SEQ + s0 + i) * 16 + h]; v[i] = run; }
        float inc = run;
#pragma unroll
        for (int o = 1; o < 64; o <<= 1) { const float t = __shfl_up(inc, o); if (F.lane >= o) inc += t; }
        if (F.lane == 63) wt[F.wave] = inc;
        __syncthreads();
        float base = inc - run;
        for (int w = 0; w < F.wave; ++w) base += wt[w];
        float* dst = CUM + (size_t)(b * 16 + h) * SEQ + s0;
#pragma unroll
        for (int i = 0; i < 16; ++i) dst[i] = -(base + v[i]) * 11.313708498984761f;
        __syncthreads();
    }
}
__device__ __forceinline__ void kmean_phase(ARGS_T A, const Frame& F0) {
    Frame F = F0; F.tid = opaque_tid(F0.wave); F.lane = F.tid & 63; F.wave = __builtin_amdgcn_readfirstlane(F.tid >> 6);
    const bf16* QKV = (const bf16*)(A.ws + WS_QKV); float* KM = (float*)(A.ws + WS_KMEAN);
    LAS float* red = (LAS float*)F.lds;
    for (int u = blockIdx.x; u < BATCH * 8 * 32; u += F.G) {
        const int b = u >> 8, h = (u >> 5) & 7, blk = u & 31, c = F.tid & 15, rg = F.tid >> 4;
        float s[8] = {0.f, 0.f, 0.f, 0.f, 0.f, 0.f, 0.f, 0.f};
#pragma unroll
        for (int i = 0; i < 8; ++i) { const v4u w = *(const v4u*)(QKV + (size_t)(b * SEQ + blk * 256 + rg + 32 * i) * NQKV + 4096 + h * 128 + 8 * c);
            s[0] += bflo(w.x); s[1] += bfhi(w.x); s[2] += bflo(w.y); s[3] += bfhi(w.y); s[4] += bflo(w.z); s[5] += bfhi(w.z); s[6] += bflo(w.w); s[7] += bfhi(w.w); }
#pragma unroll
        for (int i = 0; i < 8; ++i) red[rg * 128 + 8 * c + i] = s[i];
        __syncthreads();
        if (F.tid < 128) { float t = 0.f;
#pragma unroll
            for (int r = 0; r < 32; ++r) t += red[r * 128 + F.tid];
            KM[(size_t)u * 128 + F.tid] = t * (1.0f / 256.0f); }
        __syncthreads();
    }
}
__device__ __forceinline__ void gather_phase(ARGS_T A, const Frame& F0, int l) {
    Frame F = F0; F.tid = opaque_tid(F0.wave); F.lane = F.tid & 63; F.wave = __builtin_amdgcn_readfirstlane(F.tid >> 6);
    const unsigned* cnt = (const unsigned*)(F.ctl + CW_CNT + 64 * l);
    unsigned basev = 0;
    { unsigned t = 0;
#pragma unroll
      for (int e = 0; e < 16; ++e) { if (F.lane == e) basev = t * 256u; t += (cnt[e] + 255u) >> 8; } }
    unsigned* route = (unsigned*)(A.ws + WS_ROUTE); const bf16* H = (const bf16*)(A.ws + WS_MRG); bf16* HS = (bf16*)(A.ws + WS_QKV);
    const int gw = F.vcu * NWAVES + F.wave, NGW = F.G * NWAVES;
    for (int m = gw; m < M; m += NGW) {
        unsigned* rt = route + (size_t)m * 6;
        const unsigned e0 = rt[0], e1 = rt[1], p0 = rt[4], p1 = rt[5];
        const unsigned s0 = __shfl(basev, (int)e0) + p0, s1 = __shfl(basev, (int)e1) + p1;
        const v4u* src = (const v4u*)(H + (size_t)m * DM) + F.lane; v4u* d0 = (v4u*)(HS + (size_t)s0 * DM) + F.lane; v4u* d1 = (v4u*)(HS + (size_t)s1 * DM) + F.lane;
        v4u x[4];
#pragma unroll
        for (int j = 0; j < 4; ++j) x[j] = src[64 * j];
#pragma unroll
        for (int j = 0; j < 4; ++j) { d0[64 * j] = x[j]; d1[64 * j] = x[j]; }
        asm volatile("" ::: "memory");
        if (F.lane == 0) { rt[4] = s0; rt[5] = s1; }
    }
}
template <int L>
__device__ __forceinline__ void knorm_phase(ARGS_T A, const Frame& F0) {
    Frame F = F0; F.tid = opaque_tid(F0.wave); F.lane = F.tid & 63; F.wave = __builtin_amdgcn_readfirstlane(F.tid >> 6);
    const bf16* QKV = (const bf16*)(A.ws + WS_QKV); float* KN = (float*)(A.ws + WS_KN);
    constexpr int DQ = L == 0 ? 64 : 128;
    for (int it = blockIdx.x; it < (L == 0 ? 384 : 256); it += F.G) {
        const int u = it >> 3, tg = it & 7;
        int b, col, nch = DQ / 8;
        if (L == 0) { if (u < 32) { b = u >> 4; col = 1024 + ((u >> 1) & 7) * 128 + (u & 1) * 64; } else { b = (u - 32) >> 3; col = 4096 + ((u - 32) & 7) * 128; nch = 16; } }
        else { b = u >> 4; col = 2048 + (u & 15) * 128; }
        float mx = 0.f;
#pragma unroll
        for (int kk = 0; kk < 2; ++kk) { const bf16* kr = QKV + (size_t)(b * SEQ + tg * 1024 + 2 * F.tid + kk) * NQKV + col; float s2 = 0.f;
#pragma unroll 8
            for (int c = 0; c < nch; ++c) { const v4u w = *(const v4u*)(kr + 8 * c);
                s2 += (bflo(w.x) * bflo(w.x) + bfhi(w.x) * bfhi(w.x)) + (bflo(w.y) * bflo(w.y) + bfhi(w.y) * bfhi(w.y)) + (bflo(w.z) * bflo(w.z) + bfhi(w.z) * bfhi(w.z)) + (bflo(w.w) * bflo(w.w) + bfhi(w.w) * bfhi(w.w)); }
            mx = fmaxf(mx, s2); }
#pragma unroll
        for (int o = 1; o < 32; o <<= 1) mx = fmaxf(mx, __shfl_xor(mx, o));
        if ((F.tid & 31) == 0) KN[(size_t)u * 128 + tg * 16 + (F.tid >> 5)] = sqrtf(mx) * 1.001f;
    }
}
#ifndef NAIVE_ATTN
#define NAIVE_ATTN 0
#endif
#if NAIVE_ATTN
template <int DQ>
__device__ __forceinline__ void naive_span(const bf16* Kp, const bf16* Vp, const LAS float* q, int kb, int ke, int pos, float scale, float slope, const float* CUMrow, float cq,
                                           float& mrun, float& lrun, float& o0, float& o1, int lane) {
    for (int kc = kb; kc < ke; kc += 64) {
        const int key = kc + lane;
        float s = 0.f;
        { const bf16* kr = Kp + (size_t)key * NQKV;
#pragma unroll
          for (int c = 0; c < DQ / 8; ++c) { const v4u w = *(const v4u*)(kr + 8 * c); const f32x4 qa = *(const LAS f32x4*)(q + 8 * c), qb = *(const LAS f32x4*)(q + 8 * c + 4);
              s += (qa.x * bflo(w.x) + qa.y * bfhi(w.x)) + (qa.z * bflo(w.y) + qa.w * bfhi(w.y)) + (qb.x * bflo(w.z) + qb.y * bfhi(w.z)) + (qb.z * bflo(w.w) + qb.w * bfhi(w.w)); } }
        s = s * scale + (CUMrow ? (CUMrow[key] - cq) * scale : slope * (float)(key - pos));
        if (key > pos || key >= ke) s = -__builtin_inff();
        const float cm = wave_max(s);
        if (cm == -__builtin_inff()) continue;
        const float mn = fmaxf(mrun, cm), al = __expf(mrun - mn), p = __expf(s - mn);
        lrun = lrun * al + wave_sum(p); o0 *= al; o1 *= al; mrun = mn;
        for (int j = 0; j < 64; ++j) { const float pj = __shfl(p, j); const unsigned vv = *(const unsigned*)(Vp + (size_t)(kc + j) * NQKV + 2 * lane); o0 += pj * bflo(vv); o1 += pj * bfhi(vv); }
    }
}
template <int VAR>
__global__ void __launch_bounds__(256) naive_attn(const bf16* __restrict__ QKV, bf16* __restrict__ MRG, const float* __restrict__ CUM, const float* __restrict__ KMEAN,
                                                  const float* __restrict__ lamp, const float* __restrict__ subg) {
    __shared__ float qs[4][128];
    constexpr int NH = VAR == 2 ? 16 : 8;
    const int wave = threadIdx.x >> 6, lane = threadIdx.x & 63;
    const long id = (long)blockIdx.x * 4 + wave; const int m = (int)(id / NH), hh = (int)(id % NH), b = m >> 13, pos = m & 8191;
    const bf16* row = QKV + (size_t)m * NQKV; const bf16* base = QKV + (size_t)b * SEQ * NQKV;
    LAS float* q = (LAS float*)qs[wave];
    if (VAR == 0) {
        const float slope = exp2f(-(2.0f * hh + 1.0f) * 0.5f);
        float O0[2], O1[2];
#pragma unroll
        for (int mp = 0; mp < 2; ++mp) {
            q[lane] = bflo((unsigned)row[hh * 128 + mp * 64 + lane]); __builtin_amdgcn_wave_barrier(); LDS_WAIT();
            float mr = -1e30f, lr = 0.f, o0 = 0.f, o1 = 0.f;
            naive_span<64>(base + 1024 + hh * 128 + mp * 64, base + 2048 + hh * 128, q, 0, pos + 1, pos, 0.125f, slope, nullptr, 0.f, mr, lr, o0, o1, lane);
            O0[mp] = o0 / lr; O1[mp] = o1 / lr; __builtin_amdgcn_wave_barrier();
        }
        const float lam = *lamp; const float a0 = O0[0] - lam * O0[1], a1 = O1[0] - lam * O1[1];
        const float r = 1.0f / sqrtf(wave_sum(a0 * a0 + a1 * a1) * (1.0f / 128.0f) + EPS);
        *(unsigned*)(MRG + (size_t)m * DM + hh * 128 + 2 * lane) = pk2(a0 * r * subg[2 * lane] * 0.8f, a1 * r * subg[2 * lane + 1] * 0.8f);
    } else if (VAR == 1) {
        const float slope = exp2f(-(float)(hh + 1));
        q[lane] = bflo((unsigned)row[3072 + hh * 128 + lane]); q[64 + lane] = bflo((unsigned)row[3072 + hh * 128 + 64 + lane]); __builtin_amdgcn_wave_barrier(); LDS_WAIT();
        const int own = pos >> 8;
        float g = -3.0e38f;
        if (lane < own) { const float* km = KMEAN + ((size_t)(b * 8 + hh) * 32 + lane) * 128; float s = 0.f;
            for (int d = 0; d < 128; ++d) s += q[d] * km[d]; g = s; }
        unsigned long long selm = 0ull;
        for (int t = 0; t < 3 && t < own; ++t) { const float mx = wave_max(g); const unsigned long long bal = __ballot(g == mx); const int pick = __ffsll((long long)bal) - 1;
            selm |= 1ull << pick; if (lane == pick) g = -3.0e38f; }
        float mr = -1e30f, lr = 0.f, o0 = 0.f, o1 = 0.f;
        for (int n = 0; n < own; ++n) if ((selm >> n) & 1ull)
            naive_span<128>(base + 4096 + hh * 128, base + 5120 + hh * 128, q, n * 256, n * 256 + 256, pos, 0.08838834764831845f, slope, nullptr, 0.f, mr, lr, o0, o1, lane);
        naive_span<128>(base + 4096 + hh * 128, base + 5120 + hh * 128, q, own * 256, pos + 1, pos, 0.08838834764831845f, slope, nullptr, 0.f, mr, lr, o0, o1, lane);
        *(unsigned*)(MRG + (size_t)m * DM + 1024 + hh * 128 + 2 * lane) = pk2(o0 / lr, o1 / lr);
    } else {
        q[lane] = bflo((unsigned)row[hh * 128 + lane]); q[64 + lane] = bflo((unsigned)row[hh * 128 + 64 + lane]); __builtin_amdgcn_wave_barrier(); LDS_WAIT();
        const float* cr = CUM + (size_t)(b * 16 + hh) * SEQ;
        float mr = -1e30f, lr = 0.f, o0 = 0.f, o1 = 0.f;
        naive_span<128>(base + 2048 + hh * 128, base + 4096 + hh * 128, q, 0, pos + 1, pos, 0.08838834764831845f, 0.f, cr, cr[pos], mr, lr, o0, o1, lane);
        *(unsigned*)(MRG + (size_t)m * DM + hh * 128 + 2 * lane) = pk2(o0 / lr, o1 / lr);
    }
}
#endif
namespace att {
constexpr int V_OFF = 0, K_OFF = 49152, C_OFF = 98304, T_OFF = 99328  , G_KM = 0, G_GT = G_KM + 17408, G_SEL = G_GT + 256 * 33 * 4, G_OR = G_SEL + 1024, ATT_LDS = G_OR + 16;
static_assert(ATT_LDS <= RING_BYTES, "attention LDS");
constexpr float THR = 8.f;
#define SBAR() __builtin_amdgcn_sched_barrier(0)
__device__ __forceinline__ int v_st(int k, int c) { const int kk = (k & ~0xC) | ((k & 4) << 1) | ((k & 8) >> 1); return ((kk >> 3) * 4 + (c >> 5)) * 512 + ((kk & 7) * 32 + (c & 31)) * 2; }
__device__ __forceinline__ int v_rd_base(int lane) { return ((lane & 3) << 3) | (((lane >> 2) & 3) << 6) | (((lane >> 4) & 1) << 5) | (((lane >> 5) & 1) << 8); }
__device__ __forceinline__ unsigned cvtpk(float lo, float hi) { unsigned r; asm volatile("v_cvt_pk_bf16_f32 %0, %1, %2" : "=v"(r) : "v"(lo), "v"(hi)); return r; }

struct TileIt { unsigned rem; int blk, sub; };
template <int VAR> __device__ __forceinline__ void ti_init(TileIt& it, unsigned mask) { it.rem = mask; it.sub = 0; it.blk = VAR == 1 ? __builtin_ctz(mask) : 0; }
template <int VAR> __device__ __forceinline__ int ti_kb(const TileIt& it) { return VAR == 1 ? it.blk * 256 + it.sub * 64 : it.sub * 64; }
template <int VAR> __device__ __forceinline__ void ti_adv(TileIt& it) { if (VAR == 1) { if (++it.sub == 4) { it.sub = 0; it.rem &= it.rem - 1u; it.blk = it.rem ? __builtin_ctz(it.rem) : 0; } } else ++it.sub; }
#define ATT_VMW(n) asm volatile("s_waitcnt vmcnt(%0)" :: "i"(n) : "memory")
#define ATT_BAR() do { asm volatile("s_waitcnt lgkmcnt(0)" ::: "memory"); __builtin_amdgcn_s_barrier(); asm volatile("" ::: "memory"); } while (0)
template <int VAR>
__device__ __forceinline__ void attn_block(const int wv, LAS unsigned char* lds, const bf16* __restrict__ Qp, const bf16* __restrict__ Kp, const bf16* __restrict__ Vp, const int P0,
                                           const float slope, const float* __restrict__ cumrow, const float* __restrict__ knrow, f32x16 (&o)[4], float& l_out) {
    constexpr int DQK = VAR == 0 ? 64 : 128, NQ = DQK / 16;
    constexpr int NKL = (VAR == 0 ? 1 : 2) + (VAR == 2 ? 1 : 0), NVL = 2;
    constexpr float SCALE = VAR == 0 ? 0.125f : 0.08838834764831845f, C2 = SCALE * 1.4426950408889634f, ISC = 1.0f / SCALE;
    const int tid = opaque_tid(wv), wid = wv, lane = tid & 63, r32 = lane & 31, hi = lane >> 5;
    const int qb = P0 >> 8, qlo = P0 + wid * 32, qpos = qlo + r32;
    bf16x8 qr[NQ];
#pragma unroll
    for (int d0 = 0; d0 < NQ; ++d0) qr[d0] = *(const bf16x8*)(Qp + (unsigned)((wid * 32 + r32) * NQKV + hi * 8) + d0 * 16);
    unsigned offK, offV;
    if (VAR == 0) { const int row = wid * 8 + (lane >> 3), c = (lane & 7) ^ ((row >> 1) & 7); offK = (unsigned)(row * NQKV + c * 8); }
    else { const int row = wid * 4 + (lane >> 4), c = (lane & 15) ^ (row & 7); offK = (unsigned)(row * NQKV + c * 8); }
    { const int t = (lane & 31) >> 2, k = (wid >> 2) * 16 + (t >> 2) * 8 + ((wid >> 1) & 1) * 4 + (t & 3), c = ((wid & 1) * 2 + (lane >> 5)) * 32 + (lane & 3) * 8; offV = (unsigned)(k * NQKV + c); }
    const unsigned vb0 = (unsigned)(uintptr_t)(lds + V_OFF) + (unsigned)v_rd_base(lane);
    const unsigned kofs0 = VAR == 0 ? (unsigned)(r32 * 128) : (unsigned)(r32 * 256 + ((hi * 16) ^ ((r32 & 7) << 4)));
    const int sw64 = ((r32 >> 1) & 7) << 4;
    static_assert(VAR != 1, "the pipelined body walks plain causal tiles (MoBA uses attn_block_s)");
    const int NT = 4 * (qb + 1);
    const float sl = slope * ISC;
    constexpr float TSKIP = 110.0f;
    LAS float* tbK = (LAS float*)(lds + T_OFF);
    LAS float* tbC = tbK + 128;
    LAS unsigned* votes = (LAS unsigned*)(tbK + 256);
    if (tid < 128) { tbK[tid] = tid < NT ? knrow[tid] : 0.f; if (VAR == 2) tbC[tid] = tid < NT ? cumrow[64 * tid + 63] : 0.f; }
    float qn;
    { float s2 = 0.f;
#pragma unroll
      for (int d0 = 0; d0 < NQ; ++d0) { const v4u w = __builtin_bit_cast(v4u, qr[d0]);
          s2 += (bflo(w.x) * bflo(w.x) + bfhi(w.x) * bfhi(w.x)) + (bflo(w.y) * bflo(w.y) + bfhi(w.y) * bfhi(w.y)) + (bflo(w.z) * bflo(w.z) + bfhi(w.z) * bfhi(w.z)) + (bflo(w.w) * bflo(w.w) + bfhi(w.w) * bfhi(w.w)); }
      auto rr = __builtin_amdgcn_permlane32_swap(__float_as_uint(s2), __float_as_uint(s2), false, false);
      qn = sqrtf(__uint_as_float(rr[0]) + __uint_as_float(rr[1])) * 1.001f; }
    __syncthreads();
    if (tid < 128) { float mx = 0.f; for (int i = 0; i <= tid; ++i) mx = fmaxf(mx, tbK[i]); asm volatile("s_waitcnt lgkmcnt(0)" ::: "memory"); __builtin_amdgcn_s_barrier(); tbK[tid] = mx; }
    else { __builtin_amdgcn_s_barrier(); }
#define KBT(t_) (64 * (NT - 1 - (t_)))
#define GLDS(src, dstoff) __builtin_amdgcn_global_load_lds((const unsigned*)(src), (LAS unsigned*)(lds + (dstoff)), 16, 0, 0)
#define STAGE_K(kb, sl_) do { const bf16* kb_ = Kp + (size_t)(kb) * NQKV + offK; GLDS(kb_, K_OFF + (sl_) * 16384 + wid * 1024); if (VAR != 0) GLDS(kb_ + 32 * NQKV, K_OFF + (sl_) * 16384 + 8192 + wid * 1024); \
        if (VAR == 2) __builtin_amdgcn_global_load_lds((const unsigned*)(cumrow + (kb) + lane), (LAS unsigned*)(lds + C_OFF + (sl_) * 256), 4, 0, 0); } while (0)
#define STAGE_V(kb, sl_) do { const bf16* vb_ = Vp + (size_t)(kb) * NQKV + offV; GLDS(vb_, V_OFF + (sl_) * 16384 + wid * 1024); GLDS(vb_ + 32 * NQKV, V_OFF + (sl_) * 16384 + 8192 + wid * 1024); } while (0)
    float m_reg = -1e30f, l_reg = 0.f;
#pragma unroll
    for (int d0 = 0; d0 < 4; ++d0)
#pragma unroll
        for (int r = 0; r < 16; ++r) o[d0][r] = 0.f;
#define QKT(P0_, P1_, kbx, ks_) do { \
        if (VAR == 2) { const LAS float* cp = (const LAS float*)(lds + C_OFF + (ks_) * 256) + 4 * hi; \
            const f32x4 c0 = *(const LAS f32x4*)(cp), c1 = *(const LAS f32x4*)(cp + 8), c2 = *(const LAS f32x4*)(cp + 16), c3 = *(const LAS f32x4*)(cp + 24); \
            const f32x4 e0 = *(const LAS f32x4*)(cp + 32), e1 = *(const LAS f32x4*)(cp + 40), e2 = *(const LAS f32x4*)(cp + 48), e3 = *(const LAS f32x4*)(cp + 56); \
            P0_ = (f32x16){c0[0], c0[1], c0[2], c0[3], c1[0], c1[1], c1[2], c1[3], c2[0], c2[1], c2[2], c2[3], c3[0], c3[1], c3[2], c3[3]}; \
            P1_ = (f32x16){e0[0], e0[1], e0[2], e0[3], e1[0], e1[1], e1[2], e1[3], e2[0], e2[1], e2[2], e2[3], e3[0], e3[1], e3[2], e3[3]}; \
        } else { const float t0_ = sl * (float)((kbx) - P0 + 4 * hi); \
            _Pragma("unroll") for (int r = 0; r < 16; ++r) { P0_[r] = __builtin_fmaf(sl, (float)((r & 3) + 8 * (r >> 2)), t0_); P1_[r] = __builtin_fmaf(sl, (float)(32 + (r & 3) + 8 * (r >> 2)), t0_); } } \
        const LAS unsigned char* kt_ = lds + K_OFF + (ks_) * 16384; \
        if (VAR == 0) { const LAS unsigned char* ka = kt_ + kofs0; \
            _Pragma("unroll") for (int d0 = 0; d0 < 4; ++d0) { const int cb = ((2 * d0 + hi) * 16) ^ sw64; \
                const bf16x8 b0 = *(const LAS bf16x8*)(ka + cb), b1 = *(const LAS bf16x8*)(ka + cb + 32 * 128); \
                P0_ = __builtin_amdgcn_mfma_f32_32x32x16_bf16(b0, qr[d0], P0_, 0, 0, 0); P1_ = __builtin_amdgcn_mfma_f32_32x32x16_bf16(b1, qr[d0], P1_, 0, 0, 0); } \
        } else { \
            const unsigned kb0_ = (unsigned)(uintptr_t)kt_ + kofs0; \
            _Pragma("unroll") for (int d0 = 0; d0 < NQ; ++d0) { const LAS unsigned char* a = (const LAS unsigned char*)(uintptr_t)(kb0_ ^ (unsigned)((d0 & 3) << 5)) + (d0 >> 2) * 128; \
                const bf16x8 b0 = *(const LAS bf16x8*)(a), b1 = *(const LAS bf16x8*)(a + 32 * 256); \
                P0_ = __builtin_amdgcn_mfma_f32_32x32x16_bf16(b0, qr[d0], P0_, 0, 0, 0); P1_ = __builtin_amdgcn_mfma_f32_32x32x16_bf16(b1, qr[d0], P1_, 0, 0, 0); } } } while (0)
#define MASKX(P0_, P1_, kbx, blkx) do { const float NEG = -__builtin_inff(); \
        if ((kbx) + 63 > qlo) { const int dq = qpos - (kbx) - 4 * hi; \
            _Pragma("unroll") for (int r = 0; r < 16; ++r) { const int c = (r & 3) + 8 * (r >> 2); if (c > dq) P0_[r] = NEG; if (c + 32 > dq) P1_[r] = NEG; } } \
        } while (0)
#define PARTSM(P0_, P1_, alX) do { float pmax = P0_[0]; \
        _Pragma("unroll") for (int r = 1; r < 16; ++r) pmax = fmaxf(pmax, P0_[r]); \
        _Pragma("unroll") for (int r = 0; r < 16; ++r) pmax = fmaxf(pmax, P1_[r]); \
        { auto rr = __builtin_amdgcn_permlane32_swap(__float_as_uint(pmax), __float_as_uint(pmax), false, false); pmax = fmaxf(__uint_as_float(rr[0]), __uint_as_float(rr[1])); } \
        float mn_; \
        if (__builtin_expect(__all((pmax - m_reg) * SCALE <= THR), 1)) { mn_ = m_reg; alX = 1.f; } \
        else { mn_ = fmaxf(m_reg, pmax); alX = __builtin_amdgcn_exp2f((m_reg - mn_) * C2); m_reg = mn_; } \
        const float mnL = -mn_ * C2; \
        _Pragma("unroll") for (int r = 0; r < 16; ++r) { P0_[r] = __builtin_amdgcn_exp2f(fmaf(P0_[r], C2, mnL)); P1_[r] = fmaf(P1_[r], C2, mnL); } } while (0)
#define PK4(P, B_, OUT) do { unsigned a0 = cvtpk(P[B_ + 0], P[B_ + 1]), a1 = cvtpk(P[B_ + 2], P[B_ + 3]); unsigned b0 = cvtpk(P[B_ + 4], P[B_ + 5]), b1 = cvtpk(P[B_ + 6], P[B_ + 7]); \
        auto r0 = __builtin_amdgcn_permlane32_swap(a0, b0, false, false); auto r1 = __builtin_amdgcn_permlane32_swap(a1, b1, false, false); \
        v4u w = {r0[0], r1[0], r0[1], r1[1]}; OUT = __builtin_bit_cast(bf16x8, w); } while (0)
#define FINSM(P0_, P1_, alY) do { \
        _Pragma("unroll") for (int r = 0; r < 16; ++r) P1_[r] = __builtin_amdgcn_exp2f(P1_[r]); \
        float ps = 0.f; \
        _Pragma("unroll") for (int r = 0; r < 16; ++r) ps += P0_[r] + P1_[r]; \
        l_reg = l_reg * alY + ps; \
        PK4(P0_, 0, pa0); PK4(P0_, 8, pa1); PK4(P1_, 0, pa2); PK4(P1_, 8, pa3); } while (0)
#define TRRD(dst, off) asm volatile("ds_read_b64_tr_b16 %0, %1 offset:%2" : "=&v"(dst) : "v"(vbs_), "i"(off) : "memory")
#define PV_D0(d0) do { s16x4 l0, l1, l2, l3, h0, h1, h2, h3; constexpr int b_ = (d0) * 512; \
        TRRD(l0, b_); TRRD(h0, b_ + 2048); TRRD(l1, b_ + 4096); TRRD(h1, b_ + 6144); TRRD(l2, b_ + 8192); TRRD(h2, b_ + 10240); TRRD(l3, b_ + 12288); TRRD(h3, b_ + 14336); \
        asm volatile("s_waitcnt lgkmcnt(0)" ::: "memory"); SBAR(); \
        o[d0] = __builtin_amdgcn_mfma_f32_32x32x16_bf16((bf16x8){l0[0], l0[1], l0[2], l0[3], h0[0], h0[1], h0[2], h0[3]}, pa0, o[d0], 0, 0, 0); \
        o[d0] = __builtin_amdgcn_mfma_f32_32x32x16_bf16((bf16x8){l1[0], l1[1], l1[2], l1[3], h1[0], h1[1], h1[2], h1[3]}, pa1, o[d0], 0, 0, 0); \
        o[d0] = __builtin_amdgcn_mfma_f32_32x32x16_bf16((bf16x8){l2[0], l2[1], l2[2], l2[3], h2[0], h2[1], h2[2], h2[3]}, pa2, o[d0], 0, 0, 0); \
        o[d0] = __builtin_amdgcn_mfma_f32_32x32x16_bf16((bf16x8){l3[0], l3[1], l3[2], l3[3], h3[0], h3[1], h3[2], h3[3]}, pa3, o[d0], 0, 0, 0); } while (0)
#define PVT(vs_) do { const unsigned vbs_ = vb0 + (unsigned)(vs_) * 16384u; PV_D0(0); PV_D0(1); PV_D0(2); PV_D0(3); } while (0)
#define RESC(alX) do { if (__any((alX) < 1.f)) { \
        _Pragma("unroll") for (int d0 = 0; d0 < 4; ++d0) _Pragma("unroll") for (int r = 0; r < 16; ++r) o[d0][r] *= (alX); } } while (0)
    f32x16 pA0, pA1, pB0, pB1; float alA = 1.f, alB = 1.f; bf16x8 pa0, pa1, pa2, pa3;
    int ks = 0, vs = 2;
    STAGE_K(KBT(0), 0); STAGE_V(KBT(0), 0);
    STAGE_K(KBT(1), 1);
    ATT_VMW(NKL); ATT_BAR();
    { const int kbx = KBT(0);
      SBAR(); QKT(pA0, pA1, kbx, 0); SBAR();
      STAGE_K(KBT(2), 2); STAGE_V(KBT(1), 1);
      MASKX(pA0, pA1, kbx, 0); PARTSM(pA0, pA1, alA);
      ATT_VMW(NKL + NVL); ATT_BAR(); ks = 1; vs = 0; }
    bool stop = false; int nvotes = 0;
#define HALF_STEP(PX0, PX1, alX, PY0, PY1, alY, t, VOTE) do { \
        const int kbx = KBT(t); \
        SBAR(); QKT(PX0, PX1, kbx, ks); \
        FINSM(PY0, PY1, alY); SBAR(); \
        const bool moreK = (t) + 2 < NT, moreV = (t) + 1 < NT; \
        if (moreK) { const int ksn = ks == 0 ? 2 : ks - 1; STAGE_K(KBT((t) + 2), ksn); } \
        if (moreV) { const int vsn = vs == 0 ? 2 : vs - 1; STAGE_V(KBT((t) + 1), vsn); } \
        SBAR(); PVT(vs); \
        MASKX(PX0, PX1, kbx, 0); PARTSM(PX0, PX1, alX); \
        RESC(alX); \
          \
        if (VOTE) { if (moreV) { const int jn = NT - 2 - (t); const float bmax = VAR == 2 ? tbC[jn] : sl * (float)(64 * jn + 63 - P0); \
            const bool dn = __all((qn * tbK[jn] + bmax - m_reg) * SCALE < -TSKIP); if (lane == 0) votes[(nvotes & 1) * 8 + wid] = dn ? 1u : 0u; } } \
        if (moreK) ATT_VMW(NKL + NVL); else if (moreV) ATT_VMW(NVL); else ATT_VMW(0); \
        ATT_BAR(); ks = ks == 2 ? 0 : ks + 1; vs = vs == 2 ? 0 : vs + 1; \
        if (VOTE) { if (moreV) { const LAS unsigned* vp = votes + (nvotes & 1) * 8; const unsigned all8 = vp[0] & vp[1] & vp[2] & vp[3] & vp[4] & vp[5] & vp[6] & vp[7]; \
            stop = __builtin_amdgcn_readfirstlane(all8) != 0u; ++nvotes; } } } while (0)
    HALF_STEP(pB0, pB1, alB, pA0, pA1, alA, 1, false);
    for (int t = 2; t < NT && !stop; t += 2) {
        HALF_STEP(pA0, pA1, alA, pB0, pB1, alB, t, false);
        HALF_STEP(pB0, pB1, alB, pA0, pA1, alA, t + 1, true);
    }
    FINSM(pB0, pB1, alB); SBAR(); PVT(vs);
    ATT_VMW(0);
    { auto rr = __builtin_amdgcn_permlane32_swap(__float_as_uint(l_reg), __float_as_uint(l_reg), false, false); l_out = __uint_as_float(rr[0]) + __uint_as_float(rr[1]); }
    ATT_BAR();
#undef GLDS
#undef STAGE_K
#undef STAGE_V
#undef QKT
#undef MASKX
#undef PARTSM
#undef PK4
#undef FINSM
#undef TRRD
#undef PV_D0
#undef PVT
#undef RESC
#undef HALF_STEP
#undef KBT
}
constexpr int MB_V = 0, MB_K = 65536, EXTRA_OFF = RING_BYTES + 1024;
template <bool GATHER>
__device__ __forceinline__ void moba_block(const int wv, LAS unsigned char* lds, const bf16* __restrict__ rowb, const int h, const int kblk, const int qpos, const float slope,
                                           f32x16 (&o)[4], float& l_out, float& M_out, float& qn_out) {
    constexpr float SCALE = 0.08838834764831845f, C2 = SCALE * 1.4426950408889634f, ISC = 1.0f / SCALE;
    const int tid = opaque_tid(wv), wid = wv, lane = tid & 63, r32 = lane & 31, hi = lane >> 5;
    const bf16* Kp = rowb + (size_t)(kblk * 256) * NQKV + 4096 + h * 128; const bf16* Vp = Kp + 1024;
    unsigned offK, offV;
    { const int row = wid * 4 + (lane >> 4), c = (lane & 15) ^ (row & 7); offK = (unsigned)(row * NQKV + c * 8); }
    { const int t = (lane & 31) >> 2, k = (wid >> 2) * 16 + (t >> 2) * 8 + ((wid >> 1) & 1) * 4 + (t & 3), c = ((wid & 1) * 2 + (lane >> 5)) * 32 + (lane & 3) * 8; offV = (unsigned)(k * NQKV + c); }
#pragma unroll
    for (int t = 0; t < 4; ++t) { const bf16* kb_ = Kp + (size_t)(64 * t) * NQKV + offK; const bf16* vb_ = Vp + (size_t)(64 * t) * NQKV + offV;
        __builtin_amdgcn_global_load_lds((const unsigned*)kb_, (LAS unsigned*)(lds + MB_K + t * 16384 + wid * 1024), 16, 0, 0);
        __builtin_amdgcn_global_load_lds((const unsigned*)(kb_ + 32 * NQKV), (LAS unsigned*)(lds + MB_K + t * 16384 + 8192 + wid * 1024), 16, 0, 0);
        __builtin_amdgcn_global_load_lds((const unsigned*)vb_, (LAS unsigned*)(lds + MB_V + t * 16384 + wid * 1024), 16, 0, 0);
        __builtin_amdgcn_global_load_lds((const unsigned*)(vb_ + 32 * NQKV), (LAS unsigned*)(lds + MB_V + t * 16384 + 8192 + wid * 1024), 16, 0, 0); }
    bf16x8 qr[8];
#pragma unroll
    for (int d0 = 0; d0 < 8; ++d0) qr[d0] = *(const bf16x8*)(rowb + (unsigned)(qpos * NQKV + 3072 + h * 128 + hi * 8) + d0 * 16);
    { float s2 = 0.f;
#pragma unroll
      for (int d0 = 0; d0 < 8; ++d0) { const v4u w = __builtin_bit_cast(v4u, qr[d0]);
          s2 += (bflo(w.x) * bflo(w.x) + bfhi(w.x) * bfhi(w.x)) + (bflo(w.y) * bflo(w.y) + bfhi(w.y) * bfhi(w.y)) + (bflo(w.z) * bflo(w.z) + bfhi(w.z) * bfhi(w.z)) + (bflo(w.w) * bflo(w.w) + bfhi(w.w) * bfhi(w.w)); }
      auto rr = __builtin_amdgcn_permlane32_swap(__float_as_uint(s2), __float_as_uint(s2), false, false);
      qn_out = sqrtf(__uint_as_float(rr[0]) + __uint_as_float(rr[1])) * 1.001f; }
    const float sl = slope * ISC;
    const unsigned vb0 = (unsigned)(uintptr_t)(lds + MB_V) + (unsigned)v_rd_base(lane);
    const unsigned kofs0 = (unsigned)(r32 * 256 + ((hi * 16) ^ ((r32 & 7) << 4)));
    float m_reg = -1e30f, l_reg = 0.f;
#pragma unroll
    for (int d0 = 0; d0 < 4; ++d0)
#pragma unroll
        for (int r = 0; r < 16; ++r) o[d0][r] = 0.f;
    VM_WAIT(); __syncthreads();
#pragma unroll 1
    for (int t = 0; t < 4; ++t) {
        f32x16 p0, p1;
        { const float t0_ = sl * (float)(64 * t + 4 * hi);
#pragma unroll
          for (int r = 0; r < 16; ++r) { p0[r] = __builtin_fmaf(sl, (float)((r & 3) + 8 * (r >> 2)), t0_); p1[r] = __builtin_fmaf(sl, (float)(32 + (r & 3) + 8 * (r >> 2)), t0_); } }
        { const unsigned kb0_ = (unsigned)(uintptr_t)(lds + MB_K) + (unsigned)t * 16384u + kofs0;
#pragma unroll
          for (int d0 = 0; d0 < 8; ++d0) { const LAS unsigned char* a = (const LAS unsigned char*)(uintptr_t)(kb0_ ^ (unsigned)((d0 & 3) << 5)) + (d0 >> 2) * 128;
              const bf16x8 b0 = *(const LAS bf16x8*)(a), b1 = *(const LAS bf16x8*)(a + 32 * 256);
              p0 = __builtin_amdgcn_mfma_f32_32x32x16_bf16(b0, qr[d0], p0, 0, 0, 0); p1 = __builtin_amdgcn_mfma_f32_32x32x16_bf16(b1, qr[d0], p1, 0, 0, 0); } }
        if (!GATHER) { const float NEG = -__builtin_inff(); const int dq = qpos - (kblk * 256 + 64 * t) - 4 * hi;
#pragma unroll
            for (int r = 0; r < 16; ++r) { const int c = (r & 3) + 8 * (r >> 2); if (c > dq) p0[r] = NEG; if (c + 32 > dq) p1[r] = NEG; } }
        float pmax = p0[0];
#pragma unroll
        for (int r = 1; r < 16; ++r) pmax = fmaxf(pmax, p0[r]);
#pragma unroll
        for (int r = 0; r < 16; ++r) pmax = fmaxf(pmax, p1[r]);
        { auto rr = __builtin_amdgcn_permlane32_swap(__float_as_uint(pmax), __float_as_uint(pmax), false, false); pmax = fmaxf(__uint_as_float(rr[0]), __uint_as_float(rr[1])); }
        const bool need = (pmax - m_reg) * SCALE > THR;
        const float mn = need ? fmaxf(m_reg, pmax) : m_reg, alpha = need ? __builtin_amdgcn_exp2f((m_reg - mn) * C2) : 1.f; m_reg = mn;
        const float mnL = -mn * C2; float ps = 0.f;
#pragma unroll
        for (int r = 0; r < 16; ++r) { p0[r] = __builtin_amdgcn_exp2f(fmaf(p0[r], C2, mnL)); p1[r] = __builtin_amdgcn_exp2f(fmaf(p1[r], C2, mnL)); }
#pragma unroll
        for (int r = 0; r < 16; ++r) ps += p0[r] + p1[r];
        l_reg = l_reg * alpha + ps;
        if (__any(alpha < 1.f)) {
#pragma unroll
            for (int d0 = 0; d0 < 4; ++d0)
#pragma unroll
                for (int r = 0; r < 16; ++r) o[d0][r] *= alpha; }
        bf16x8 pa0, pa1, pa2, pa3;
#define PK4(P, B_, OUT) do { unsigned a0 = cvtpk(P[B_ + 0], P[B_ + 1]), a1 = cvtpk(P[B_ + 2], P[B_ + 3]); unsigned b0 = cvtpk(P[B_ + 4], P[B_ + 5]), b1 = cvtpk(P[B_ + 6], P[B_ + 7]); \
        auto r0 = __builtin_amdgcn_permlane32_swap(a0, b0, false, false); auto r1 = __builtin_amdgcn_permlane32_swap(a1, b1, false, false); \
        v4u w = {r0[0], r1[0], r0[1], r1[1]}; OUT = __builtin_bit_cast(bf16x8, w); } while (0)
        PK4(p0, 0, pa0); PK4(p0, 8, pa1); PK4(p1, 0, pa2); PK4(p1, 8, pa3);
#undef PK4
        const unsigned vbs_ = vb0 + (unsigned)t * 16384u;
#define TRRD(dst, off) asm volatile("ds_read_b64_tr_b16 %0, %1 offset:%2" : "=&v"(dst) : "v"(vbs_), "i"(off) : "memory")
#define PV_D0(d0) do { s16x4 l0, l1, l2, l3, h0, h1, h2, h3; constexpr int b_ = (d0) * 512; \
        TRRD(l0, b_); TRRD(h0, b_ + 2048); TRRD(l1, b_ + 4096); TRRD(h1, b_ + 6144); TRRD(l2, b_ + 8192); TRRD(h2, b_ + 10240); TRRD(l3, b_ + 12288); TRRD(h3, b_ + 14336); \
        asm volatile("s_waitcnt lgkmcnt(0)" ::: "memory"); SBAR(); \
        o[d0] = __builtin_amdgcn_mfma_f32_32x32x16_bf16((bf16x8){l0[0], l0[1], l0[2], l0[3], h0[0], h0[1], h0[2], h0[3]}, pa0, o[d0], 0, 0, 0); \
        o[d0] = __builtin_amdgcn_mfma_f32_32x32x16_bf16((bf16x8){l1[0], l1[1], l1[2], l1[3], h1[0], h1[1], h1[2], h1[3]}, pa1, o[d0], 0, 0, 0); \
        o[d0] = __builtin_amdgcn_mfma_f32_32x32x16_bf16((bf16x8){l2[0], l2[1], l2[2], l2[3], h2[0], h2[1], h2[2], h2[3]}, pa2, o[d0], 0, 0, 0); \
        o[d0] = __builtin_amdgcn_mfma_f32_32x32x16_bf16((bf16x8){l3[0], l3[1], l3[2], l3[3], h3[0], h3[1], h3[2], h3[3]}, pa3, o[d0], 0, 0, 0); } while (0)
        PV_D0(0); PV_D0(1); PV_D0(2); PV_D0(3);
#undef PV_D0
#undef TRRD
    }
    { auto rr = __builtin_amdgcn_permlane32_swap(__float_as_uint(l_reg), __float_as_uint(l_reg), false, false); l_out = __uint_as_float(rr[0]) + __uint_as_float(rr[1]); }
    M_out = m_reg + sl * (float)(kblk * 256 - qpos);
    __syncthreads();
}
__device__ __forceinline__ void store_block(const int wv, bf16* Op  , const int pitch, const f32x16 (&o)[4], float inv_l) {
    const int tid = opaque_tid(wv), wid = wv, lane = tid & 63, r32 = lane & 31, hi = lane >> 5;
    bf16* rowp = Op + (unsigned)((wid * 32 + r32) * pitch + 4 * hi);
#pragma unroll
    for (int d0 = 0; d0 < 4; ++d0)
#pragma unroll
        for (int g = 0; g < 4; ++g) { v2u w; w.x = cvtpk(o[d0][4 * g] * inv_l, o[d0][4 * g + 1] * inv_l); w.y = cvtpk(o[d0][4 * g + 2] * inv_l, o[d0][4 * g + 3] * inv_l);
            *(v2u*)(rowp + 32 * d0 + 8 * g) = w; }
}
}

__device__ __forceinline__ void moba_own_phase(ARGS_T A, const Frame& F0, const int rep = 0) {
    Frame F = F0; F.tid = opaque_tid(F0.wave); F.lane = F.tid & 63; F.wave = __builtin_amdgcn_readfirstlane(F.tid >> 6);
    const bf16* QKV = (const bf16*)(A.ws + WS_QKV); bf16* MRG = (bf16*)(A.ws + WS_MRG);
    for (;;) {
        int it = 0; if (F.tid == 0) F.MISC[17] = __hip_atomic_fetch_add(F.ctl + CW_Q + 64 + rep, 1u, RLX_AGENT);
        __syncthreads(); it = __builtin_amdgcn_readfirstlane((int)F.MISC[17]); __syncthreads();
        if (it >= 512) break;
        const int bh = it & 15, qb = 31 - (it >> 4), b = bh >> 3, h = bh & 7, P0 = qb * 256;
        const float slope = exp2f(-(float)(h + 1));
        const bf16* rowb = QKV + (size_t)b * SEQ * NQKV;
        const float* KM = (const float*)(A.ws + WS_KMEAN) + (size_t)bh * 32 * 128;
        const int tid = opaque_tid(F.wave), lane = tid & 63, r32 = lane & 31, hi = lane >> 5;
        LAS float* km = (LAS float*)(F.lds + att::G_KM); LAS float* gt = (LAS float*)(F.lds + att::G_GT);
        LAS unsigned* sel = (LAS unsigned*)(F.lds + att::EXTRA_OFF);
        if (qb >= 4) {
            for (int i = tid; i < 32 * 128; i += 512) { const int n = i >> 7, d = i & 127; km[n * 129 + d] = n < qb ? KM[i] : 0.f; }
            unsigned qw[64];
            { const v4u* qrow = (const v4u*)(rowb + (size_t)(P0 + (tid >> 6) * 32 + r32) * NQKV + 3072 + h * 128);
#pragma unroll
              for (int c = 0; c < 16; ++c) { const v4u w = qrow[c]; qw[4 * c] = w.x; qw[4 * c + 1] = w.y; qw[4 * c + 2] = w.z; qw[4 * c + 3] = w.w; } }
            __syncthreads();
            f32x16 g = {0.f, 0.f, 0.f, 0.f, 0.f, 0.f, 0.f, 0.f, 0.f, 0.f, 0.f, 0.f, 0.f, 0.f, 0.f, 0.f};
            const LAS float* kmp = km + r32 * 129 + hi;
#pragma unroll
            for (int ks = 0; ks < 64; ++ks) { const float a = hi ? bfhi(qw[ks]) : bflo(qw[ks]); const float bq = kmp[2 * ks];
                g = __builtin_amdgcn_mfma_f32_32x32x2f32(a, bq, g, 0, 0, 0); }
#pragma unroll
            for (int r = 0; r < 16; ++r) gt[((tid >> 6) * 32 + (r & 3) + 8 * (r >> 2) + 4 * hi) * 33 + r32] = g[r];
            __syncthreads();
            if (tid < 256) { unsigned msk = 0u;
                for (int t = 0; t < 3; ++t) { float best = -3.0e38f; int bi = 0;
                    for (int n = 0; n < qb; ++n) { const float v = gt[tid * 33 + n]; if (!((msk >> n) & 1u) && v > best) { best = v; bi = n; } }
                    msk |= 1u << bi; }
                sel[tid] = msk; }
        } else { if (tid < 256) sel[tid] = (1u << qb) - 1u; }
        __syncthreads();
        const unsigned selrow = sel[(tid >> 6) * 32 + r32];
        __syncthreads();
        const int qpos = P0 + (tid >> 6) * 32 + r32;
        f32x16 o[4]; float l, Mo, qn;
        att::moba_block<false>(F.wave, F.lds, rowb, h, qb, qpos, slope, o, l, Mo, qn);
        att::store_block(F.wave, MRG + (size_t)(b * SEQ + P0) * DM + 1024 + h * 128, DM, o, 1.0f / l);
        LAS unsigned* lc = sel + 256; LAS unsigned* lb = lc + 32;
        if (tid < 32) lc[tid] = 0u;
        __syncthreads();
        const size_t qh = ((size_t)(b * SEQ + qpos)) * 8 + h;
        int nn[3]; bool on[3]; unsigned lp[3];
        {   const float* knb = (const float*)(A.ws + WS_KN) + (size_t)(32 + bh) * 128;
            unsigned rem = selrow; const float sl = slope * 11.313708498984761f;
#pragma unroll
            for (int s = 0; s < 3; ++s) { on[s] = rem != 0u; nn[s] = on[s] ? __builtin_ctz(rem) : 0; rem &= rem - 1u;
                const int n = nn[s];
                const float kn = fmaxf(fmaxf(knb[4 * n], knb[4 * n + 1]), fmaxf(knb[4 * n + 2], knb[4 * n + 3]));
                const float ub = qn * kn + sl * (float)(256 * n + 255 - qpos);
                on[s] = on[s] && hi == 0 && !((ub - Mo) * 0.08838834764831845f < -110.0f);
                lp[s] = on[s] ? __hip_atomic_fetch_add((unsigned*)(lc + n), 1u, __ATOMIC_RELAXED, __HIP_MEMORY_SCOPE_WORKGROUP) : 0u; } }
        __syncthreads();
        if (tid < 32) { const unsigned c = lc[tid]; lb[tid] = c ? __hip_atomic_fetch_add((unsigned*)(F.ctl + CW_LC + rep * 1024) + bh * 32 + tid, c, RLX_AGENT) : 0u; }
        __syncthreads();
        if (hi == 0) {
            float* mlo = (float*)(A.ws + WS_MLO) + qh * 2; mlo[0] = Mo; mlo[1] = l;
            unsigned* list = (unsigned*)(A.ws + WS_LIST) + (size_t)bh * 32 * 8192; unsigned vm = 0u;
#pragma unroll
            for (int s = 0; s < 3; ++s) if (on[s]) { list[(size_t)nn[s] * 8192 + lb[nn[s]] + lp[s]] = (unsigned)qpos | ((unsigned)s << 16); vm |= 1u << s; }
            ((unsigned*)(A.ws + WS_VM))[qh] = vm;
        }
    }
}
__device__ __forceinline__ void attn_even_phase(ARGS_T A, const Frame& F0, const int rep = 0, const int lcset = 0) {
    Frame F = F0; F.tid = opaque_tid(F0.wave); F.lane = F.tid & 63; F.wave = __builtin_amdgcn_readfirstlane(F.tid >> 6);
    const bf16* QKV = (const bf16*)(A.ws + WS_QKV);
    LAS unsigned* pre = (LAS unsigned*)(F.lds + att::EXTRA_OFF + 1024);
    { const unsigned* lcnt = (const unsigned*)(F.ctl + CW_LC + lcset * 1024); const unsigned nch = (lcnt[F.tid] + 255u) >> 8;
      unsigned inc = nch;
#pragma unroll
      for (int o = 1; o < 64; o <<= 1) { const unsigned t = __shfl_up(inc, o); if (F.lane >= o) inc += t; }
      LAS unsigned* wt = pre + 512;
      if (F.lane == 63) wt[F.wave] = inc;
      __syncthreads();
      unsigned base = 0; for (int w = 0; w < F.wave; ++w) base += wt[w];
      pre[F.tid] = base + inc;
      __syncthreads(); }
    const int nb1 = (int)pre[511];
    for (;;) {
        int it = 0; if (F.tid == 0) F.MISC[16] = __hip_atomic_fetch_add(F.ctl + CW_Q + 0 + rep, 1u, RLX_AGENT);
        __syncthreads(); it = __builtin_amdgcn_readfirstlane((int)F.MISC[16]); __syncthreads();
        if (it >= 1024 + CV_A_WG + nb1) break;
        if (it >= 256 && it < 256 + CV_A_WG) { convert_wg_item<0>(A, F.lds, F.wave, it - 256); continue; }
        if (it >= 256 + CV_A_WG) it -= CV_A_WG;
        if (it < 1024) {
            const int mp = it & 1, bh = (it >> 1) & 15, qb = 31 - (it >> 5), b = bh >> 3, h = bh & 7, P0 = qb * 256;
            const float slope = exp2f(-(2.0f * h + 1.0f) * 0.5f);
            const float* KN = (const float*)(A.ws + WS_KN);
            const bf16* rowb = QKV + (size_t)b * SEQ * NQKV;
            f32x16 o[4]; float l;
            att::attn_block<0>(F.wave, F.lds, rowb + (size_t)P0 * NQKV + h * 128 + mp * 64, rowb + 1024 + h * 128 + mp * 64, rowb + 2048 + h * 128, P0, slope, nullptr, KN + (size_t)(bh * 2 + mp) * 128, o, l);
            att::store_block(F.wave, (bf16*)(A.ws + (mp ? WS_OA1 : WS_OA0)) + (size_t)(b * SEQ + P0) * 1024 + h * 128, 1024, o, 1.0f / l);
        } else {
            const int c = it - 1024; int lo_ = 0, hi_ = 511;
            while (lo_ < hi_) { const int mid = (lo_ + hi_) >> 1; if ((int)pre[mid] > c) hi_ = mid; else lo_ = mid + 1; }
            const int bhn = __builtin_amdgcn_readfirstlane(lo_), chunk = c - (bhn ? (int)pre[bhn - 1] : 0), bh = bhn >> 5, n = bhn & 31, b = bh >> 3, h = bh & 7;
            const float slope = exp2f(-(float)(h + 1));
            const bf16* rowb = QKV + (size_t)b * SEQ * NQKV;
            const int cnt = (int)((const unsigned*)(F.ctl + CW_LC + lcset * 1024))[bhn];
            const int tid = opaque_tid(F.wave), lane = tid & 63, r32 = lane & 31, hi = lane >> 5;
            const int idx = chunk * 256 + (tid >> 6) * 32 + r32; const bool valid = idx < cnt;
            const unsigned e = ((const unsigned*)(A.ws + WS_LIST))[(size_t)bhn * 8192 + (valid ? idx : cnt - 1)];
            const int qpos = (int)(e & 0xffffu), slot = (int)(e >> 16);
            f32x16 o[4]; float l, Mo, qn;
            att::moba_block<true>(F.wave, F.lds, rowb, h, n, qpos, slope, o, l, Mo, qn);
            if (valid) { const size_t qhs = (((size_t)(b * SEQ + qpos)) * 8 + h) * 3 + slot; const float il = 1.0f / l;
                bf16* rowp = (bf16*)(A.ws + WS_PART) + qhs * 128 + 4 * hi;
#pragma unroll
                for (int d0 = 0; d0 < 4; ++d0)
#pragma unroll
                    for (int g = 0; g < 4; ++g) { v2u w; w.x = att::cvtpk(o[d0][4 * g] * il, o[d0][4 * g + 1] * il); w.y = att::cvtpk(o[d0][4 * g + 2] * il, o[d0][4 * g + 3] * il);
                        *(v2u*)(rowp + 32 * d0 + 8 * g) = w; }
                if (hi == 0) { float* mlp = (float*)(A.ws + WS_MLP) + qhs * 2; mlp[0] = Mo; mlp[1] = l; } }
        }
    }
}
__device__ __forceinline__ void even_merge_phase(ARGS_T A, const Frame& F0, const bool dry = false) {
    Frame F = F0; F.tid = opaque_tid(F0.wave); F.lane = F.tid & 63; F.wave = __builtin_amdgcn_readfirstlane(F.tid >> 6);
    bf16* MRG = (bf16*)(A.ws + WS_MRG); const float lam = *(const float*)(A.ws + WS_LAM);
    const unsigned* OA0 = (const unsigned*)(A.ws + WS_OA0); const unsigned* OA1 = (const unsigned*)(A.ws + WS_OA1);
    const float g0 = A.in[I_SUBLN][2 * F.lane] * 0.8f, g1 = A.in[I_SUBLN][2 * F.lane + 1] * 0.8f;
    constexpr float C2 = 0.08838834764831845f * 1.4426950408889634f;
    const int gw = F.vcu * NWAVES + F.wave, NGW = F.G * NWAVES, lane = F.lane;
    const float* MLO = (const float*)(A.ws + WS_MLO); const float* MLP = (const float*)(A.ws + WS_MLP); const unsigned* VMp = (const unsigned*)(A.ws + WS_VM);
    const unsigned* PO = (const unsigned*)(A.ws + WS_PART);
    for (int m = gw; m < M; m += NGW) {
        unsigned* mrow = (unsigned*)(MRG + (size_t)m * DM); unsigned* wrow = dry ? (unsigned*)((bf16*)(A.ws + WS_H) + (size_t)m * DM) : mrow;
        const unsigned vmv = VMp[(size_t)m * 8 + (lane & 7)]; const float mlov = MLO[(size_t)m * 16 + (lane & 15)]; const float mlpv = lane < 48 ? MLP[(size_t)m * 48 + lane] : 0.f;
        unsigned a0w[8], a1w[8], ow[8], pw[8][3];
#pragma unroll
        for (int h = 0; h < 8; ++h) { a0w[h] = OA0[(size_t)m * 512 + h * 64 + lane]; a1w[h] = OA1[(size_t)m * 512 + h * 64 + lane]; ow[h] = mrow[512 + h * 64 + lane];
#pragma unroll
            for (int s = 0; s < 3; ++s) pw[h][s] = PO[((size_t)m * 8 + h) * 192 + s * 64 + lane]; }
        float wn[4];
        { const int hh = lane & 7; const float M0 = __shfl(mlov, 2 * hh), l0 = __shfl(mlov, 2 * hh + 1); float Ms[3], ls[3]; float Mx = M0;
#pragma unroll
          for (int s = 0; s < 3; ++s) { Ms[s] = __shfl(mlpv, 6 * hh + 2 * s); ls[s] = __shfl(mlpv, 6 * hh + 2 * s + 1); if ((vmv >> s) & 1u) Mx = fmaxf(Mx, Ms[s]); }
          wn[0] = l0 * __builtin_amdgcn_exp2f((M0 - Mx) * C2); float L = wn[0];
#pragma unroll
          for (int s = 0; s < 3; ++s) { wn[1 + s] = ((vmv >> s) & 1u) ? ls[s] * __builtin_amdgcn_exp2f((Ms[s] - Mx) * C2) : 0.f; L += wn[1 + s]; }
          const float iL = 1.0f / L;
#pragma unroll
          for (int s = 0; s < 4; ++s) wn[s] *= iL; }
#pragma unroll
        for (int h = 0; h < 8; ++h) {
            const float v0 = bflo(a0w[h]) - lam * bflo(a1w[h]), v1 = bfhi(a0w[h]) - lam * bfhi(a1w[h]);
            const float r = 1.0f / sqrtf(wave_sum(v0 * v0 + v1 * v1) * (1.0f / 128.0f) + EPS);
            wrow[h * 64 + lane] = pk2(v0 * r * g0, v1 * r * g1);
            const float w0 = __shfl(wn[0], h); float b0 = w0 * bflo(ow[h]), b1 = w0 * bfhi(ow[h]);
#pragma unroll
            for (int s = 0; s < 3; ++s) { const float ws_ = __shfl(wn[1 + s], h); const unsigned p = ws_ != 0.f ? pw[h][s] : 0u; b0 += ws_ * bflo(p); b1 += ws_ * bfhi(p); }
            wrow[512 + h * 64 + lane] = pk2(b0, b1); }
    }
}
__device__ __forceinline__ void attn_odd_phase(ARGS_T A, const Frame& F0, const int rep = 0) {
    Frame F = F0; F.tid = opaque_tid(F0.wave); F.lane = F.tid & 63; F.wave = __builtin_amdgcn_readfirstlane(F.tid >> 6);
    const bf16* QKV = (const bf16*)(A.ws + WS_QKV); bf16* MRG = (bf16*)(A.ws + WS_MRG);
    for (;;) {
        int it = 0; if (F.tid == 0) F.MISC[18] = __hip_atomic_fetch_add(F.ctl + CW_Q + 128 + rep, 1u, RLX_AGENT);
        __syncthreads(); it = __builtin_amdgcn_readfirstlane((int)F.MISC[18]); __syncthreads();
        if (it >= 1024 + CV_B_WG) break;
        if (it >= 256 && it < 256 + CV_B_WG) { convert_wg_item<1>(A, F.lds, F.wave, it - 256); continue; }
        if (it >= 256 + CV_B_WG) it -= CV_B_WG;
        const int bh = it & 31, qb = 31 - (it >> 5), b = bh >> 4, h = bh & 15;
        const bf16* rowb = QKV + (size_t)b * SEQ * NQKV;
        const float* cumrow = (const float*)(A.ws + WS_CUM) + (size_t)bh * SEQ; const float* KN = (const float*)(A.ws + WS_KN);
        {
            const int P0 = qb * 256;
            f32x16 o[4]; float l;
            att::attn_block<2>(F.wave, F.lds, rowb + (size_t)P0 * NQKV + h * 128, rowb + 2048 + h * 128, rowb + 4096 + h * 128, P0, 0.f, cumrow, KN + (size_t)bh * 128, o, l);
            att::store_block(F.wave, MRG + (size_t)(b * SEQ + P0) * DM + h * 128, DM, o, 1.0f / l);
        }
    }
}
#ifndef REP_PRO
#define REP_PRO 1
#endif
#ifndef REP_BAR
#define REP_BAR 1
#endif
#ifndef REP_NORM0
#define REP_NORM0 1
#endif
#ifndef REP_KN
#define REP_KN 1
#endif
#ifndef REP_MERGE
#define REP_MERGE 1
#endif
#ifndef PROBE_PH
#define PROBE_PH -1
#endif
#ifndef REP_INPROJ
#define REP_INPROJ 1
#endif
#ifndef REP_ATTA
#define REP_ATTA 1
#endif
#ifndef REP_ATTB
#define REP_ATTB 1
#endif
#ifndef REP_ATTC
#define REP_ATTC 1
#endif
#ifndef REP_MOEUP
#define REP_MOEUP 1
#endif
#ifndef REP_MOEDN
#define REP_MOEDN 1
#endif
#ifndef REP_OUTP0
#define REP_OUTP0 1
#endif
#ifndef ONE_LAUNCH
#define ONE_LAUNCH 1
#endif
constexpr int N_PHASES = 20;
__device__ __forceinline__ const __attribute__((address_space(4))) Args* opaque_args() {
    const __attribute__((address_space(4))) Args* p = (const __attribute__((address_space(4))) Args*)__builtin_amdgcn_kernarg_segment_ptr(); asm volatile("" : "+s"(p)); return p; }
#define IN(k) (lo <= (k) && (k) < hi)
#define SEAM(k) do { if (IN(k) && IN((k) + 1)) { for (int rb_ = 0; rb_ < REP_BAR; ++rb_) xcd_barrier(bar); } } while (0)
#define T0(id) do { if (PROBE_PH == (id)) tp0 = __builtin_amdgcn_s_memrealtime(); } while (0)
#define T1(id) do { if (PROBE_PH == (id)) tp1 = __builtin_amdgcn_s_memrealtime(); } while (0)
template <int l>
__device__ __forceinline__ void layer_phases(const Frame& F, const XcdBarrier& bar, const int lo, const int hi, unsigned long long& tp0, unsigned long long& tp1) {
#define args (*opaque_args())
        const int pb = 1 + 9 * l;
        if (IN(pb + 0)) { T0(pb + 0); if (l == 0) { for (int rep = 0; rep < REP_NORM0; ++rep) norm_phase<0>(args, F, l); } else norm_phase<2>(args, F, l); SEAM(pb + 0); T1(pb + 0); }
        if (IN(pb + 1)) { T0(pb + 1);
            if (l == 1) { scan_phase(args, F); }
            pg8::Gemm g{(const bf16*)(args.ws + WS_H), (const bf16*)(args.ws + WS_WIN) + (size_t)l * NQKV * DM, M, NQKV, DM}; pg8::StaticOrder S; S.init(M, NQKV, F.G, (int)blockIdx.x);
            pg8::EpiBf16<0> E{(bf16*)(args.ws + WS_QKV), NQKV, nullptr, 0, 0, 1.f};
            for (int rep = 0; rep < (l == 0 ? REP_INPROJ : 1); ++rep) { pg8::gemm_phase<pg8::EpiBf16<0>, pg8::StaticOrder, PG8_ALIGN, PG8_SP2>(F.wave, F.lds + RING_OFF, g, S, E); if (rep + 1 < (l == 0 ? REP_INPROJ : 1)) xcd_barrier(bar); }
            SEAM(pb + 1); T1(pb + 1);
        }
        if (IN(pb + 2)) { T0(pb + 2); for (int rep = 0; rep < REP_KN; ++rep) { if (l == 0) kmean_phase(args, F); knorm_phase<l>(args, F); } SEAM(pb + 2); T1(pb + 2); }
        if (IN(pb + 3)) { T0(pb + 3);
            if (l == 0) { for (int rep = 0; rep < REP_ATTB; ++rep) { moba_own_phase(args, F, rep); xcd_barrier(bar); }
                          for (int rep = 0; rep < REP_ATTA; ++rep) { attn_even_phase(args, F, rep, REP_ATTB - 1); xcd_barrier(bar); }
                          for (int rep = 1; rep < REP_MERGE; ++rep) even_merge_phase(args, F, true);
                          even_merge_phase(args, F); }
            else { for (int rep = 0; rep < REP_ATTC; ++rep) { if (!(NAIVE_ATTN & 4)) attn_odd_phase(args, F, rep); if (rep + 1 < REP_ATTC) xcd_barrier(bar); } }
            SEAM(pb + 3); T1(pb + 3);
        }
        if (IN(pb + 4)) { T0(pb + 4);
            pg8::Gemm g{(const bf16*)(args.ws + WS_MRG), (const bf16*)(args.ws + WS_WOUT) + (size_t)l * DM * DM, M, DM, DM}; pg8::StaticOrder S; S.init(M, DM, F.G, (int)blockIdx.x);
            pg8::EpiBf16<0> E{(bf16*)(args.ws + WS_H), DM, nullptr, 0, 0, 1.f};
            for (int rep = 0; rep < (l == 0 ? REP_OUTP0 : 1); ++rep) { pg8::gemm_phase<pg8::EpiBf16<0>, pg8::StaticOrder, PG8_ALIGN, PG8_SP2>(F.wave, F.lds + RING_OFF, g, S, E); if (rep + 1 < (l == 0 ? REP_OUTP0 : 1)) xcd_barrier(bar); }
            SEAM(pb + 4); T1(pb + 4);
        }
        if (IN(pb + 5)) { T0(pb + 5); norm_phase<1>(args, F, l); SEAM(pb + 5); T1(pb + 5); }
        if (IN(pb + 6)) { T0(pb + 6); gather_phase(args, F, l); SEAM(pb + 6); T1(pb + 6); }
        if (IN(pb + 7)) { T0(pb + 7);
            pg8::Gemm g{(const bf16*)(args.ws + WS_QKV), (const bf16*)(args.ws + WS_W13) + (size_t)l * 16384 * DM, MAXROWS, 16384, DM};
            pg8::MoeOrder S; S.init((const unsigned*)(F.ctl + CW_CNT + 64 * l), 2, F.G, (int)blockIdx.x);
            pg8::EpiSwiGLU E{(bf16*)(args.ws + WS_ACT)};
            for (int rep = 0; rep < (l == 0 ? REP_MOEUP : 1); ++rep) { pg8::gemm_phase<pg8::EpiSwiGLU, pg8::MoeOrder, PG8_ALIGN, PG8_SP2>(F.wave, F.lds + RING_OFF, g, S, E); if (rep + 1 < (l == 0 ? REP_MOEUP : 1)) xcd_barrier(bar); }
            SEAM(pb + 7); T1(pb + 7);
        }
        if (IN(pb + 8)) { T0(pb + 8);
            pg8::Gemm g{(const bf16*)(args.ws + WS_ACT), (const bf16*)(args.ws + WS_W2) + (size_t)l * 32768 * FFE, MAXROWS, 32768, FFE};
            pg8::MoeOrder S; S.init((const unsigned*)(F.ctl + CW_CNT + 64 * l), 3, F.G, (int)blockIdx.x);
            pg8::EpiBf16<0> E{(bf16*)(args.ws + WS_OSL), DM, nullptr, DM, 0, 1.f};
            for (int rep = 0; rep < (l == 0 ? REP_MOEDN : 1); ++rep) { pg8::gemm_phase<pg8::EpiBf16<0>, pg8::MoeOrder, PG8_ALIGN, PG8_SP2>(F.wave, F.lds + RING_OFF, g, S, E); if (rep + 1 < (l == 0 ? REP_MOEDN : 1)) xcd_barrier(bar); }
            SEAM(pb + 8); T1(pb + 8);
        }
}
#undef args
#undef IN
#undef SEAM
__global__ void __launch_bounds__(NWAVES * 64, 2) skel_fwd(Args args) {
    extern __shared__ __attribute__((aligned(16))) unsigned char lds[];
    Frame F;
    F.lds = (LAS unsigned char*)lds;
    F.MISC = (volatile LAS unsigned*)(F.lds + MISC_OFF);
    F.tid = threadIdx.x; F.lane = F.tid & 63; F.wave = __builtin_amdgcn_readfirstlane(F.tid >> 6);
    F.G = gridDim.x; { const int bx = blockIdx.x; F.vcu = (F.G % 8 == 0) ? (bx % 8) * (F.G / 8) + bx / 8 : bx; }
    unsigned char* ws = args.ws;
    F.ctl = (gu32*)(ws + WS_CTL);
    for (int u = F.tid; u < (LDS_BYTES - LDSCTL_OFF) / 4; u += NWAVES * 64) ((LAS unsigned*)(F.lds + LDSCTL_OFF))[u] = 0u;
    __syncthreads();
    const int lo = args.ph_lo, hi = args.ph_hi;
    XcdBarrier bar; bar.bar = (unsigned*)(F.ctl + CW_BAR); bar.x = 0; bar.st = nullptr;
    if (hi - lo > 1) bar = xcd_barrier_post((unsigned*)(F.ctl + CW_BAR), F.MISC + 8);
    bar.w = F.wave;
#define IN(k) (lo <= (k) && (k) < hi)
#define SEAM(k) do { if (IN(k) && IN((k) + 1)) xcd_barrier(bar); } while (0)

    if (IN(0)) { for (int rep = 0; rep < REP_PRO; ++rep) { p0_prologue(*opaque_args(), F); if (rep + 1 < REP_PRO) xcd_barrier(bar); } SEAM(0); }
    unsigned long long tp0 = 0, tp1 = 0;
    layer_phases<0>(F, bar, lo, hi, tp0, tp1);
    layer_phases<1>(F, bar, lo, hi, tp0, tp1);
    if (IN(19)) { if (PROBE_PH == 19) tp0 = __builtin_amdgcn_s_memrealtime(); norm_phase<3>(*opaque_args(), F, 1); if (PROBE_PH == 19) { asm volatile("s_waitcnt vmcnt(0)" ::: "memory"); tp1 = __builtin_amdgcn_s_memrealtime(); } }
    if (PROBE_PH >= 0 && blockIdx.x == 0) { const unsigned long long t0 = __builtin_amdgcn_s_memrealtime(), dt = 8ull * (tp1 - tp0); while (__builtin_amdgcn_s_memrealtime() - t0 < dt) __builtin_amdgcn_s_sleep(32); }
#undef IN
#undef SEAM
}

extern "C" void kernel_launch(void* const* d_in, const int* in_sizes, int n_in, void* d_out, int out_size, void* d_ws, size_t ws_size, hipStream_t stream) {
    static int grid = 0;
    if (grid == 0) {
        if (n_in != 22 || in_sizes[0] != M * DM || out_size != M * DM || ws_size < WS_END) { fprintf(stderr, "kernel_launch: unexpected shapes (n_in %d, in0 %d, out %d, ws %zu; need ws >= %zu); nothing launched\n", n_in, n_in > 0 ? in_sizes[0] : -1, out_size, ws_size, (size_t)WS_END); grid = -1; return; }
        int dev = 0, cus = 0, per_cu = 0;
        if (hipGetDevice(&dev) != hipSuccess || hipDeviceGetAttribute(&cus, hipDeviceAttributeMultiprocessorCount, dev) != hipSuccess) { grid = -1; return; }
        if (hipFuncSetAttribute((const void*)skel_fwd, hipFuncAttributeMaxDynamicSharedMemorySize, LDS_BYTES) != hipSuccess) { fprintf(stderr, "kernel_launch: hipFuncSetAttribute failed\n"); grid = -1; return; }
        if (hipOccupancyMaxActiveBlocksPerMultiprocessor(&per_cu, (const void*)skel_fwd, NWAVES * 64, LDS_BYTES) != hipSuccess || per_cu < 1) { fprintf(stderr, "kernel_launch: occupancy query says %d blocks per CU\n", per_cu); }
        (void)hipGetLastError();
        grid = cus;
    }
    if (grid < 0) return;
    if (hipMemsetAsync((char*)d_ws + WS_CTL, 0, CTL_ZERO_BYTES, stream) != hipSuccess) return;
    Args a{};
    for (int i = 0; i < 22; ++i) a.in[i] = (const float*)d_in[i];
    a.out = (float*)d_out; a.ws = (unsigned char*)d_ws;
#if ONE_LAUNCH
    a.ph_lo = 0; a.ph_hi = N_PHASES;
    hipLaunchKernelGGL(skel_fwd, dim3(grid), dim3(NWAVES * 64), LDS_BYTES, stream, a);
#else
    unsigned char* ws = (unsigned char*)d_ws;
    for (int p = 0; p < N_PHASES; ++p) {
#if NAIVE_ATTN
        if (p == 4) {
            if (NAIVE_ATTN & 1) naive_attn<0><<<M * 8 / 4, 256, 0, stream>>>((const bf16*)(ws + WS_QKV), (bf16*)(ws + WS_MRG), nullptr, nullptr, (const float*)(ws + WS_LAM), (const float*)d_in[I_SUBLN]);
            if (NAIVE_ATTN & 2) naive_attn<1><<<M * 8 / 4, 256, 0, stream>>>((const bf16*)(ws + WS_QKV), (bf16*)(ws + WS_MRG), nullptr, (const float*)(ws + WS_KMEAN), nullptr, nullptr);
            if ((NAIVE_ATTN & 3) == 3) continue; }
        if (p == 13 && (NAIVE_ATTN & 4)) { naive_attn<2><<<M * 16 / 4, 256, 0, stream>>>((const bf16*)(ws + WS_QKV), (bf16*)(ws + WS_MRG), (const float*)(ws + WS_CUM), nullptr, nullptr, nullptr); continue; }
#endif
        a.ph_lo = p; a.ph_hi = p + 1;
        hipLaunchKernelGGL(skel_fwd, dim3(grid), dim3(NWAVES * 64), LDS_BYTES, stream, a);
    }
#endif
}
```

```cpp
#include <hip/hip_runtime.h>
#include <cstdio>
#include <cstdint>
namespace pg8 {
#define PG8_LAS __attribute__((address_space(3)))
typedef unsigned short bf16_t;
typedef short bf16x8 __attribute__((ext_vector_type(8)));
typedef float f32x4 __attribute__((ext_vector_type(4)));
typedef unsigned u32x4 __attribute__((ext_vector_type(4)));
constexpr int BM = 256, BK = 64, HALF = 128, HTB = HALF * BK * 2  , STAGE_BYTES = 8 * HTB, NXCD = 8, WGM = 8;

__host__ __device__ __forceinline__ int lds_byte(int r, int c) { const int st = (r >> 4) * 2 + (c >> 5), rr = r & 15, cc = c & 31, ob = rr * 64 + cc * 2; return st * 1024 + (ob ^ (((ob >> 9) & 1) << 5)); }
__host__ __device__ __forceinline__ void stage_rc(int b, int& R, int& C) { const int st = b / 1024, sb = b % 1024, swz = sb ^ (((sb >> 9) & 1) << 5); R = (st >> 1) * 16 + swz / 64; C = (st & 1) * 32 + (swz % 64) / 2; }
__host__ __device__ __forceinline__ int perm32(int rho) { const int n = rho >> 4, i = rho & 15; return 8 * (i >> 2) + 4 * n + (i & 3); }

struct Unit { int pm, pn; };
struct Gemm { const bf16_t* A; const bf16_t* Bt; int M, N, K; };

struct StaticOrder {
    int nM, nN, nwg, G, c;
    __host__ __device__ void init(int M, int N, int G_, int c_) { nM = M / BM; nN = N / BM; nwg = nM * nN; G = G_; c = c_; }
    __host__ __device__ bool next(int i, Unit& u) const {
        const long L = (long)i * G + c; if (L >= nwg) return false;
        int wgid = (int)L; { const int q = nwg / NXCD, r = nwg % NXCD, xcd = wgid % NXCD, off = wgid / NXCD; wgid = (xcd < r ? xcd * (q + 1) : r * (q + 1) + (xcd - r) * q) + off; }
        const int nig = WGM * nN, gid = wgid / nig, fm = gid * WGM, gsz = (nM - fm) < WGM ? (nM - fm) : WGM;
        u.pm = fm + ((wgid % nig) % gsz); u.pn = (wgid % nig) / gsz; return true;
    }
    __device__ __forceinline__ void a_ready(const Unit&) const {}
    __device__ __forceinline__ void done(const Unit&) const {}
};

__device__ __forceinline__ unsigned cvt_pk_bf16(float lo, float hi) { unsigned r; asm volatile("v_cvt_pk_bf16_f32 %0, %1, %2" : "=v"(r) : "v"(lo), "v"(hi)); return r; }
typedef float f32x2 __attribute__((ext_vector_type(2)));
__device__ __forceinline__ f32x2 gelu_pk(f32x2 v) {
    const f32x2 av = __builtin_elementwise_abs(v), d = av * 0.2316418882f + 1.0f;
    f32x2 t; t.x = __builtin_amdgcn_rcpf(d.x); t.y = __builtin_amdgcn_rcpf(d.y);
    f32x2 q = t * 0.5307027145f + (-0.7265760135f); q = q * t + 0.7107068705f; q = q * t + (-0.142248368f); q = q * t + 0.127414796f; q = q * t;
    const f32x2 s = (v * v) * (-0.72134752044f);
    f32x2 e; e.x = __builtin_amdgcn_exp2f(s.x); e.y = __builtin_amdgcn_exp2f(s.y);
    const f32x2 m = v * (q * e), r = v - m;
    f32x2 o; o.x = v.x < 0.f ? m.x : r.x; o.y = v.y < 0.f ? m.y : r.y; return o;
}

template <int ACT  > struct EpiBf16 {
    static constexpr bool PERM = true, AFTER_DRAIN = false; static_assert(ACT == 0 || ACT == 1, "EpiBf16: ACT is 0 (none) or 1 (gelu_pk)");
    bf16_t* O; int ldc; const float* bias; int split_cols; size_t split_stride; float scale0;
    __device__ __forceinline__ void operator()(const f32x4 (&acc)[2][2][4][2], const Unit& u, int wr, int wc, int fr, int fq) const {
        const int row0 = u.pm * BM + wr * 64 + fr; int colt = u.pn * BM; bf16_t* base = O;
        float sc = 1.f; if (split_cols) { const int t = colt / split_cols; base += (size_t)t * split_stride; colt -= t * split_cols; if (t == 0) sc = scale0; }
        const int col0 = colt + wc * 32 + 8 * fq, bcol0 = u.pn * BM + wc * 32 + 8 * fq;
        f32x4 bv[2][2];
#pragma unroll
        for (int bj = 0; bj < 2; ++bj)
#pragma unroll
            for (int n = 0; n < 2; ++n) bv[bj][n] = bias ? *(const f32x4*)(bias + bcol0 + bj * HALF + 4 * n) : (f32x4){0.f, 0.f, 0.f, 0.f};
#pragma unroll
        for (int ai = 0; ai < 2; ++ai)
#pragma unroll
            for (int m = 0; m < 4; ++m) { bf16_t* rowp = base + (size_t)(row0 + ai * HALF + m * 16) * ldc + col0;
#pragma unroll
                for (int bj = 0; bj < 2; ++bj) { f32x4 v0 = acc[ai][bj][m][0] + bv[bj][0], v1 = acc[ai][bj][m][1] + bv[bj][1];
                    if (ACT == 1) { f32x2 a = gelu_pk((f32x2){v0[0], v0[1]}), b = gelu_pk((f32x2){v0[2], v0[3]}), c = gelu_pk((f32x2){v1[0], v1[1]}), d = gelu_pk((f32x2){v1[2], v1[3]});
                        v0 = (f32x4){a.x, a.y, b.x, b.y}; v1 = (f32x4){c.x, c.y, d.x, d.y}; }
                    v0 = v0 * sc; v1 = v1 * sc; u32x4 w; w.x = cvt_pk_bf16(v0[0], v0[1]); w.y = cvt_pk_bf16(v0[2], v0[3]); w.z = cvt_pk_bf16(v1[0], v1[1]); w.w = cvt_pk_bf16(v1[2], v1[3]);
                    *(u32x4*)(rowp + bj * HALF) = w; } }
    }
};

struct EpiResid {
    static constexpr bool PERM = false, AFTER_DRAIN = false;
    const float* base; float* out; const float* gate; int gate_bstride; int rows_per_batch;
    __device__ __forceinline__ void operator()(const f32x4 (&acc)[2][2][4][2], const Unit& u, int wr, int wc, int fr, int fq) const {
        const int row0 = u.pm * BM + wr * 64 + fr, col0 = u.pn * BM + wc * 32 + 4 * fq;
        const float* gp = gate + (size_t)((u.pm * BM) / rows_per_batch) * gate_bstride + col0;
        f32x4 gv[2][2];
#pragma unroll
        for (int bj = 0; bj < 2; ++bj)
#pragma unroll
            for (int n = 0; n < 2; ++n) gv[bj][n] = *(const f32x4*)(gp + bj * HALF + n * 16);
#pragma unroll
        for (int ai = 0; ai < 2; ++ai)
#pragma unroll
            for (int m = 0; m < 4; ++m) { const size_t off = (size_t)(row0 + ai * HALF + m * 16) * 2048 + col0;
#pragma unroll
                for (int bj = 0; bj < 2; ++bj)
#pragma unroll
                    for (int n = 0; n < 2; ++n) { const f32x4 bs = *(const f32x4*)(base + off + bj * HALF + n * 16);
                        *(f32x4*)(out + off + bj * HALF + n * 16) = bs + gv[bj][n] * acc[ai][bj][m][n]; }
                if (m & 1) asm volatile("" ::: "memory"); }
    }
};
struct EpiSwiGLU {
    static constexpr bool PERM = true, AFTER_DRAIN = false;
    bf16_t* O;
    __device__ __forceinline__ void operator()(const f32x4 (&acc)[2][2][4][2], const Unit& u, int wr, int wc, int fr, int fq) const {
        const int row0 = u.pm * BM + wr * 64 + fr; const int f0 = (u.pn & 3) * 128 + wc * 16 + 4 * fq;
#pragma unroll
        for (int ai = 0; ai < 2; ++ai)
#pragma unroll
            for (int m = 0; m < 4; ++m) { bf16_t* rowp = O + (size_t)(row0 + ai * HALF + m * 16) * 512 + f0;
#pragma unroll
                for (int bj = 0; bj < 2; ++bj) { const f32x4 v0 = acc[ai][bj][m][0], v1 = acc[ai][bj][m][1];
                    float r[4]; const float a[4] = {v0[0], v0[2], v1[0], v1[2]}, b[4] = {v0[1], v0[3], v1[1], v1[3]};
#pragma unroll
                    for (int q = 0; q < 4; ++q) r[q] = a[q] * b[q] * __builtin_amdgcn_rcpf(1.0f + __builtin_amdgcn_exp2f(-1.4426950408889634f * a[q]));
                    typedef unsigned u32x2 __attribute__((ext_vector_type(2)));
                    u32x2 w; w.x = cvt_pk_bf16(r[0], r[1]); w.y = cvt_pk_bf16(r[2], r[3]);
                    *(u32x2*)(rowp + bj * 64) = w; } }
    }
};
struct MoeOrder {
    unsigned pk[4]; int njs, G, c;
    __device__ __forceinline__ void init(const unsigned* cnt, int njs_, int G_, int c_) {
        njs = njs_; G = G_; c = c_; unsigned t = 0; pk[0] = pk[1] = pk[2] = pk[3] = 0u;
#pragma unroll
        for (int e = 0; e < 16; ++e) { t += (__builtin_amdgcn_readfirstlane(cnt[e]) + 255u) >> 8; pk[e >> 2] |= t << (8 * (e & 3)); }
    }
    __device__ __forceinline__ bool next(int i, Unit& u) const {
        const int L = i * G + c, rt = L >> njs, j = L & ((1 << njs) - 1);
        if (rt >= (int)(pk[3] >> 24)) return false;
        int e = 0;
#pragma unroll
        for (int q = 0; q < 16; ++q) e += ((int)((pk[q >> 2] >> (8 * (q & 3))) & 255u) <= rt) ? 1 : 0;
        u.pm = rt; u.pn = (e << njs) + j; return true;
    }
    __device__ __forceinline__ void a_ready(const Unit&) const {}
    __device__ __forceinline__ void done(const Unit&) const {}
};

template <class Epi, class Sched, bool ALIGN_EPI = false, bool SP2 = false>
__device__ __forceinline__ void gemm_phase(const int wave_id  , PG8_LAS unsigned char* lds, const Gemm g, const Sched& S, const Epi& E) {
    int lid_; asm volatile("v_mbcnt_lo_u32_b32 %0, -1, 0\n\tv_mbcnt_hi_u32_b32 %0, -1, %0" : "=v"(lid_)); const int tid_ = (wave_id << 6) + lid_;
    const int tid = tid_, wid = wave_id, lane = tid & 63, wr = wid >> 2, wc = wid & 3, fr = lane & 15, fq = lane >> 4;
    const int K = g.K, nt = K / BK;
    unsigned voffA[2], voffB[2];
#pragma unroll
    for (int i = 0; i < 2; ++i) { int R, C; stage_rc(tid * 16 + i * 8192, R, C); const int Rb = Epi::PERM ? ((R & ~31) + perm32(R & 31)) : R;
        voffA[i] = (unsigned)(R * K + C) * 2u; voffB[i] = (unsigned)(Rb * K + C) * 2u; }
    const size_t kstep = (size_t)(BK * 2);
    const size_t hstep = (size_t)HALF * K * 2;
    const size_t tstep = 2 * hstep;
    const unsigned ldsw = (unsigned)wid * 1024u;
    const int aoff = lds_byte(wr * 64 + fr, fq * 8), boff = lds_byte(wc * 32 + fr, fq * 8);
#define PG8_SA(b, h) (((b) * 2 + (h)) * HTB)
#define PG8_SB(b, h) ((4 + (b) * 2 + (h)) * HTB)
#define PG8_STAGE(bufoff, gbase, voff) do { _Pragma("unroll") for (int _i = 0; _i < 2; ++_i) \
        __builtin_amdgcn_global_load_lds((const unsigned*)((const char*)(gbase) + (voff)[_i]), (PG8_LAS unsigned*)(lds + (bufoff) + ldsw + _i * 8192), 16, 0, 0); } while (0)
#define PG8_LDA(dst, b, h) do { _Pragma("unroll") for (int m = 0; m < 4; ++m) _Pragma("unroll") for (int k = 0; k < 2; ++k) dst[m][k] = *(const PG8_LAS bf16x8*)(lds + PG8_SA(b, h) + aoff + m * 2048 + k * 1024); } while (0)
#define PG8_LDB(dst, b, h) do { _Pragma("unroll") for (int n = 0; n < 2; ++n) _Pragma("unroll") for (int k = 0; k < 2; ++k) dst[n][k] = *(const PG8_LAS bf16x8*)(lds + PG8_SB(b, h) + boff + n * 2048 + k * 1024); } while (0)
#define PG8_MMA(ai, bj, At, Bt) do { __builtin_amdgcn_s_setprio(1); _Pragma("unroll") for (int m = 0; m < 4; ++m) _Pragma("unroll") for (int n = 0; n < 2; ++n) _Pragma("unroll") for (int k = 0; k < 2; ++k) \
        acc[ai][bj][m][n] = __builtin_amdgcn_mfma_f32_16x16x32_bf16(Bt[n][k], At[m][k], acc[ai][bj][m][n], 0, 0, 0); __builtin_amdgcn_s_setprio(0); } while (0)
#define PG8_WAIT_V(n) asm volatile("s_waitcnt vmcnt(" #n ")" ::: "memory")
#define PG8_WAIT_L(n) asm volatile("s_waitcnt lgkmcnt(" #n ")" ::: "memory")
#define PG8_BAR __builtin_amdgcn_s_barrier()
#define PG8_SCHED __builtin_amdgcn_sched_barrier(0)
    Unit cur, nxt; int ui = 0;
    if (!S.next(0, cur)) return;
    f32x4 acc[2][2][4][2];
#pragma unroll
    for (int a = 0; a < 2; ++a)
#pragma unroll
        for (int b = 0; b < 2; ++b)
#pragma unroll
            for (int m = 0; m < 4; ++m)
#pragma unroll
                for (int n = 0; n < 2; ++n) acc[a][b][m][n] = (f32x4){0.f, 0.f, 0.f, 0.f};
    bf16x8 At[4][2], B0[2][2], B1[2][2];
    const char* cA = (const char*)g.A + (size_t)cur.pm * tstep; const char* cB = (const char*)g.Bt + (size_t)cur.pn * tstep;
    S.a_ready(cur);
    if constexpr (SP2) {
        PG8_STAGE(PG8_SB(0, 0), cB, voffB); PG8_STAGE(PG8_SB(0, 1), cB + hstep, voffB); PG8_STAGE(PG8_SA(0, 0), cA, voffA); PG8_STAGE(PG8_SA(0, 1), cA + hstep, voffA);
        if (wr == 1) PG8_BAR;
        PG8_WAIT_V(2); PG8_BAR;
        PG8_STAGE(PG8_SB(1, 0), cB + kstep, voffB); PG8_STAGE(PG8_SA(1, 0), cA + kstep, voffA); PG8_STAGE(PG8_SB(1, 1), cB + hstep + kstep, voffB);
        PG8_WAIT_V(6); PG8_BAR;
    } else {
        PG8_STAGE(PG8_SB(0, 0), cB, voffB); PG8_STAGE(PG8_SA(0, 0), cA, voffA); PG8_STAGE(PG8_SB(0, 1), cB + hstep, voffB); PG8_STAGE(PG8_SA(0, 1), cA + hstep, voffA);
        if (wr == 1) PG8_BAR;
        PG8_WAIT_V(4); PG8_BAR;
        PG8_STAGE(PG8_SB(1, 0), cB + kstep, voffB); PG8_STAGE(PG8_SA(1, 0), cA + kstep, voffA); PG8_STAGE(PG8_SB(1, 1), cB + hstep + kstep, voffB);
        PG8_WAIT_V(6); PG8_BAR;
    }
    for (;;) {
        const bool has_next = S.next(ui + 1, nxt);
        const char* nA = has_next ? (const char*)g.A + (size_t)nxt.pm * tstep : cA; const char* nB = has_next ? (const char*)g.Bt + (size_t)nxt.pn * tstep : cB;
        for (int t = 0; t < nt; t += 2) {
            const bool last = (t == nt - 2);
            const char* a1 = cA + (size_t)(t + 1) * kstep;
            const char* a2 = last ? nA : cA + (size_t)(t + 2) * kstep; const char* b2 = last ? nB : cB + (size_t)(t + 2) * kstep;
            const char* a3 = a2 + kstep; const char* b3 = b2 + kstep;
            if (last && has_next) S.a_ready(nxt);
            if constexpr (SP2) {
            PG8_LDB(B0, 0, 0); PG8_LDB(B1, 0, 1); PG8_SCHED; PG8_LDA(At, 0, 0); PG8_STAGE(PG8_SA(1, 1), a1 + hstep, voffA);
            PG8_WAIT_V(8); PG8_WAIT_L(0); PG8_BAR; PG8_MMA(0, 0, At, B0); PG8_MMA(0, 1, At, B1); PG8_BAR; PG8_SCHED;
            PG8_LDA(At, 0, 1); PG8_STAGE(PG8_SB(0, 0), b2, voffB); PG8_STAGE(PG8_SB(0, 1), b2 + hstep, voffB); PG8_STAGE(PG8_SA(0, 0), a2, voffA);
            PG8_WAIT_V(8); PG8_WAIT_L(0); PG8_BAR; PG8_MMA(1, 0, At, B0); PG8_MMA(1, 1, At, B1); PG8_BAR; PG8_SCHED;
            PG8_LDB(B0, 1, 0); PG8_LDB(B1, 1, 1); PG8_SCHED; PG8_LDA(At, 1, 0); PG8_STAGE(PG8_SA(0, 1), a2 + hstep, voffA);
            PG8_WAIT_V(8); PG8_WAIT_L(0); PG8_BAR; PG8_MMA(0, 0, At, B0); PG8_MMA(0, 1, At, B1); PG8_BAR; PG8_SCHED;
            PG8_LDA(At, 1, 1); PG8_STAGE(PG8_SB(1, 0), b3, voffB); PG8_STAGE(PG8_SB(1, 1), b3 + hstep, voffB); PG8_STAGE(PG8_SA(1, 0), a3, voffA);
            PG8_WAIT_V(8); PG8_WAIT_L(0); PG8_BAR; PG8_MMA(1, 0, At, B0); PG8_MMA(1, 1, At, B1); PG8_BAR; PG8_SCHED;
            } else {
            PG8_LDB(B0, 0, 0); PG8_SCHED; PG8_LDA(At, 0, 0); PG8_STAGE(PG8_SA(1, 1), a1 + hstep, voffA);
            PG8_WAIT_L(8); PG8_BAR; PG8_WAIT_L(0); PG8_MMA(0, 0, At, B0); PG8_BAR; PG8_SCHED;
            PG8_LDB(B1, 0, 1); PG8_STAGE(PG8_SB(0, 0), b2, voffB);
            PG8_BAR; PG8_WAIT_L(0); PG8_MMA(0, 1, At, B1); PG8_BAR;
            PG8_LDA(At, 0, 1); PG8_STAGE(PG8_SA(0, 0), a2, voffA);
            PG8_BAR; PG8_WAIT_L(0); PG8_MMA(1, 0, At, B0); PG8_BAR; PG8_SCHED;
            PG8_STAGE(PG8_SB(0, 1), b2 + hstep, voffB);
            PG8_WAIT_V(6); PG8_BAR; PG8_MMA(1, 1, At, B1); PG8_BAR;
            PG8_LDB(B0, 1, 0); PG8_SCHED; PG8_LDA(At, 1, 0); PG8_STAGE(PG8_SA(0, 1), a2 + hstep, voffA);
            PG8_WAIT_L(8); PG8_BAR; PG8_WAIT_L(0); PG8_MMA(0, 0, At, B0); PG8_BAR; PG8_SCHED;
            PG8_LDB(B1, 1, 1); PG8_STAGE(PG8_SB(1, 0), b3, voffB);
            PG8_BAR; PG8_WAIT_L(0); PG8_MMA(0, 1, At, B1); PG8_BAR;
            PG8_LDA(At, 1, 1); PG8_STAGE(PG8_SA(1, 0), a3, voffA);
            PG8_BAR; PG8_WAIT_L(0); PG8_MMA(1, 0, At, B0); PG8_BAR; PG8_SCHED;
            PG8_STAGE(PG8_SB(1, 1), b3 + hstep, voffB);
            PG8_WAIT_V(6); PG8_BAR; PG8_MMA(1, 1, At, B1); PG8_BAR;
            }
        }
        if constexpr (ALIGN_EPI) { if (wr == 0) PG8_BAR; }
        if constexpr (!Epi::AFTER_DRAIN) { E(acc, cur, wr, wc, fr, fq); S.done(cur); }
        if (!has_next) break;
#pragma unroll
        for (int a = 0; a < 2; ++a)
#pragma unroll
            for (int b = 0; b < 2; ++b)
#pragma unroll
                for (int m = 0; m < 4; ++m)
#pragma unroll
                    for (int n = 0; n < 2; ++n) acc[a][b][m][n] = (f32x4){0.f, 0.f, 0.f, 0.f};
        cur = nxt; cA = nA; cB = nB; ++ui;
        if constexpr (ALIGN_EPI) { if (wr == 1) PG8_BAR; }
    }
    PG8_WAIT_V(0);
    if constexpr (!ALIGN_EPI) { if (wr == 0) PG8_BAR; }
    PG8_BAR;
    if constexpr (Epi::AFTER_DRAIN) { E.fused(acc, cur, wr, wc, fr, fq, lds, wid, lane); S.done(cur); }
#undef PG8_SA
#undef PG8_SB
#undef PG8_STAGE
#undef PG8_LDA
#undef PG8_LDB
#undef PG8_MMA
#undef PG8_WAIT_V
#undef PG8_WAIT_L
#undef PG8_BAR
#undef PG8_SCHED
}
}

#ifndef PG8_SP2
#define PG8_SP2 true
#endif
#ifndef PG8_ALIGN
#define PG8_ALIGN true
#endif
constexpr int NWAVES = 8;
constexpr int BATCH = 2, SEQ = 8192, DM = 2048, M = BATCH * SEQ;
constexpr int NQKV = 6144, NQKV_ODD = 6160;
constexpr int NE = 16, FFE = 512;
constexpr int MODW = 6 * DM;
constexpr float EPS = 1e-6f;
constexpr int MAXROWS = 36864;

constexpr size_t MiB = 1u << 20;
constexpr size_t WS_CTL = 0, CTL_ZERO_BYTES = 1 * MiB;
constexpr size_t WS_MOD = 1 * MiB;
constexpr size_t WS_LAM = WS_MOD + 2 * 2 * MODW * 4;
constexpr size_t WS_KMEAN = 2 * MiB;
constexpr size_t WS_WFG = 3 * MiB;
constexpr size_t WS_WRT = 3 * MiB + 128 * 1024;
constexpr size_t WS_ROUTE = 4 * MiB;
constexpr size_t WS_LOGF = 5 * MiB;
constexpr size_t WS_CUM = 6 * MiB;
constexpr size_t WS_KN = 7 * MiB;
constexpr size_t WS_OA0 = 8 * MiB;
constexpr size_t WS_MLO = 4 * MiB + 512 * 1024;
constexpr size_t WS_VM = 6 * MiB;
constexpr size_t WS_WIN = 40 * MiB;
constexpr size_t WS_WOUT = 88 * MiB;
constexpr size_t WS_W13 = 104 * MiB;
constexpr size_t WS_W2 = 232 * MiB;
constexpr size_t WS_H = 296 * MiB;
constexpr size_t WS_QKV = 360 * MiB;
constexpr size_t WS_MRG = 552 * MiB;
constexpr size_t WS_ACT = 616 * MiB;
constexpr size_t WS_OSL = 652 * MiB;
constexpr size_t WS_OA1 = WS_ACT;
constexpr size_t WS_PART = WS_OSL;
constexpr size_t WS_MLP = WS_OSL + 96 * MiB;
constexpr size_t WS_LIST = WS_OSL + 100 * MiB;
constexpr size_t WS_END = 796 * MiB;
constexpr int CW_TMO = 0;
constexpr int CW_CNT = 1024;
constexpr int CW_LC = 1536;
constexpr int CW_Q = 2048;
constexpr int CW_BAR = 4096;

constexpr int RING_OFF = 0, RING_BYTES = 131072;
constexpr int LDSCTL_OFF = RING_BYTES, MISC_OFF = LDSCTL_OFF + 320;
constexpr int LDS_BYTES = 147456;

#define GAS __attribute__((address_space(1)))
#define LAS __attribute__((address_space(3)))
typedef unsigned short bf16;
typedef unsigned v4u __attribute__((ext_vector_type(4)));
typedef unsigned v2u __attribute__((ext_vector_type(2)));
typedef float f32x4 __attribute__((ext_vector_type(4)));
typedef float f32x16 __attribute__((ext_vector_type(16)));
typedef short bf16x8 __attribute__((ext_vector_type(8)));
typedef short s16x4 __attribute__((ext_vector_type(4)));
typedef GAS unsigned gu32;
#define RLX_AGENT __ATOMIC_RELAXED, __HIP_MEMORY_SCOPE_AGENT
#define LDS_WAIT() asm volatile("s_waitcnt lgkmcnt(0)" ::: "memory")
#define VM_WAIT() asm volatile("s_waitcnt vmcnt(0)" ::: "memory")
__device__ __forceinline__ unsigned f2bf(float f) { unsigned u = __builtin_bit_cast(unsigned, f); return (u + 0x7fffu + ((u >> 16) & 1u)) >> 16; }
__device__ __forceinline__ unsigned pk2(float lo, float hi) { return f2bf(lo) | (f2bf(hi) << 16); }
__device__ __forceinline__ float bflo(unsigned w) { return __builtin_bit_cast(float, w << 16); }
__device__ __forceinline__ float bfhi(unsigned w) { return __builtin_bit_cast(float, w & 0xffff0000u); }
#define ARGS_T const __attribute__((address_space(4))) Args&
__device__ __forceinline__ int lane_id_asm() { int l; asm volatile("v_mbcnt_lo_u32_b32 %0, -1, 0\n\tv_mbcnt_hi_u32_b32 %0, -1, %0" : "=v"(l)); return l; }
__device__ __forceinline__ int opaque_tid(int wave) { return (wave << 6) + lane_id_asm(); }
#define DPP_ADD(t, ctrl) (t) += __builtin_bit_cast(float, __builtin_amdgcn_update_dpp(0, __builtin_bit_cast(int, (t)), (ctrl), 0xf, 0xf, true))
__device__ __forceinline__ float wave_sum(float v) {
    float t = v;
    DPP_ADD(t, 0xB1);
    DPP_ADD(t, 0x4E);
    DPP_ADD(t, 0x124);
    DPP_ADD(t, 0x128);
    const float r0 = __builtin_bit_cast(float, __builtin_amdgcn_readlane(__builtin_bit_cast(int, t), 0)), r1 = __builtin_bit_cast(float, __builtin_amdgcn_readlane(__builtin_bit_cast(int, t), 16));
    const float r2 = __builtin_bit_cast(float, __builtin_amdgcn_readlane(__builtin_bit_cast(int, t), 32)), r3 = __builtin_bit_cast(float, __builtin_amdgcn_readlane(__builtin_bit_cast(int, t), 48));
    return (r0 + r1) + (r2 + r3);
}
__device__ __forceinline__ float wave_max(float v) {
#pragma unroll
    for (int o = 1; o < 64; o <<= 1) v = fmaxf(v, __shfl_xor(v, o));
    return v;
}
#define XB_TMO      128
#define XB_XCNT(j)  (256  + 64 * (j))
#define XB_XSUB(j)  (1280 + 64 * (j))
#define XB_XGEN(j)  (2304 + 64 * (j))
#define XB_TOP      3328
#define XB_TOPGEN   3392
#define XCD_BAR_WORDS 3456
#define XB_SPIN_CAP (1u << 18)

__device__ __forceinline__ unsigned xb_ld(unsigned* p)              { return __hip_atomic_load(p, __ATOMIC_RELAXED, __HIP_MEMORY_SCOPE_AGENT); }
__device__ __forceinline__ unsigned xb_add(unsigned* p, unsigned v) { return __hip_atomic_fetch_add(p, v, __ATOMIC_RELAXED, __HIP_MEMORY_SCOPE_AGENT); }
__device__ __forceinline__ unsigned xb_xcc_id() { return (unsigned)__builtin_amdgcn_s_getreg((3 << 11) | 20) & 0xFu; }
#define XB_SPIN(cond, bar) do { unsigned _sp = 0; while (cond) { __builtin_amdgcn_s_sleep(1); \
    if ((++_sp & 255u) == 0u) { if (xb_ld(&(bar)[XB_TMO])) break; if (_sp > XB_SPIN_CAP) { atomicAdd(&(bar)[XB_TMO], 1u); break; } } } } while (0)

struct XcdBarrier {
    unsigned* bar; unsigned x;
    volatile LAS unsigned* st;
    int w;
};

__device__ __forceinline__ XcdBarrier xcd_barrier_post(unsigned* bar, volatile LAS unsigned* st) {
    XcdBarrier b; b.bar = bar; b.x = xb_xcc_id(); b.st = st;
    if (threadIdx.x == 0) (void)xb_add(&bar[XB_XCNT(b.x)], 1u);
    return b;
}
__device__ __forceinline__ void xcd_barrier_complete(unsigned* bar, unsigned x, unsigned& nloc, unsigned& nx) {
    const unsigned G = gridDim.x * gridDim.y * gridDim.z;
    unsigned sum, cnt, mine, sp = 0u;
    for (;;) {
        sum = 0u; cnt = 0u; mine = 0u;
#pragma unroll
        for (unsigned j = 0; j < 16; ++j) { const unsigned c = xb_ld(&bar[XB_XCNT(j)]); sum += c; cnt += (c > 0u) ? 1u : 0u; mine = (j == x) ? c : mine; }
        if (sum == G) break;
        __builtin_amdgcn_s_sleep(1);
        if ((++sp & 255u) == 0u) { if (xb_ld(&bar[XB_TMO])) break; if (sp > XB_SPIN_CAP) { atomicAdd(&bar[XB_TMO], 1u); break; } }
    }
    nloc = mine > 0u ? mine : 1u; nx = cnt > 0u ? cnt : 1u;
}

__device__ __forceinline__ void xcd_barrier(const XcdBarrier& b) {
    asm volatile("s_waitcnt vmcnt(0)" ::: "memory");
    __syncthreads();
    if (b.w == 0 && lane_id_asm() == 0) {
        unsigned* bar = b.bar;
        __builtin_amdgcn_s_waitcnt(0);
        unsigned nloc = b.st[0], nx = b.st[1];
        if (nloc == 0u) { xcd_barrier_complete(bar, b.x, nloc, nx); b.st[0] = nloc; b.st[1] = nx; }
        const unsigned old = xb_add(&bar[XB_XSUB(b.x)], 1u);
        const unsigned gen = old / nloc;
        if (old + 1u == (gen + 1u) * nloc) {
            __builtin_amdgcn_fence(__ATOMIC_RELEASE, "agent");
            asm volatile("s_waitcnt vmcnt(0)" ::: "memory");
            const unsigned og = xb_add(&bar[XB_TOP], 1u);
            const unsigned tg = og / nx;
            if (og + 1u == (tg + 1u) * nx) xb_add(&bar[XB_TOPGEN], 1u);
            else XB_SPIN(xb_ld(&bar[XB_TOPGEN]) == tg, bar);
            __builtin_amdgcn_fence(__ATOMIC_ACQUIRE, "agent");
            xb_add(&bar[XB_XGEN(b.x)], 1u);
            asm volatile("s_waitcnt vmcnt(0)" ::: "memory");
        } else {
            XB_SPIN(xb_ld(&bar[XB_XGEN(b.x)]) == gen, bar);
            __builtin_amdgcn_fence(__ATOMIC_ACQUIRE, "agent");
            asm volatile("s_waitcnt vmcnt(0)" ::: "memory");
        }
    }
    __syncthreads();
}
struct Args { const float* in[22]; float* out; unsigned char* ws; int ph_lo, ph_hi; };
struct Frame { LAS unsigned char* lds; volatile LAS unsigned* MISC; gu32* ctl; int tid, lane, wave, vcu, G; };
enum { I_X = 0, I_C = 1, I_ADAW = 2, I_ADAB = 3, I_ANG = 4, I_FNG = 5, I_WINE = 6, I_WOUTE = 7, I_LQ1 = 8, I_LK1 = 9, I_LQ2 = 10, I_LK2 = 11, I_SUBLN = 12,
       I_WINO = 13, I_BF = 14, I_WOUTO = 15, I_RW = 16, I_RB = 17, I_W1 = 18, I_W3 = 19, I_W2 = 20, I_FING = 21 };

__device__ __forceinline__ void transpose_item(const float* W, int ldw, int K, int ncols, bf16* WT, int row_off, int rs, LAS float* scr, int item, int lane) {
    const int nblk = ncols / 32, kb = item / nblk, nb = item % nblk, k0 = 64 * kb, n0 = 32 * nb;
    float t[32];
    { const float* wp = W + (size_t)(k0 + (lane >> 5)) * ldw + n0 + (lane & 31);
#pragma unroll
      for (int i = 0; i < 32; ++i) t[i] = wp[(size_t)(2 * i) * ldw]; }
#pragma unroll
    for (int i = 0; i < 32; ++i) scr[(2 * i + (lane >> 5)) * 33 + (lane & 31)] = t[i];
    LDS_WAIT(); asm volatile("" ::: "memory");
    const int c = lane & 7;
#pragma unroll
    for (int j = 0; j < 4; ++j) { const int n = (lane >> 3) + 8 * j; const LAS float* s = scr + (8 * c) * 33 + n;
        v4u o; o.x = pk2(s[0 * 33], s[1 * 33]); o.y = pk2(s[2 * 33], s[3 * 33]); o.z = pk2(s[4 * 33], s[5 * 33]); o.w = pk2(s[6 * 33], s[7 * 33]);
        *(GAS v4u*)(WT + (size_t)(row_off + (n0 + n) * rs) * K + k0 + 8 * c) = o; }
    LDS_WAIT(); asm volatile("" ::: "memory");
}
constexpr int CV_IN = 32 * 192, CV_OUT = 32 * 64, CV_MOEL = 16 * 512;
constexpr int CV_A = CV_IN + 2 * CV_OUT + 3 * CV_MOEL, CV_B = 3 * CV_MOEL;
constexpr int CV_PER_WG = 128, CV_A_WG = CV_A / CV_PER_WG, CV_B_WG = CV_B / CV_PER_WG;
static_assert(CV_A % CV_PER_WG == 0 && CV_B % CV_PER_WG == 0, "conversion deal");
__device__ __forceinline__ void convert_moe(ARGS_T A, int l, int r  , LAS float* scr, int lane) {
    unsigned char* ws = A.ws; const int which = r / CV_MOEL, rr = r - which * CV_MOEL, e = rr >> 9, le = l * 16 + e;
    if (which < 2) transpose_item(A.in[which ? I_W3 : I_W1] + (size_t)le * DM * FFE, FFE, DM, FFE, (bf16*)(ws + WS_W13) + (size_t)l * 16384 * DM, e * 1024 + which, 2, scr, rr & 511, lane);
    else transpose_item(A.in[I_W2] + (size_t)le * FFE * DM, DM, FFE, DM, (bf16*)(ws + WS_W2) + (size_t)l * 32768 * FFE, e * 2048, 1, scr, rr & 511, lane);
}
__device__ __forceinline__ void convert_item_A(ARGS_T A, int r, LAS float* scr, int lane) {
    unsigned char* ws = A.ws;
    if (r < CV_IN) { transpose_item(A.in[I_WINO], NQKV_ODD, DM, NQKV, (bf16*)(ws + WS_WIN) + (size_t)NQKV * DM, 0, 1, scr, r, lane); return; } r -= CV_IN;
    if (r < CV_OUT) { transpose_item(A.in[I_WOUTE], DM, DM, DM, (bf16*)(ws + WS_WOUT), 0, 1, scr, r, lane); return; } r -= CV_OUT;
    if (r < CV_OUT) { transpose_item(A.in[I_WOUTO], DM, DM, DM, (bf16*)(ws + WS_WOUT) + (size_t)DM * DM, 0, 1, scr, r, lane); return; } r -= CV_OUT;
    convert_moe(A, 0, r, scr, lane);
}
template <int LIST>
__device__ __forceinline__ void convert_wg_item(ARGS_T A, LAS unsigned char* lds, int wave, int wgitem) {
    const int lane = lane_id_asm();
    LAS float* scr = (LAS float*)(lds + wave * 16384);
    const int base = wgitem * CV_PER_WG + wave * (CV_PER_WG / NWAVES);
    for (int k = 0; k < CV_PER_WG / NWAVES; ++k) { if (LIST == 0) convert_item_A(A, base + k, scr, lane); else convert_moe(A, 1, base + k, scr, lane); }
}
__device__ __forceinline__ void p0_prologue(ARGS_T A, const Frame& F0) {
    Frame F = F0; F.tid = opaque_tid(F0.wave); F.lane = F.tid & 63; F.wave = __builtin_amdgcn_readfirstlane(F.tid >> 6);
    unsigned char* ws = A.ws;
    for (int it = blockIdx.x; it < 96; it += F.G) {
        LAS float* cond = (LAS float*)(F.lds); LAS float* red = (LAS float*)(F.lds + 16384);
        for (int i = F.tid; i < 4096; i += 512) { const float cv = A.in[I_C][i]; cond[i] = cv / (1.0f + __expf(-cv)); }
        __syncthreads();
        const int l = it / 48, cg = it % 48;
        const float* W = A.in[I_ADAW] + (size_t)l * DM * MODW + cg * 256 + 4 * F.lane;
        f32x4 a0 = {0.f, 0.f, 0.f, 0.f}, a1 = {0.f, 0.f, 0.f, 0.f};
        const int kb = 256 * F.wave;
#pragma unroll 8
        for (int k = 0; k < 256; ++k) { const f32x4 w = *(const f32x4*)(W + (size_t)(kb + k) * MODW); a0 += cond[kb + k] * w; a1 += cond[2048 + kb + k] * w; }
        *(LAS f32x4*)(red + (F.wave * 2 + 0) * 256 + 4 * F.lane) = a0; *(LAS f32x4*)(red + (F.wave * 2 + 1) * 256 + 4 * F.lane) = a1;
        __syncthreads();
        { const int b = F.tid >> 8, n = F.tid & 255; float s = A.in[I_ADAB][l * MODW + cg * 256 + n];
#pragma unroll
          for (int w = 0; w < 8; ++w) s += red[(w * 2 + b) * 256 + n];
          ((float*)(ws + WS_MOD))[(l * 2 + b) * MODW + cg * 256 + n] = s; }
        __syncthreads();
    }
    if (blockIdx.x == 0 && F.tid == 0) { float s1 = 0.f, s2 = 0.f;
        for (int i = 0; i < 64; ++i) { s1 += A.in[I_LQ1][i] * A.in[I_LK1][i]; s2 += A.in[I_LQ2][i] * A.in[I_LK2][i]; }
        *(float*)(ws + WS_LAM) = __expf(s1) - __expf(s2) + 0.2f; }
    for (int i = blockIdx.x * 512 + F.tid; i < 16 * DM; i += F.G * 512) { const int j = i >> 11, k = i & 2047;
        ((float*)(ws + WS_WFG))[i] = A.in[I_WINO][(size_t)k * NQKV_ODD + NQKV + j]; ((float*)(ws + WS_WRT))[i] = A.in[I_RW][k * 16 + j]; }
    LAS float* scr = (LAS float*)(F.lds + F.wave * 16384);
    const int gw = F.vcu * NWAVES + F.wave, NGW = F.G * NWAVES;
    for (int it = gw; it < CV_IN; it += NGW) transpose_item(A.in[I_WINE], NQKV, DM, NQKV, (bf16*)(ws + WS_WIN), 0, 1, scr, it, F.lane);
}
template <int MODE>
__device__ __forceinline__ void norm_phase(ARGS_T A, const Frame& F0, int l) {
    Frame F = F0; F.tid = opaque_tid(F0.wave); F.lane = F.tid & 63; F.wave = __builtin_amdgcn_readfirstlane(F.tid >> 6);
    unsigned char* ws = A.ws;
    constexpr bool SIDE = (MODE == 1 || MODE == 2), COMB = (MODE == 2 || MODE == 3);
    LAS float* WT = (LAS float*)F.lds;
    LAS unsigned* lcnt = (LAS unsigned*)(F.lds + RING_BYTES + 1024); LAS unsigned* lbase = lcnt + 16; LAS unsigned* rinfo = lcnt + 32;
    if (MODE == 1 && F.tid < 16) lcnt[F.tid] = 0u;
    if (SIDE) { const f32x4* src = (const f32x4*)(ws + (MODE == 1 ? WS_WRT : WS_WFG));
        for (int i = F.tid; i < 16 * DM / 4; i += 512) *(LAS f32x4*)(WT + 4 * i) = src[i];
        __syncthreads(); }
    int krow = 0;
    const float* modl = (const float*)(ws + WS_MOD) + (size_t)l * 2 * MODW;
    const float* gain = MODE == 3 ? A.in[I_FING] : (MODE == 1 ? A.in[I_FNG] + l * DM : A.in[I_ANG] + l * DM);
    const int lprev = MODE == 1 ? l : (MODE == 3 ? 1 : 0);
    const float* xsrc = (MODE == 0 || lprev == 0) ? A.in[I_X] : A.out;
    const float* modprev = (const float*)(ws + WS_MOD) + (size_t)lprev * 2 * MODW;
    const bf16* Y = (const bf16*)(ws + WS_H);
    const unsigned* route = (const unsigned*)(ws + WS_ROUTE);
    const bf16* OSL = (const bf16*)(ws + WS_OSL);
    bf16* H = (bf16*)(ws + (MODE == 1 ? WS_MRG : WS_H));
    const int gw = F.vcu * NWAVES + F.wave, NGW = F.G * NWAVES, lane = F.lane;
    for (int m = gw; m < M; m += NGW) {
        const int b = m >> 13;
        f32x4 v[8];
        { const f32x4* xr = (const f32x4*)(xsrc + (size_t)m * DM) + lane;
#pragma unroll
          for (int j = 0; j < 8; ++j) v[j] = xr[64 * j]; }
        if (MODE != 0) {
            const v2u* yp = (const v2u*)(Y + (size_t)m * DM) + lane; const f32x4* g1 = (const f32x4*)(modprev + (size_t)b * MODW + 2 * DM) + lane;
#pragma unroll
            for (int j = 0; j < 8; ++j) { const v2u a = yp[64 * j]; const f32x4 g = g1[64 * j];
                v[j].x += g.x * bflo(a.x); v[j].y += g.y * bfhi(a.x); v[j].z += g.z * bflo(a.y); v[j].w += g.w * bfhi(a.y); }
        }
        if (COMB) {
            const unsigned* rt = route + (size_t)m * 6;
            const float w0 = __builtin_bit_cast(float, rt[2]), w1 = __builtin_bit_cast(float, rt[3]);
            const v2u* o0 = (const v2u*)(OSL + (size_t)rt[4] * DM) + lane; const v2u* o1 = (const v2u*)(OSL + (size_t)rt[5] * DM) + lane;
            const f32x4* g2 = (const f32x4*)(modprev + (size_t)b * MODW + 5 * DM) + lane;
#pragma unroll
            for (int j = 0; j < 8; ++j) { const v2u a = o0[64 * j], c = o1[64 * j]; const f32x4 g = g2[64 * j];
                v[j].x += g.x * (w0 * bflo(a.x) + w1 * bflo(c.x)); v[j].y += g.y * (w0 * bfhi(a.x) + w1 * bfhi(c.x));
                v[j].z += g.z * (w0 * bflo(a.y) + w1 * bflo(c.y)); v[j].w += g.w * (w0 * bfhi(a.y) + w1 * bfhi(c.y)); }
            if (MODE == 2) { f32x4* xw = (f32x4*)(A.out + (size_t)m * DM) + lane;
#pragma unroll
                for (int j = 0; j < 8; ++j) xw[64 * j] = v[j]; }
        }
        float ss = 0.f;
#pragma unroll
        for (int j = 0; j < 8; ++j) ss += (v[j].x * v[j].x + v[j].y * v[j].y) + (v[j].z * v[j].z + v[j].w * v[j].w);
        const float rstd = __builtin_amdgcn_rsqf(wave_sum(ss) * (1.0f / DM) + EPS);
        if (MODE == 3) {
            f32x4* ow = (f32x4*)(A.out + (size_t)m * DM) + lane; const f32x4* gp = (const f32x4*)gain + lane;
#pragma unroll
            for (int j = 0; j < 8; ++j) ow[64 * j] = v[j] * rstd * gp[64 * j];
            continue;
        }
        { const f32x4* gp = (const f32x4*)gain + lane;
          const f32x4* shp = (const f32x4*)(modl + (size_t)b * MODW + (MODE == 1 ? 3 : 0) * DM) + lane;
          const f32x4* scp = (const f32x4*)(modl + (size_t)b * MODW + (MODE == 1 ? 4 : 1) * DM) + lane;
          v2u* hw = (v2u*)(H + (size_t)m * DM) + lane;
#pragma unroll
          for (int j = 0; j < 8; ++j) { v[j] = v[j] * rstd * gp[64 * j] * (1.0f + scp[64 * j]) + shp[64 * j];
              v2u o; o.x = pk2(v[j].x, v[j].y); o.y = pk2(v[j].z, v[j].w); hw[64 * j] = o; } }
        if (SIDE) {
            float z = 0.f;
#pragma unroll 1
            for (int q = 0; q < 16; ++q) { float d = 0.f;
#pragma unroll
                for (int j = 0; j < 8; ++j) { const f32x4 w = *(const LAS f32x4*)(WT + q * DM + 256 * j + 4 * lane); d += (v[j].x * w.x + v[j].y * w.y) + (v[j].z * w.z + v[j].w * w.w); }
                d = wave_sum(d); if (lane == q) z = d; }
            if (MODE == 2) {
                if (lane < 16) { z += A.in[I_BF][lane]; const float r = z >= 0.f ? -log1pf(__expf(-z)) : z - log1pf(__expf(z));
                    ((float*)(ws + WS_LOGF))[(size_t)m * 16 + lane] = r; }
            } else {
                float aff[16], sel[16];
#pragma unroll
                for (int q = 0; q < 16; ++q) { const float lgq = __builtin_bit_cast(float, __builtin_amdgcn_readlane(__builtin_bit_cast(int, z), q)); aff[q] = __builtin_amdgcn_rcpf(1.0f + __builtin_amdgcn_exp2f(-1.4426950408889634f * lgq)); sel[q] = aff[q] + A.in[I_RB][q]; }
                int best = 0; float bs = -3.0e38f;
#pragma unroll
                for (int g = 0; g < 4; ++g) { const float a = sel[4 * g], bq = sel[4 * g + 1], c = sel[4 * g + 2], d = sel[4 * g + 3];
                    const float t2 = fmaxf(fmaxf(fmaxf(a + bq, a + c), fmaxf(a + d, bq + c)), fmaxf(bq + d, c + d));
                    if (t2 > bs) { bs = t2; best = g; } }
                float cs[4], ca[4];
#pragma unroll
                for (int i = 0; i < 4; ++i) { cs[i] = sel[i]; ca[i] = aff[i]; }
#pragma unroll
                for (int g = 1; g < 4; ++g) if (best == g) {
#pragma unroll
                    for (int i = 0; i < 4; ++i) { cs[i] = sel[4 * g + i]; ca[i] = aff[4 * g + i]; } }
                int i1 = 0; float s1 = cs[0], a1 = ca[0];
#pragma unroll
                for (int i = 1; i < 4; ++i) if (cs[i] > s1) { s1 = cs[i]; a1 = ca[i]; i1 = i; }
                int i2 = -1; float s2 = -3.0e38f, a2 = 0.f;
#pragma unroll
                for (int i = 0; i < 4; ++i) if (i != i1 && cs[i] > s2) { s2 = cs[i]; a2 = ca[i]; i2 = i; }
                const int e0 = best * 4 + i1, e1 = best * 4 + i2; const float inv = __builtin_amdgcn_rcpf(a1 + a2);
                if (lane == 0) {
                    const unsigned p0 = __hip_atomic_fetch_add((unsigned*)(lcnt + e0), 1u, __ATOMIC_RELAXED, __HIP_MEMORY_SCOPE_WORKGROUP), p1 = __hip_atomic_fetch_add((unsigned*)(lcnt + e1), 1u, __ATOMIC_RELAXED, __HIP_MEMORY_SCOPE_WORKGROUP);
                    unsigned* rt = (unsigned*)(ws + WS_ROUTE) + (size_t)m * 6;
                    rt[0] = (unsigned)e0; rt[1] = (unsigned)e1; rt[2] = __builtin_bit_cast(unsigned, a1 * inv); rt[3] = __builtin_bit_cast(unsigned, a2 * inv);
                    LAS unsigned* ri = rinfo + (F.wave * 16 + (krow & 15)) * 4; ri[0] = (unsigned)e0; ri[1] = (unsigned)e1; ri[2] = p0; ri[3] = p1; }
                ++krow;
            }
        }
    }
    if (MODE == 1) {
        __syncthreads();
        if (F.tid < 16) lbase[F.tid] = __hip_atomic_fetch_add((unsigned*)(F.ctl + CW_CNT + 64 * l) + F.tid, lcnt[F.tid], RLX_AGENT);
        __syncthreads();
        if (F.tid < 128) { const int w = F.tid >> 4, k = F.tid & 15; const int m = (F.vcu * NWAVES + w) + k * NGW;
            if (m < M) { const LAS unsigned* ri = rinfo + (w * 16 + k) * 4; unsigned* rt = (unsigned*)(ws + WS_ROUTE) + (size_t)m * 6; rt[4] = lbase[ri[0]] + ri[2]; rt[5] = lbase[ri[1]] + ri[3]; } }
    }
}
__device__ __forceinline__ void scan_phase(ARGS_T A, const Frame& F0) {
    Frame F = F0; F.tid = opaque_tid(F0.wave); F.lane = F.tid & 63; F.wave = __builtin_amdgcn_readfirstlane(F.tid >> 6);
    const float* LOGF = (const float*)(A.ws + WS_LOGF); float* CUM = (float*)(A.ws + WS_CUM);
    LAS float* wt = (LAS float*)F.lds;
    for (int u = blockIdx.x; u < BATCH * 16; u += F.G) {
        const int b = u >> 4, h = u & 15, s0 = F.tid * 16;
        float v[16]; float run = 0.f;
#pragma unroll
        for (int i = 0; i < 16; ++i) { run += LOGF[(size_t)(b * SEQ + s0 + i) * 16 + h]; v[i] = run; }
        float inc = run;
#pragma unroll
        for (int o = 1; o < 64; o <<= 1) { const float t = __shfl_up(inc, o); if (F.lane >= o) inc += t; }
        if (F.lane == 63) wt[F.wave] = inc;
        __syncthreads();
        float base = inc - run;
        for (int w = 0; w < F.wave; ++w) base += wt[w];
        float* dst = CUM + (size_t)(b * 16 + h) * SEQ + s0;
#pragma unroll
        for (int i = 0; i < 16; ++i) dst[i] = -(base + v[i]) * 11.313708498984761f;
        __syncthreads();
    }
}
__device__ __forceinline__ void kmean_phase(ARGS_T A, const Frame& F0) {
    Frame F = F0; F.tid = opaque_tid(F0.wave); F.lane = F.tid & 63; F.wave = __builtin_amdgcn_readfirstlane(F.tid >> 6);
    const bf16* QKV = (const bf16*)(A.ws + WS_QKV); float* KM = (float*)(A.ws + WS_KMEAN);
    LAS float* red = (LAS float*)F.lds;
    for (int u = blockIdx.x; u < BATCH * 8 * 32; u += F.G) {
        const int b = u >> 8, h = (u >> 5) & 7, blk = u & 31, c = F.tid & 15, rg = F.tid >> 4;
        float s[8] = {0.f, 0.f, 0.f, 0.f, 0.f, 0.f, 0.f, 0.f};
#pragma unroll
        for (int i = 0; i < 8; ++i) { const v4u w = *(const v4u*)(QKV + (size_t)(b * SEQ + blk * 256 + rg + 32 * i) * NQKV + 4096 + h * 128 + 8 * c);
            s[0] += bflo(w.x); s[1] += bfhi(w.x); s[2] += bflo(w.y); s[3] += bfhi(w.y); s[4] += bflo(w.z); s[5] += bfhi(w.z); s[6] += bflo(w.w); s[7] += bfhi(w.w); }
#pragma unroll
        for (int i = 0; i < 8; ++i) red[rg * 128 + 8 * c + i] = s[i];
        __syncthreads();
        if (F.tid < 128) { float t = 0.f;
#pragma unroll
            for (int r = 0; r < 32; ++r) t += red[r * 128 + F.tid];
            KM[(size_t)u * 128 + F.tid] = t * (1.0f / 256.0f); }
        __syncthreads();
    }
}
__device__ __forceinline__ void gather_phase(ARGS_T A, const Frame& F0, int l) {
    Frame F = F0; F.tid = opaque_tid(F0.wave); F.lane = F.tid & 63; F.wave = __builtin_amdgcn_readfirstlane(F.tid >> 6);
    const unsigned* cnt = (const unsigned*)(F.ctl + CW_CNT + 64 * l);
    unsigned basev = 0;
    { unsigned t = 0;
#pragma unroll
      for (int e = 0; e < 16; ++e) { if (F.lane == e) basev = t * 256u; t += (cnt[e] + 255u) >> 8; } }
    unsigned* route = (unsigned*)(A.ws + WS_ROUTE); const bf16* H = (const bf16*)(A.ws + WS_MRG); bf16* HS = (bf16*)(A.ws + WS_QKV);
    const int gw = F.vcu * NWAVES + F.wave, NGW = F.G * NWAVES;
    for (int m = gw; m < M; m += NGW) {
        unsigned* rt = route + (size_t)m * 6;
        const unsigned e0 = rt[0], e1 = rt[1], p0 = rt[4], p1 = rt[5];
        const unsigned s0 = __shfl(basev, (int)e0) + p0, s1 = __shfl(basev, (int)e1) + p1;
        const v4u* src = (const v4u*)(H + (size_t)m * DM) + F.lane; v4u* d0 = (v4u*)(HS + (size_t)s0 * DM) + F.lane; v4u* d1 = (v4u*)(HS + (size_t)s1 * DM) + F.lane;
        v4u x[4];
#pragma unroll
        for (int j = 0; j < 4; ++j) x[j] = src[64 * j];
#pragma unroll
        for (int j = 0; j < 4; ++j) { d0[64 * j] = x[j]; d1[64 * j] = x[j]; }
        asm volatile("" ::: "memory");
        if (F.lane == 0) { rt[4] = s0; rt[5] = s1; }
    }
}
template <int L>
__device__ __forceinline__ void knorm_phase(ARGS_T A, const Frame& F0) {
    Frame F = F0; F.tid = opaque_tid(F0.wave); F.lane = F.tid & 63; F.wave = __builtin_amdgcn_readfirstlane(F.tid >> 6);
    const bf16* QKV = (const bf16*)(A.ws + WS_QKV); float* KN = (float*)(A.ws + WS_KN);
    constexpr int DQ = L == 0 ? 64 : 128;
    for (int it = blockIdx.x; it < (L == 0 ? 384 : 256); it += F.G) {
        const int u = it >> 3, tg = it & 7;
        int b, col, nch = DQ / 8;
        if (L == 0) { if (u < 32) { b = u >> 4; col = 1024 + ((u >> 1) & 7) * 128 + (u & 1) * 64; } else { b = (u - 32) >> 3; col = 4096 + ((u - 32) & 7) * 128; nch = 16; } }
        else { b = u >> 4; col = 2048 + (u & 15) * 128; }
        float mx = 0.f;
#pragma unroll
        for (int kk = 0; kk < 2; ++kk) { const bf16* kr = QKV + (size_t)(b * SEQ + tg * 1024 + 2 * F.tid + kk) * NQKV + col; float s2 = 0.f;
#pragma unroll 8
            for (int c = 0; c < nch; ++c) { const v4u w = *(const v4u*)(kr + 8 * c);
                s2 += (bflo(w.x) * bflo(w.x) + bfhi(w.x) * bfhi(w.x)) + (bflo(w.y) * bflo(w.y) + bfhi(w.y) * bfhi(w.y)) + (bflo(w.z) * bflo(w.z) + bfhi(w.z) * bfhi(w.z)) + (bflo(w.w) * bflo(w.w) + bfhi(w.w) * bfhi(w.w)); }
            mx = fmaxf(mx, s2); }
#pragma unroll
        for (int o = 1; o < 32; o <<= 1) mx = fmaxf(mx, __shfl_xor(mx, o));
        if ((F.tid & 31) == 0) KN[(size_t)u * 128 + tg * 16 + (F.tid >> 5)] = sqrtf(mx) * 1.001f;
    }
}
#ifndef NAIVE_ATTN
#define NAIVE_ATTN 0
#endif
#if NAIVE_ATTN
template <int DQ>
__device__ __forceinline__ void naive_span(const bf16* Kp, const bf16* Vp, const LAS float* q, int kb, int ke, int pos, float scale, float slope, const float* CUMrow, float cq,
                                           float& mrun, float& lrun, float& o0, float& o1, int lane) {
    for (int kc = kb; kc < ke; kc += 64) {
        const int key = kc + lane;
        float s = 0.f;
        { const bf16* kr = Kp + (size_t)key * NQKV;
#pragma unroll
          for (int c = 0; c < DQ / 8; ++c) { const v4u w = *(const v4u*)(kr + 8 * c); const f32x4 qa = *(const LAS f32x4*)(q + 8 * c), qb = *(const LAS f32x4*)(q + 8 * c + 4);
              s += (qa.x * bflo(w.x) + qa.y * bfhi(w.x)) + (qa.z * bflo(w.y) + qa.w * bfhi(w.y)) + (qb.x * bflo(w.z) + qb.y * bfhi(w.z)) + (qb.z * bflo(w.w) + qb.w * bfhi(w.w)); } }
        s = s * scale + (CUMrow ? (CUMrow[key] - cq) * scale : slope * (float)(key - pos));
        if (key > pos || key >= ke) s = -__builtin_inff();
        const float cm = wave_max(s);
        if (cm == -__builtin_inff()) continue;
        const float mn = fmaxf(mrun, cm), al = __expf(mrun - mn), p = __expf(s - mn);
        lrun = lrun * al + wave_sum(p); o0 *= al; o1 *= al; mrun = mn;
        for (int j = 0; j < 64; ++j) { const float pj = __shfl(p, j); const unsigned vv = *(const unsigned*)(Vp + (size_t)(kc + j) * NQKV + 2 * lane); o0 += pj * bflo(vv); o1 += pj * bfhi(vv); }
    }
}
template <int VAR>
__global__ void __launch_bounds__(256) naive_attn(const bf16* __restrict__ QKV, bf16* __restrict__ MRG, const float* __restrict__ CUM, const float* __restrict__ KMEAN,
                                                  const float* __restrict__ lamp, const float* __restrict__ subg) {
    __shared__ float qs[4][128];
    constexpr int NH = VAR == 2 ? 16 : 8;
    const int wave = threadIdx.x >> 6, lane = threadIdx.x & 63;
    const long id = (long)blockIdx.x * 4 + wave; const int m = (int)(id / NH), hh = (int)(id % NH), b = m >> 13, pos = m & 8191;
    const bf16* row = QKV + (size_t)m * NQKV; const bf16* base = QKV + (size_t)b * SEQ * NQKV;
    LAS float* q = (LAS float*)qs[wave];
    if (VAR == 0) {
        const float slope = exp2f(-(2.0f * hh + 1.0f) * 0.5f);
        float O0[2], O1[2];
#pragma unroll
        for (int mp = 0; mp < 2; ++mp) {
            q[lane] = bflo((unsigned)row[hh * 128 + mp * 64 + lane]); __builtin_amdgcn_wave_barrier(); LDS_WAIT();
            float mr = -1e30f, lr = 0.f, o0 = 0.f, o1 = 0.f;
            naive_span<64>(base + 1024 + hh * 128 + mp * 64, base + 2048 + hh * 128, q, 0, pos + 1, pos, 0.125f, slope, nullptr, 0.f, mr, lr, o0, o1, lane);
            O0[mp] = o0 / lr; O1[mp] = o1 / lr; __builtin_amdgcn_wave_barrier();
        }
        const float lam = *lamp; const float a0 = O0[0] - lam * O0[1], a1 = O1[0] - lam * O1[1];
        const float r = 1.0f / sqrtf(wave_sum(a0 * a0 + a1 * a1) * (1.0f / 128.0f) + EPS);
        *(unsigned*)(MRG + (size_t)m * DM + hh * 128 + 2 * lane) = pk2(a0 * r * subg[2 * lane] * 0.8f, a1 * r * subg[2 * lane + 1] * 0.8f);
    } else if (VAR == 1) {
        const float slope = exp2f(-(float)(hh + 1));
        q[lane] = bflo((unsigned)row[3072 + hh * 128 + lane]); q[64 + lane] = bflo((unsigned)row[3072 + hh * 128 + 64 + lane]); __builtin_amdgcn_wave_barrier(); LDS_WAIT();
        const int own = pos >> 8;
        float g = -3.0e38f;
        if (lane < own) { const float* km = KMEAN + ((size_t)(b * 8 + hh) * 32 + lane) * 128; float s = 0.f;
            for (int d = 0; d < 128; ++d) s += q[d] * km[d]; g = s; }
        unsigned long long selm = 0ull;
        for (int t = 0; t < 3 && t < own; ++t) { const float mx = wave_max(g); const unsigned long long bal = __ballot(g == mx); const int pick = __ffsll((long long)bal) - 1;
            selm |= 1ull << pick; if (lane == pick) g = -3.0e38f; }
        float mr = -1e30f, lr = 0.f, o0 = 0.f, o1 = 0.f;
        for (int n = 0; n < own; ++n) if ((selm >> n) & 1ull)
            naive_span<128>(base + 4096 + hh * 128, base + 5120 + hh * 128, q, n * 256, n * 256 + 256, pos, 0.08838834764831845f, slope, nullptr, 0.f, mr, lr, o0, o1, lane);
        naive_span<128>(base + 4096 + hh * 128, base + 5120 + hh * 128, q, own * 256, pos + 1, pos, 0.08838834764831845f, slope, nullptr, 0.f, mr, lr, o0, o1, lane);
        *(unsigned*)(MRG + (size_t)m * DM + 1024 + hh * 128 + 2 * lane) = pk2(o0 / lr, o1 / lr);
    } else {
        q[lane] = bflo((unsigned)row[hh * 128 + lane]); q[64 + lane] = bflo((unsigned)row[hh * 128 + 64 + lane]); __builtin_amdgcn_wave_barrier(); LDS_WAIT();
        const float* cr = CUM + (size_t)(b * 16 + hh) * SEQ;
        float mr = -1e30f, lr = 0.f, o0 = 0.f, o1 = 0.f;
        naive_span<128>(base + 2048 + hh * 128, base + 4096 + hh * 128, q, 0, pos + 1, pos, 0.08838834764831845f, 0.f, cr, cr[pos], mr, lr, o0, o1, lane);
        *(unsigned*)(MRG + (size_t)m * DM + hh * 128 + 2 * lane) = pk2(o0 / lr, o1 / lr);
    }
}
#endif
namespace att {
constexpr int V_OFF = 0, K_OFF = 49152, C_OFF = 98304, T_OFF = 99328  , G_KM = 0, G_GT = G_KM + 17408, G_SEL = G_GT + 256 * 33 * 4, G_OR = G_SEL + 1024, ATT_LDS = G_OR + 16;
static_assert(ATT_LDS <= RING_BYTES, "attention LDS");
constexpr float THR = 8.f;
#define SBAR() __builtin_amdgcn_sched_barrier(0)
__device__ __forceinline__ int v_st(int k, int c) { const int kk = (k & ~0xC) | ((k & 4) << 1) | ((k & 8) >> 1); return ((kk >> 3) * 4 + (c >> 5)) * 512 + ((kk & 7) * 32 + (c & 31)) * 2; }
__device__ __forceinline__ int v_rd_base(int lane) { return ((lane & 3) << 3) | (((lane >> 2) & 3) << 6) | (((lane >> 4) & 1) << 5) | (((lane >> 5) & 1) << 8); }
__device__ __forceinline__ unsigned cvtpk(float lo, float hi) { unsigned r; asm volatile("v_cvt_pk_bf16_f32 %0, %1, %2" : "=v"(r) : "v"(lo), "v"(hi)); return r; }

struct TileIt { unsigned rem; int blk, sub; };
template <int VAR> __device__ __forceinline__ void ti_init(TileIt& it, unsigned mask) { it.rem = mask; it.sub = 0; it.blk = VAR == 1 ? __builtin_ctz(mask) : 0; }
template <int VAR> __device__ __forceinline__ int ti_kb(const TileIt& it) { return VAR == 1 ? it.blk * 256 + it.sub * 64 : it.sub * 64; }
template <int VAR> __device__ __forceinline__ void ti_adv(TileIt& it) { if (VAR == 1) { if (++it.sub == 4) { it.sub = 0; it.rem &= it.rem - 1u; it.blk = it.rem ? __builtin_ctz(it.rem) : 0; } } else ++it.sub; }
#define ATT_VMW(n) asm volatile("s_waitcnt vmcnt(%0)" :: "i"(n) : "memory")
#define ATT_BAR() do { asm volatile("s_waitcnt lgkmcnt(0)" ::: "memory"); __builtin_amdgcn_s_barrier(); asm volatile("" ::: "memory"); } while (0)
template <int VAR>
__device__ __forceinline__ void attn_block(const int wv, LAS unsigned char* lds, const bf16* __restrict__ Qp, const bf16* __restrict__ Kp, const bf16* __restrict__ Vp, const int P0,
                                           const float slope, const float* __restrict__ cumrow, const float* __restrict__ knrow, f32x16 (&o)[4], float& l_out) {
    constexpr int DQK = VAR == 0 ? 64 : 128, NQ = DQK / 16;
    constexpr int NKL = (VAR == 0 ? 1 : 2) + (VAR == 2 ? 1 : 0), NVL = 2;
    constexpr float SCALE = VAR == 0 ? 0.125f : 0.08838834764831845f, C2 = SCALE * 1.4426950408889634f, ISC = 1.0f / SCALE;
    const int tid = opaque_tid(wv), wid = wv, lane = tid & 63, r32 = lane & 31, hi = lane >> 5;
    const int qb = P0 >> 8, qlo = P0 + wid * 32, qpos = qlo + r32;
    bf16x8 qr[NQ];
#pragma unroll
    for (int d0 = 0; d0 < NQ; ++d0) qr[d0] = *(const bf16x8*)(Qp + (unsigned)((wid * 32 + r32) * NQKV + hi * 8) + d0 * 16);
    unsigned offK, offV;
    if (VAR == 0) { const int row = wid * 8 + (lane >> 3), c = (lane & 7) ^ ((row >> 1) & 7); offK = (unsigned)(row * NQKV + c * 8); }
    else { const int row = wid * 4 + (lane >> 4), c = (lane & 15) ^ (row & 7); offK = (unsigned)(row * NQKV + c * 8); }
    { const int t = (lane & 31) >> 2, k = (wid >> 2) * 16 + (t >> 2) * 8 + ((wid >> 1) & 1) * 4 + (t & 3), c = ((wid & 1) * 2 + (lane >> 5)) * 32 + (lane & 3) * 8; offV = (unsigned)(k * NQKV + c); }
    const unsigned vb0 = (unsigned)(uintptr_t)(lds + V_OFF) + (unsigned)v_rd_base(lane);
    const unsigned kofs0 = VAR == 0 ? (unsigned)(r32 * 128) : (unsigned)(r32 * 256 + ((hi * 16) ^ ((r32 & 7) << 4)));
    const int sw64 = ((r32 >> 1) & 7) << 4;
    static_assert(VAR != 1, "the pipelined body walks plain causal tiles (MoBA uses attn_block_s)");
    const int NT = 4 * (qb + 1);
    const float sl = slope * ISC;
    constexpr float TSKIP = 110.0f;
    LAS float* tbK = (LAS float*)(lds + T_OFF);
    LAS float* tbC = tbK + 128;
    LAS unsigned* votes = (LAS unsigned*)(tbK + 256);
    if (tid < 128) { tbK[tid] = tid < NT ? knrow[tid] : 0.f; if (VAR == 2) tbC[tid] = tid < NT ? cumrow[64 * tid + 63] : 0.f; }
    float qn;
    { float s2 = 0.f;
#pragma unroll
      for (int d0 = 0; d0 < NQ; ++d0) { const v4u w = __builtin_bit_cast(v4u, qr[d0]);
          s2 += (bflo(w.x) * bflo(w.x) + bfhi(w.x) * bfhi(w.x)) + (bflo(w.y) * bflo(w.y) + bfhi(w.y) * bfhi(w.y)) + (bflo(w.z) * bflo(w.z) + bfhi(w.z) * bfhi(w.z)) + (bflo(w.w) * bflo(w.w) + bfhi(w.w) * bfhi(w.w)); }
      auto rr = __builtin_amdgcn_permlane32_swap(__float_as_uint(s2), __float_as_uint(s2), false, false);
      qn = sqrtf(__uint_as_float(rr[0]) + __uint_as_float(rr[1])) * 1.001f; }
    __syncthreads();
    if (tid < 128) { float mx = 0.f; for (int i = 0; i <= tid; ++i) mx = fmaxf(mx, tbK[i]); asm volatile("s_waitcnt lgkmcnt(0)" ::: "memory"); __builtin_amdgcn_s_barrier(); tbK[tid] = mx; }
    else { __builtin_amdgcn_s_barrier(); }
#define KBT(t_) (64 * (NT - 1 - (t_)))
#define GLDS(src, dstoff) __builtin_amdgcn_global_load_lds((const unsigned*)(src), (LAS unsigned*)(lds + (dstoff)), 16, 0, 0)
#define STAGE_K(kb, sl_) do { const bf16* kb_ = Kp + (size_t)(kb) * NQKV + offK; GLDS(kb_, K_OFF + (sl_) * 16384 + wid * 1024); if (VAR != 0) GLDS(kb_ + 32 * NQKV, K_OFF + (sl_) * 16384 + 8192 + wid * 1024); \
        if (VAR == 2) __builtin_amdgcn_global_load_lds((const unsigned*)(cumrow + (kb) + lane), (LAS unsigned*)(lds + C_OFF + (sl_) * 256), 4, 0, 0); } while (0)
#define STAGE_V(kb, sl_) do { const bf16* vb_ = Vp + (size_t)(kb) * NQKV + offV; GLDS(vb_, V_OFF + (sl_) * 16384 + wid * 1024); GLDS(vb_ + 32 * NQKV, V_OFF + (sl_) * 16384 + 8192 + wid * 1024); } while (0)
    float m_reg = -1e30f, l_reg = 0.f;
#pragma unroll
    for (int d0 = 0; d0 < 4; ++d0)
#pragma unroll
        for (int r = 0; r < 16; ++r) o[d0][r] = 0.f;
#define QKT(P0_, P1_, kbx, ks_) do { \
        if (VAR == 2) { const LAS float* cp = (const LAS float*)(lds + C_OFF + (ks_) * 256) + 4 * hi; \
            const f32x4 c0 = *(const LAS f32x4*)(cp), c1 = *(const LAS f32x4*)(cp + 8), c2 = *(const LAS f32x4*)(cp + 16), c3 = *(const LAS f32x4*)(cp + 24); \
            const f32x4 e0 = *(const LAS f32x4*)(cp + 32), e1 = *(const LAS f32x4*)(cp + 40), e2 = *(const LAS f32x4*)(cp + 48), e3 = *(const LAS f32x4*)(cp + 56); \
            P0_ = (f32x16){c0[0], c0[1], c0[2], c0[3], c1[0], c1[1], c1[2], c1[3], c2[0], c2[1], c2[2], c2[3], c3[0], c3[1], c3[2], c3[3]}; \
            P1_ = (f32x16){e0[0], e0[1], e0[2], e0[3], e1[0], e1[1], e1[2], e1[3], e2[0], e2[1], e2[2], e2[3], e3[0], e3[1], e3[2], e3[3]}; \
        } else { const float t0_ = sl * (float)((kbx) - P0 + 4 * hi); \
            _Pragma("unroll") for (int r = 0; r < 16; ++r) { P0_[r] = __builtin_fmaf(sl, (float)((r & 3) + 8 * (r >> 2)), t0_); P1_[r] = __builtin_fmaf(sl, (float)(32 + (r & 3) + 8 * (r >> 2)), t0_); } } \
        const LAS unsigned char* kt_ = lds + K_OFF + (ks_) * 16384; \
        if (VAR == 0) { const LAS unsigned char* ka = kt_ + kofs0; \
            _Pragma("unroll") for (int d0 = 0; d0 < 4; ++d0) { const int cb = ((2 * d0 + hi) * 16) ^ sw64; \
                const bf16x8 b0 = *(const LAS bf16x8*)(ka + cb), b1 = *(const LAS bf16x8*)(ka + cb + 32 * 128); \
                P0_ = __builtin_amdgcn_mfma_f32_32x32x16_bf16(b0, qr[d0], P0_, 0, 0, 0); P1_ = __builtin_amdgcn_mfma_f32_32x32x16_bf16(b1, qr[d0], P1_, 0, 0, 0); } \
        } else { \
            const unsigned kb0_ = (unsigned)(uintptr_t)kt_ + kofs0; \
            _Pragma("unroll") for (int d0 = 0; d0 < NQ; ++d0) { const LAS unsigned char* a = (const LAS unsigned char*)(uintptr_t)(kb0_ ^ (unsigned)((d0 & 3) << 5)) + (d0 >> 2) * 128; \
                const bf16x8 b0 = *(const LAS bf16x8*)(a), b1 = *(const LAS bf16x8*)(a + 32 * 256); \
                P0_ = __builtin_amdgcn_mfma_f32_32x32x16_bf16(b0, qr[d0], P0_, 0, 0, 0); P1_ = __builtin_amdgcn_mfma_f32_32x32x16_bf16(b1, qr[d0], P1_, 0, 0, 0); } } } while (0)
#define MASKX(P0_, P1_, kbx, blkx) do { const float NEG = -__builtin_inff(); \
        if ((kbx) + 63 > qlo) { const int dq = qpos - (kbx) - 4 * hi; \
            _Pragma("unroll") for (int r = 0; r < 16; ++r) { const int c = (r & 3) + 8 * (r >> 2); if (c > dq) P0_[r] = NEG; if (c + 32 > dq) P1_[r] = NEG; } } \
        } while (0)
#define PARTSM(P0_, P1_, alX) do { float pmax = P0_[0]; \
        _Pragma("unroll") for (int r = 1; r < 16; ++r) pmax = fmaxf(pmax, P0_[r]); \
        _Pragma("unroll") for (int r = 0; r < 16; ++r) pmax = fmaxf(pmax, P1_[r]); \
        { auto rr = __builtin_amdgcn_permlane32_swap(__float_as_uint(pmax), __float_as_uint(pmax), false, false); pmax = fmaxf(__uint_as_float(rr[0]), __uint_as_float(rr[1])); } \
        float mn_; \
        if (__builtin_expect(__all((pmax - m_reg) * SCALE <= THR), 1)) { mn_ = m_reg; alX = 1.f; } \
        else { mn_ = fmaxf(m_reg, pmax); alX = __builtin_amdgcn_exp2f((m_reg - mn_) * C2); m_reg = mn_; } \
        const float mnL = -mn_ * C2; \
        _Pragma("unroll") for (int r = 0; r < 16; ++r) { P0_[r] = __builtin_amdgcn_exp2f(fmaf(P0_[r], C2, mnL)); P1_[r] = fmaf(P1_[r], C2, mnL); } } while (0)
#define PK4(P, B_, OUT) do { unsigned a0 = cvtpk(P[B_ + 0], P[B_ + 1]), a1 = cvtpk(P[B_ + 2], P[B_ + 3]); unsigned b0 = cvtpk(P[B_ + 4], P[B_ + 5]), b1 = cvtpk(P[B_ + 6], P[B_ + 7]); \
        auto r0 = __builtin_amdgcn_permlane32_swap(a0, b0, false, false); auto r1 = __builtin_amdgcn_permlane32_swap(a1, b1, false, false); \
        v4u w = {r0[0], r1[0], r0[1], r1[1]}; OUT = __builtin_bit_cast(bf16x8, w); } while (0)
#define FINSM(P0_, P1_, alY) do { \
        _Pragma("unroll") for (int r = 0; r < 16; ++r) P1_[r] = __builtin_amdgcn_exp2f(P1_[r]); \
        float ps = 0.f; \
        _Pragma("unroll") for (int r = 0; r < 16; ++r) ps += P0_[r] + P1_[r]; \
        l_reg = l_reg * alY + ps; \
        PK4(P0_, 0, pa0); PK4(P0_, 8, pa1); PK4(P1_, 0, pa2); PK4(P1_, 8, pa3); } while (0)
#define TRRD(dst, off) asm volatile("ds_read_b64_tr_b16 %0, %1 offset:%2" : "=&v"(dst) : "v"(vbs_), "i"(off) : "memory")
#define PV_D0(d0) do { s16x4 l0, l1, l2, l3, h0, h1, h2, h3; constexpr int b_ = (d0) * 512; \
        TRRD(l0, b_); TRRD(h0, b_ + 2048); TRRD(l1, b_ + 4096); TRRD(h1, b_ + 6144); TRRD(l2, b_ + 8192); TRRD(h2, b_ + 10240); TRRD(l3, b_ + 12288); TRRD(h3, b_ + 14336); \
        asm volatile("s_waitcnt lgkmcnt(0)" ::: "memory"); SBAR(); \
        o[d0] = __builtin_amdgcn_mfma_f32_32x32x16_bf16((bf16x8){l0[0], l0[1], l0[2], l0[3], h0[0], h0[1], h0[2], h0[3]}, pa0, o[d0], 0, 0, 0); \
        o[d0] = __builtin_amdgcn_mfma_f32_32x32x16_bf16((bf16x8){l1[0], l1[1], l1[2], l1[3], h1[0], h1[1], h1[2], h1[3]}, pa1, o[d0], 0, 0, 0); \
        o[d0] = __builtin_amdgcn_mfma_f32_32x32x16_bf16((bf16x8){l2[0], l2[1], l2[2], l2[3], h2[0], h2[1], h2[2], h2[3]}, pa2, o[d0], 0, 0, 0); \
        o[d0] = __builtin_amdgcn_mfma_f32_32x32x16_bf16((bf16x8){l3[0], l3[1], l3[2], l3[3], h3[0], h3[1], h3[2], h3[3]}, pa3, o[d0], 0, 0, 0); } while (0)
#define PVT(vs_) do { const unsigned vbs_ = vb0 + (unsigned)(vs_) * 16384u; PV_D0(0); PV_D0(1); PV_D0(2); PV_D0(3); } while (0)
#define RESC(alX) do { if (__any((alX) < 1.f)) { \
        _Pragma("unroll") for (int d0 = 0; d0 < 4; ++d0) _Pragma("unroll") for (int r = 0; r < 16; ++r) o[d0][r] *= (alX); } } while (0)
    f32x16 pA0, pA1, pB0, pB1; float alA = 1.f, alB = 1.f; bf16x8 pa0, pa1, pa2, pa3;
    int ks = 0, vs = 2;
    STAGE_K(KBT(0), 0); STAGE_V(KBT(0), 0);
    STAGE_K(KBT(1), 1);
    ATT_VMW(NKL); ATT_BAR();
    { const int kbx = KBT(0);
      SBAR(); QKT(pA0, pA1, kbx, 0); SBAR();
      STAGE_K(KBT(2), 2); STAGE_V(KBT(1), 1);
      MASKX(pA0, pA1, kbx, 0); PARTSM(pA0, pA1, alA);
      ATT_VMW(NKL + NVL); ATT_BAR(); ks = 1; vs = 0; }
    bool stop = false; int nvotes = 0;
#define HALF_STEP(PX0, PX1, alX, PY0, PY1, alY, t, VOTE) do { \
        const int kbx = KBT(t); \
        SBAR(); QKT(PX0, PX1, kbx, ks); \
        FINSM(PY0, PY1, alY); SBAR(); \
        const bool moreK = (t) + 2 < NT, moreV = (t) + 1 < NT; \
        if (moreK) { const int ksn = ks == 0 ? 2 : ks - 1; STAGE_K(KBT((t) + 2), ksn); } \
        if (moreV) { const int vsn = vs == 0 ? 2 : vs - 1; STAGE_V(KBT((t) + 1), vsn); } \
        SBAR(); PVT(vs); \
        MASKX(PX0, PX1, kbx, 0); PARTSM(PX0, PX1, alX); \
        RESC(alX); \
          \
        if (VOTE) { if (moreV) { const int jn = NT - 2 - (t); const float bmax = VAR == 2 ? tbC[jn] : sl * (float)(64 * jn + 63 - P0); \
            const bool dn = __all((qn * tbK[jn] + bmax - m_reg) * SCALE < -TSKIP); if (lane == 0) votes[(nvotes & 1) * 8 + wid] = dn ? 1u : 0u; } } \
        if (moreK) ATT_VMW(NKL + NVL); else if (moreV) ATT_VMW(NVL); else ATT_VMW(0); \
        ATT_BAR(); ks = ks == 2 ? 0 : ks + 1; vs = vs == 2 ? 0 : vs + 1; \
        if (VOTE) { if (moreV) { const LAS unsigned* vp = votes + (nvotes & 1) * 8; const unsigned all8 = vp[0] & vp[1] & vp[2] & vp[3] & vp[4] & vp[5] & vp[6] & vp[7]; \
            stop = __builtin_amdgcn_readfirstlane(all8) != 0u; ++nvotes; } } } while (0)
    HALF_STEP(pB0, pB1, alB, pA0, pA1, alA, 1, false);
    for (int t = 2; t < NT && !stop; t += 2) {
        HALF_STEP(pA0, pA1, alA, pB0, pB1, alB, t, false);
        HALF_STEP(pB0, pB1, alB, pA0, pA1, alA, t + 1, true);
    }
    FINSM(pB0, pB1, alB); SBAR(); PVT(vs);
    ATT_VMW(0);
    { auto rr = __builtin_amdgcn_permlane32_swap(__float_as_uint(l_reg), __float_as_uint(l_reg), false, false); l_out = __uint_as_float(rr[0]) + __uint_as_float(rr[1]); }
    ATT_BAR();
#undef GLDS
#undef STAGE_K
#undef STAGE_V
#undef QKT
#undef MASKX
#undef PARTSM
#undef PK4
#undef FINSM
#undef TRRD
#undef PV_D0
#undef PVT
#undef RESC
#undef HALF_STEP
#undef KBT
}
constexpr int MB_V = 0, MB_K = 65536, EXTRA_OFF = RING_BYTES + 1024;
template <bool GATHER>
__device__ __forceinline__ void moba_block(const int wv, LAS unsigned char* lds, const bf16* __restrict__ rowb, const int h, const int kblk, const int qpos, const float slope,
                                           f32x16 (&o)[4], float& l_out, float& M_out, float& qn_out) {
    constexpr float SCALE = 0.08838834764831845f, C2 = SCALE * 1.4426950408889634f, ISC = 1.0f / SCALE;
    const int tid = opaque_tid(wv), wid = wv, lane = tid & 63, r32 = lane & 31, hi = lane >> 5;
    const bf16* Kp = rowb + (size_t)(kblk * 256) * NQKV + 4096 + h * 128; const bf16* Vp = Kp + 1024;
    unsigned offK, offV;
    { const int row = wid * 4 + (lane >> 4), c = (lane & 15) ^ (row & 7); offK = (unsigned)(row * NQKV + c * 8); }
    { const int t = (lane & 31) >> 2, k = (wid >> 2) * 16 + (t >> 2) * 8 + ((wid >> 1) & 1) * 4 + (t & 3), c = ((wid & 1) * 2 + (lane >> 5)) * 32 + (lane & 3) * 8; offV = (unsigned)(k * NQKV + c); }
#pragma unroll
    for (int t = 0; t < 4; ++t) { const bf16* kb_ = Kp + (size_t)(64 * t) * NQKV + offK; const bf16* vb_ = Vp + (size_t)(64 * t) * NQKV + offV;
        __builtin_amdgcn_global_load_lds((const unsigned*)kb_, (LAS unsigned*)(lds + MB_K + t * 16384 + wid * 1024), 16, 0, 0);
        __builtin_amdgcn_global_load_lds((const unsigned*)(kb_ + 32 * NQKV), (LAS unsigned*)(lds + MB_K + t * 16384 + 8192 + wid * 1024), 16, 0, 0);
        __builtin_amdgcn_global_load_lds((const unsigned*)vb_, (LAS unsigned*)(lds + MB_V + t * 16384 + wid * 1024), 16, 0, 0);
        __builtin_amdgcn_global_load_lds((const unsigned*)(vb_ + 32 * NQKV), (LAS unsigned*)(lds + MB_V + t * 16384 + 8192 + wid * 1024), 16, 0, 0); }
    bf16x8 qr[8];
#pragma unroll
    for (int d0 = 0; d0 < 8; ++d0) qr[d0] = *(const bf16x8*)(rowb + (unsigned)(qpos * NQKV + 3072 + h * 128 + hi * 8) + d0 * 16);
    { float s2 = 0.f;
#pragma unroll
      for (int d0 = 0; d0 < 8; ++d0) { const v4u w = __builtin_bit_cast(v4u, qr[d0]);
          s2 += (bflo(w.x) * bflo(w.x) + bfhi(w.x) * bfhi(w.x)) + (bflo(w.y) * bflo(w.y) + bfhi(w.y) * bfhi(w.y)) + (bflo(w.z) * bflo(w.z) + bfhi(w.z) * bfhi(w.z)) + (bflo(w.w) * bflo(w.w) + bfhi(w.w) * bfhi(w.w)); }
      auto rr = __builtin_amdgcn_permlane32_swap(__float_as_uint(s2), __float_as_uint(s2), false, false);
      qn_out = sqrtf(__uint_as_float(rr[0]) + __uint_as_float(rr[1])) * 1.001f; }
    const float sl = slope * ISC;
    const unsigned vb0 = (unsigned)(uintptr_t)(lds + MB_V) + (unsigned)v_rd_base(lane);
    const unsigned kofs0 = (unsigned)(r32 * 256 + ((hi * 16) ^ ((r32 & 7) << 4)));
    float m_reg = -1e30f, l_reg = 0.f;
#pragma unroll
    for (int d0 = 0; d0 < 4; ++d0)
#pragma unroll
        for (int r = 0; r < 16; ++r) o[d0][r] = 0.f;
    VM_WAIT(); __syncthreads();
#pragma unroll 1
    for (int t = 0; t < 4; ++t) {
        f32x16 p0, p1;
        { const float t0_ = sl * (float)(64 * t + 4 * hi);
#pragma unroll
          for (int r = 0; r < 16; ++r) { p0[r] = __builtin_fmaf(sl, (float)((r & 3) + 8 * (r >> 2)), t0_); p1[r] = __builtin_fmaf(sl, (float)(32 + (r & 3) + 8 * (r >> 2)), t0_); } }
        { const unsigned kb0_ = (unsigned)(uintptr_t)(lds + MB_K) + (unsigned)t * 16384u + kofs0;
#pragma unroll
          for (int d0 = 0; d0 < 8; ++d0) { const LAS unsigned char* a = (const LAS unsigned char*)(uintptr_t)(kb0_ ^ (unsigned)((d0 & 3) << 5)) + (d0 >> 2) * 128;
              const bf16x8 b0 = *(const LAS bf16x8*)(a), b1 = *(const LAS bf16x8*)(a + 32 * 256);
              p0 = __builtin_amdgcn_mfma_f32_32x32x16_bf16(b0, qr[d0], p0, 0, 0, 0); p1 = __builtin_amdgcn_mfma_f32_32x32x16_bf16(b1, qr[d0], p1, 0, 0, 0); } }
        if (!GATHER) { const float NEG = -__builtin_inff(); const int dq = qpos - (kblk * 256 + 64 * t) - 4 * hi;
#pragma unroll
            for (int r = 0; r < 16; ++r) { const int c = (r & 3) + 8 * (r >> 2); if (c > dq) p0[r] = NEG; if (c + 32 > dq) p1[r] = NEG; } }
        float pmax = p0[0];
#pragma unroll
        for (int r = 1; r < 16; ++r) pmax = fmaxf(pmax, p0[r]);
#pragma unroll
        for (int r = 0; r < 16; ++r) pmax = fmaxf(pmax, p1[r]);
        { auto rr = __builtin_amdgcn_permlane32_swap(__float_as_uint(pmax), __float_as_uint(pmax), false, false); pmax = fmaxf(__uint_as_float(rr[0]), __uint_as_float(rr[1])); }
        const bool need = (pmax - m_reg) * SCALE > THR;
        const float mn = need ? fmaxf(m_reg, pmax) : m_reg, alpha = need ? __builtin_amdgcn_exp2f((m_reg - mn) * C2) : 1.f; m_reg = mn;
        const float mnL = -mn * C2; float ps = 0.f;
#pragma unroll
        for (int r = 0; r < 16; ++r) { p0[r] = __builtin_amdgcn_exp2f(fmaf(p0[r], C2, mnL)); p1[r] = __builtin_amdgcn_exp2f(fmaf(p1[r], C2, mnL)); }
#pragma unroll
        for (int r = 0; r < 16; ++r) ps += p0[r] + p1[r];
        l_reg = l_reg * alpha + ps;
        if (__any(alpha < 1.f)) {
#pragma unroll
            for (int d0 = 0; d0 < 4; ++d0)
#pragma unroll
                for (int r = 0; r < 16; ++r) o[d0][r] *= alpha; }
        bf16x8 pa0, pa1, pa2, pa3;
#define PK4(P, B_, OUT) do { unsigned a0 = cvtpk(P[B_ + 0], P[B_ + 1]), a1 = cvtpk(P[B_ + 2], P[B_ + 3]); unsigned b0 = cvtpk(P[B_ + 4], P[B_ + 5]), b1 = cvtpk(P[B_ + 6], P[B_ + 7]); \
        auto r0 = __builtin_amdgcn_permlane32_swap(a0, b0, false, false); auto r1 = __builtin_amdgcn_permlane32_swap(a1, b1, false, false); \
        v4u w = {r0[0], r1[0], r0[1], r1[1]}; OUT = __builtin_bit_cast(bf16x8, w); } while (0)
        PK4(p0, 0, pa0); PK4(p0, 8, pa1); PK4(p1, 0, pa2); PK4(p1, 8, pa3);
#undef PK4
        const unsigned vbs_ = vb0 + (unsigned)t * 16384u;
#define TRRD(dst, off) asm volatile("ds_read_b64_tr_b16 %0, %1 offset:%2" : "=&v"(dst) : "v"(vbs_), "i"(off) : "memory")
#define PV_D0(d0) do { s16x4 l0, l1, l2, l3, h0, h1, h2, h3; constexpr int b_ = (d0) * 512; \
        TRRD(l0, b_); TRRD(h0, b_ + 2048); TRRD(l1, b_ + 4096); TRRD(h1, b_ + 6144); TRRD(l2, b_ + 8192); TRRD(h2, b_ + 10240); TRRD(l3, b_ + 12288); TRRD(h3, b_ + 14336); \
        asm volatile("s_waitcnt lgkmcnt(0)" ::: "memory"); SBAR(); \
        o[d0] = __builtin_amdgcn_mfma_f32_32x32x16_bf16((bf16x8){l0[0], l0[1], l0[2], l0[3], h0[0], h0[1], h0[2], h0[3]}, pa0, o[d0], 0, 0, 0); \
        o[d0] = __builtin_amdgcn_mfma_f32_32x32x16_bf16((bf16x8){l1[0], l1[1], l1[2], l1[3], h1[0], h1[1], h1[2], h1[3]}, pa1, o[d0], 0, 0, 0); \
        o[d0] = __builtin_amdgcn_mfma_f32_32x32x16_bf16((bf16x8){l2[0], l2[1], l2[2], l2[3], h2[0], h2[1], h2[2], h2[3]}, pa2, o[d0], 0, 0, 0); \
        o[d0] = __builtin_amdgcn_mfma_f32_32x32x16_bf16((bf16x8){l3[0], l3[1], l3[2], l3[3], h3[0], h3[1], h3[2], h3[3]}, pa3, o[d0], 0, 0, 0); } while (0)
        PV_D0(0); PV_D0(1); PV_D0(2); PV_D0(3);
#undef PV_D0
#undef TRRD
    }
    { auto rr = __builtin_amdgcn_permlane32_swap(__float_as_uint(l_reg), __float_as_uint(l_reg), false, false); l_out = __uint_as_float(rr[0]) + __uint_as_float(rr[1]); }
    M_out = m_reg + sl * (float)(kblk * 256 - qpos);
    __syncthreads();
}
__device__ __forceinline__ void store_block(const int wv, bf16* Op  , const int pitch, const f32x16 (&o)[4], float inv_l) {
    const int tid = opaque_tid(wv), wid = wv, lane = tid & 63, r32 = lane & 31, hi = lane >> 5;
    bf16* rowp = Op + (unsigned)((wid * 32 + r32) * pitch + 4 * hi);
#pragma unroll
    for (int d0 = 0; d0 < 4; ++d0)
#pragma unroll
        for (int g = 0; g < 4; ++g) { v2u w; w.x = cvtpk(o[d0][4 * g] * inv_l, o[d0][4 * g + 1] * inv_l); w.y = cvtpk(o[d0][4 * g + 2] * inv_l, o[d0][4 * g + 3] * inv_l);
            *(v2u*)(rowp + 32 * d0 + 8 * g) = w; }
}
}

__device__ __forceinline__ void moba_own_phase(ARGS_T A, const Frame& F0, const int rep = 0) {
    Frame F = F0; F.tid = opaque_tid(F0.wave); F.lane = F.tid & 63; F.wave = __builtin_amdgcn_readfirstlane(F.tid >> 6);
    const bf16* QKV = (const bf16*)(A.ws + WS_QKV); bf16* MRG = (bf16*)(A.ws + WS_MRG);
    for (;;) {
        int it = 0; if (F.tid == 0) F.MISC[17] = __hip_atomic_fetch_add(F.ctl + CW_Q + 64 + rep, 1u, RLX_AGENT);
        __syncthreads(); it = __builtin_amdgcn_readfirstlane((int)F.MISC[17]); __syncthreads();
        if (it >= 512) break;
        const int bh = it & 15, qb = 31 - (it >> 4), b = bh >> 3, h = bh & 7, P0 = qb * 256;
        const float slope = exp2f(-(float)(h + 1));
        const bf16* rowb = QKV + (size_t)b * SEQ * NQKV;
        const float* KM = (const float*)(A.ws + WS_KMEAN) + (size_t)bh * 32 * 128;
        const int tid = opaque_tid(F.wave), lane = tid & 63, r32 = lane & 31, hi = lane >> 5;
        LAS float* km = (LAS float*)(F.lds + att::G_KM); LAS float* gt = (LAS float*)(F.lds + att::G_GT);
        LAS unsigned* sel = (LAS unsigned*)(F.lds + att::EXTRA_OFF);
        if (qb >= 4) {
            for (int i = tid; i < 32 * 128; i += 512) { const int n = i >> 7, d = i & 127; km[n * 129 + d] = n < qb ? KM[i] : 0.f; }
            unsigned qw[64];
            { const v4u* qrow = (const v4u*)(rowb + (size_t)(P0 + (tid >> 6) * 32 + r32) * NQKV + 3072 + h * 128);
#pragma unroll
              for (int c = 0; c < 16; ++c) { const v4u w = qrow[c]; qw[4 * c] = w.x; qw[4 * c + 1] = w.y; qw[4 * c + 2] = w.z; qw[4 * c + 3] = w.w; } }
            __syncthreads();
            f32x16 g = {0.f, 0.f, 0.f, 0.f, 0.f, 0.f, 0.f, 0.f, 0.f, 0.f, 0.f, 0.f, 0.f, 0.f, 0.f, 0.f};
            const LAS float* kmp = km + r32 * 129 + hi;
#pragma unroll
            for (int ks = 0; ks < 64; ++ks) { const float a = hi ? bfhi(qw[ks]) : bflo(qw[ks]); const float bq = kmp[2 * ks];
                g = __builtin_amdgcn_mfma_f32_32x32x2f32(a, bq, g, 0, 0, 0); }
#pragma unroll
            for (int r = 0; r < 16; ++r) gt[((tid >> 6) * 32 + (r & 3) + 8 * (r >> 2) + 4 * hi) * 33 + r32] = g[r];
            __syncthreads();
            if (tid < 256) { unsigned msk = 0u;
                for (int t = 0; t < 3; ++t) { float best = -3.0e38f; int bi = 0;
                    for (int n = 0; n < qb; ++n) { const float v = gt[tid * 33 + n]; if (!((msk >> n) & 1u) && v > best) { best = v; bi = n; } }
                    msk |= 1u << bi; }
                sel[tid] = msk; }
        } else { if (tid < 256) sel[tid] = (1u << qb) - 1u; }
        __syncthreads();
        const unsigned selrow = sel[(tid >> 6) * 32 + r32];
        __syncthreads();
        const int qpos = P0 + (tid >> 6) * 32 + r32;
        f32x16 o[4]; float l, Mo, qn;
        att::moba_block<false>(F.wave, F.lds, rowb, h, qb, qpos, slope, o, l, Mo, qn);
        att::store_block(F.wave, MRG + (size_t)(b * SEQ + P0) * DM + 1024 + h * 128, DM, o, 1.0f / l);
        LAS unsigned* lc = sel + 256; LAS unsigned* lb = lc + 32;
        if (tid < 32) lc[tid] = 0u;
        __syncthreads();
        const size_t qh = ((size_t)(b * SEQ + qpos)) * 8 + h;
        int nn[3]; bool on[3]; unsigned lp[3];
        {   const float* knb = (const float*)(A.ws + WS_KN) + (size_t)(32 + bh) * 128;
            unsigned rem = selrow; const float sl = slope * 11.313708498984761f;
#pragma unroll
            for (int s = 0; s < 3; ++s) { on[s] = rem != 0u; nn[s] = on[s] ? __builtin_ctz(rem) : 0; rem &= rem - 1u;
                const int n = nn[s];
                const float kn = fmaxf(fmaxf(knb[4 * n], knb[4 * n + 1]), fmaxf(knb[4 * n + 2], knb[4 * n + 3]));
                const float ub = qn * kn + sl * (float)(256 * n + 255 - qpos);
                on[s] = on[s] && hi == 0 && !((ub - Mo) * 0.08838834764831845f < -110.0f);
                lp[s] = on[s] ? __hip_atomic_fetch_add((unsigned*)(lc + n), 1u, __ATOMIC_RELAXED, __HIP_MEMORY_SCOPE_WORKGROUP) : 0u; } }
        __syncthreads();
        if (tid < 32) { const unsigned c = lc[tid]; lb[tid] = c ? __hip_atomic_fetch_add((unsigned*)(F.ctl + CW_LC + rep * 1024) + bh * 32 + tid, c, RLX_AGENT) : 0u; }
        __syncthreads();
        if (hi == 0) {
            float* mlo = (float*)(A.ws + WS_MLO) + qh * 2; mlo[0] = Mo; mlo[1] = l;
            unsigned* list = (unsigned*)(A.ws + WS_LIST) + (size_t)bh * 32 * 8192; unsigned vm = 0u;
#pragma unroll
            for (int s = 0; s < 3; ++s) if (on[s]) { list[(size_t)nn[s] * 8192 + lb[nn[s]] + lp[s]] = (unsigned)qpos | ((unsigned)s << 16); vm |= 1u << s; }
            ((unsigned*)(A.ws + WS_VM))[qh] = vm;
        }
    }
}
__device__ __forceinline__ void attn_even_phase(ARGS_T A, const Frame& F0, const int rep = 0, const int lcset = 0) {
    Frame F = F0; F.tid = opaque_tid(F0.wave); F.lane = F.tid & 63; F.wave = __builtin_amdgcn_readfirstlane(F.tid >> 6);
    const bf16* QKV = (const bf16*)(A.ws + WS_QKV);
    LAS unsigned* pre = (LAS unsigned*)(F.lds + att::EXTRA_OFF + 1024);
    { const unsigned* lcnt = (const unsigned*)(F.ctl + CW_LC + lcset * 1024); const unsigned nch = (lcnt[F.tid] + 255u) >> 8;
      unsigned inc = nch;
#pragma unroll
      for (int o = 1; o < 64; o <<= 1) { const unsigned t = __shfl_up(inc, o); if (F.lane >= o) inc += t; }
      LAS unsigned* wt = pre + 512;
      if (F.lane == 63) wt[F.wave] = inc;
      __syncthreads();
      unsigned base = 0; for (int w = 0; w < F.wave; ++w) base += wt[w];
      pre[F.tid] = base + inc;
      __syncthreads(); }
    const int nb1 = (int)pre[511];
    for (;;) {
        int it = 0; if (F.tid == 0) F.MISC[16] = __hip_atomic_fetch_add(F.ctl + CW_Q + 0 + rep, 1u, RLX_AGENT);
        __syncthreads(); it = __builtin_amdgcn_readfirstlane((int)F.MISC[16]); __syncthreads();
        if (it >= 1024 + CV_A_WG + nb1) break;
        if (it >= 256 && it < 256 + CV_A_WG) { convert_wg_item<0>(A, F.lds, F.wave, it - 256); continue; }
        if (it >= 256 + CV_A_WG) it -= CV_A_WG;
        if (it < 1024) {
            const int mp = it & 1, bh = (it >> 1) & 15, qb = 31 - (it >> 5), b = bh >> 3, h = bh & 7, P0 = qb * 256;
            const float slope = exp2f(-(2.0f * h + 1.0f) * 0.5f);
            const float* KN = (const float*)(A.ws + WS_KN);
            const bf16* rowb = QKV + (size_t)b * SEQ * NQKV;
            f32x16 o[4]; float l;
            att::attn_block<0>(F.wave, F.lds, rowb + (size_t)P0 * NQKV + h * 128 + mp * 64, rowb + 1024 + h * 128 + mp * 64, rowb + 2048 + h * 128, P0, slope, nullptr, KN + (size_t)(bh * 2 + mp) * 128, o, l);
            att::store_block(F.wave, (bf16*)(A.ws + (mp ? WS_OA1 : WS_OA0)) + (size_t)(b * SEQ + P0) * 1024 + h * 128, 1024, o, 1.0f / l);
        } else {
            const int c = it - 1024; int lo_ = 0, hi_ = 511;
            while (lo_ < hi_) { const int mid = (lo_ + hi_) >> 1; if ((int)pre[mid] > c) hi_ = mid; else lo_ = mid + 1; }
            const int bhn = __builtin_amdgcn_readfirstlane(lo_), chunk = c - (bhn ? (int)pre[bhn - 1] : 0), bh = bhn >> 5, n = bhn & 31, b = bh >> 3, h = bh & 7;
            const float slope = exp2f(-(float)(h + 1));
            const bf16* rowb = QKV + (size_t)b * SEQ * NQKV;
            const int cnt = (int)((const unsigned*)(F.ctl + CW_LC + lcset * 1024))[bhn];
            const int tid = opaque_tid(F.wave), lane = tid & 63, r32 = lane & 31, hi = lane >> 5;
            const int idx = chunk * 256 + (tid >> 6) * 32 + r32; const bool valid = idx < cnt;
            const unsigned e = ((const unsigned*)(A.ws + WS_LIST))[(size_t)bhn * 8192 + (valid ? idx : cnt - 1)];
            const int qpos = (int)(e & 0xffffu), slot = (int)(e >> 16);
            f32x16 o[4]; float l, Mo, qn;
            att::moba_block<true>(F.wave, F.lds, rowb, h, n, qpos, slope, o, l, Mo, qn);
            if (valid) { const size_t qhs = (((size_t)(b * SEQ + qpos)) * 8 + h) * 3 + slot; const float il = 1.0f / l;
                bf16* rowp = (bf16*)(A.ws + WS_PART) + qhs * 128 + 4 * hi;
#pragma unroll
                for (int d0 = 0; d0 < 4; ++d0)
#pragma unroll
                    for (int g = 0; g < 4; ++g) { v2u w; w.x = att::cvtpk(o[d0][4 * g] * il, o[d0][4 * g + 1] * il); w.y = att::cvtpk(o[d0][4 * g + 2] * il, o[d0][4 * g + 3] * il);
                        *(v2u*)(rowp + 32 * d0 + 8 * g) = w; }
                if (hi == 0) { float* mlp = (float*)(A.ws + WS_MLP) + qhs * 2; mlp[0] = Mo; mlp[1] = l; } }
        }
    }
}
__device__ __forceinline__ void even_merge_phase(ARGS_T A, const Frame& F0, const bool dry = false) {
    Frame F = F0; F.tid = opaque_tid(F0.wave); F.lane = F.tid & 63; F.wave = __builtin_amdgcn_readfirstlane(F.tid >> 6);
    bf16* MRG = (bf16*)(A.ws + WS_MRG); const float lam = *(const float*)(A.ws + WS_LAM);
    const unsigned* OA0 = (const unsigned*)(A.ws + WS_OA0); const unsigned* OA1 = (const unsigned*)(A.ws + WS_OA1);
    const float g0 = A.in[I_SUBLN][2 * F.lane] * 0.8f, g1 = A.in[I_SUBLN][2 * F.lane + 1] * 0.8f;
    constexpr float C2 = 0.08838834764831845f * 1.4426950408889634f;
    const int gw = F.vcu * NWAVES + F.wave, NGW = F.G * NWAVES, lane = F.lane;
    const float* MLO = (const float*)(A.ws + WS_MLO); const float* MLP = (const float*)(A.ws + WS_MLP); const unsigned* VMp = (const unsigned*)(A.ws + WS_VM);
    const unsigned* PO = (const unsigned*)(A.ws + WS_PART);
    for (int m = gw; m < M; m += NGW) {
        unsigned* mrow = (unsigned*)(MRG + (size_t)m * DM); unsigned* wrow = dry ? (unsigned*)((bf16*)(A.ws + WS_H) + (size_t)m * DM) : mrow;
        const unsigned vmv = VMp[(size_t)m * 8 + (lane & 7)]; const float mlov = MLO[(size_t)m * 16 + (lane & 15)]; const float mlpv = lane < 48 ? MLP[(size_t)m * 48 + lane] : 0.f;
        unsigned a0w[8], a1w[8], ow[8], pw[8][3];
#pragma unroll
        for (int h = 0; h < 8; ++h) { a0w[h] = OA0[(size_t)m * 512 + h * 64 + lane]; a1w[h] = OA1[(size_t)m * 512 + h * 64 + lane]; ow[h] = mrow[512 + h * 64 + lane];
#pragma unroll
            for (int s = 0; s < 3; ++s) pw[h][s] = PO[((size_t)m * 8 + h) * 192 + s * 64 + lane]; }
        float wn[4];
        { const int hh = lane & 7; const float M0 = __shfl(mlov, 2 * hh), l0 = __shfl(mlov, 2 * hh + 1); float Ms[3], ls[3]; float Mx = M0;
#pragma unroll
          for (int s = 0; s < 3; ++s) { Ms[s] = __shfl(mlpv, 6 * hh + 2 * s); ls[s] = __shfl(mlpv, 6 * hh + 2 * s + 1); if ((vmv >> s) & 1u) Mx = fmaxf(Mx, Ms[s]); }
          wn[0] = l0 * __builtin_amdgcn_exp2f((M0 - Mx) * C2); float L = wn[0];
#pragma unroll
          for (int s = 0; s < 3; ++s) { wn[1 + s] = ((vmv >> s) & 1u) ? ls[s] * __builtin_amdgcn_exp2f((Ms[s] - Mx) * C2) : 0.f; L += wn[1 + s]; }
          const float iL = __builtin_amdgcn_rcpf(L);
#pragma unroll
          for (int s = 0; s < 4; ++s) wn[s] *= iL; }
#pragma unroll
        for (int h = 0; h < 8; ++h) {
            const float v0 = bflo(a0w[h]) - lam * bflo(a1w[h]), v1 = bfhi(a0w[h]) - lam * bfhi(a1w[h]);
            const float r = __builtin_amdgcn_rsqf(wave_sum(v0 * v0 + v1 * v1) * (1.0f / 128.0f) + EPS);
            wrow[h * 64 + lane] = pk2(v0 * r * g0, v1 * r * g1);
            const float w0 = __builtin_bit_cast(float, __builtin_amdgcn_readlane(__builtin_bit_cast(int, wn[0]), h)); float b0 = w0 * bflo(ow[h]), b1 = w0 * bfhi(ow[h]);
#pragma unroll
            for (int s = 0; s < 3; ++s) { const float ws_ = __builtin_bit_cast(float, __builtin_amdgcn_readlane(__builtin_bit_cast(int, wn[1 + s]), h)); const unsigned p = ws_ != 0.f ? pw[h][s] : 0u; b0 += ws_ * bflo(p); b1 += ws_ * bfhi(p); }
            wrow[512 + h * 64 + lane] = pk2(b0, b1); }
    }
}
__device__ __forceinline__ void attn_odd_phase(ARGS_T A, const Frame& F0, const int rep = 0) {
    Frame F = F0; F.tid = opaque_tid(F0.wave); F.lane = F.tid & 63; F.wave = __builtin_amdgcn_readfirstlane(F.tid >> 6);
    const bf16* QKV = (const bf16*)(A.ws + WS_QKV); bf16* MRG = (bf16*)(A.ws + WS_MRG);
    for (;;) {
        int it = 0; if (F.tid == 0) F.MISC[18] = __hip_atomic_fetch_add(F.ctl + CW_Q + 128 + rep, 1u, RLX_AGENT);
        __syncthreads(); it = __builtin_amdgcn_readfirstlane((int)F.MISC[18]); __syncthreads();
        if (it >= 1024 + CV_B_WG) break;
        if (it >= 256 && it < 256 + CV_B_WG) { convert_wg_item<1>(A, F.lds, F.wave, it - 256); continue; }
        if (it >= 256 + CV_B_WG) it -= CV_B_WG;
        const int bh = it & 31, qb = 31 - (it >> 5), b = bh >> 4, h = bh & 15;
        const bf16* rowb = QKV + (size_t)b * SEQ * NQKV;
        const float* cumrow = (const float*)(A.ws + WS_CUM) + (size_t)bh * SEQ; const float* KN = (const float*)(A.ws + WS_KN);
        {
            const int P0 = qb * 256;
            f32x16 o[4]; float l;
            att::attn_block<2>(F.wave, F.lds, rowb + (size_t)P0 * NQKV + h * 128, rowb + 2048 + h * 128, rowb + 4096 + h * 128, P0, 0.f, cumrow, KN + (size_t)bh * 128, o, l);
            att::store_block(F.wave, MRG + (size_t)(b * SEQ + P0) * DM + h * 128, DM, o, 1.0f / l);
        }
    }
}
#ifndef REP_PRO
#define REP_PRO 1
#endif
#ifndef REP_BAR
#define REP_BAR 1
#endif
#ifndef REP_NORM0
#define REP_NORM0 1
#endif
#ifndef REP_KN
#define REP_KN 1
#endif
#ifndef REP_MERGE
#define REP_MERGE 1
#endif
#ifndef PROBE_PH
#define PROBE_PH -1
#endif
#ifndef REP_INPROJ
#define REP_INPROJ 1
#endif
#ifndef REP_ATTA
#define REP_ATTA 1
#endif
#ifndef REP_ATTB
#define REP_ATTB 1
#endif
#ifndef REP_ATTC
#define REP_ATTC 1
#endif
#ifndef REP_MOEUP
#define REP_MOEUP 1
#endif
#ifndef REP_MOEDN
#define REP_MOEDN 1
#endif
#ifndef REP_OUTP0
#define REP_OUTP0 1
#endif
#ifndef ONE_LAUNCH
#define ONE_LAUNCH 1
#endif
constexpr int N_PHASES = 20;
__device__ __forceinline__ const __attribute__((address_space(4))) Args* opaque_args() {
    const __attribute__((address_space(4))) Args* p = (const __attribute__((address_space(4))) Args*)__builtin_amdgcn_kernarg_segment_ptr(); asm volatile("" : "+s"(p)); return p; }
#define IN(k) (lo <= (k) && (k) < hi)
#define SEAM(k) do { if (IN(k) && IN((k) + 1)) { for (int rb_ = 0; rb_ < REP_BAR; ++rb_) xcd_barrier(bar); } } while (0)
#define T0(id) do { if (PROBE_PH == (id)) tp0 = __builtin_amdgcn_s_memrealtime(); } while (0)
#define T1(id) do { if (PROBE_PH == (id)) tp1 = __builtin_amdgcn_s_memrealtime(); } while (0)
template <int l>
__device__ __forceinline__ void layer_phases(const Frame& F, const XcdBarrier& bar, const int lo, const int hi, unsigned long long& tp0, unsigned long long& tp1) {
#define args (*opaque_args())
        const int pb = 1 + 9 * l;
        if (IN(pb + 0)) { T0(pb + 0); if (l == 0) { for (int rep = 0; rep < REP_NORM0; ++rep) norm_phase<0>(args, F, l); } else norm_phase<2>(args, F, l); SEAM(pb + 0); T1(pb + 0); }
        if (IN(pb + 1)) { T0(pb + 1);
            if (l == 1) { scan_phase(args, F); }
            pg8::Gemm g{(const bf16*)(args.ws + WS_H), (const bf16*)(args.ws + WS_WIN) + (size_t)l * NQKV * DM, M, NQKV, DM}; pg8::StaticOrder S; S.init(M, NQKV, F.G, (int)blockIdx.x);
            pg8::EpiBf16<0> E{(bf16*)(args.ws + WS_QKV), NQKV, nullptr, 0, 0, 1.f};
            for (int rep = 0; rep < (l == 0 ? REP_INPROJ : 1); ++rep) { pg8::gemm_phase<pg8::EpiBf16<0>, pg8::StaticOrder, PG8_ALIGN, PG8_SP2>(F.wave, F.lds + RING_OFF, g, S, E); if (rep + 1 < (l == 0 ? REP_INPROJ : 1)) xcd_barrier(bar); }
            SEAM(pb + 1); T1(pb + 1);
        }
        if (IN(pb + 2)) { T0(pb + 2); for (int rep = 0; rep < REP_KN; ++rep) { if (l == 0) kmean_phase(args, F); knorm_phase<l>(args, F); } SEAM(pb + 2); T1(pb + 2); }
        if (IN(pb + 3)) { T0(pb + 3);
            if (l == 0) { for (int rep = 0; rep < REP_ATTB; ++rep) { moba_own_phase(args, F, rep); xcd_barrier(bar); }
                          for (int rep = 0; rep < REP_ATTA; ++rep) { attn_even_phase(args, F, rep, REP_ATTB - 1); xcd_barrier(bar); }
                          for (int rep = 1; rep < REP_MERGE; ++rep) even_merge_phase(args, F, true);
                          even_merge_phase(args, F); }
            else { for (int rep = 0; rep < REP_ATTC; ++rep) { if (!(NAIVE_ATTN & 4)) attn_odd_phase(args, F, rep); if (rep + 1 < REP_ATTC) xcd_barrier(bar); } }
            SEAM(pb + 3); T1(pb + 3);
        }
        if (IN(pb + 4)) { T0(pb + 4);
            pg8::Gemm g{(const bf16*)(args.ws + WS_MRG), (const bf16*)(args.ws + WS_WOUT) + (size_t)l * DM * DM, M, DM, DM}; pg8::StaticOrder S; S.init(M, DM, F.G, (int)blockIdx.x);
            pg8::EpiBf16<0> E{(bf16*)(args.ws + WS_H), DM, nullptr, 0, 0, 1.f};
            for (int rep = 0; rep < (l == 0 ? REP_OUTP0 : 1); ++rep) { pg8::gemm_phase<pg8::EpiBf16<0>, pg8::StaticOrder, PG8_ALIGN, PG8_SP2>(F.wave, F.lds + RING_OFF, g, S, E); if (rep + 1 < (l == 0 ? REP_OUTP0 : 1)) xcd_barrier(bar); }
            SEAM(pb + 4); T1(pb + 4);
        }
        if (IN(pb + 5)) { T0(pb + 5); norm_phase<1>(args, F, l); SEAM(pb + 5); T1(pb + 5); }
        if (IN(pb + 6)) { T0(pb + 6); gather_phase(args, F, l); SEAM(pb + 6); T1(pb + 6); }
        if (IN(pb + 7)) { T0(pb + 7);
            pg8::Gemm g{(const bf16*)(args.ws + WS_QKV), (const bf16*)(args.ws + WS_W13) + (size_t)l * 16384 * DM, MAXROWS, 16384, DM};
            pg8::MoeOrder S; S.init((const unsigned*)(F.ctl + CW_CNT + 64 * l), 2, F.G, (int)blockIdx.x);
            pg8::EpiSwiGLU E{(bf16*)(args.ws + WS_ACT)};
            for (int rep = 0; rep < (l == 0 ? REP_MOEUP : 1); ++rep) { pg8::gemm_phase<pg8::EpiSwiGLU, pg8::MoeOrder, PG8_ALIGN, PG8_SP2>(F.wave, F.lds + RING_OFF, g, S, E); if (rep + 1 < (l == 0 ? REP_MOEUP : 1)) xcd_barrier(bar); }
            SEAM(pb + 7); T1(pb + 7);
        }
        if (IN(pb + 8)) { T0(pb + 8);
            pg8::Gemm g{(const bf16*)(args.ws + WS_ACT), (const bf16*)(args.ws + WS_W2) + (size_t)l * 32768 * FFE, MAXROWS, 32768, FFE};
            pg8::MoeOrder S; S.init((const unsigned*)(F.ctl + CW_CNT + 64 * l), 3, F.G, (int)blockIdx.x);
            pg8::EpiBf16<0> E{(bf16*)(args.ws + WS_OSL), DM, nullptr, DM, 0, 1.f};
            for (int rep = 0; rep < (l == 0 ? REP_MOEDN : 1); ++rep) { pg8::gemm_phase<pg8::EpiBf16<0>, pg8::MoeOrder, PG8_ALIGN, PG8_SP2>(F.wave, F.lds + RING_OFF, g, S, E); if (rep + 1 < (l == 0 ? REP_MOEDN : 1)) xcd_barrier(bar); }
            SEAM(pb + 8); T1(pb + 8);
        }
}
#undef args
#undef IN
#undef SEAM
__global__ void __launch_bounds__(NWAVES * 64, 2) skel_fwd(Args args) {
    extern __shared__ __attribute__((aligned(16))) unsigned char lds[];
    Frame F;
    F.lds = (LAS unsigned char*)lds;
    F.MISC = (volatile LAS unsigned*)(F.lds + MISC_OFF);
    F.tid = threadIdx.x; F.lane = F.tid & 63; F.wave = __builtin_amdgcn_readfirstlane(F.tid >> 6);
    F.G = gridDim.x; { const int bx = blockIdx.x; F.vcu = (F.G % 8 == 0) ? (bx % 8) * (F.G / 8) + bx / 8 : bx; }
    unsigned char* ws = args.ws;
    F.ctl = (gu32*)(ws + WS_CTL);
    for (int u = F.tid; u < (LDS_BYTES - LDSCTL_OFF) / 4; u += NWAVES * 64) ((LAS unsigned*)(F.lds + LDSCTL_OFF))[u] = 0u;
    __syncthreads();
    const int lo = args.ph_lo, hi = args.ph_hi;
    XcdBarrier bar; bar.bar = (unsigned*)(F.ctl + CW_BAR); bar.x = 0; bar.st = nullptr;
    if (hi - lo > 1) bar = xcd_barrier_post((unsigned*)(F.ctl + CW_BAR), F.MISC + 8);
    bar.w = F.wave;
#define IN(k) (lo <= (k) && (k) < hi)
#define SEAM(k) do { if (IN(k) && IN((k) + 1)) xcd_barrier(bar); } while (0)

    if (IN(0)) { for (int rep = 0; rep < REP_PRO; ++rep) { p0_prologue(*opaque_args(), F); if (rep + 1 < REP_PRO) xcd_barrier(bar); } SEAM(0); }
    unsigned long long tp0 = 0, tp1 = 0;
    layer_phases<0>(F, bar, lo, hi, tp0, tp1);
    layer_phases<1>(F, bar, lo, hi, tp0, tp1);
    if (IN(19)) { if (PROBE_PH == 19) tp0 = __builtin_amdgcn_s_memrealtime(); norm_phase<3>(*opaque_args(), F, 1); if (PROBE_PH == 19) { asm volatile("s_waitcnt vmcnt(0)" ::: "memory"); tp1 = __builtin_amdgcn_s_memrealtime(); } }
    if (PROBE_PH >= 0 && blockIdx.x == 0) { const unsigned long long t0 = __builtin_amdgcn_s_memrealtime(), dt = 8ull * (tp1 - tp0); while (__builtin_amdgcn_s_memrealtime() - t0 < dt) __builtin_amdgcn_s_sleep(32); }
#undef IN
#undef SEAM
}

extern "C" void kernel_launch(void* const* d_in, const int* in_sizes, int n_in, void* d_out, int out_size, void* d_ws, size_t ws_size, hipStream_t stream) {
    static int grid = 0;
    if (grid == 0) {
        if (n_in != 22 || in_sizes[0] != M * DM || out_size != M * DM || ws_size < WS_END) { fprintf(stderr, "kernel_launch: unexpected shapes (n_in %d, in0 %d, out %d, ws %zu; need ws >= %zu); nothing launched\n", n_in, n_in > 0 ? in_sizes[0] : -1, out_size, ws_size, (size_t)WS_END); grid = -1; return; }
        int dev = 0, cus = 0, per_cu = 0;
        if (hipGetDevice(&dev) != hipSuccess || hipDeviceGetAttribute(&cus, hipDeviceAttributeMultiprocessorCount, dev) != hipSuccess) { grid = -1; return; }
        if (hipFuncSetAttribute((const void*)skel_fwd, hipFuncAttributeMaxDynamicSharedMemorySize, LDS_BYTES) != hipSuccess) { fprintf(stderr, "kernel_launch: hipFuncSetAttribute failed\n"); grid = -1; return; }
        if (hipOccupancyMaxActiveBlocksPerMultiprocessor(&per_cu, (const void*)skel_fwd, NWAVES * 64, LDS_BYTES) != hipSuccess || per_cu < 1) { fprintf(stderr, "kernel_launch: occupancy query says %d blocks per CU\n", per_cu); }
        (void)hipGetLastError();
        grid = cus;
    }
    if (grid < 0) return;
    if (hipMemsetAsync((char*)d_ws + WS_CTL, 0, CTL_ZERO_BYTES, stream) != hipSuccess) return;
    Args a{};
    for (int i = 0; i < 22; ++i) a.in[i] = (const float*)d_in[i];
    a.out = (float*)d_out; a.ws = (unsigned char*)d_ws;
#if ONE_LAUNCH
    a.ph_lo = 0; a.ph_hi = N_PHASES;
    hipLaunchKernelGGL(skel_fwd, dim3(grid), dim3(NWAVES * 64), LDS_BYTES, stream, a);
#else
    unsigned char* ws = (unsigned char*)d_ws;
    for (int p = 0; p < N_PHASES; ++p) {
#if NAIVE_ATTN
        if (p == 4) {
            if (NAIVE_ATTN & 1) naive_attn<0><<<M * 8 / 4, 256, 0, stream>>>((const bf16*)(ws + WS_QKV), (bf16*)(ws + WS_MRG), nullptr, nullptr, (const float*)(ws + WS_LAM), (const float*)d_in[I_SUBLN]);
            if (NAIVE_ATTN & 2) naive_attn<1><<<M * 8 / 4, 256, 0, stream>>>((const bf16*)(ws + WS_QKV), (bf16*)(ws + WS_MRG), nullptr, (const float*)(ws + WS_KMEAN), nullptr, nullptr);
            if ((NAIVE_ATTN & 3) == 3) continue; }
        if (p == 13 && (NAIVE_ATTN & 4)) { naive_attn<2><<<M * 16 / 4, 256, 0, stream>>>((const bf16*)(ws + WS_QKV), (bf16*)(ws + WS_MRG), (const float*)(ws + WS_CUM), nullptr, nullptr, nullptr); continue; }
#endif
        a.ph_lo = p; a.ph_hi = p + 1;
        hipLaunchKernelGGL(skel_fwd, dim3(grid), dim3(NWAVES * 64), LDS_BYTES, stream, a);
    }
#endif
}
```
